# Optimizing an MI355X kernel written in HIP

```python
import math
import jax, jax.numpy as jnp
from jax import lax
import numpy as np

D_MODEL = 1024
BATCH = 16
SEQ = 256
DEPTH = 2
DEC_BATCH = 2
DEC_SEQ = 2048
PAST_LEN = 256

GRID_W = 64
HEAD_DIM = 64
N_MIXERS = 4
GROUP_W = D_MODEL // N_MIXERS
N_HG = GROUP_W // HEAD_DIM
D_FF = 4 * D_MODEL
CHUNK = 64
CONV_K = 5
RWKV_W_RANK = 64
RWKV_A_RANK = 64
RWKV_G_RANK = 128
ROPE_BASE = 10000.0
LN_EPS = 1e-5
DEEPNORM_ALPHA = (2 * DEPTH) ** 0.25
DEEPNORM_BETA = (8 * DEPTH) ** -0.25

A_SIZES = (GROUP_W, GROUP_W, GROUP_W, GROUP_W, 2 * N_HG, 2 * N_HG)
B_SIZES = (3 * GROUP_W, GROUP_W, 2 * N_HG, 2 * N_HG)
C_SIZES = (GROUP_W, GROUP_W, GROUP_W, GROUP_W)
D_SIZES = (GROUP_W, GROUP_W, GROUP_W, 2 * RWKV_W_RANK, 2 * RWKV_A_RANK, RWKV_G_RANK)
GROUP_COLS = (sum(A_SIZES), sum(B_SIZES), sum(C_SIZES), sum(D_SIZES))
P_IN = sum(GROUP_COLS)

kernel_name = 'hybrid_bidir_recurrent_diffusion_step'


def split_cols(x, sizes):
    offsets = [sum(sizes[:i + 1]) for i in range(len(sizes) - 1)]
    return jnp.split(x, offsets, axis=-1)


def layer_norm(x, gain=None, bias=None):
    xf = x.astype(jnp.float32)
    mu = jnp.mean(xf, axis=-1, keepdims=True)
    var = jnp.mean(jnp.square(xf - mu), axis=-1, keepdims=True)
    y = (xf - mu) * lax.rsqrt(var + LN_EPS)
    if gain is not None:
        y = y * gain + bias
    return y.astype(x.dtype)


def head_norm(y, gain, center):
    if center:
        y = y - jnp.mean(y, axis=-1, keepdims=True)
    y = y * lax.rsqrt(jnp.mean(jnp.square(y), axis=-1, keepdims=True) + LN_EPS)
    return y * gain.reshape(N_HG, HEAD_DIM)


def l2norm(x):
    return x * lax.rsqrt(jnp.sum(jnp.square(x), axis=-1, keepdims=True) + 1e-6)


def heads(x):
    return x.reshape(x.shape[:2] + (N_HG, HEAD_DIM))


def bidir(x):
    x = jnp.swapaxes(x, 1, 2)
    return jnp.stack([x, jnp.flip(x, axis=2)], axis=0)


def merge_dirs(y):
    return jnp.swapaxes(y[0] + jnp.flip(y[1], axis=2), 1, 2)


def dir_gate(g):
    g = jnp.transpose(g.reshape(g.shape[:2] + (2, N_HG)), (2, 0, 3, 1))
    return jnp.stack([g[0], jnp.flip(g[1], axis=2)], axis=0)


def dir_vec(x):
    x = jnp.transpose(x, (2, 0, 3, 1, 4))
    return jnp.stack([x[0], jnp.flip(x[1], axis=2)], axis=0)


def to_chunks(x):
    s = x.shape
    x = x.reshape(s[:3] + (s[3] // CHUNK, CHUNK) + s[4:])
    return jnp.moveaxis(x, 3, 0)


def from_chunks(y):
    y = jnp.moveaxis(y, 0, 3)
    s = y.shape
    return y.reshape(s[:3] + (s[3] * s[4],) + s[5:])


def chunk_masks():
    idx = jnp.arange(CHUNK)
    return idx[:, None] >= idx[None, :], idx[:, None] > idx[None, :]


def short_conv(x, w):
    return lax.conv_general_dilated(x, w[:, None, :].astype(x.dtype), window_strides=(1,),
                                    padding=[(CONV_K // 2, CONV_K // 2)],
                                    dimension_numbers=('NWC', 'WIO', 'NWC'),
                                    feature_group_count=x.shape[-1])


def centred_shift(x):
    pad = jnp.pad(x, ((0, 0), (1, 1), (0, 0)))
    return 0.5 * (pad[:, :-2] + pad[:, 2:])


def grid_rope(x, pos):
    half = HEAD_DIM // 2
    nf = half // 2
    inv = ROPE_BASE ** (-jnp.arange(nf, dtype=jnp.float32) / nf)

    def rot(xp, p):
        ang = p.astype(jnp.float32)[:, None] * inv[None, :]
        cos, sin = jnp.cos(ang)[:, None, :], jnp.sin(ang)[:, None, :]
        x1, x2 = xp[..., :nf], xp[..., nf:]
        return jnp.concatenate([x1 * cos - x2 * sin, x1 * sin + x2 * cos], axis=-1)

    return jnp.concatenate([rot(x[..., :half], pos[0]), rot(x[..., half:], pos[1])], axis=-1)


def mlstm_scan(q, k, v, li, lf, c0, n0, m0):
    incl, _ = chunk_masks()

    def step(carry, xs):
        cm, nv, m = carry
        qc, kc, vc, ic, fc = xs
        b = jnp.cumsum(fc, axis=-1)
        bl = b[..., -1]
        logd = jnp.where(incl, b[..., :, None] - b[..., None, :] + ic[..., None, :], -jnp.inf)
        inter = b + m[..., None]
        mt = jnp.maximum(inter, jnp.max(logd, axis=-1))
        s = jnp.einsum('zbhld,zbhsd->zbhls', qc, kc) * jnp.exp(logd - mt[..., None])
        ew = jnp.exp(inter - mt)
        num = jnp.einsum('zbhls,zbhse->zbhle', s, vc) + jnp.einsum('zbhld,zbhde->zbhle', qc, cm) * ew[..., None]
        den = jnp.sum(s, axis=-1) + jnp.einsum('zbhld,zbhd->zbhl', qc, nv) * ew
        h = num / jnp.maximum(jnp.abs(den), jnp.exp(-mt))[..., None]
        wk = bl[..., None] - b + ic
        m_new = jnp.maximum(bl + m, jnp.max(wk, axis=-1))
        sk = jnp.exp(wk - m_new[..., None])
        sp = jnp.exp(bl + m - m_new)
        c_new = cm * sp[..., None, None] + jnp.einsum('zbhs,zbhsd,zbhse->zbhde', sk, kc, vc)
        n_new = nv * sp[..., None] + jnp.einsum('zbhs,zbhsd->zbhd', sk, kc)
        return (c_new, n_new, m_new), h

    xs = (to_chunks(q), to_chunks(k), to_chunks(v), to_chunks(li), to_chunks(lf))
    (c1, n1, m1), h = lax.scan(step, (c0, n0, m0), xs)
    return from_chunks(h), c1, n1, m1


def delta_scan(q, k, v, beta, g, s0):
    incl, strict = chunk_masks()
    eye = jnp.eye(CHUNK, dtype=jnp.float32)

    def step(s, xs):
        qc, kc, vc, bc, gc = xs
        gcum = jnp.cumsum(gc, axis=-1)
        decay = jnp.exp(jnp.where(incl, gcum[..., :, None] - gcum[..., None, :], -jnp.inf))
        a = jnp.where(strict, jnp.einsum('zbhld,zbhsd->zbhls', kc, kc) * decay, 0.0) * bc[..., :, None]
        rhs = jnp.concatenate([vc * bc[..., None], kc * (bc * jnp.exp(gcum))[..., None]], axis=-1)
        x = lax.linalg.triangular_solve(eye + a, rhs, left_side=True, lower=True, unit_diagonal=True)
        u, w = x[..., :HEAD_DIM], x[..., HEAD_DIM:]
        v_new = u - jnp.einsum('zbhld,zbhde->zbhle', w, s)
        qk = jnp.einsum('zbhld,zbhsd->zbhls', qc, kc) * decay
        o = jnp.einsum('zbhld,zbhde->zbhle', qc * jnp.exp(gcum)[..., None], s) + jnp.einsum('zbhls,zbhse->zbhle', qk, v_new)
        gl = gcum[..., -1]
        s_new = s * jnp.exp(gl)[..., None, None] + jnp.einsum('zbhs,zbhsd,zbhse->zbhde', jnp.exp(gl[..., None] - gcum), kc, v_new)
        return s_new, o

    xs = (to_chunks(q), to_chunks(k), to_chunks(v), to_chunks(beta), to_chunks(g))
    s1, o = lax.scan(step, s0, xs)
    return from_chunks(o), s1


def retention_scan(q, k, v, log_gamma, s0):
    incl, _ = chunk_masks()
    idx = jnp.arange(CHUNK, dtype=jnp.float32)
    lg = log_gamma.astype(jnp.float32)[:, None, :, None]
    dmat = jnp.exp(jnp.where(incl, (idx[:, None] - idx[None, :]) * lg[..., None], -jnp.inf))
    xi = jnp.exp((idx + 1.0) * lg)
    zeta = jnp.exp((CHUNK - 1.0 - idx) * lg)
    gl = jnp.exp(CHUNK * lg[..., 0])

    def step(s, xs):
        qc, kc, vc = xs
        sc = jnp.einsum('zbhld,zbhsd->zbhls', qc, kc) * dmat
        o = jnp.einsum('zbhls,zbhse->zbhle', sc, vc) + jnp.einsum('zbhld,zbhde->zbhle', qc, s) * xi[..., None]
        s_new = s * gl[..., None, None] + jnp.einsum('zbhsd,zbhse->zbhde', kc * zeta[..., None], vc)
        return s_new, o

    s1, o = lax.scan(step, s0, (to_chunks(q), to_chunks(k), to_chunks(v)))
    return from_chunks(o), s1


def rwkv_scan(r, kh, kt, v, w, a, s0):
    def step(s, xs):
        rt, kht, ktt, vt, wt, at = xs
        sk = jnp.einsum('zbhij,zbhj->zbhi', s, kht)
        s = s * wt[..., None, :] - sk[..., :, None] * (at * kht)[..., None, :] + vt[..., :, None] * ktt[..., None, :]
        return s, jnp.einsum('zbhij,zbhj->zbhi', s, rt)

    xs = (jnp.moveaxis(r, 3, 0), jnp.moveaxis(kh, 3, 0), jnp.moveaxis(kt, 3, 0),
          jnp.moveaxis(v, 3, 0), jnp.moveaxis(w, 3, 0), jnp.moveaxis(a, 3, 0))
    s1, y = lax.scan(step, s0, xs)
    return jnp.moveaxis(y, 0, 3), s1


def zero_states(bsz):
    f = jnp.float32
    mat = (2, bsz, N_HG, HEAD_DIM, HEAD_DIM)
    return (jnp.zeros(mat, f), jnp.zeros((2, bsz, N_HG, HEAD_DIM), f), jnp.zeros((2, bsz, N_HG), f),
            jnp.zeros(mat, f), jnp.zeros(mat, f), jnp.zeros(mat, f))


def mixing_block(u, lp, init, pos):
    bsz, t = u.shape[0], u.shape[1]
    c0, n0, m0, sb0, sc0, sd0 = init
    pa, pb, pc, pd = split_cols((u @ lp['w_in']).astype(jnp.float32), GROUP_COLS)

    aq, ak, av, ao, ai, af = split_cols(pa, A_SIZES)
    li = dir_gate(ai + lp['mlstm_i_bias'].reshape(-1))
    lf = jax.nn.log_sigmoid(dir_gate(af + lp['mlstm_f_bias'].reshape(-1)))
    ha, c1, n1, m1 = mlstm_scan(bidir(heads(aq)), bidir(heads(ak) * HEAD_DIM ** -0.5), bidir(heads(av)),
                                li, lf, c0, n0, m0)
    ya = jax.nn.sigmoid(heads(ao)) * head_norm(merge_dirs(ha), lp['mlstm_norm'], True)

    bqkv, bz, bbeta, balpha = split_cols(pb, B_SIZES)
    bq, bk, bv = jnp.split(jax.nn.silu(short_conv(bqkv, lp['delta_conv'])), 3, axis=-1)
    beta = jax.nn.sigmoid(dir_gate(bbeta))
    g = -jnp.exp(lp['delta_a_log'])[:, None, :, None] * jax.nn.softplus(dir_gate(balpha) + lp['delta_dt_bias'][:, None, :, None])
    hb, sb1 = delta_scan(bidir(l2norm(heads(bq)) * HEAD_DIM ** -0.5), bidir(l2norm(heads(bk))),
                         bidir(heads(bv)), beta, g, sb0)
    yb = head_norm(merge_dirs(hb), lp['delta_norm'], False) * jax.nn.silu(heads(bz))

    cq, ck, cv, cg = split_cols(pc, C_SIZES)
    q, k = heads(cq) * HEAD_DIM ** -0.5, heads(ck)
    if pos is not None:
        q, k = grid_rope(q, pos), grid_rope(k, pos)
    hc, sc1 = retention_scan(bidir(q), bidir(k), bidir(heads(cv)), -jnp.exp(lp['ret_decay']), sc0)
    yc = jax.nn.silu(heads(cg)) * head_norm(merge_dirs(hc), lp['ret_norm'], True)

    pd = pd + lp['rwkv_mu'] * (centred_shift(pd) - pd)
    dr, dk, dv, dw, da, dg = split_cols(pd, D_SIZES)
    r, k, v = heads(dr), heads(dk), heads(dv)
    w_pre = lp['rwkv_w0'] + jnp.einsum('btzr,zrc->btzc', jnp.tanh(dw.reshape(bsz, t, 2, RWKV_W_RANK)), lp['rwkv_w2'])
    decay = jnp.exp(-jnp.exp(-jax.nn.softplus(-w_pre) - 0.5))
    a = jax.nn.sigmoid(lp['rwkv_a0'] + jnp.einsum('btzr,zrc->btzc', da.reshape(bsz, t, 2, RWKV_A_RANK), lp['rwkv_a2']))
    a = a.reshape(bsz, t, 2, N_HG, HEAD_DIM)
    kh = l2norm(k * lp['rwkv_kk'].reshape(N_HG, HEAD_DIM))
    kt = k[:, :, None] * (1.0 + (a - 1.0) * lp['rwkv_ka'].reshape(N_HG, HEAD_DIM))
    hd, sd1 = rwkv_scan(bidir(r), bidir(kh), dir_vec(kt), bidir(v),
                        dir_vec(decay.reshape(bsz, t, 2, N_HG, HEAD_DIM)), dir_vec(a), sd0)
    bonus = jnp.sum(r[:, :, None] * kt * lp['rwkv_rk'], axis=-1, keepdims=True) * v[:, :, None]
    yd = heads(jax.nn.sigmoid(dg) @ lp['rwkv_g2']) * (head_norm(merge_dirs(hd), lp['rwkv_norm'], True) + jnp.sum(bonus, axis=2))

    y = jnp.concatenate([ya, yb, yc, yd], axis=2).reshape(bsz, t, D_MODEL)
    return y.astype(u.dtype) @ lp['w_out'], (c1, n1, m1, sb1, sc1, sd1)


def trunk_layer(h, mod, lp, init, pos):
    sh1, sc1, g1, sh2, sc2, g2 = jnp.split(mod, 6, axis=-1)
    y, states = mixing_block(layer_norm(h) * (1.0 + sc1) + sh1, lp, init, pos)
    h = layer_norm(DEEPNORM_ALPHA * h + g1 * y, lp['ln1_g'], lp['ln1_b'])
    u = layer_norm(h) * (1.0 + sc2) + sh2
    f = jnp.square(jax.nn.relu(u @ lp['w_ff1'])) @ lp['w_ff2']
    h = layer_norm(DEEPNORM_ALPHA * h + g2 * f, lp['ln2_g'], lp['ln2_b'])
    return h, states


def setup_inputs(seed: int = 0) -> dict:
    key = jax.random.key(seed)
    keys = iter(jax.random.split(key, 64))
    f32 = jnp.float32
    H, d, G = N_HG, HEAD_DIM, GROUP_W

    def nrm(shape, scale):
        return scale * jax.random.normal(next(keys), shape, f32)

    def gain(shape):
        return 1.0 + nrm(shape, 0.02)

    ret_base = jnp.log(-jnp.log(1.0 - 2.0 ** (-5.0 - jnp.arange(H, dtype=f32))))
    dt = jnp.exp(jax.random.uniform(next(keys), (DEPTH, 2, H), f32, math.log(1e-3), math.log(1e-1)))
    mat = (DEC_BATCH, DEPTH, 2, H, d, d)
    return {
        'x_prompt': nrm((BATCH, SEQ, D_MODEL), 1.0),
        'x_sample': nrm((DEC_BATCH, DEC_SEQ, D_MODEL), 1.0),
        'c': nrm((DEC_BATCH, D_MODEL), 1.0),
        'state_mlstm_C': nrm(mat, 0.1),
        'state_mlstm_n': nrm((DEC_BATCH, DEPTH, 2, H, d), 0.1),
        'state_mlstm_m': nrm((DEC_BATCH, DEPTH, 2, H), 0.5),
        'state_delta': nrm(mat, 0.1),
        'state_ret': nrm(mat, 0.3),
        'state_rwkv': nrm(mat, 0.1),
        'c_ctx': nrm((D_MODEL,), 1.0),
        'w_mod': nrm((DEPTH, D_MODEL, 6 * D_MODEL), 0.5 * D_MODEL ** -0.5),
        'b_mod': nrm((DEPTH, 6 * D_MODEL), 0.02),
        'w_in': nrm((DEPTH, D_MODEL, P_IN), D_MODEL ** -0.5),
        'w_out': nrm((DEPTH, D_MODEL, D_MODEL), DEEPNORM_BETA * D_MODEL ** -0.5),
        'ln1_g': gain((DEPTH, D_MODEL)),
        'ln1_b': nrm((DEPTH, D_MODEL), 0.02),
        'ln2_g': gain((DEPTH, D_MODEL)),
        'ln2_b': nrm((DEPTH, D_MODEL), 0.02),
        'w_ff1': nrm((DEPTH, D_MODEL, D_FF), D_MODEL ** -0.5),
        'w_ff2': nrm((DEPTH, D_FF, D_MODEL), DEEPNORM_BETA * D_FF ** -0.5),
        'mlstm_i_bias': nrm((DEPTH, 2, H), 0.1),
        'mlstm_f_bias': jnp.linspace(3.0, 6.0, H, dtype=f32) + nrm((DEPTH, 2, H), 0.1),
        'mlstm_norm': gain((DEPTH, G)),
        'delta_conv': nrm((DEPTH, CONV_K, 3 * G), CONV_K ** -0.5),
        'delta_a_log': jnp.log(jax.random.uniform(next(keys), (DEPTH, 2, H), f32, 1.0, 16.0)),
        'delta_dt_bias': dt + jnp.log(-jnp.expm1(-dt)),
        'delta_norm': gain((DEPTH, G)),
        'ret_decay': ret_base + nrm((DEPTH, 2, H), 0.05),
        'ret_norm': gain((DEPTH, G)),
        'rwkv_mu': jax.random.uniform(next(keys), (DEPTH, GROUP_COLS[3]), f32, 0.2, 0.8),
        'rwkv_w0': jnp.linspace(-6.5, -1.5, G, dtype=f32) + nrm((DEPTH, 2, G), 0.1),
        'rwkv_w2': nrm((DEPTH, 2, RWKV_W_RANK, G), 0.5 * RWKV_W_RANK ** -0.5),
        'rwkv_a0': nrm((DEPTH, 2, G), 0.1),
        'rwkv_a2': nrm((DEPTH, 2, RWKV_A_RANK, G), 0.5 * RWKV_A_RANK ** -0.5),
        'rwkv_g2': nrm((DEPTH, RWKV_G_RANK, G), RWKV_G_RANK ** -0.5),
        'rwkv_kk': 0.85 + nrm((DEPTH, G), 0.02),
        'rwkv_ka': 1.0 + nrm((DEPTH, G), 0.02),
        'rwkv_rk': nrm((DEPTH, H, d), 0.1),
        'rwkv_norm': gain((DEPTH, G)),
    }


def reference(x_prompt, x_sample, c, state_mlstm_C, state_mlstm_n, state_mlstm_m, state_delta, state_ret,
              state_rwkv, c_ctx, w_mod, b_mod, w_in, w_out, ln1_g, ln1_b, ln2_g, ln2_b, w_ff1, w_ff2,
              mlstm_i_bias, mlstm_f_bias, mlstm_norm, delta_conv, delta_a_log, delta_dt_bias, delta_norm,
              ret_decay, ret_norm, rwkv_mu, rwkv_w0, rwkv_w2, rwkv_a0, rwkv_a2, rwkv_g2, rwkv_kk, rwkv_ka,
              rwkv_rk, rwkv_norm):
    n_rows = x_sample.shape[1] // GRID_W
    pos = (jnp.repeat(jnp.arange(n_rows), GRID_W), jnp.tile(jnp.arange(GRID_W), n_rows))
    caches = (state_mlstm_C, state_mlstm_n, state_mlstm_m, state_delta, state_ret, state_rwkv)
    hp, hs = x_prompt, x_sample
    ctx_states = []
    for l in range(DEPTH):
        lp = {'w_in': w_in[l], 'w_out': w_out[l], 'ln1_g': ln1_g[l], 'ln1_b': ln1_b[l],
              'ln2_g': ln2_g[l], 'ln2_b': ln2_b[l], 'w_ff1': w_ff1[l], 'w_ff2': w_ff2[l],
              'mlstm_i_bias': mlstm_i_bias[l], 'mlstm_f_bias': mlstm_f_bias[l], 'mlstm_norm': mlstm_norm[l],
              'delta_conv': delta_conv[l], 'delta_a_log': delta_a_log[l], 'delta_dt_bias': delta_dt_bias[l],
              'delta_norm': delta_norm[l], 'ret_decay': ret_decay[l], 'ret_norm': ret_norm[l],
              'rwkv_mu': rwkv_mu[l], 'rwkv_w0': rwkv_w0[l], 'rwkv_w2': rwkv_w2[l], 'rwkv_a0': rwkv_a0[l],
              'rwkv_a2': rwkv_a2[l], 'rwkv_g2': rwkv_g2[l], 'rwkv_kk': rwkv_kk[l], 'rwkv_ka': rwkv_ka[l],
              'rwkv_rk': rwkv_rk[l], 'rwkv_norm': rwkv_norm[l]}
        mod_ctx = jax.nn.silu(c_ctx) @ w_mod[l] + b_mod[l]
        hp, st = trunk_layer(hp, mod_ctx, lp, zero_states(hp.shape[0]), None)
        ctx_states.append(st)
        mod_lat = (jax.nn.silu(c) @ w_mod[l] + b_mod[l])[:, None, :]
        init = tuple(jnp.swapaxes(s[:, l], 0, 1).astype(jnp.float32) for s in caches)
        hs, _ = trunk_layer(hs, mod_lat, lp, init, pos)
    new_mlstm_C, new_mlstm_n, new_mlstm_m, new_delta, new_ret, new_rwkv = [
        jnp.stack([jnp.swapaxes(st[i], 0, 1) for st in ctx_states], axis=1) for i in range(6)]
    return (hp, hs, new_mlstm_C, new_mlstm_n, new_mlstm_m, new_delta, new_ret, new_rwkv)
```

```cpp
#include <hip/hip_runtime.h>
#include <hip/hip_cooperative_groups.h>
#include <cstdio>
#include <cstdint>
namespace cg = cooperative_groups;

typedef unsigned short bf16_t;
typedef short bf16x8 __attribute__((ext_vector_type(8)));
typedef float f32x16 __attribute__((ext_vector_type(16)));
typedef float f32x4 __attribute__((ext_vector_type(4)));
#define DEV __device__ __forceinline__

constexpr int NTOK = 8192, DM = 1024, PIN = 4256, PINP = 4352, NABC = 3104, NPD = 1152, DFF = 4096;
constexpr float ALPHA = 1.41421356237f, LNEPS = 1e-5f;
constexpr int LDB = 72;
constexpr int TILE_B = 64 * LDB * 2;
constexpr int LDS_BYTES = 77824;
constexpr int NTHREADS = 256;
constexpr size_t O_C = 8388608, O_N = 9437184, O_M = 9453568, O_DELTA = 9453824, O_RET = 10502400, O_RWKV = 11550976;

struct Params {
  const float *x_prompt, *x_sample, *c, *st_C, *st_n, *st_m, *st_delta, *st_ret, *st_rwkv, *c_ctx;
  const float *w_mod, *b_mod, *w_in, *w_out, *ln1_g, *ln1_b, *ln2_g, *ln2_b, *w_ff1, *w_ff2;
  const float *mlstm_i_bias, *mlstm_f_bias, *mlstm_norm, *delta_conv, *delta_a_log, *delta_dt_bias, *delta_norm;
  const float *ret_decay, *ret_norm, *rwkv_mu, *rwkv_w0, *rwkv_w2, *rwkv_a0, *rwkv_a2, *rwkv_g2, *rwkv_kk, *rwkv_ka, *rwkv_rk, *rwkv_norm;
  float* out;
  bf16_t *wt_in, *wt_out, *wt_ff1, *wt_ff2, *ubuf, *hdir, *gbuf, *hidden;
  float *mod, *projABC, *pdraw, *rkv, *wa, *khinv, *bonus;
  unsigned* ctr;
  long long phase_lo, phase_hi;
};

DEV int opaque_i(int v) { asm volatile("" : "+v"(v)); return v; }
#define THREAD_ID opaque_i((int)threadIdx.x)
DEV bf16_t f2bf(float f) { unsigned u = __float_as_uint(f); u += 0x7fffu + ((u >> 16) & 1u); return (bf16_t)(u >> 16); }
DEV float bf2f(bf16_t h) { return __uint_as_float(((unsigned)h) << 16); }
DEV unsigned pack2(float a, float b) { return (unsigned)f2bf(a) | ((unsigned)f2bf(b) << 16); }
DEV float sigmoidf_(float x) { return 1.f / (1.f + __expf(-x)); }
DEV float siluf_(float x) { return x / (1.f + __expf(-x)); }
DEV float softplusf_(float x) { return x > 20.f ? x : log1pf(__expf(x)); }
DEV float logsigmoidf_(float x) { return -softplusf_(-x); }
template <int CTRL> DEV float dppf(float x) { return __builtin_bit_cast(float, __builtin_amdgcn_mov_dpp(__builtin_bit_cast(int, x), CTRL, 0xf, 0xf, true)); }
DEV float red4(float x) { x += dppf<0xB1>(x); x += dppf<0x4E>(x); return x; }
DEV float red16(float x) { x = red4(x); x += dppf<0x141>(x); x += dppf<0x128>(x); return x; }
DEV float wave_sum(float x) { for (int o = 32; o > 0; o >>= 1) x += __shfl_xor(x, o); return x; }
DEV void tok_info(int g, int& gs, int& T, int& ci) {
  if (g < 4096) { gs = g & ~255; T = 256; ci = 0; } else { int b = (g - 4096) >> 11; gs = 4096 + (b << 11); T = 2048; ci = 1 + b; }
}
DEV const float* xin_row(const Params& P, int g) { return g < 4096 ? P.x_prompt + (size_t)g * DM : P.x_sample + (size_t)(g - 4096) * DM; }

DEV f32x16 mm64(const bf16_t* A, const bf16_t* Bt, int wr, int wc, int lane, f32x16 acc) {
  const bf16_t* ap = A + (wr * 32 + (lane & 31)) * LDB + (lane >> 5) * 8;
  const bf16_t* bp = Bt + (wc * 32 + (lane & 31)) * LDB + (lane >> 5) * 8;
#pragma unroll
  for (int s = 0; s < 4; ++s) {
    bf16x8 a = *(const bf16x8*)(ap + s * 16);
    bf16x8 b = *(const bf16x8*)(bp + s * 16);
    acc = __builtin_amdgcn_mfma_f32_32x32x16_bf16(a, b, acc, 0, 0, 0);
  }
  return acc;
}
DEV f32x16 zero16() { f32x16 z; for (int i = 0; i < 16; ++i) z[i] = 0.f; return z; }
#define ACC_ROW(idx) (wr * 32 + ((idx) & 3) + 8 * ((idx) >> 2) + 4 * (lane >> 5))
#define ACC_COL (wc * 32 + (lane & 31))

DEV void conv_tile(const float* __restrict__ src, bf16_t* __restrict__ dst, int K, int N, int tk, int tn, float* tile) {
  const int tid = THREAD_ID;
  const int k0 = tk * 64, n0 = tn * 64;
  { const int r = tid >> 2, cs = (tid & 3) * 16;
#pragma unroll
    for (int e = 0; e < 16; e += 4) {
      const int n = n0 + cs + e;
      float4 v = make_float4(0.f, 0.f, 0.f, 0.f);
      if (n < N) v = *(const float4*)(src + (size_t)(k0 + r) * N + n);
      tile[r * 65 + cs + e] = v.x; tile[r * 65 + cs + e + 1] = v.y; tile[r * 65 + cs + e + 2] = v.z; tile[r * 65 + cs + e + 3] = v.w;
    } }
  __syncthreads();
  { const int nl = tid >> 2, ks = (tid & 3) * 16;
    unsigned pk[8];
#pragma unroll
    for (int e = 0; e < 8; ++e) pk[e] = pack2(tile[(ks + 2 * e) * 65 + nl], tile[(ks + 2 * e + 1) * 65 + nl]);
    uint4* d = (uint4*)(dst + (size_t)(n0 + nl) * K + k0 + ks);
    d[0] = make_uint4(pk[0], pk[1], pk[2], pk[3]); d[1] = make_uint4(pk[4], pk[5], pk[6], pk[7]); }
  __syncthreads();
}

DEV void mod_gemv_item(const Params& P, int item, float* red) {
  const int tid = THREAD_ID;
  const int j0 = item * 64, l = j0 / 6144, jj = j0 % 6144;
  const int cq = tid & 15, kg = tid >> 4;
  const float* W = P.w_mod + (size_t)l * DM * 6144 + jj + cq * 4;
  float a0[4] = {0, 0, 0, 0}, a1[4] = {0, 0, 0, 0}, a2[4] = {0, 0, 0, 0};
  for (int kk = 0; kk < 64; ++kk) {
    const int k = kg * 64 + kk;
    const float4 w = *(const float4*)(W + (size_t)k * 6144);
    const float s0 = siluf_(P.c_ctx[k]), s1 = siluf_(P.c[k]), s2 = siluf_(P.c[DM + k]);
    a0[0] += s0 * w.x; a0[1] += s0 * w.y; a0[2] += s0 * w.z; a0[3] += s0 * w.w;
    a1[0] += s1 * w.x; a1[1] += s1 * w.y; a1[2] += s1 * w.z; a1[3] += s1 * w.w;
    a2[0] += s2 * w.x; a2[1] += s2 * w.y; a2[2] += s2 * w.z; a2[3] += s2 * w.w;
  }
#pragma unroll
  for (int e = 0; e < 4; ++e) { red[(kg * 3 + 0) * 64 + cq * 4 + e] = a0[e]; red[(kg * 3 + 1) * 64 + cq * 4 + e] = a1[e]; red[(kg * 3 + 2) * 64 + cq * 4 + e] = a2[e]; }
  __syncthreads();
  if (tid < 192) {
    const int ci = tid >> 6, col = tid & 63;
    float s = P.b_mod[l * 6144 + jj + col];
    for (int g = 0; g < 16; ++g) s += red[(g * 3 + ci) * 64 + col];
    P.mod[(size_t)(l * 3 + ci) * 6144 + jj + col] = s;
  }
  __syncthreads();
}

DEV void phase_prologue(const Params& P, char* smem) {
  float* tile = (float*)smem;
  const int n_in = 16 * 68, n_out = 16 * 16, n_ff = 1024;
  const int total = 192 + 2 * n_in + 2 * n_out + 2 * n_ff;
  for (int t = blockIdx.x; t < total; t += gridDim.x) {
    if (t < 192) { mod_gemv_item(P, t, tile); continue; }
    int u = t - 192;
    if (u < 2 * n_in) { const int l = u / n_in, r = u % n_in; conv_tile(P.w_in + (size_t)l * DM * PIN, P.wt_in + (size_t)l * PINP * DM, DM, PIN, r / 68, r % 68, tile); continue; }
    u -= 2 * n_in;
    if (u < 2 * n_out) { const int l = u / n_out, r = u % n_out; conv_tile(P.w_out + (size_t)l * DM * DM, P.wt_out + (size_t)l * DM * DM, DM, DM, r / 16, r % 16, tile); continue; }
    u -= 2 * n_out;
    if (u < n_ff) { conv_tile(P.w_ff1, P.wt_ff1, DM, DFF, u / 64, u % 64, tile); continue; }
    u -= n_ff;
    conv_tile(P.w_ff2, P.wt_ff2, DFF, DM, u / 16, u % 16, tile);
  }
}
DEV void conv_ff_layer1_item(const Params& P, int u, char* smem) {
  float* tile = (float*)smem;
  if (u < 1024) conv_tile(P.w_ff1 + (size_t)DM * DFF, P.wt_ff1, DM, DFF, u / 64, u % 64, tile);
  else { u -= 1024; conv_tile(P.w_ff2 + (size_t)DM * DFF, P.wt_ff2, DFF, DM, u / 16, u % 16, tile); }
}

DEV void phase_ln(const Params& P, int mode, int l) {
  const int tid_ = THREAD_ID;
  const int lane = tid_ & 63;
  const int wid = blockIdx.x * (NTHREADS / 64) + (tid_ >> 6), nw = gridDim.x * (NTHREADS / 64);
  for (int g = wid; g < NTOK; g += nw) {
    int gs, T, ci; tok_info(g, gs, T, ci);
    float v[16];
    const float* src = (mode == 0) ? xin_row(P, g) : (P.out + (size_t)g * DM);
#pragma unroll
    for (int k = 0; k < 4; ++k) { const float4 t = *(const float4*)(src + k * 256 + lane * 4); v[4 * k] = t.x; v[4 * k + 1] = t.y; v[4 * k + 2] = t.z; v[4 * k + 3] = t.w; }
    float s = 0.f;
#pragma unroll
    for (int i = 0; i < 16; ++i) s += v[i];
    float mu = wave_sum(s) * (1.f / DM);
    float q = 0.f;
#pragma unroll
    for (int i = 0; i < 16; ++i) { v[i] -= mu; q += v[i] * v[i]; }
    float rstd = rsqrtf(wave_sum(q) * (1.f / DM) + LNEPS);
#pragma unroll
    for (int i = 0; i < 16; ++i) v[i] *= rstd;
    int lm = l, shoff = 0, scoff = 1024;
    bool write_u = true;
    if (mode != 0) {
      const float* gg = (mode == 1 ? P.ln1_g : P.ln2_g) + l * DM;
      const float* bb = (mode == 1 ? P.ln1_b : P.ln2_b) + l * DM;
#pragma unroll
      for (int k = 0; k < 4; ++k) {
        const float4 g4 = *(const float4*)(gg + k * 256 + lane * 4), b4 = *(const float4*)(bb + k * 256 + lane * 4);
        v[4 * k] = v[4 * k] * g4.x + b4.x; v[4 * k + 1] = v[4 * k + 1] * g4.y + b4.y; v[4 * k + 2] = v[4 * k + 2] * g4.z + b4.z; v[4 * k + 3] = v[4 * k + 3] * g4.w + b4.w;
        *(float4*)(P.out + (size_t)g * DM + k * 256 + lane * 4) = make_float4(v[4 * k], v[4 * k + 1], v[4 * k + 2], v[4 * k + 3]);
      }
      if (mode == 1) { shoff = 3072; scoff = 4096; } else { lm = l + 1; write_u = (l == 0); }
      if (write_u) {
        s = 0.f;
#pragma unroll
        for (int i = 0; i < 16; ++i) s += v[i];
        mu = wave_sum(s) * (1.f / DM);
        q = 0.f;
#pragma unroll
        for (int i = 0; i < 16; ++i) { v[i] -= mu; q += v[i] * v[i]; }
        rstd = rsqrtf(wave_sum(q) * (1.f / DM) + LNEPS);
#pragma unroll
        for (int i = 0; i < 16; ++i) v[i] *= rstd;
      }
    }
    if (write_u) {
      const float* md = P.mod + (size_t)(lm * 3 + ci) * 6144;
#pragma unroll
      for (int k = 0; k < 4; ++k) {
        const float4 sh = *(const float4*)(md + shoff + k * 256 + lane * 4), sc = *(const float4*)(md + scoff + k * 256 + lane * 4);
        uint2 o;
        o.x = pack2(v[4 * k] * (1.f + sc.x) + sh.x, v[4 * k + 1] * (1.f + sc.y) + sh.y);
        o.y = pack2(v[4 * k + 2] * (1.f + sc.z) + sh.z, v[4 * k + 3] * (1.f + sc.w) + sh.w);
        *(uint2*)(P.ubuf + (size_t)g * DM + k * 256 + lane * 4) = o;
      }
    }
  }
}

template <int EPI>
DEV void phase_gemm(const Params& P, const bf16_t* __restrict__ A, const bf16_t* __restrict__ Bt, int NT, int K, int l, int gate_off, bool res_from_input, char* smem) {
  const int tid = THREAD_ID, lane = tid & 63, w = tid >> 6, wm = w >> 1, wn = w & 1;
  bf16_t* sA = (bf16_t*)smem;
  bf16_t* sB = sA + 128 * LDB;
  const int ntiles = 64 * NT;
  for (int tile = blockIdx.x; tile < ntiles; tile += gridDim.x) {
    const int tm = tile & 63, tn = tile >> 6;
    const int m0 = tm * 128, n0 = tn * 128;
    f32x16 acc[2][2];
#pragma unroll
    for (int i = 0; i < 2; ++i)
#pragma unroll
      for (int j = 0; j < 2; ++j) acc[i][j] = zero16();
    uint4 ra0, ra1, ra2, ra3, rb0, rb1, rb2, rb3;
    const int lrow = tid >> 3, lkc = (tid & 7) * 8;
    const bf16_t* Ag = A + (size_t)(m0 + lrow) * K + lkc;
    const bf16_t* Bg = Bt + (size_t)(n0 + lrow) * K + lkc;
    const size_t r32 = (size_t)32 * K;
#define GLOAD(KO) { ra0 = *(const uint4*)(Ag + (KO)); ra1 = *(const uint4*)(Ag + r32 + (KO)); ra2 = *(const uint4*)(Ag + 2 * r32 + (KO)); ra3 = *(const uint4*)(Ag + 3 * r32 + (KO)); \
                    rb0 = *(const uint4*)(Bg + (KO)); rb1 = *(const uint4*)(Bg + r32 + (KO)); rb2 = *(const uint4*)(Bg + 2 * r32 + (KO)); rb3 = *(const uint4*)(Bg + 3 * r32 + (KO)); }
    GLOAD(0)
    for (int k0 = 0; k0 < K; k0 += 64) {
      __syncthreads();
      *(uint4*)(sA + (lrow) * LDB + lkc) = ra0; *(uint4*)(sA + (lrow + 32) * LDB + lkc) = ra1; *(uint4*)(sA + (lrow + 64) * LDB + lkc) = ra2; *(uint4*)(sA + (lrow + 96) * LDB + lkc) = ra3;
      *(uint4*)(sB + (lrow) * LDB + lkc) = rb0; *(uint4*)(sB + (lrow + 32) * LDB + lkc) = rb1; *(uint4*)(sB + (lrow + 64) * LDB + lkc) = rb2; *(uint4*)(sB + (lrow + 96) * LDB + lkc) = rb3;
      __syncthreads();
      if (k0 + 64 < K) GLOAD(k0 + 64)
#pragma unroll
      for (int s = 0; s < 4; ++s) {
        bf16x8 af[2], bfr[2];
#pragma unroll
        for (int i = 0; i < 2; ++i) {
          af[i] = *(const bf16x8*)(sA + (wm * 64 + i * 32 + (lane & 31)) * LDB + s * 16 + (lane >> 5) * 8);
          bfr[i] = *(const bf16x8*)(sB + (wn * 64 + i * 32 + (lane & 31)) * LDB + s * 16 + (lane >> 5) * 8);
        }
#pragma unroll
        for (int i = 0; i < 2; ++i)
#pragma unroll
          for (int j = 0; j < 2; ++j) acc[i][j] = __builtin_amdgcn_mfma_f32_32x32x16_bf16(bfr[j], af[i], acc[i][j], 0, 0, 0);
      }
    }
#pragma unroll
    for (int i = 0; i < 2; ++i) {
      const int m = m0 + wm * 64 + i * 32 + (lane & 31);
      int gs, T, ci; tok_info(m, gs, T, ci);
#pragma unroll
      for (int j = 0; j < 2; ++j)
#pragma unroll
        for (int g4 = 0; g4 < 4; ++g4) {
          const int n = n0 + wn * 64 + j * 32 + 8 * g4 + 4 * (lane >> 5);
          float4 v = make_float4(acc[i][j][4 * g4], acc[i][j][4 * g4 + 1], acc[i][j][4 * g4 + 2], acc[i][j][4 * g4 + 3]);
          if (EPI == 0) {
            if (n < NABC) *(float4*)(P.projABC + (size_t)m * NABC + n) = v;
            else if (n < PIN) *(float4*)(P.pdraw + (size_t)m * NPD + (n - NABC)) = v;
          } else if (EPI == 1) {
            const float4 gt = *(const float4*)(P.mod + (size_t)(l * 3 + ci) * 6144 + gate_off + n);
            const float* xr = res_from_input ? xin_row(P, m) : (P.out + (size_t)m * DM);
            const float4 x = *(const float4*)(xr + n);
            *(float4*)(P.out + (size_t)m * DM + n) = make_float4(ALPHA * x.x + gt.x * v.x, ALPHA * x.y + gt.y * v.y, ALPHA * x.z + gt.z * v.z, ALPHA * x.w + gt.w * v.w);
          } else {
            v.x = fmaxf(v.x, 0.f); v.y = fmaxf(v.y, 0.f); v.z = fmaxf(v.z, 0.f); v.w = fmaxf(v.w, 0.f);
            uint2 o; o.x = pack2(v.x * v.x, v.y * v.y); o.y = pack2(v.z * v.z, v.w * v.w);
            *(uint2*)(P.hidden + (size_t)m * DFF + n) = o;
          }
        }
    }
  }
}

DEV float shiftmix(const float* __restrict__ pd, int g, int col, bool hp, bool hn, float mu) {
  const float x = pd[(size_t)g * NPD + col];
  const float xp = hp ? pd[(size_t)(g - 1) * NPD + col] : 0.f;
  const float xn = hn ? pd[(size_t)(g + 1) * NPD + col] : 0.f;
  return x + mu * (0.5f * (xp + xn) - x);
}
DEV void rwkv_prep_item(const Params& P, int l, int item, char* smem) {
  const int tid = THREAD_ID, lane = tid & 63, w = tid >> 6;
  const int tile = item / 11, part = item % 11;
  const int g0 = tile * 64;
  int gs, T, ci; tok_info(g0, gs, T, ci);
  const float* mu = P.rwkv_mu + l * NPD;
  const float* pd = P.pdraw;
  if (part == 0) {
    for (int idx = tid; idx < 64 * 128; idx += NTHREADS) {
      const int row = idx >> 7, c4 = (idx & 127) * 4;
      const int col = c4 < 256 ? c4 : (c4 + 256);
      const int g = g0 + row; const bool hp = g > gs, hn = g + 1 < gs + T;
      const float4 x = *(const float4*)(pd + (size_t)g * NPD + col);
      float4 xp = make_float4(0, 0, 0, 0), xn = make_float4(0, 0, 0, 0);
      if (hp) xp = *(const float4*)(pd + (size_t)(g - 1) * NPD + col);
      if (hn) xn = *(const float4*)(pd + (size_t)(g + 1) * NPD + col);
      const float4 m4 = *(const float4*)(mu + col);
      float4 o;
      o.x = x.x + m4.x * (0.5f * (xp.x + xn.x) - x.x); o.y = x.y + m4.y * (0.5f * (xp.y + xn.y) - x.y);
      o.z = x.z + m4.z * (0.5f * (xp.z + xn.z) - x.z); o.w = x.w + m4.w * (0.5f * (xp.w + xn.w) - x.w);
      *(float4*)(P.rkv + (size_t)g * 768 + col) = o;
    }
    { const int row = tid >> 2, h = tid & 3; const int g = g0 + row; const bool hp = g > gs, hn = g + 1 < gs + T;
      float ss = 0.f;
      for (int c4 = 0; c4 < 64; c4 += 4) {
        const int col = 256 + h * 64 + c4;
        const float4 x = *(const float4*)(pd + (size_t)g * NPD + col);
        float4 xp = make_float4(0, 0, 0, 0), xn = make_float4(0, 0, 0, 0);
        if (hp) xp = *(const float4*)(pd + (size_t)(g - 1) * NPD + col);
        if (hn) xn = *(const float4*)(pd + (size_t)(g + 1) * NPD + col);
        const float4 m4 = *(const float4*)(mu + col);
        const float4 kk = *(const float4*)(P.rwkv_kk + l * 256 + h * 64 + c4);
        float4 o;
        o.x = x.x + m4.x * (0.5f * (xp.x + xn.x) - x.x); o.y = x.y + m4.y * (0.5f * (xp.y + xn.y) - x.y);
        o.z = x.z + m4.z * (0.5f * (xp.z + xn.z) - x.z); o.w = x.w + m4.w * (0.5f * (xp.w + xn.w) - x.w);
        *(float4*)(P.rkv + (size_t)g * 768 + col) = o;
        ss += (o.x * kk.x) * (o.x * kk.x) + (o.y * kk.y) * (o.y * kk.y) + (o.z * kk.z) * (o.z * kk.z) + (o.w * kk.w) * (o.w * kk.w);
      }
      P.khinv[g * 4 + h] = rsqrtf(ss + 1e-6f);
    }
    return;
  }
  const bool isg = part >= 9;
  const int KK = isg ? 128 : 64;
  const int lda = KK + 8;
  int z = 0, kind = 0, half = 0;
  if (isg) half = part - 9; else { const int p = part - 1; z = p >> 2; kind = (p >> 1) & 1; half = p & 1; }
  const int acol0 = isg ? 1024 : (768 + kind * 128 + z * 64);
  bf16_t* sA = (bf16_t*)smem;
  bf16_t* sB = sA + 64 * 136;
  for (int idx = tid; idx < 64 * KK; idx += NTHREADS) {
    const int row = idx / KK, r = idx % KK; const int g = g0 + row;
    float v = shiftmix(pd, g, acol0 + r, g > gs, g + 1 < gs + T, mu[acol0 + r]);
    v = isg ? sigmoidf_(v) : (kind == 0 ? tanhf(v) : v);
    sA[row * lda + r] = f2bf(v);
  }
  const float* Bsrc = isg ? (P.rwkv_g2 + (size_t)l * 128 * 256) : ((kind == 0 ? P.rwkv_w2 : P.rwkv_a2) + (size_t)(l * 2 + z) * 64 * 256);
  for (int idx = tid; idx < KK * 128; idx += NTHREADS) {
    const int r = idx >> 7, c = idx & 127;
    sB[c * lda + r] = f2bf(Bsrc[(size_t)r * 256 + half * 128 + c]);
  }
  __syncthreads();
  f32x16 acc[2] = {zero16(), zero16()};
  for (int s = 0; s < KK / 16; ++s) {
    const bf16x8 b = *(const bf16x8*)(sB + (w * 32 + (lane & 31)) * lda + s * 16 + (lane >> 5) * 8);
#pragma unroll
    for (int mi = 0; mi < 2; ++mi) {
      const bf16x8 a = *(const bf16x8*)(sA + (mi * 32 + (lane & 31)) * lda + s * 16 + (lane >> 5) * 8);
      acc[mi] = __builtin_amdgcn_mfma_f32_32x32x16_bf16(a, b, acc[mi], 0, 0, 0);
    }
  }
  const int c = half * 128 + w * 32 + (lane & 31);
  float bias = 0.f;
  if (!isg) bias = (kind == 0 ? P.rwkv_w0 : P.rwkv_a0)[(l * 2 + z) * 256 + c];
#pragma unroll
  for (int mi = 0; mi < 2; ++mi)
#pragma unroll
    for (int idx = 0; idx < 16; ++idx) {
      const int row = mi * 32 + (idx & 3) + 8 * (idx >> 2) + 4 * (lane >> 5);
      const int g = g0 + row;
      const float v = acc[mi][idx];
      if (isg) P.gbuf[(size_t)g * 256 + c] = f2bf(v);
      else {
        const float sg = sigmoidf_(v + bias);
        P.wa[((size_t)(g * 2 + z) * 2 + kind) * 256 + c] = (kind == 0) ? __expf(-0.60653065971f * sg) : sg;
      }
    }
  __syncthreads();
}

DEV void load16(const float* __restrict__ p, float* v) {
#pragma unroll
  for (int e = 0; e < 4; ++e) { const float4 t = *(const float4*)(p + 4 * e); v[4 * e] = t.x; v[4 * e + 1] = t.y; v[4 * e + 2] = t.z; v[4 * e + 3] = t.w; }
}
DEV void store_row16(bf16_t* dst, const float* v) {
  uint4 a, b;
  a.x = pack2(v[0], v[1]); a.y = pack2(v[2], v[3]); a.z = pack2(v[4], v[5]); a.w = pack2(v[6], v[7]);
  b.x = pack2(v[8], v[9]); b.y = pack2(v[10], v[11]); b.z = pack2(v[12], v[13]); b.w = pack2(v[14], v[15]);
  *(uint4*)dst = a; *(uint4*)(dst + 8) = b;
}
DEV void decode_chain(int task, int& z, int& seq, int& h, bool& sample) {
  if (task < 16) { sample = true; z = task >> 3; seq = 16 + ((task >> 2) & 1); h = task & 3; }
  else { const int t = task - 16; sample = false; z = t >> 6; seq = (t >> 2) & 15; h = t & 3; }
}
DEV void seq_base(int seq, int& gs, int& T) { if (seq < 16) { gs = seq * 256; T = 256; } else { gs = 4096 + (seq - 16) * 2048; T = 2048; } }
DEV float wave_incl_scan_add(float x, int lane) {
#pragma unroll
  for (int o = 1; o < 64; o <<= 1) { const float y = __shfl_up(x, o); if (lane >= o) x += y; }
  return x;
}
DEV float wave_incl_scan_max(float x, int lane) {
#pragma unroll
  for (int o = 1; o < 64; o <<= 1) { const float y = __shfl_up(x, o); if (lane >= o) x = fmaxf(x, y); }
  return x;
}

DEV void ret_task(const Params& P, int l, int task, char* smem) {
  const int tid = THREAD_ID, lane = tid & 63, w = tid >> 6, wr = w >> 1, wc = w & 1;
  int z, seq, h; bool sample; decode_chain(task, z, seq, h, sample);
  int gs, T; seq_base(seq, gs, T);
  bf16_t* sQ = (bf16_t*)smem; bf16_t* sK = sQ + 64 * LDB; bf16_t* sKzt = sK + 64 * LDB; bf16_t* sVt = sKzt + 64 * LDB; bf16_t* sP = sVt + 64 * LDB; bf16_t* sSt = sP + 64 * LDB;
  const float lg = -__expf(P.ret_decay[(l * 2 + z) * 4 + h]);
  const float gl = __expf(64.f * lg);
  f32x16 st = zero16();
  if (sample) {
    const float* s0 = P.st_ret + ((size_t)(((seq - 16) * 2 + l) * 2 + z) * 4 + h) * 4096;
#pragma unroll
    for (int idx = 0; idx < 16; ++idx) st[idx] = s0[ACC_COL * 64 + ACC_ROW(idx)];
  }
#pragma unroll
  for (int idx = 0; idx < 16; ++idx) sSt[ACC_ROW(idx) * LDB + ACC_COL] = f2bf(st[idx]);
  const int row = tid >> 2, seg = (tid & 3) * 16;
  const int nch = T / 64;
  for (int c = 0; c < nch; ++c) {
    const int p = c * 64 + row; const int t = z ? (T - 1 - p) : p; const int g = gs + t;
    float q[16], k[16], v[16];
    const float* pr = P.projABC + (size_t)g * NABC + 2080 + h * 64;
    load16(pr + seg, q); load16(pr + 256 + seg, k); load16(pr + 512 + seg, v);
    if (sample) {
      float q2[16], k2[16];
      load16(pr + (seg ^ 16), q2); load16(pr + 256 + (seg ^ 16), k2);
      const float pos = (seg < 32) ? (float)(t >> 6) : (float)(t & 63);
      const bool first = (seg & 16) == 0;
#pragma unroll
      for (int e = 0; e < 16; ++e) {
        const float inv = __expf(-(float)e * (9.210340371976184f / 16.f));
        const float sn = __sinf(pos * inv), cs = __cosf(pos * inv);
        const float qs = first ? -q2[e] : q2[e], ks = first ? -k2[e] : k2[e];
        q[e] = q[e] * cs + qs * sn; k[e] = k[e] * cs + ks * sn;
      }
    }
    const float zeta = __expf((63.f - (float)row) * lg);
    float qq[16];
#pragma unroll
    for (int e = 0; e < 16; ++e) qq[e] = q[e] * 0.125f;
    store_row16(sQ + row * LDB + seg, qq);
    store_row16(sK + row * LDB + seg, k);
#pragma unroll
    for (int e = 0; e < 16; ++e) { sKzt[(seg + e) * LDB + row] = f2bf(k[e] * zeta); sVt[(seg + e) * LDB + row] = f2bf(v[e]); }
    __syncthreads();
    f32x16 s = mm64(sQ, sK, wr, wc, lane, zero16());
#pragma unroll
    for (int idx = 0; idx < 16; ++idx) {
      const int i = ACC_ROW(idx), j = ACC_COL;
      const float val = (i >= j) ? s[idx] * __expf((float)(i - j) * lg) : 0.f;
      sP[i * LDB + j] = f2bf(val);
    }
    __syncthreads();
    f32x16 o1 = mm64(sP, sVt, wr, wc, lane, zero16());
    f32x16 o2 = mm64(sQ, sSt, wr, wc, lane, zero16());
#pragma unroll
    for (int idx = 0; idx < 16; ++idx) {
      const int i = ACC_ROW(idx), e = ACC_COL;
      const float xi = __expf((float)(i + 1) * lg);
      const int pp = c * 64 + i; const int tt = z ? (T - 1 - pp) : pp;
      P.hdir[((size_t)z * NTOK + gs + tt) * DM + 512 + h * 64 + e] = f2bf(o1[idx] + xi * o2[idx]);
    }
#pragma unroll
    for (int idx = 0; idx < 16; ++idx) st[idx] *= gl;
    st = mm64(sVt, sKzt, wr, wc, lane, st);
    __syncthreads();
#pragma unroll
    for (int idx = 0; idx < 16; ++idx) sSt[ACC_ROW(idx) * LDB + ACC_COL] = f2bf(st[idx]);
    __syncthreads();
  }
  if (!sample) {
    float* o = P.out + O_RET + ((size_t)((seq * 2 + l) * 2 + z) * 4 + h) * 4096;
#pragma unroll
    for (int idx = 0; idx < 16; ++idx) o[ACC_COL * 64 + ACC_ROW(idx)] = st[idx];
  }
}

DEV void mlstm_task(const Params& P, int l, int task, char* smem) {
  const int tid = THREAD_ID, lane = tid & 63, w = tid >> 6, wr = w >> 1, wc = w & 1;
  int z, seq, h; bool sample; decode_chain(task, z, seq, h, sample);
  int gs, T; seq_base(seq, gs, T);
  bf16_t* sQ = (bf16_t*)smem; bf16_t* sK = sQ + 64 * LDB; bf16_t* sKt = sK + 64 * LDB; bf16_t* sVt = sKt + 64 * LDB; bf16_t* sP = sVt + 64 * LDB; bf16_t* sCt = sP + 64 * LDB;
  float* fs = (float*)(sCt + 64 * LDB);
  float* s_a = fs; float* s_b = fs + 64; float* s_M = fs + 128; float* s_ew = fs + 192; float* s_sk = fs + 256; float* s_n = fs + 320; float* s_dinv = fs + 384; float* s_sc = fs + 448;
  const int sidx = sample ? ((((seq - 16) * 2 + l) * 2 + z) * 4 + h) : 0;
  f32x16 st = zero16();
  if (sample) {
    const float* c0 = P.st_C + (size_t)sidx * 4096;
#pragma unroll
    for (int idx = 0; idx < 16; ++idx) st[idx] = c0[ACC_COL * 64 + ACC_ROW(idx)];
  }
#pragma unroll
  for (int idx = 0; idx < 16; ++idx) sCt[ACC_ROW(idx) * LDB + ACC_COL] = f2bf(st[idx]);
  if (tid < 64) s_n[tid] = sample ? P.st_n[sidx * 64 + tid] : 0.f;
  if (tid == 0) s_sc[0] = sample ? P.st_m[sidx] : 0.f;
  const float ib = P.mlstm_i_bias[(l * 2 + z) * 4 + h], fb = P.mlstm_f_bias[(l * 2 + z) * 4 + h];
  const int row = tid >> 2, seg = (tid & 3) * 16;
  const int nch = T / 64;
  __syncthreads();
  for (int c = 0; c < nch; ++c) {
    const int p = c * 64 + row; const int t = z ? (T - 1 - p) : p; const int g = gs + t;
    float q[16], k[16], v[16];
    const float* pr = P.projABC + (size_t)g * NABC + h * 64;
    load16(pr + seg, q); load16(pr + 256 + seg, k); load16(pr + 512 + seg, v);
    if (w == 0) {
      const int pj = c * 64 + lane; const int tj = z ? (T - 1 - pj) : pj;
      const float* gp = P.projABC + (size_t)(gs + tj) * NABC + 1024 + z * 4 + h;
      const float li = gp[0] + ib, lf = logsigmoidf_(gp[8] + fb);
      const float b = wave_incl_scan_add(lf, lane);
      const float a = li - b;
      const float cm = wave_incl_scan_max(a, lane);
      const float m = s_sc[0];
      const float M = fmaxf(m, cm);
      const float M63 = __shfl(M, 63), bl = __shfl(b, 63);
      s_a[lane] = a; s_b[lane] = b; s_M[lane] = M; s_ew[lane] = __expf(m - M); s_sk[lane] = __expf(a - M63);
      if (lane == 0) { s_sc[1] = __expf(m - M63); s_sc[2] = bl + M63; }
    }
    __syncthreads();
    {
      const float skj = s_sk[row];
      store_row16(sQ + row * LDB + seg, q);
      float kk[16];
#pragma unroll
      for (int e = 0; e < 16; ++e) kk[e] = k[e] * 0.125f;
      store_row16(sK + row * LDB + seg, kk);
#pragma unroll
      for (int e = 0; e < 16; ++e) { sKt[(seg + e) * LDB + row] = f2bf(kk[e] * skj); sVt[(seg + e) * LDB + row] = f2bf(v[e]); }
    }
    __syncthreads();
    f32x16 s = mm64(sQ, sK, wr, wc, lane, zero16());
#pragma unroll
    for (int idx = 0; idx < 16; ++idx) {
      const int i = ACC_ROW(idx), j = ACC_COL;
      const float val = (i >= j) ? s[idx] * __expf(s_a[j] - s_M[i]) : 0.f;
      sP[i * LDB + j] = f2bf(val);
    }
    __syncthreads();
    f32x16 o1 = mm64(sP, sVt, wr, wc, lane, zero16());
    f32x16 o2 = mm64(sQ, sCt, wr, wc, lane, zero16());
    {
      float rs = 0.f, qn = 0.f;
#pragma unroll
      for (int e = 0; e < 16; ++e) { rs += bf2f(sP[row * LDB + seg + e]); qn += bf2f(sQ[row * LDB + seg + e]) * s_n[seg + e]; }
      rs = red4(rs); qn = red4(qn);
      const float den = rs + qn * s_ew[row];
      const float mt = s_b[row] + s_M[row];
      if ((tid & 3) == 0) s_dinv[row] = 1.f / fmaxf(fabsf(den), __expf(-mt));
    }
    __syncthreads();
#pragma unroll
    for (int idx = 0; idx < 16; ++idx) {
      const int i = ACC_ROW(idx), e = ACC_COL;
      const int pp = c * 64 + i; const int tt = z ? (T - 1 - pp) : pp;
      P.hdir[((size_t)z * NTOK + gs + tt) * DM + h * 64 + e] = f2bf((o1[idx] + s_ew[i] * o2[idx]) * s_dinv[i]);
    }
    const float sp = s_sc[1];
#pragma unroll
    for (int idx = 0; idx < 16; ++idx) st[idx] *= sp;
    st = mm64(sVt, sKt, wr, wc, lane, st);
    if (tid < 64) {
      float a = s_n[tid] * sp;
      for (int j = 0; j < 64; ++j) a += bf2f(sKt[tid * LDB + j]);
      s_n[tid] = a;
    }
#pragma unroll
    for (int idx = 0; idx < 16; ++idx) sCt[ACC_ROW(idx) * LDB + ACC_COL] = f2bf(st[idx]);
    __syncthreads();
    if (tid == 0) s_sc[0] = s_sc[2];
    __syncthreads();
  }
  if (!sample) {
    const int oi = ((seq * 2 + l) * 2 + z) * 4 + h;
    float* o = P.out + O_C + (size_t)oi * 4096;
#pragma unroll
    for (int idx = 0; idx < 16; ++idx) o[ACC_COL * 64 + ACC_ROW(idx)] = st[idx];
    if (tid < 64) P.out[O_N + oi * 64 + tid] = s_n[tid];
    if (tid == 0) P.out[O_M + oi] = s_sc[0];
  }
}

DEV void delta_task(const Params& P, int l, int task, char* smem) {
  const int tid = THREAD_ID, lane = tid & 63, w = tid >> 6, wr = w >> 1, wc = w & 1;
  int z, seq, h; bool sample; decode_chain(task, z, seq, h, sample);
  int gs, T; seq_base(seq, gs, T);
  float* sA = (float*)smem;
  float* s_beta = sA + 2016; float* s_gc = s_beta + 64;
  bf16_t* sQ = (bf16_t*)(smem + 8576); bf16_t* sK = sQ + 64 * LDB; bf16_t* sKbt = sK + 64 * LDB; bf16_t* sKgt = sKbt + 64 * LDB; bf16_t* sVbt = sKgt + 64 * LDB; bf16_t* sT = sVbt + 64 * LDB; bf16_t* sSt = sT + 64 * LDB;
  bf16_t* sW = sKbt; bf16_t* sVnt = sVbt; bf16_t* sP = sT;
  f32x16 st = zero16();
  if (sample) {
    const float* s0 = P.st_delta + ((size_t)(((seq - 16) * 2 + l) * 2 + z) * 4 + h) * 4096;
#pragma unroll
    for (int idx = 0; idx < 16; ++idx) st[idx] = s0[ACC_COL * 64 + ACC_ROW(idx)];
  }
#pragma unroll
  for (int idx = 0; idx < 16; ++idx) sSt[ACC_ROW(idx) * LDB + ACC_COL] = f2bf(st[idx]);
  const float aneg = -__expf(P.delta_a_log[(l * 2 + z) * 4 + h]), dtb = P.delta_dt_bias[(l * 2 + z) * 4 + h];
  const float* cw = P.delta_conv + (size_t)l * 5 * 768;
  const int row = tid >> 2, seg = (tid & 3) * 16;
  const int nch = T / 64;
  for (int c = 0; c < nch; ++c) {
    const int p = c * 64 + row; const int t = z ? (T - 1 - p) : p;
    float q[16], k[16], v[16];
#pragma unroll
    for (int e = 0; e < 16; ++e) { q[e] = 0.f; k[e] = 0.f; v[e] = 0.f; }
#pragma unroll 1
    for (int j = 0; j < 5; ++j) {
      const int tt = t + j - 2;
      if (tt >= 0 && tt < T) {
        const float* pr = P.projABC + (size_t)(gs + tt) * NABC + 1040 + h * 64 + seg;
        const float* cj = cw + j * 768 + h * 64 + seg;
        float x[16], wv[16];
        load16(pr, x); load16(cj, wv);
#pragma unroll
        for (int e = 0; e < 16; ++e) q[e] += x[e] * wv[e];
        load16(pr + 256, x); load16(cj + 256, wv);
#pragma unroll
        for (int e = 0; e < 16; ++e) k[e] += x[e] * wv[e];
        load16(pr + 512, x); load16(cj + 512, wv);
#pragma unroll
        for (int e = 0; e < 16; ++e) v[e] += x[e] * wv[e];
      }
    }
    float sq = 0.f, sk2 = 0.f;
#pragma unroll
    for (int e = 0; e < 16; ++e) { q[e] = siluf_(q[e]); k[e] = siluf_(k[e]); v[e] = siluf_(v[e]); sq += q[e] * q[e]; sk2 += k[e] * k[e]; }
    sq = red4(sq); sk2 = red4(sk2);
    const float qs = rsqrtf(sq + 1e-6f) * 0.125f, ks = rsqrtf(sk2 + 1e-6f);
#pragma unroll
    for (int e = 0; e < 16; ++e) { q[e] *= qs; k[e] *= ks; }
    if (w == 0) {
      const int pj = c * 64 + lane; const int tj = z ? (T - 1 - pj) : pj;
      const float* gp = P.projABC + (size_t)(gs + tj) * NABC + 2064 + z * 4 + h;
      const float beta = sigmoidf_(gp[0]);
      const float gj = aneg * softplusf_(gp[8] + dtb);
      s_beta[lane] = beta; s_gc[lane] = wave_incl_scan_add(gj, lane);
    }
    __syncthreads();
    {
      const float bj = s_beta[row], gcj = s_gc[row], glast = s_gc[63];
      const float f1 = bj * __expf(gcj), f2 = __expf(glast - gcj);
      store_row16(sQ + row * LDB + seg, q);
      store_row16(sK + row * LDB + seg, k);
#pragma unroll
      for (int e = 0; e < 16; ++e) {
        sKbt[(seg + e) * LDB + row] = f2bf(k[e] * f1);
        sKgt[(seg + e) * LDB + row] = f2bf(k[e] * f2);
        sVbt[(seg + e) * LDB + row] = f2bf(v[e] * bj);
      }
    }
    __syncthreads();
    {
      f32x16 kkm = mm64(sK, sK, wr, wc, lane, zero16());
#pragma unroll
      for (int idx = 0; idx < 16; ++idx) {
        const int i = ACC_ROW(idx), j = ACC_COL;
        if (i > j) sA[i * (i - 1) / 2 + j] = kkm[idx] * __expf(s_gc[i] - s_gc[j]) * s_beta[i];
      }
    }
    __syncthreads();
    if (w == 0) {
      float x[64];
      const float flane = (float)lane;
#pragma unroll
      for (int i = 0; i < 64; ++i) {
        float a = fmaxf(0.f, 1.f - fabsf(flane - (float)i));
#pragma unroll
        for (int j = 0; j < i; ++j) a -= sA[i * (i - 1) / 2 + j] * x[j];
        x[i] = a;
        sT[i * LDB + lane] = f2bf(a);
      }
    }
    __syncthreads();
    f32x16 U = mm64(sT, sVbt, wr, wc, lane, zero16());
    f32x16 Wm = mm64(sT, sKbt, wr, wc, lane, zero16());
    f32x16 qk = mm64(sQ, sK, wr, wc, lane, zero16());
    __syncthreads();
#pragma unroll
    for (int idx = 0; idx < 16; ++idx) {
      const int i = ACC_ROW(idx), j = ACC_COL;
      sW[i * LDB + j] = f2bf(Wm[idx]);
      sP[i * LDB + j] = f2bf((i >= j) ? qk[idx] * __expf(s_gc[i] - s_gc[j]) : 0.f);
    }
    __syncthreads();
    {
      f32x16 ws = mm64(sW, sSt, wr, wc, lane, zero16());
#pragma unroll
      for (int g4 = 0; g4 < 4; ++g4) {
        const int e = ACC_COL, i0 = wr * 32 + 8 * g4 + 4 * (lane >> 5);
        uint2 o; o.x = pack2(U[4 * g4] - ws[4 * g4], U[4 * g4 + 1] - ws[4 * g4 + 1]); o.y = pack2(U[4 * g4 + 2] - ws[4 * g4 + 2], U[4 * g4 + 3] - ws[4 * g4 + 3]);
        *(uint2*)(sVnt + e * LDB + i0) = o;
      }
    }
    __syncthreads();
    f32x16 o1 = mm64(sP, sVnt, wr, wc, lane, zero16());
    f32x16 o2 = mm64(sQ, sSt, wr, wc, lane, zero16());
#pragma unroll
    for (int idx = 0; idx < 16; ++idx) {
      const int i = ACC_ROW(idx), e = ACC_COL;
      const int pp = c * 64 + i; const int tt = z ? (T - 1 - pp) : pp;
      P.hdir[((size_t)z * NTOK + gs + tt) * DM + 256 + h * 64 + e] = f2bf(o1[idx] + __expf(s_gc[i]) * o2[idx]);
    }
    const float egl = __expf(s_gc[63]);
#pragma unroll
    for (int idx = 0; idx < 16; ++idx) st[idx] *= egl;
    st = mm64(sVnt, sKgt, wr, wc, lane, st);
    __syncthreads();
#pragma unroll
    for (int idx = 0; idx < 16; ++idx) sSt[ACC_ROW(idx) * LDB + ACC_COL] = f2bf(st[idx]);
    __syncthreads();
  }
  if (!sample) {
    float* o = P.out + O_DELTA + ((size_t)((seq * 2 + l) * 2 + z) * 4 + h) * 4096;
#pragma unroll
    for (int idx = 0; idx < 16; ++idx) o[ACC_COL * 64 + ACC_ROW(idx)] = st[idx];
  }
}

DEV void rwkv_task(const Params& P, int l, int task, char* smem) {
  const int tid = THREAD_ID;
  const int chain = task >> 2, rb = task & 3;
  int z, seq, h; bool sample; decode_chain(chain, z, seq, h, sample);
  int gs, T; seq_base(seq, gs, T);
  float* s_kh = (float*)smem; float* s_w = s_kh + 2048; float* s_b = s_w + 2048; float* s_kt = s_b + 2048; float* s_r = s_kt + 2048; float* s_v = s_r + 2048; float* s_y = s_v + 512;
  const int rl = tid >> 4, cg4 = (tid & 15) * 4;
  const int irow = rb * 16 + rl;
  float S0 = 0.f, S1 = 0.f, S2 = 0.f, S3 = 0.f;
  if (sample) {
    const float4 s4 = *(const float4*)(P.st_rwkv + ((size_t)(((seq - 16) * 2 + l) * 2 + z) * 4 + h) * 4096 + irow * 64 + cg4);
    S0 = s4.x; S1 = s4.y; S2 = s4.z; S3 = s4.w;
  }
  const int si = tid >> 3, sc = (tid & 7) * 8;
  float kkc[8], kac[8], rkc[8];
#pragma unroll
  for (int e = 0; e < 8; ++e) { kkc[e] = P.rwkv_kk[l * 256 + h * 64 + sc + e]; kac[e] = P.rwkv_ka[l * 256 + h * 64 + sc + e]; rkc[e] = P.rwkv_rk[(l * 4 + h) * 64 + sc + e]; }
  const int nch = T / 32;
  float4 pr0, pr1, pk0, pk1, pw0, pw1, pa0, pa1, pv_ = make_float4(0.f, 0.f, 0.f, 0.f); float pinv;
#define RWKV_PREFETCH(C) { \
    const int p_ = (C) * 32 + si; const int t_ = z ? (T - 1 - p_) : p_; const int g_ = gs + t_; \
    const float* rk_ = P.rkv + (size_t)g_ * 768 + h * 64 + sc; \
    pr0 = *(const float4*)rk_; pr1 = *(const float4*)(rk_ + 4); \
    pk0 = *(const float4*)(rk_ + 256); pk1 = *(const float4*)(rk_ + 260); \
    const float* wp_ = P.wa + ((size_t)(g_ * 2 + z) * 2) * 256 + h * 64 + sc; \
    pw0 = *(const float4*)wp_; pw1 = *(const float4*)(wp_ + 4); \
    pa0 = *(const float4*)(wp_ + 256); pa1 = *(const float4*)(wp_ + 260); \
    pinv = P.khinv[g_ * 4 + h]; \
    if (tid < 128) { \
      const int p2_ = (C) * 32 + (tid >> 2); const int t2_ = z ? (T - 1 - p2_) : p2_; \
      pv_ = *(const float4*)(P.rkv + (size_t)(gs + t2_) * 768 + 512 + h * 64 + rb * 16 + (tid & 3) * 4); \
    } }
  RWKV_PREFETCH(0)
  for (int c = 0; c < nch; ++c) {
    {
      const float rr[8] = {pr0.x, pr0.y, pr0.z, pr0.w, pr1.x, pr1.y, pr1.z, pr1.w};
      const float kk[8] = {pk0.x, pk0.y, pk0.z, pk0.w, pk1.x, pk1.y, pk1.z, pk1.w};
      const float aa[8] = {pa0.x, pa0.y, pa0.z, pa0.w, pa1.x, pa1.y, pa1.z, pa1.w};
      float bsum = 0.f;
      float okh[8], ob[8], okt[8];
#pragma unroll
      for (int e = 0; e < 8; ++e) {
        okh[e] = kk[e] * kkc[e] * pinv; ob[e] = aa[e] * okh[e]; okt[e] = kk[e] * (1.f + (aa[e] - 1.f) * kac[e]);
        bsum += rr[e] * okt[e] * rkc[e];
      }
      float* d;
      d = s_kh + si * 64 + sc; *(float4*)d = make_float4(okh[0], okh[1], okh[2], okh[3]); *(float4*)(d + 4) = make_float4(okh[4], okh[5], okh[6], okh[7]);
      d = s_w + si * 64 + sc; *(float4*)d = pw0; *(float4*)(d + 4) = pw1;
      d = s_b + si * 64 + sc; *(float4*)d = make_float4(ob[0], ob[1], ob[2], ob[3]); *(float4*)(d + 4) = make_float4(ob[4], ob[5], ob[6], ob[7]);
      d = s_kt + si * 64 + sc; *(float4*)d = make_float4(okt[0], okt[1], okt[2], okt[3]); *(float4*)(d + 4) = make_float4(okt[4], okt[5], okt[6], okt[7]);
      d = s_r + si * 64 + sc; *(float4*)d = pr0; *(float4*)(d + 4) = pr1;
      if (tid < 128) *(float4*)(s_v + (tid >> 2) * 16 + (tid & 3) * 4) = pv_;
      bsum += dppf<0xB1>(bsum); bsum += dppf<0x4E>(bsum); bsum += dppf<0x141>(bsum);
      if (rb == 0 && (tid & 7) == 0) {
        const int p = c * 32 + si; const int t = z ? (T - 1 - p) : p;
        P.bonus[((size_t)z * NTOK + gs + t) * 4 + h] = bsum;
      }
    }
    __syncthreads();
    if (c + 1 < nch) RWKV_PREFETCH(c + 1)
#pragma unroll 4
    for (int i = 0; i < 32; ++i) {
      const float4 kh = *(const float4*)(s_kh + i * 64 + cg4);
      const float4 ww = *(const float4*)(s_w + i * 64 + cg4);
      const float4 bb = *(const float4*)(s_b + i * 64 + cg4);
      const float4 kt = *(const float4*)(s_kt + i * 64 + cg4);
      const float4 rr = *(const float4*)(s_r + i * 64 + cg4);
      const float vi = s_v[i * 16 + rl];
      float sk = (S0 * kh.x + S1 * kh.y) + (S2 * kh.z + S3 * kh.w);
      sk = red16(sk);
      S0 = S0 * ww.x - sk * bb.x + vi * kt.x;
      S1 = S1 * ww.y - sk * bb.y + vi * kt.y;
      S2 = S2 * ww.z - sk * bb.z + vi * kt.z;
      S3 = S3 * ww.w - sk * bb.w + vi * kt.w;
      float y = (S0 * rr.x + S1 * rr.y) + (S2 * rr.z + S3 * rr.w);
      y = red16(y);
      if ((tid & 15) == 0) s_y[i * 16 + rl] = y;
    }
    __syncthreads();
    if (tid < 64) {
      const int i = tid >> 1, hf = tid & 1;
      const int p = c * 32 + i; const int t = z ? (T - 1 - p) : p;
      const float* ys = s_y + i * 16 + hf * 8;
      uint4 o; o.x = pack2(ys[0], ys[1]); o.y = pack2(ys[2], ys[3]); o.z = pack2(ys[4], ys[5]); o.w = pack2(ys[6], ys[7]);
      *(uint4*)(P.hdir + ((size_t)z * NTOK + gs + t) * DM + 768 + h * 64 + rb * 16 + hf * 8) = o;
    }
  }
  if (!sample) {
    *(float4*)(P.out + O_RWKV + ((size_t)((seq * 2 + l) * 2 + z) * 4 + h) * 4096 + irow * 64 + cg4) = make_float4(S0, S1, S2, S3);
  }
}

DEV void phase_scan(const Params& P, int l, char* smem) {
  __shared__ int s_task;
  const int ntask = 1008 + (l == 1 ? 2048 : 0);
  for (;;) {
    __syncthreads();
    if (threadIdx.x == 0) s_task = (int)atomicAdd(P.ctr + l, 1u);
    __syncthreads();
    const int t = s_task;
    if (t >= ntask) break;
    if (t < 64) rwkv_task(P, l, t, smem);
    else if (t < 80) delta_task(P, l, t - 64, smem);
    else if (t < 96) mlstm_task(P, l, t - 80, smem);
    else if (t < 112) ret_task(P, l, t - 96, smem);
    else if (t < 624) rwkv_task(P, l, (t - 112) + 64, smem);
    else if (t < 752) delta_task(P, l, (t - 624) + 16, smem);
    else if (t < 880) mlstm_task(P, l, (t - 752) + 16, smem);
    else if (t < 1008) ret_task(P, l, (t - 880) + 16, smem);
    else conv_ff_layer1_item(P, t - 1008, smem);
  }
}

DEV void phase_combine(const Params& P, int l) {
  const int tid_ = THREAD_ID;
  const int lane = tid_ & 63;
  const int wid = blockIdx.x * (NTHREADS / 64) + (tid_ >> 6), nw = gridDim.x * (NTHREADS / 64);
  for (int it = wid; it < NTOK * 4; it += nw) {
    const int g = it >> 2, m = it & 3;
    const int c = lane * 4, head = lane >> 4;
    const uint2 h0 = *(const uint2*)(P.hdir + (size_t)g * DM + m * 256 + c);
    const uint2 h1 = *(const uint2*)(P.hdir + ((size_t)NTOK + g) * DM + m * 256 + c);
    float y[4];
    y[0] = __uint_as_float(h0.x << 16) + __uint_as_float(h1.x << 16);
    y[1] = __uint_as_float(h0.x & 0xffff0000u) + __uint_as_float(h1.x & 0xffff0000u);
    y[2] = __uint_as_float(h0.y << 16) + __uint_as_float(h1.y << 16);
    y[3] = __uint_as_float(h0.y & 0xffff0000u) + __uint_as_float(h1.y & 0xffff0000u);
    if (m != 1) {
      const float mean = red16(y[0] + y[1] + y[2] + y[3]) * (1.f / 64.f);
#pragma unroll
      for (int e = 0; e < 4; ++e) y[e] -= mean;
    }
    const float var = red16(y[0] * y[0] + y[1] * y[1] + y[2] * y[2] + y[3] * y[3]) * (1.f / 64.f);
    const float rs = rsqrtf(var + LNEPS);
    const float* gn = (m == 0 ? P.mlstm_norm : m == 1 ? P.delta_norm : m == 2 ? P.ret_norm : P.rwkv_norm) + l * 256 + c;
    const float4 g4 = *(const float4*)gn;
    y[0] *= rs * g4.x; y[1] *= rs * g4.y; y[2] *= rs * g4.z; y[3] *= rs * g4.w;
    float o[4];
    if (m == 3) {
      const uint2 gg = *(const uint2*)(P.gbuf + (size_t)g * 256 + c);
      const float gt[4] = {__uint_as_float(gg.x << 16), __uint_as_float(gg.x & 0xffff0000u), __uint_as_float(gg.y << 16), __uint_as_float(gg.y & 0xffff0000u)};
      const float bn = P.bonus[(size_t)g * 4 + head] + P.bonus[((size_t)NTOK + g) * 4 + head];
      const float4 v4 = *(const float4*)(P.rkv + (size_t)g * 768 + 512 + c);
      o[0] = gt[0] * (y[0] + bn * v4.x); o[1] = gt[1] * (y[1] + bn * v4.y); o[2] = gt[2] * (y[2] + bn * v4.z); o[3] = gt[3] * (y[3] + bn * v4.w);
    } else {
      const int goff = (m == 0) ? 768 : (m == 1) ? 1808 : 2848;
      const float4 a4 = *(const float4*)(P.projABC + (size_t)g * NABC + goff + c);
      if (m == 0) { o[0] = sigmoidf_(a4.x) * y[0]; o[1] = sigmoidf_(a4.y) * y[1]; o[2] = sigmoidf_(a4.z) * y[2]; o[3] = sigmoidf_(a4.w) * y[3]; }
      else { o[0] = siluf_(a4.x) * y[0]; o[1] = siluf_(a4.y) * y[1]; o[2] = siluf_(a4.z) * y[2]; o[3] = siluf_(a4.w) * y[3]; }
    }
    uint2 ov; ov.x = pack2(o[0], o[1]); ov.y = pack2(o[2], o[3]);
    *(uint2*)(P.ubuf + (size_t)g * DM + m * 256 + c) = ov;
  }
}

__global__ void __launch_bounds__(NTHREADS, 2) mega(Params P) {
  extern __shared__ __attribute__((aligned(16))) char smem[];
  cg::grid_group grid = cg::this_grid();
  for (int ph = (int)P.phase_lo; ph < (int)P.phase_hi; ++ph) {
    if (ph == 0) phase_prologue(P, smem);
    else if (ph == 1) phase_ln(P, 0, 0);
    else {
      const int l = (ph - 2) / 9, s = (ph - 2) % 9;
      switch (s) {
        case 0: phase_gemm<0>(P, P.ubuf, P.wt_in + (size_t)l * PINP * DM, PINP / 128, DM, l, 0, false, smem); break;
        case 1: for (int it = blockIdx.x; it < 128 * 11; it += gridDim.x) rwkv_prep_item(P, l, it, smem); break;
        case 2: phase_scan(P, l, smem); break;
        case 3: phase_combine(P, l); break;
        case 4: phase_gemm<1>(P, P.ubuf, P.wt_out + (size_t)l * DM * DM, DM / 128, DM, l, 2048, l == 0, smem); break;
        case 5: phase_ln(P, 1, l); break;
        case 6: phase_gemm<2>(P, P.ubuf, P.wt_ff1, DFF / 128, DM, l, 0, false, smem); break;
        case 7: phase_gemm<1>(P, P.hidden, P.wt_ff2, DM / 128, DFF, l, 5120, false, smem); break;
        case 8: phase_ln(P, 2, l); break;
      }
    }
    if (ph + 1 < (int)P.phase_hi) grid.sync();
  }
}

#ifndef MK_MULTI
#define MK_MULTI 0
#endif

extern "C" void kernel_launch(void* const* d_in, const int* in_sizes, int n_in, void* d_out, int out_size, void* d_ws, size_t ws_size, hipStream_t stream) {
  static int grid_blocks = 0;
  if (!grid_blocks) {
    int dev = 0, cus = 0, per_cu = 0;
    hipGetDevice(&dev);
    hipDeviceGetAttribute(&cus, hipDeviceAttributeMultiprocessorCount, dev);
    if (hipFuncSetAttribute((const void*)mega, hipFuncAttributeMaxDynamicSharedMemorySize, LDS_BYTES) != hipSuccess) fprintf(stderr, "hipFuncSetAttribute failed\n");
    hipOccupancyMaxActiveBlocksPerMultiprocessor(&per_cu, (const void*)mega, NTHREADS, LDS_BYTES);
    if (per_cu < 1) { fprintf(stderr, "occupancy query returned %d\n", per_cu); per_cu = 1; }
    if (per_cu > 2) per_cu = 2;
    grid_blocks = cus * per_cu;
    fprintf(stderr, "mega: cus %d per_cu %d grid %d ws %zu\n", cus, per_cu, grid_blocks, ws_size);
  }
  Params p{};
  const float** pin = (const float**)&p;
  for (int i = 0; i < 39; ++i) pin[i] = (const float*)d_in[i];
  p.out = (float*)d_out;
  char* ws = (char*)d_ws; size_t off = 0;
  auto take = [&](size_t bytes) { char* r = ws + off; off += (bytes + 255) & ~(size_t)255; return r; };
  p.ctr = (unsigned*)take(256);
  p.wt_in = (bf16_t*)take((size_t)2 * PINP * DM * 2);
  p.wt_out = (bf16_t*)take((size_t)2 * DM * DM * 2);
  p.wt_ff1 = (bf16_t*)take((size_t)DM * DFF * 2);
  p.wt_ff2 = (bf16_t*)take((size_t)DM * DFF * 2);
  p.ubuf = (bf16_t*)take((size_t)NTOK * DM * 2);
  p.projABC = (float*)take((size_t)NTOK * NABC * 4);
  p.hidden = (bf16_t*)p.projABC;
  p.pdraw = (float*)take((size_t)NTOK * NPD * 4);
  p.hdir = (bf16_t*)p.pdraw;
  p.rkv = (float*)take((size_t)NTOK * 768 * 4);
  p.wa = (float*)take((size_t)NTOK * 1024 * 4);
  p.gbuf = (bf16_t*)take((size_t)NTOK * 256 * 2);
  p.mod = (float*)take((size_t)2 * 3 * 6144 * 4);
  p.khinv = (float*)take((size_t)NTOK * 4 * 4);
  p.bonus = (float*)take((size_t)2 * NTOK * 4 * 4);
  if (off > ws_size) { fprintf(stderr, "workspace too small: need %zu have %zu\n", off, ws_size); return; }
  hipMemsetAsync(p.ctr, 0, 256, stream);
  const int nph = 2 + 9 * 2;
#if MK_MULTI
  for (int ph = 0; ph < nph; ++ph) {
    p.phase_lo = ph; p.phase_hi = ph + 1;
    void* args[] = {&p};
    hipLaunchCooperativeKernel((const void*)mega, dim3(grid_blocks), dim3(NTHREADS), args, LDS_BYTES, stream);
  }
#else
  p.phase_lo = 0; p.phase_hi = nph;
  void* args[] = {&p};
  hipError_t e = hipLaunchCooperativeKernel((const void*)mega, dim3(grid_blocks), dim3(NTHREADS), args, LDS_BYTES, stream);
  if (e != hipSuccess) fprintf(stderr, "cooperative launch failed: %s (grid %d)\n", hipGetErrorString(e), grid_blocks);
#endif
}
```

```cpp
#include <hip/hip_runtime.h>
#include <hip/hip_cooperative_groups.h>
#include <cstdio>
#include <cstdint>
namespace cg = cooperative_groups;

typedef unsigned short bf16_t;
typedef short bf16x8 __attribute__((ext_vector_type(8)));
typedef float f32x16 __attribute__((ext_vector_type(16)));
typedef float f32x4 __attribute__((ext_vector_type(4)));
#define DEV __device__ __forceinline__

#ifndef PROBE_SCAN_CLASS
#define PROBE_SCAN_CLASS 31
#endif
#ifndef PROBE_DUP_PRO
#define PROBE_DUP_PRO 0
#endif
#ifndef PROBE_EXTRA_SYNCS
#define PROBE_EXTRA_SYNCS 0
#endif
#ifndef PROBE_DUP_MASK
#define PROBE_DUP_MASK 0
#endif
constexpr int NTOK = 8192, DM = 1024, PIN = 4256, PINP = 4352, NABC = 3104, NPD = 1152, DFF = 4096;
constexpr float ALPHA = 1.41421356237f, LNEPS = 1e-5f;
constexpr int LDB = 72;
constexpr int TILE_B = 64 * LDB * 2;
constexpr int HALF_LDS = 77824;
constexpr int LDS_BYTES = 2 * HALF_LDS;
constexpr int NTHREADS = 512;
constexpr size_t O_C = 8388608, O_N = 9437184, O_M = 9453568, O_DELTA = 9453824, O_RET = 10502400, O_RWKV = 11550976;

struct Params {
  const float *x_prompt, *x_sample, *c, *st_C, *st_n, *st_m, *st_delta, *st_ret, *st_rwkv, *c_ctx;
  const float *w_mod, *b_mod, *w_in, *w_out, *ln1_g, *ln1_b, *ln2_g, *ln2_b, *w_ff1, *w_ff2;
  const float *mlstm_i_bias, *mlstm_f_bias, *mlstm_norm, *delta_conv, *delta_a_log, *delta_dt_bias, *delta_norm;
  const float *ret_decay, *ret_norm, *rwkv_mu, *rwkv_w0, *rwkv_w2, *rwkv_a0, *rwkv_a2, *rwkv_g2, *rwkv_kk, *rwkv_ka, *rwkv_rk, *rwkv_norm;
  float* out;
  bf16_t *wt_in, *wt_out, *wt_ff1, *wt_ff2, *ubuf, *hdir, *gbuf, *hidden;
  float *mod, *projABC, *pdraw, *rkv, *wa, *khinv, *bonus, *dbeta, *dgc, *ff2tmp;
  bf16_t *dT, *w2t, *a2t, *g2t;
  unsigned* ctr; unsigned* bar;
  long long phase_lo, phase_hi;
};

DEV int opaque_i(int v) { asm volatile("" : "+v"(v)); return v; }
#define THREAD_ID opaque_i((int)threadIdx.x)
typedef float f32x2_t __attribute__((ext_vector_type(2)));
typedef __bf16 bf16x2_t __attribute__((ext_vector_type(2)));
DEV unsigned pack2(float a, float b) { f32x2_t v = {a, b}; bf16x2_t r = __builtin_convertvector(v, bf16x2_t); return __builtin_bit_cast(unsigned, r); }
DEV bf16_t f2bf(float f) { return (bf16_t)pack2(f, f); }
DEV float bf2f(bf16_t h) { return __uint_as_float(((unsigned)h) << 16); }
DEV float sigmoidf_(float x) { return 1.f / (1.f + __expf(-x)); }
DEV float siluf_(float x) { return x / (1.f + __expf(-x)); }
DEV float softplusf_(float x) { return x > 20.f ? x : log1pf(__expf(x)); }
DEV float logsigmoidf_(float x) { return -softplusf_(-x); }
template <int CTRL> DEV float dppf(float x) { return __builtin_bit_cast(float, __builtin_amdgcn_mov_dpp(__builtin_bit_cast(int, x), CTRL, 0xf, 0xf, true)); }
DEV float red4(float x) { x += dppf<0xB1>(x); x += dppf<0x4E>(x); return x; }
DEV float red16(float x) { x = red4(x); x += dppf<0x141>(x); x += dppf<0x128>(x); return x; }
DEV float wave_sum(float x) { x = red16(x); x += __shfl_xor(x, 16); x += __shfl_xor(x, 32); return x; }
DEV void tok_info(int g, int& gs, int& T, int& ci) {
  if (g < 4096) { gs = g & ~255; T = 256; ci = 0; } else { int b = (g - 4096) >> 11; gs = 4096 + (b << 11); T = 2048; ci = 1 + b; }
}
DEV const float* xin_row(const Params& P, int g) { return g < 4096 ? P.x_prompt + (size_t)g * DM : P.x_sample + (size_t)(g - 4096) * DM; }

DEV f32x16 mm64(const bf16_t* A, const bf16_t* Bt, int wr, int wc, int lane, f32x16 acc) {
  const bf16_t* ap = A + (wr * 32 + (lane & 31)) * LDB + (lane >> 5) * 8;
  const bf16_t* bp = Bt + (wc * 32 + (lane & 31)) * LDB + (lane >> 5) * 8;
#pragma unroll
  for (int s = 0; s < 4; ++s) {
    bf16x8 a = *(const bf16x8*)(ap + s * 16);
    bf16x8 b = *(const bf16x8*)(bp + s * 16);
    acc = __builtin_amdgcn_mfma_f32_32x32x16_bf16(a, b, acc, 0, 0, 0);
  }
  return acc;
}
DEV f32x16 zero16() { f32x16 z; for (int i = 0; i < 16; ++i) z[i] = 0.f; return z; }
#define ACC_ROW(idx) (wr * 32 + ((idx) & 3) + 8 * ((idx) >> 2) + 4 * (lane >> 5))
#define ACC_COL (wc * 32 + (lane & 31))

DEV void conv_tile(const float* __restrict__ src, bf16_t* __restrict__ dst, int K, int N, int tk, int tn, float* tile, const int tid_in, const int dst_row_shift = 0) {
  const int tid = opaque_i(tid_in);
  const int k0 = tk * 64, n0 = tn * 64;
  { const int r = tid >> 2, cs = (tid & 3) * 16;
#pragma unroll
    for (int e = 0; e < 16; e += 4) {
      const int n = n0 + cs + e;
      float4 v = make_float4(0.f, 0.f, 0.f, 0.f);
      if (n < N) v = *(const float4*)(src + (size_t)(k0 + r) * N + n);
      tile[r * 65 + cs + e] = v.x; tile[r * 65 + cs + e + 1] = v.y; tile[r * 65 + cs + e + 2] = v.z; tile[r * 65 + cs + e + 3] = v.w;
    } }
  __syncthreads();
  { const int nl = tid >> 2, ks = (tid & 3) * 16;
    unsigned pk[8];
#pragma unroll
    for (int e = 0; e < 8; ++e) pk[e] = pack2(tile[(ks + 2 * e) * 65 + nl], tile[(ks + 2 * e + 1) * 65 + nl]);
    uint4* d = (uint4*)(dst + (size_t)(n0 + nl + dst_row_shift) * K + k0 + ks);
    d[0] = make_uint4(pk[0], pk[1], pk[2], pk[3]); d[1] = make_uint4(pk[4], pk[5], pk[6], pk[7]); }
  __syncthreads();
}

DEV void mod_gemv_item(const Params& P, int item, float* red, const int tid) {
  const int j0 = item * 64, l = j0 / 6144, jj = j0 % 6144;
  const int cq = tid & 15, kg = tid >> 4;
  const float* W = P.w_mod + (size_t)l * DM * 6144 + jj + cq * 4;
  float a0[4] = {0, 0, 0, 0}, a1[4] = {0, 0, 0, 0}, a2[4] = {0, 0, 0, 0};
  for (int kk = 0; kk < 64; ++kk) {
    const int k = kg * 64 + kk;
    const float4 w = *(const float4*)(W + (size_t)k * 6144);
    const float s0 = siluf_(P.c_ctx[k]), s1 = siluf_(P.c[k]), s2 = siluf_(P.c[DM + k]);
    a0[0] += s0 * w.x; a0[1] += s0 * w.y; a0[2] += s0 * w.z; a0[3] += s0 * w.w;
    a1[0] += s1 * w.x; a1[1] += s1 * w.y; a1[2] += s1 * w.z; a1[3] += s1 * w.w;
    a2[0] += s2 * w.x; a2[1] += s2 * w.y; a2[2] += s2 * w.z; a2[3] += s2 * w.w;
  }
#pragma unroll
  for (int e = 0; e < 4; ++e) { red[(kg * 3 + 0) * 64 + cq * 4 + e] = a0[e]; red[(kg * 3 + 1) * 64 + cq * 4 + e] = a1[e]; red[(kg * 3 + 2) * 64 + cq * 4 + e] = a2[e]; }
  __syncthreads();
  if (tid < 192) {
    const int ci = tid >> 6, col = tid & 63;
    float s = P.b_mod[l * 6144 + jj + col];
    for (int g = 0; g < 16; ++g) s += red[(g * 3 + ci) * 64 + col];
    P.mod[(size_t)(l * 3 + ci) * 6144 + jj + col] = s;
  }
  __syncthreads();
}

DEV void prologue_item(const Params& P, int t, float* tile, const int tid) {
  const int n_in = 16 * 68, n_out = 16 * 16, n_ff = 1024;
  const int total = 192 + 48 + n_in + n_out + 2 * n_ff;
  if (t >= total) { __syncthreads(); __syncthreads(); return; }
  if (t < 192) { mod_gemv_item(P, t, tile, tid); return; }
  if (t < 240) {
    const int v = t - 192;
    if (v < 32) { const int m = v >> 2, tn = v & 3, lz = m >> 1, kind = m & 1;
      conv_tile((kind == 0 ? P.rwkv_w2 : P.rwkv_a2) + (size_t)lz * 64 * 256, (kind == 0 ? P.w2t : P.a2t) + (size_t)lz * 256 * 64, 64, 256, 0, tn, tile, tid); }
    else { const int m = (v - 32) >> 3, r = (v - 32) & 7; conv_tile(P.rwkv_g2 + (size_t)m * 128 * 256, P.g2t + (size_t)m * 256 * 128, 128, 256, r >> 2, r & 3, tile, tid); }
    return;
  }
  int u = t - 240;
  if (u < n_in) { const int tn = u % 68; conv_tile(P.w_in, P.wt_in, DM, PIN, u / 68, tn, tile, tid, tn < 12 ? 0 : (tn < 16 ? 3328 : -256)); return; }
  u -= n_in;
  if (u < n_out) { conv_tile(P.w_out, P.wt_out, DM, DM, u / 16, u % 16, tile, tid); return; }
  u -= n_out;
  if (u < n_ff) { conv_tile(P.w_ff1, P.wt_ff1, DM, DFF, u / 64, u % 64, tile, tid); return; }
  u -= n_ff;
  { const int tk = u / 16, kh = tk >> 5; conv_tile(P.w_ff2 + (size_t)kh * 2048 * DM, P.wt_ff2 + (size_t)kh * DM * 2048, 2048, DM, tk & 31, u % 16, tile, tid); }
}
DEV void phase_prologue(const Params& P, char* smem, int rep) {
  const int tid_ = THREAD_ID; const int half = tid_ >> 8, tid = tid_ & 255;
  float* tile = (float*)(smem + half * HALF_LDS);
  const int total = 192 + 48 + 16 * 68 + 256 + 2 * 1024;
  __shared__ int4 s_pj4; int& s_pj = *(int*)&s_pj4;
  for (;;) {
    __syncthreads();
    if (threadIdx.x == 0) s_pj = (int)atomicAdd(P.ctr + 6 + rep, 1u);
    __syncthreads();
    const int j = s_pj;
    if (2 * j >= total) break;
    prologue_item(P, 2 * j + half, tile, tid);
  }
}
struct ConvDesc { const float* src; bf16_t* dst; int K, N, tk, tn, shift; };
DEV void conv_tile_load(const ConvDesc& d, const int tid, float4& a, float4& b, float4& c, float4& e4) {
  const int r = tid >> 2, cs = (tid & 3) * 16;
  const float* p = d.src + (size_t)(d.tk * 64 + r) * d.N + d.tn * 64 + cs;
  const float4 z4 = make_float4(0.f, 0.f, 0.f, 0.f);
  const int n = d.tn * 64 + cs;
  a = z4; b = z4; c = z4; e4 = z4;
  if (n < d.N) a = *(const float4*)p;
  if (n + 4 < d.N) b = *(const float4*)(p + 4);
  if (n + 8 < d.N) c = *(const float4*)(p + 8);
  if (n + 12 < d.N) e4 = *(const float4*)(p + 12);
}
DEV void conv_tile_finish(const ConvDesc& d, float* tile, const int tid, const float4 a, const float4 b, const float4 c, const float4 e4) {
  { const int r = tid >> 2, cs = (tid & 3) * 16;
    float* t = tile + r * 65 + cs;
    t[0] = a.x; t[1] = a.y; t[2] = a.z; t[3] = a.w; t[4] = b.x; t[5] = b.y; t[6] = b.z; t[7] = b.w;
    t[8] = c.x; t[9] = c.y; t[10] = c.z; t[11] = c.w; t[12] = e4.x; t[13] = e4.y; t[14] = e4.z; t[15] = e4.w; }
  __syncthreads();
  { const int nl = tid >> 2, ks = (tid & 3) * 16;
    unsigned pk[8];
#pragma unroll
    for (int e = 0; e < 8; ++e) pk[e] = pack2(tile[(ks + 2 * e) * 65 + nl], tile[(ks + 2 * e + 1) * 65 + nl]);
    uint4* o = (uint4*)(d.dst + (size_t)(d.tn * 64 + nl + d.shift) * d.K + d.tk * 64 + ks);
    o[0] = make_uint4(pk[0], pk[1], pk[2], pk[3]); o[1] = make_uint4(pk[4], pk[5], pk[6], pk[7]); }
  __syncthreads();
}
DEV ConvDesc deferred_conv_desc(const Params& P, int l, int u) {
  ConvDesc d; d.shift = 0;
  if (l == 1) {
    if (u < 1024) { d.src = P.w_ff1 + (size_t)DM * DFF; d.dst = P.wt_ff1; d.K = DM; d.N = DFF; d.tk = u / 64; d.tn = u % 64; }
    else { u -= 1024; const int tk = u / 16, kh = tk >> 5; d.src = P.w_ff2 + (size_t)DM * DFF + (size_t)kh * 2048 * DM; d.dst = P.wt_ff2 + (size_t)kh * DM * 2048; d.K = 2048; d.N = DM; d.tk = tk & 31; d.tn = u % 16; }
  } else {
    if (u < 1088) { const int tn = u % 68; d.src = P.w_in + (size_t)DM * PIN; d.dst = P.wt_in + (size_t)PINP * DM; d.K = DM; d.N = PIN; d.tk = u / 68; d.tn = tn; d.shift = tn < 12 ? 0 : (tn < 16 ? 3328 : -256); }
    else { u -= 1088; d.src = P.w_out + (size_t)DM * DM; d.dst = P.wt_out + (size_t)DM * DM; d.K = DM; d.N = DM; d.tk = u / 16; d.tn = u % 16; }
  }
  return d;
}
DEV void conv_inout_layer1_item(const Params& P, int u, char* smem, const int tid) {
  float* tile = (float*)smem;
  if (u < 1088) { const int tn = u % 68; conv_tile(P.w_in + (size_t)DM * PIN, P.wt_in + (size_t)PINP * DM, DM, PIN, u / 68, tn, tile, tid, tn < 12 ? 0 : (tn < 16 ? 3328 : -256)); }
  else { u -= 1088; conv_tile(P.w_out + (size_t)DM * DM, P.wt_out + (size_t)DM * DM, DM, DM, u / 16, u % 16, tile, tid); }
}
DEV void conv_ff_layer1_item(const Params& P, int u, char* smem, const int tid) {
  float* tile = (float*)smem;
  if (u < 1024) conv_tile(P.w_ff1 + (size_t)DM * DFF, P.wt_ff1, DM, DFF, u / 64, u % 64, tile, tid);
  else { u -= 1024; const int tk = u / 16, kh = tk >> 5; conv_tile(P.w_ff2 + (size_t)DM * DFF + (size_t)kh * 2048 * DM, P.wt_ff2 + (size_t)kh * DM * 2048, 2048, DM, tk & 31, u % 16, tile, tid); }
}

DEV void phase_ln(const Params& P, int mode, int l) {
  const int tid_ = THREAD_ID;
  const int lane = tid_ & 63;
  const int wid = blockIdx.x * (NTHREADS / 64) + (tid_ >> 6), nw = gridDim.x * (NTHREADS / 64);
  float4 nx0, nx1, nx2, nx3, nt0, nt1, nt2, nt3;
  nt0 = nt1 = nt2 = nt3 = make_float4(0.f, 0.f, 0.f, 0.f);
#define LN_LOAD(G) { const float* src_ = (mode == 0) ? xin_row(P, (G)) : (P.out + (size_t)(G) * DM); \
    nx0 = *(const float4*)(src_ + lane * 4); nx1 = *(const float4*)(src_ + 256 + lane * 4); nx2 = *(const float4*)(src_ + 512 + lane * 4); nx3 = *(const float4*)(src_ + 768 + lane * 4); \
    if (mode == 2) { const float* t_ = P.ff2tmp + (size_t)(G) * DM + lane * 4; nt0 = *(const float4*)t_; nt1 = *(const float4*)(t_ + 256); nt2 = *(const float4*)(t_ + 512); nt3 = *(const float4*)(t_ + 768); } }
  if (wid < NTOK) LN_LOAD(wid)
  for (int g = wid; g < NTOK; g += nw) {
    int gs, T, ci; tok_info(g, gs, T, ci);
    float v[16];
    { const float4 xs[4] = {nx0, nx1, nx2, nx3};
#pragma unroll
      for (int k = 0; k < 4; ++k) { v[4 * k] = xs[k].x; v[4 * k + 1] = xs[k].y; v[4 * k + 2] = xs[k].z; v[4 * k + 3] = xs[k].w; } }
    if (mode == 2) {
      const float* gt = P.mod + (size_t)(l * 3 + ci) * 6144 + 5120;
      const float4 ts[4] = {nt0, nt1, nt2, nt3};
#pragma unroll
      for (int k = 0; k < 4; ++k) { const float4 t = ts[k], g4 = *(const float4*)(gt + k * 256 + lane * 4);
        v[4 * k] += g4.x * t.x; v[4 * k + 1] += g4.y * t.y; v[4 * k + 2] += g4.z * t.z; v[4 * k + 3] += g4.w * t.w; }
    }
    if (g + nw < NTOK) LN_LOAD(g + nw)
    float s = 0.f;
#pragma unroll
    for (int i = 0; i < 16; ++i) s += v[i];
    float mu = wave_sum(s) * (1.f / DM);
    float q = 0.f;
#pragma unroll
    for (int i = 0; i < 16; ++i) { v[i] -= mu; q += v[i] * v[i]; }
    float rstd = rsqrtf(wave_sum(q) * (1.f / DM) + LNEPS);
#pragma unroll
    for (int i = 0; i < 16; ++i) v[i] *= rstd;
    int lm = l, shoff = 0, scoff = 1024;
    bool write_u = true;
    if (mode != 0) {
      const float* gg = (mode == 1 ? P.ln1_g : P.ln2_g) + l * DM;
      const float* bb = (mode == 1 ? P.ln1_b : P.ln2_b) + l * DM;
#pragma unroll
      for (int k = 0; k < 4; ++k) {
        const float4 g4 = *(const float4*)(gg + k * 256 + lane * 4), b4 = *(const float4*)(bb + k * 256 + lane * 4);
        v[4 * k] = v[4 * k] * g4.x + b4.x; v[4 * k + 1] = v[4 * k + 1] * g4.y + b4.y; v[4 * k + 2] = v[4 * k + 2] * g4.z + b4.z; v[4 * k + 3] = v[4 * k + 3] * g4.w + b4.w;
        *(float4*)(P.out + (size_t)g * DM + k * 256 + lane * 4) = make_float4(v[4 * k], v[4 * k + 1], v[4 * k + 2], v[4 * k + 3]);
      }
      if (mode == 1) { shoff = 3072; scoff = 4096; } else { lm = l + 1; write_u = (l == 0); }
      if (write_u) {
        s = 0.f;
#pragma unroll
        for (int i = 0; i < 16; ++i) s += v[i];
        mu = wave_sum(s) * (1.f / DM);
        q = 0.f;
#pragma unroll
        for (int i = 0; i < 16; ++i) { v[i] -= mu; q += v[i] * v[i]; }
        rstd = rsqrtf(wave_sum(q) * (1.f / DM) + LNEPS);
#pragma unroll
        for (int i = 0; i < 16; ++i) v[i] *= rstd;
      }
    }
    if (write_u) {
      const float* md = P.mod + (size_t)(lm * 3 + ci) * 6144;
#pragma unroll
      for (int k = 0; k < 4; ++k) {
        const float4 sh = *(const float4*)(md + shoff + k * 256 + lane * 4), sc = *(const float4*)(md + scoff + k * 256 + lane * 4);
        uint2 o;
        o.x = pack2(v[4 * k] * (1.f + sc.x) + sh.x, v[4 * k + 1] * (1.f + sc.y) + sh.y);
        o.y = pack2(v[4 * k + 2] * (1.f + sc.z) + sh.z, v[4 * k + 3] * (1.f + sc.w) + sh.w);
        *(uint2*)(P.ubuf + (size_t)g * DM + k * 256 + lane * 4) = o;
      }
    }
  }
}

namespace pg8 {
#define PG8_LAS __attribute__((address_space(3)))
typedef unsigned short bf16_t;
typedef short bf16x8 __attribute__((ext_vector_type(8)));
typedef float f32x4 __attribute__((ext_vector_type(4)));
typedef unsigned u32x4 __attribute__((ext_vector_type(4)));
constexpr int BM = 256, BK = 64, HALF = 128, HTB = HALF * BK * 2  , STAGE_BYTES = 8 * HTB, NXCD = 8, WGM = 8;

__host__ __device__ __forceinline__ int lds_byte(int r, int c) { const int st = (r >> 4) * 2 + (c >> 5), rr = r & 15, cc = c & 31, ob = rr * 64 + cc * 2; return st * 1024 + (ob ^ (((ob >> 9) & 1) << 5)); }
__host__ __device__ __forceinline__ void stage_rc(int b, int& R, int& C) { const int st = b / 1024, sb = b % 1024, swz = sb ^ (((sb >> 9) & 1) << 5); R = (st >> 1) * 16 + swz / 64; C = (st & 1) * 32 + (swz % 64) / 2; }
__host__ __device__ __forceinline__ int perm32(int rho) { const int n = rho >> 4, i = rho & 15; return 8 * (i >> 2) + 4 * n + (i & 3); }

struct Unit { int pm, pn; };
struct Gemm { const bf16_t* A; const bf16_t* Bt; int M, N, K; int lda; int nsplit; };

struct StaticOrder {
    int nM, nN, nwg, G, c;
    __host__ __device__ void init(int M, int N, int G_, int c_) { nM = M / BM; nN = N / BM; nwg = nM * nN; G = G_; c = c_; }
    __host__ __device__ bool next(int i, Unit& u) const {
        const long L = (long)i * G + c; if (L >= nwg) return false;
        int wgid = (int)L; { const int q = nwg / NXCD, r = nwg % NXCD, xcd = wgid % NXCD, off = wgid / NXCD; wgid = (xcd < r ? xcd * (q + 1) : r * (q + 1) + (xcd - r) * q) + off; }
        const int nig = WGM * nN, gid = wgid / nig, fm = gid * WGM, gsz = (nM - fm) < WGM ? (nM - fm) : WGM;
        u.pm = fm + ((wgid % nig) % gsz); u.pn = (wgid % nig) / gsz; return true;
    }
    __device__ __forceinline__ void a_ready(const Unit&) const {}
    __device__ __forceinline__ void done(const Unit&) const {}
};
__device__ __forceinline__ unsigned cvt_pk_bf16(float lo, float hi) { unsigned r; asm volatile("v_cvt_pk_bf16_f32 %0, %1, %2" : "=v"(r) : "v"(lo), "v"(hi)); return r; }
template <class Epi, class Sched, bool STAMP = false>
__device__ __forceinline__ void gemm_phase(PG8_LAS unsigned char* lds, const Gemm g, const Sched& S, const Epi& E, unsigned long long* stamps) {
    const int tid = THREAD_ID, wid = __builtin_amdgcn_readfirstlane(tid >> 6), lane = tid & 63, wr = wid >> 2, wc = wid & 3, fr = lane & 15, fq = lane >> 4;
    const int K = g.K, nt = K / BK;
    int ts_lo = 0, ts_hi = 0, nts = 0; const unsigned long long rt_entry = STAMP ? (unsigned long long)wall_clock64() : 0ull;
#define PG8_STAMP() do { if (STAMP && wid == 0 && nts < 64) { const unsigned long long _c = (unsigned long long)clock64(); \
        ts_lo = (lane == nts) ? (int)(unsigned)_c : ts_lo; ts_hi = (lane == nts) ? (int)(unsigned)(_c >> 32) : ts_hi; ++nts; } } while (0)
    PG8_STAMP();
    unsigned voffA[2], voffB[2];
#pragma unroll
    for (int i = 0; i < 2; ++i) { int R, C; stage_rc(tid * 16 + i * 8192, R, C); const int Rb = Epi::PERM ? ((R & ~31) + perm32(R & 31)) : R;
        voffA[i] = (unsigned)(R * g.lda + C) * 2u; voffB[i] = (unsigned)(Rb * K + C) * 2u; }
    const size_t kstep = (size_t)(BK * 2);
    const size_t hstep = (size_t)HALF * K * 2, hstepA = (size_t)HALF * g.lda * 2;
    const size_t tstep = 2 * hstep, tstepA = 2 * hstepA;
    const size_t ksplitA = (size_t)K * 2;
    const unsigned ldsw = (unsigned)wid * 1024u;
    const int aoff = lds_byte(wr * 64 + fr, fq * 8), boff = lds_byte(wc * 32 + fr, fq * 8);
#define PG8_SA(b, h) (((b) * 2 + (h)) * HTB)
#define PG8_SB(b, h) ((4 + (b) * 2 + (h)) * HTB)
#define PG8_STAGE(bufoff, gbase, voff) do { _Pragma("unroll") for (int _i = 0; _i < 2; ++_i) \
        __builtin_amdgcn_global_load_lds((const unsigned*)((const char*)(gbase) + (voff)[_i]), (PG8_LAS unsigned*)(lds + (bufoff) + ldsw + _i * 8192), 16, 0, 0); } while (0)
#define PG8_LDA(dst, b, h) do { _Pragma("unroll") for (int m = 0; m < 4; ++m) _Pragma("unroll") for (int k = 0; k < 2; ++k) dst[m][k] = *(const PG8_LAS bf16x8*)(lds + PG8_SA(b, h) + aoff + m * 2048 + k * 1024); } while (0)
#define PG8_LDB(dst, b, h) do { _Pragma("unroll") for (int n = 0; n < 2; ++n) _Pragma("unroll") for (int k = 0; k < 2; ++k) dst[n][k] = *(const PG8_LAS bf16x8*)(lds + PG8_SB(b, h) + boff + n * 2048 + k * 1024); } while (0)
#define PG8_MMA(ai, bj, At, Bt) do { __builtin_amdgcn_s_setprio(1); _Pragma("unroll") for (int m = 0; m < 4; ++m) _Pragma("unroll") for (int n = 0; n < 2; ++n) _Pragma("unroll") for (int k = 0; k < 2; ++k) \
        acc[ai][bj][m][n] = __builtin_amdgcn_mfma_f32_16x16x32_bf16(Bt[n][k], At[m][k], acc[ai][bj][m][n], 0, 0, 0); __builtin_amdgcn_s_setprio(0); } while (0)
#define PG8_WAIT_V(n) asm volatile("s_waitcnt vmcnt(" #n ")" ::: "memory")
#define PG8_WAIT_L(n) asm volatile("s_waitcnt lgkmcnt(" #n ")" ::: "memory")
#define PG8_BAR __builtin_amdgcn_s_barrier()
#define PG8_SCHED __builtin_amdgcn_sched_barrier(0)
    Unit cur, nxt; int ui = 0;
    if (!S.next(0, cur)) return;
    f32x4 acc[2][2][4][2];
#pragma unroll
    for (int a = 0; a < 2; ++a)
#pragma unroll
        for (int b = 0; b < 2; ++b)
#pragma unroll
            for (int m = 0; m < 4; ++m)
#pragma unroll
                for (int n = 0; n < 2; ++n) acc[a][b][m][n] = (f32x4){0.f, 0.f, 0.f, 0.f};
    bf16x8 At[4][2], B0[2][2], B1[2][2];
    const char* cA = (const char*)g.A + (size_t)cur.pm * tstepA + (cur.pn >= g.nsplit ? ksplitA : 0); const char* cB = (const char*)g.Bt + (size_t)cur.pn * tstep;
    S.a_ready(cur);
    PG8_STAGE(PG8_SB(0, 0), cB, voffB); PG8_STAGE(PG8_SA(0, 0), cA, voffA); PG8_STAGE(PG8_SB(0, 1), cB + hstep, voffB); PG8_STAGE(PG8_SA(0, 1), cA + hstepA, voffA);
    if (wr == 1) PG8_BAR;
    PG8_WAIT_V(4); PG8_BAR;
    PG8_STAGE(PG8_SB(1, 0), cB + kstep, voffB); PG8_STAGE(PG8_SA(1, 0), cA + kstep, voffA); PG8_STAGE(PG8_SB(1, 1), cB + hstep + kstep, voffB);
    PG8_WAIT_V(6); PG8_BAR;
    PG8_STAMP();
    for (;;) {
        const bool has_next = S.next(ui + 1, nxt);
        const char* nA = has_next ? (const char*)g.A + (size_t)nxt.pm * tstepA + (nxt.pn >= g.nsplit ? ksplitA : 0) : cA; const char* nB = has_next ? (const char*)g.Bt + (size_t)nxt.pn * tstep : cB;
        for (int t = 0; t < nt; t += 2) {
            const bool last = (t == nt - 2);
            const char* a1 = cA + (size_t)(t + 1) * kstep;
            const char* a2 = last ? nA : cA + (size_t)(t + 2) * kstep; const char* b2 = last ? nB : cB + (size_t)(t + 2) * kstep;
            const char* a3 = a2 + kstep; const char* b3 = b2 + kstep;
            if (last && has_next) S.a_ready(nxt);
            PG8_LDB(B0, 0, 0); PG8_SCHED; PG8_LDA(At, 0, 0); PG8_STAGE(PG8_SA(1, 1), a1 + hstepA, voffA);
            PG8_WAIT_L(8); PG8_BAR; PG8_WAIT_L(0); PG8_MMA(0, 0, At, B0); PG8_BAR; PG8_SCHED;
            PG8_LDB(B1, 0, 1); PG8_STAGE(PG8_SB(0, 0), b2, voffB);
            PG8_BAR; PG8_WAIT_L(0); PG8_MMA(0, 1, At, B1); PG8_BAR;
            PG8_LDA(At, 0, 1); PG8_STAGE(PG8_SA(0, 0), a2, voffA);
            PG8_BAR; PG8_WAIT_L(0); PG8_MMA(1, 0, At, B0); PG8_BAR; PG8_SCHED;
            PG8_STAGE(PG8_SB(0, 1), b2 + hstep, voffB);
            PG8_WAIT_V(6); PG8_BAR; PG8_MMA(1, 1, At, B1); PG8_BAR;
            PG8_LDB(B0, 1, 0); PG8_SCHED; PG8_LDA(At, 1, 0); PG8_STAGE(PG8_SA(0, 1), a2 + hstepA, voffA);
            PG8_WAIT_L(8); PG8_BAR; PG8_WAIT_L(0); PG8_MMA(0, 0, At, B0); PG8_BAR; PG8_SCHED;
            PG8_LDB(B1, 1, 1); PG8_STAGE(PG8_SB(1, 0), b3, voffB);
            PG8_BAR; PG8_WAIT_L(0); PG8_MMA(0, 1, At, B1); PG8_BAR;
            PG8_LDA(At, 1, 1); PG8_STAGE(PG8_SA(1, 0), a3, voffA);
            PG8_BAR; PG8_WAIT_L(0); PG8_MMA(1, 0, At, B0); PG8_BAR; PG8_SCHED;
            PG8_STAGE(PG8_SB(1, 1), b3 + hstep, voffB);
            PG8_WAIT_V(6); PG8_BAR; PG8_MMA(1, 1, At, B1); PG8_BAR;
        }
        PG8_STAMP();
        if constexpr (!Epi::AFTER_DRAIN) { E(acc, cur, wr, wc, fr, fq); S.done(cur); }
        PG8_STAMP();
        if (!has_next) break;
#pragma unroll
        for (int a = 0; a < 2; ++a)
#pragma unroll
            for (int b = 0; b < 2; ++b)
#pragma unroll
                for (int m = 0; m < 4; ++m)
#pragma unroll
                    for (int n = 0; n < 2; ++n) acc[a][b][m][n] = (f32x4){0.f, 0.f, 0.f, 0.f};
        cur = nxt; cA = nA; cB = nB; ++ui;
    }
    PG8_WAIT_V(0);
    if (wr == 0) PG8_BAR;
    PG8_BAR;
    if constexpr (Epi::AFTER_DRAIN) { E.fused(acc, cur, wr, wc, fr, fq, lds, wid, lane); S.done(cur); }
    PG8_STAMP();
    if (STAMP && wid == 0) { stamps[lane] = lane < nts ? (((unsigned long long)(unsigned)ts_hi << 32) | (unsigned)ts_lo) : 0ull;
        if (lane == 62) stamps[62] = rt_entry; if (lane == 63) stamps[63] = (unsigned long long)wall_clock64(); }
#undef PG8_STAMP
#undef PG8_SA
#undef PG8_SB
#undef PG8_STAGE
#undef PG8_LDA
#undef PG8_LDB
#undef PG8_MMA
#undef PG8_WAIT_V
#undef PG8_WAIT_L
#undef PG8_BAR
#undef PG8_SCHED
}
}
struct EpiProj {
  static constexpr bool PERM = false, AFTER_DRAIN = false;
  float* projABC; float* pdraw; int col0;
  __device__ __forceinline__ void operator()(const pg8::f32x4 (&acc)[2][2][4][2], const pg8::Unit& u, int wr, int wc, int fr, int fq) const {
#pragma unroll
    for (int ai = 0; ai < 2; ++ai)
#pragma unroll
      for (int m = 0; m < 4; ++m) {
        const int r = u.pm * 256 + ai * 128 + wr * 64 + m * 16 + fr;
#pragma unroll
        for (int bj = 0; bj < 2; ++bj)
#pragma unroll
          for (int n = 0; n < 2; ++n) {
            const int cp = col0 + u.pn * 256 + bj * 128 + wc * 32 + n * 16 + fq * 4;
            const int c = cp < 768 ? cp : (cp < 4000 ? cp + 256 : (cp < 4096 ? PIN : cp - 3328));
            if (c < NABC) *(pg8::f32x4*)(projABC + (size_t)r * NABC + c) = acc[ai][bj][m][n];
            else if (c < PIN) *(pg8::f32x4*)(pdraw + (size_t)r * NPD + (c - NABC)) = acc[ai][bj][m][n];
          }
      }
  }
};
struct EpiRes {
  static constexpr bool PERM = false, AFTER_DRAIN = false;
  float* out; const float* xp; const float* xs; const float* gate;
  __device__ __forceinline__ void operator()(const pg8::f32x4 (&acc)[2][2][4][2], const pg8::Unit& u, int wr, int wc, int fr, int fq) const {
#pragma unroll
    for (int ai = 0; ai < 2; ++ai)
#pragma unroll
      for (int m = 0; m < 4; ++m) {
        const int r = u.pm * 256 + ai * 128 + wr * 64 + m * 16 + fr;
        int gs, T, ci; tok_info(r, gs, T, ci);
        const float* xr = (r < 4096) ? xp + (size_t)r * DM : xs + (size_t)(r - 4096) * DM;
        const float* gr = gate + (size_t)ci * 6144;
#pragma unroll
        for (int bj = 0; bj < 2; ++bj)
#pragma unroll
          for (int n = 0; n < 2; ++n) {
            const int c = u.pn * 256 + bj * 128 + wc * 32 + n * 16 + fq * 4;
            const pg8::f32x4 x = *(const pg8::f32x4*)(xr + c), g = *(const pg8::f32x4*)(gr + c);
            *(pg8::f32x4*)(out + (size_t)r * DM + c) = x * ALPHA + g * acc[ai][bj][m][n];
          }
      }
  }
};
struct EpiResSplit {
  static constexpr bool PERM = false, AFTER_DRAIN = false;
  float* out; float* tmp; const float* gate;
  __device__ __forceinline__ void operator()(const pg8::f32x4 (&acc)[2][2][4][2], const pg8::Unit& u, int wr, int wc, int fr, int fq) const {
    const bool second = u.pn >= 4; const int pn = u.pn & 3;
#pragma unroll
    for (int ai = 0; ai < 2; ++ai)
#pragma unroll
      for (int m = 0; m < 4; ++m) {
        const int r = u.pm * 256 + ai * 128 + wr * 64 + m * 16 + fr;
        int gs, T, ci; tok_info(r, gs, T, ci);
        const float* gr = gate + (size_t)ci * 6144;
#pragma unroll
        for (int bj = 0; bj < 2; ++bj)
#pragma unroll
          for (int n = 0; n < 2; ++n) {
            const int c = pn * 256 + bj * 128 + wc * 32 + n * 16 + fq * 4;
            if (second) *(pg8::f32x4*)(tmp + (size_t)r * DM + c) = acc[ai][bj][m][n];
            else { const pg8::f32x4 x = *(const pg8::f32x4*)(out + (size_t)r * DM + c), g4 = *(const pg8::f32x4*)(gr + c);
                   *(pg8::f32x4*)(out + (size_t)r * DM + c) = x * ALPHA + g4 * acc[ai][bj][m][n]; }
          }
      }
  }
};
struct EpiFF1 {
  static constexpr bool PERM = true, AFTER_DRAIN = false;
  bf16_t* hidden;
  __device__ __forceinline__ void operator()(const pg8::f32x4 (&acc)[2][2][4][2], const pg8::Unit& u, int wr, int wc, int fr, int fq) const {
#pragma unroll
    for (int ai = 0; ai < 2; ++ai)
#pragma unroll
      for (int m = 0; m < 4; ++m) {
        const int r = u.pm * 256 + ai * 128 + wr * 64 + m * 16 + fr;
#pragma unroll
        for (int bj = 0; bj < 2; ++bj) {
          const int c = u.pn * 256 + bj * 128 + wc * 32 + fq * 8;
          pg8::f32x4 v0 = acc[ai][bj][m][0], v1 = acc[ai][bj][m][1];
#pragma unroll
          for (int e = 0; e < 4; ++e) { v0[e] = fmaxf(v0[e], 0.f); v0[e] *= v0[e]; v1[e] = fmaxf(v1[e], 0.f); v1[e] *= v1[e]; }
          uint4 o; o.x = pack2(v0[0], v0[1]); o.y = pack2(v0[2], v0[3]); o.z = pack2(v1[0], v1[1]); o.w = pack2(v1[2], v1[3]);
          *(uint4*)(hidden + (size_t)r * DFF + c) = o;
        }
      }
  }
};
template <class Epi>
DEV void phase_gemm(const bf16_t* A, const bf16_t* Bt, int N, int K, const Epi& E, char* smem, int lda = 0, int nsplit = 1 << 20, int G = 0) {
  pg8::Gemm g; g.A = A; g.Bt = Bt; g.M = NTOK; g.N = N; g.K = K; g.lda = lda ? lda : K; g.nsplit = nsplit;
  pg8::StaticOrder S; S.init(NTOK, N, G ? G : (int)gridDim.x, (int)blockIdx.x);
  pg8::gemm_phase<Epi, pg8::StaticOrder, false>((PG8_LAS unsigned char*)smem, g, S, E, nullptr);
}

DEV float shiftmix(const float* __restrict__ pd, int g, int col, bool hp, bool hn, float mu) {
  const float x = pd[(size_t)g * NPD + col];
  const float xp = hp ? pd[(size_t)(g - 1) * NPD + col] : 0.f;
  const float xn = hn ? pd[(size_t)(g + 1) * NPD + col] : 0.f;
  return x + mu * (0.5f * (xp + xn) - x);
}
DEV void rwkv_prep_item(const Params& P, int l, int tile, int part, char* smem, const int tid_in) {
  const int tid = opaque_i(tid_in);
  const int lane = tid & 63, w = tid >> 6;
  const int g0 = tile * 64;
  int gs, T, ci; tok_info(g0, gs, T, ci);
  const float* mu = P.rwkv_mu + l * NPD;
  const float* __restrict__ pd = P.pdraw;
  float* __restrict__ rkvp = P.rkv;
  if (part == 0) {
#pragma unroll 4
    for (int idx = tid; idx < 64 * 128; idx += 256) {
      const int row = idx >> 7, c4 = (idx & 127) * 4;
      const int col = c4 < 256 ? c4 : (c4 + 256);
      const int g = g0 + row; const bool hp = g > gs, hn = g + 1 < gs + T;
      const float4 x = *(const float4*)(pd + (size_t)g * NPD + col);
      float4 xp = make_float4(0, 0, 0, 0), xn = make_float4(0, 0, 0, 0);
      if (hp) xp = *(const float4*)(pd + (size_t)(g - 1) * NPD + col);
      if (hn) xn = *(const float4*)(pd + (size_t)(g + 1) * NPD + col);
      const float4 m4 = *(const float4*)(mu + col);
      float4 o;
      o.x = x.x + m4.x * (0.5f * (xp.x + xn.x) - x.x); o.y = x.y + m4.y * (0.5f * (xp.y + xn.y) - x.y);
      o.z = x.z + m4.z * (0.5f * (xp.z + xn.z) - x.z); o.w = x.w + m4.w * (0.5f * (xp.w + xn.w) - x.w);
      *(float4*)(rkvp + (size_t)g * 768 + col) = o;
    }
    { const int cgk = tid & 63, qt = tid >> 6; const int col = 256 + cgk * 4;
      const float4 m4 = *(const float4*)(mu + col);
      const float4 kk = *(const float4*)(P.rwkv_kk + l * 256 + cgk * 4);
#pragma unroll 4
      for (int i = 0; i < 16; ++i) {
        const int g = g0 + qt * 16 + i; const bool hp = g > gs, hn = g + 1 < gs + T;
        const float4 x = *(const float4*)(pd + (size_t)g * NPD + col);
        float4 xp = make_float4(0, 0, 0, 0), xn = make_float4(0, 0, 0, 0);
        if (hp) xp = *(const float4*)(pd + (size_t)(g - 1) * NPD + col);
        if (hn) xn = *(const float4*)(pd + (size_t)(g + 1) * NPD + col);
        float4 o;
        o.x = x.x + m4.x * (0.5f * (xp.x + xn.x) - x.x); o.y = x.y + m4.y * (0.5f * (xp.y + xn.y) - x.y);
        o.z = x.z + m4.z * (0.5f * (xp.z + xn.z) - x.z); o.w = x.w + m4.w * (0.5f * (xp.w + xn.w) - x.w);
        *(float4*)(rkvp + (size_t)g * 768 + col) = o;
        const float ss = red16((o.x * kk.x) * (o.x * kk.x) + (o.y * kk.y) * (o.y * kk.y) + (o.z * kk.z) * (o.z * kk.z) + (o.w * kk.w) * (o.w * kk.w));
        if ((cgk & 15) == 0) P.khinv[g * 4 + (cgk >> 4)] = rsqrtf(ss + 1e-6f);
      }
    }
    return;
  }
  const bool isg = part == 5;
  const int KK = isg ? 128 : 64;
  const int lda = KK + 8;
  int z = 0, kind = 0;
  if (!isg) { const int p = part - 1; z = p >> 1; kind = p & 1; }
  const int acol0 = isg ? 1024 : (768 + kind * 128 + z * 64);
  bf16_t* sA = (bf16_t*)smem;
  {
    const int nq = KK >> 2;
    for (int idx = tid; idx < 64 * nq; idx += 256) {
      const int row = idx / nq, r = (idx % nq) * 4; const int g = g0 + row;
      const bool hp = g > gs, hn = g + 1 < gs + T;
      const float* px = pd + (size_t)g * NPD + acol0 + r;
      const float4 x = *(const float4*)px;
      float4 xp = make_float4(0, 0, 0, 0), xn = make_float4(0, 0, 0, 0);
      if (hp) xp = *(const float4*)(px - NPD);
      if (hn) xn = *(const float4*)(px + NPD);
      const float4 m4 = *(const float4*)(mu + acol0 + r);
      float v0 = x.x + m4.x * (0.5f * (xp.x + xn.x) - x.x), v1 = x.y + m4.y * (0.5f * (xp.y + xn.y) - x.y);
      float v2 = x.z + m4.z * (0.5f * (xp.z + xn.z) - x.z), v3 = x.w + m4.w * (0.5f * (xp.w + xn.w) - x.w);
      if (isg) { v0 = sigmoidf_(v0); v1 = sigmoidf_(v1); v2 = sigmoidf_(v2); v3 = sigmoidf_(v3); }
      else if (kind == 0) { v0 = tanhf(v0); v1 = tanhf(v1); v2 = tanhf(v2); v3 = tanhf(v3); }
      uint2 o; o.x = pack2(v0, v1); o.y = pack2(v2, v3);
      *(uint2*)(sA + row * lda + r) = o;
    }
  }
  const bf16_t* Bt = isg ? (P.g2t + (size_t)l * 256 * 128) : ((kind == 0 ? P.w2t : P.a2t) + (size_t)(l * 2 + z) * 256 * 64);
  __syncthreads();
#pragma unroll 1
  for (int half = 0; half < 2; ++half) {
  const bf16_t* bp = Bt + (size_t)(half * 128 + w * 32 + (lane & 31)) * KK + (lane >> 5) * 8;
  f32x16 acc[2] = {zero16(), zero16()};
  for (int s = 0; s < KK / 16; ++s) {
    const bf16x8 b = *(const bf16x8*)(bp + s * 16);
#pragma unroll
    for (int mi = 0; mi < 2; ++mi) {
      const bf16x8 a = *(const bf16x8*)(sA + (mi * 32 + (lane & 31)) * lda + s * 16 + (lane >> 5) * 8);
      acc[mi] = __builtin_amdgcn_mfma_f32_32x32x16_bf16(a, b, acc[mi], 0, 0, 0);
    }
  }
  const int c = half * 128 + w * 32 + (lane & 31);
  float bias = 0.f;
  if (!isg) bias = (kind == 0 ? P.rwkv_w0 : P.rwkv_a0)[(l * 2 + z) * 256 + c];
#pragma unroll
  for (int mi = 0; mi < 2; ++mi)
#pragma unroll
    for (int idx = 0; idx < 16; ++idx) {
      const int row = mi * 32 + (idx & 3) + 8 * (idx >> 2) + 4 * (lane >> 5);
      const int g = g0 + row;
      const float v = acc[mi][idx];
      if (isg) P.gbuf[(size_t)g * 256 + c] = f2bf(v);
      else {
        const float sg = sigmoidf_(v + bias);
        P.wa[((size_t)(g * 2 + z) * 2 + kind) * 256 + c] = (kind == 0) ? __expf(-0.60653065971f * sg) : sg;
      }
    }
  }
  __syncthreads();
}

DEV float4 dp_load(const float* base, int g, int gs, int T) { float4 r = make_float4(0.f, 0.f, 0.f, 0.f); if (g >= gs && g < gs + T) r = *(const float4*)(base + (size_t)g * NABC); return r; }
DEV void delta_prep_item(const Params& P, int l, int tile, int X, const int tid_in) {
  const int tid = opaque_i(tid_in);
  const int cg = tid & 63, qt = tid >> 6;
  const int g0 = tile * 64 + qt * 16;
  int gs, T, ci; tok_info(g0, gs, T, ci);
  const int col = X * 256 + cg * 4;
  const float* cw = P.delta_conv + (size_t)l * 5 * 768 + col;
  const float4 w0 = *(const float4*)cw, w1 = *(const float4*)(cw + 768), w2 = *(const float4*)(cw + 2 * 768), w3 = *(const float4*)(cw + 3 * 768), w4 = *(const float4*)(cw + 4 * 768);
  const float* base = P.projABC + 1040 + col;
#define DP_LOAD(G) dp_load(base, (G), gs, T)
  float4 xm2 = DP_LOAD(g0 - 2), xm1 = DP_LOAD(g0 - 1), x0 = DP_LOAD(g0), xp1 = DP_LOAD(g0 + 1);
#pragma unroll 4
  for (int i = 0; i < 16; ++i) {
    const int g = g0 + i;
    const float4 xp2 = DP_LOAD(g + 2);
    float4 a;
    a.x = xm2.x * w0.x + xm1.x * w1.x + x0.x * w2.x + xp1.x * w3.x + xp2.x * w4.x;
    a.y = xm2.y * w0.y + xm1.y * w1.y + x0.y * w2.y + xp1.y * w3.y + xp2.y * w4.y;
    a.z = xm2.z * w0.z + xm1.z * w1.z + x0.z * w2.z + xp1.z * w3.z + xp2.z * w4.z;
    a.w = xm2.w * w0.w + xm1.w * w1.w + x0.w * w2.w + xp1.w * w3.w + xp2.w * w4.w;
    a.x = siluf_(a.x); a.y = siluf_(a.y); a.z = siluf_(a.z); a.w = siluf_(a.w);
    float sc = 1.f;
    if (X < 2) { const float ss = red16(a.x * a.x + a.y * a.y + a.z * a.z + a.w * a.w); sc = rsqrtf(ss + 1e-6f) * (X == 0 ? 0.125f : 1.f); }
    uint2 o; o.x = pack2(a.x * sc, a.y * sc); o.y = pack2(a.z * sc, a.w * sc);
    *(uint2*)(P.ubuf + (size_t)g * 768 + col) = o;
    xm2 = xm1; xm1 = x0; x0 = xp1; xp1 = xp2;
  }
#undef DP_LOAD
}

DEV void load16(const float* __restrict__ p, float* v) {
#pragma unroll
  for (int e = 0; e < 4; ++e) { const float4 t = *(const float4*)(p + 4 * e); v[4 * e] = t.x; v[4 * e + 1] = t.y; v[4 * e + 2] = t.z; v[4 * e + 3] = t.w; }
}
DEV void store_row16(bf16_t* dst, const float* v) {
  uint4 a, b;
  a.x = pack2(v[0], v[1]); a.y = pack2(v[2], v[3]); a.z = pack2(v[4], v[5]); a.w = pack2(v[6], v[7]);
  b.x = pack2(v[8], v[9]); b.y = pack2(v[10], v[11]); b.z = pack2(v[12], v[13]); b.w = pack2(v[14], v[15]);
  *(uint4*)dst = a; *(uint4*)(dst + 8) = b;
}
DEV void decode_chain(int task, int& seq, int& h, bool& sample) {
  if (task < 8) { sample = true; seq = 16 + (task >> 2); h = task & 3; }
  else { const int t = task - 8; sample = false; seq = t >> 2; h = t & 3; }
}
DEV void seq_base(int seq, int& gs, int& T) { if (seq < 16) { gs = seq * 256; T = 256; } else { gs = 4096 + (seq - 16) * 2048; T = 2048; } }
DEV float wave_incl_scan_add(float x, int lane) {
#pragma unroll
  for (int o = 1; o < 64; o <<= 1) { const float y = __shfl_up(x, o); if (lane >= o) x += y; }
  return x;
}
DEV float wave_incl_scan_max(float x, int lane) {
#pragma unroll
  for (int o = 1; o < 64; o <<= 1) { const float y = __shfl_up(x, o); if (lane >= o) x = fmaxf(x, y); }
  return x;
}

DEV void ret_task(const Params& P, int l, int task, const int z, char* smem, const int tid_in, const bool active) {
  const int tid = opaque_i(tid_in);
  const int lane = tid & 63, w = tid >> 6, wr = w >> 1, wc = w & 1;
  int seq, h; bool sample; decode_chain(task, seq, h, sample);
  int gs, T; seq_base(seq, gs, T);
  if (!active) { for (int c = 0; c < T / 64; ++c) { __syncthreads(); __syncthreads(); __syncthreads(); } return; }
  bf16_t* sQ = (bf16_t*)smem; bf16_t* sK = sQ + 64 * LDB; bf16_t* sKzt = sK + 64 * LDB; bf16_t* sVt = sKzt + 64 * LDB; bf16_t* sP = sVt + 64 * LDB; bf16_t* sSt = sP + 64 * LDB;
  const float lg = -__expf(P.ret_decay[(l * 2 + z) * 4 + h]);
  const float gl = __expf(64.f * lg);
  f32x16 st = zero16();
  if (sample) {
    const float* s0 = P.st_ret + ((size_t)(((seq - 16) * 2 + l) * 2 + z) * 4 + h) * 4096;
#pragma unroll
    for (int idx = 0; idx < 16; ++idx) st[idx] = s0[ACC_COL * 64 + ACC_ROW(idx)];
  }
#pragma unroll
  for (int idx = 0; idx < 16; ++idx) sSt[ACC_ROW(idx) * LDB + ACC_COL] = f2bf(st[idx]);
  const int nch = T / 64;
  const int tid_outer = tid;
  float4 nq[4], nk[4], nv[4], nq2[4], nk2[4];
#define RET_PREFETCH(C) { \
    const int r_ = tid_outer & 63, sg_ = (tid_outer >> 6) * 16; \
    const int p_ = (C) * 64 + r_; const int g_ = gs + (z ? (T - 1 - p_) : p_); \
    const float* pr_ = P.projABC + (size_t)g_ * NABC + 2080 + h * 64; \
    _Pragma("unroll") for (int e_ = 0; e_ < 4; ++e_) { nq[e_] = *(const float4*)(pr_ + sg_ + 4 * e_); nk[e_] = *(const float4*)(pr_ + 256 + sg_ + 4 * e_); nv[e_] = *(const float4*)(pr_ + 512 + sg_ + 4 * e_); } \
    if (sample) { _Pragma("unroll") for (int e_ = 0; e_ < 4; ++e_) { nq2[e_] = *(const float4*)(pr_ + (sg_ ^ 16) + 4 * e_); nk2[e_] = *(const float4*)(pr_ + 256 + (sg_ ^ 16) + 4 * e_); } } }
  RET_PREFETCH(0)
  for (int c = 0; c < nch; ++c) {
    const int tid = opaque_i(tid_outer);
    const int lane = tid & 63, w = tid >> 6, wr = w >> 1, wc = w & 1;
    const int row = tid & 63, seg = (tid >> 6) * 16;
    {
      const int p = c * 64 + row; const int t = z ? (T - 1 - p) : p;
      float q[16], k[16], v[16];
#pragma unroll
      for (int e = 0; e < 4; ++e) { q[4 * e] = nq[e].x; q[4 * e + 1] = nq[e].y; q[4 * e + 2] = nq[e].z; q[4 * e + 3] = nq[e].w; k[4 * e] = nk[e].x; k[4 * e + 1] = nk[e].y; k[4 * e + 2] = nk[e].z; k[4 * e + 3] = nk[e].w;
        v[4 * e] = nv[e].x; v[4 * e + 1] = nv[e].y; v[4 * e + 2] = nv[e].z; v[4 * e + 3] = nv[e].w; }
      if (sample) {
        float q2[16], k2[16];
#pragma unroll
        for (int e = 0; e < 4; ++e) { q2[4 * e] = nq2[e].x; q2[4 * e + 1] = nq2[e].y; q2[4 * e + 2] = nq2[e].z; q2[4 * e + 3] = nq2[e].w; k2[4 * e] = nk2[e].x; k2[4 * e + 1] = nk2[e].y; k2[4 * e + 2] = nk2[e].z; k2[4 * e + 3] = nk2[e].w; }
        const float pos = (seg < 32) ? (float)(t >> 6) : (float)(t & 63);
        const bool first = (seg & 16) == 0;
#pragma unroll
        for (int e = 0; e < 16; ++e) {
          const float inv = __expf(-(float)e * (9.210340371976184f / 16.f));
          const float sn = __sinf(pos * inv), cs = __cosf(pos * inv);
          const float qs = first ? -q2[e] : q2[e], ks = first ? -k2[e] : k2[e];
          q[e] = q[e] * cs + qs * sn; k[e] = k[e] * cs + ks * sn;
        }
      }
      const float zeta = __expf((63.f - (float)row) * lg);
      float qq[16];
#pragma unroll
      for (int e = 0; e < 16; ++e) qq[e] = q[e] * 0.125f;
      store_row16(sQ + row * LDB + seg, qq);
      store_row16(sK + row * LDB + seg, k);
#pragma unroll
      for (int e = 0; e < 16; ++e) { sKzt[(seg + e) * LDB + row] = f2bf(k[e] * zeta); sVt[(seg + e) * LDB + row] = f2bf(v[e]); }
    }
    __syncthreads();
    if (c + 1 < nch) RET_PREFETCH(c + 1)
    f32x16 s = mm64(sQ, sK, wr, wc, lane, zero16());
#pragma unroll
    for (int idx = 0; idx < 16; ++idx) {
      const int i = ACC_ROW(idx), j = ACC_COL;
      const float val = (i >= j) ? s[idx] * __expf((float)(i - j) * lg) : 0.f;
      sP[i * LDB + j] = f2bf(val);
    }
    __syncthreads();
    f32x16 o1 = mm64(sP, sVt, wr, wc, lane, zero16());
    f32x16 o2 = mm64(sQ, sSt, wr, wc, lane, zero16());
#pragma unroll
    for (int idx = 0; idx < 16; ++idx) st[idx] *= gl;
    st = mm64(sVt, sKzt, wr, wc, lane, st);
#pragma unroll
    for (int idx = 0; idx < 16; ++idx) {
      const int i = ACC_ROW(idx), e = ACC_COL;
      const float xi = __expf((float)(i + 1) * lg);
      const int pp = c * 64 + i; const int tt = z ? (T - 1 - pp) : pp;
      P.hdir[((size_t)z * NTOK + gs + tt) * DM + 512 + h * 64 + e] = f2bf(o1[idx] + xi * o2[idx]);
    }
    __syncthreads();
#pragma unroll
    for (int idx = 0; idx < 16; ++idx) sSt[ACC_ROW(idx) * LDB + ACC_COL] = f2bf(st[idx]);
  }
  if (!sample) {
    float* o = P.out + O_RET + ((size_t)((seq * 2 + l) * 2 + z) * 4 + h) * 4096;
#pragma unroll
    for (int idx = 0; idx < 16; ++idx) o[ACC_COL * 64 + ACC_ROW(idx)] = st[idx];
  }
}

DEV void ret_sample_task(const Params& P, int l, int task, const int z, char* smem0, const int tid_all_in) {
  const int tid_all = opaque_i(tid_all_in);
  const int half = tid_all >> 8, tid0 = tid_all & 255;
  int seq, h; bool sample; decode_chain(task, seq, h, sample);
  int gs, T; seq_base(seq, gs, T);
  const int nch = T / 64;
  const float lg = -__expf(P.ret_decay[(l * 2 + z) * 4 + h]);
#define RT_SET(B) ((bf16_t*)(smem0 + (B) * HALF_LDS))
  bf16_t* sP = RT_SET(0) + 4 * 64 * LDB; bf16_t* sSt = sP + 64 * LDB;
  if (half == 1) {
    const int tid = tid0;
    float4 nq[4], nk[4], nv[4], nq2[4], nk2[4];
#define RT_PREFETCH(C) { \
      const int r_ = tid & 63, sg_ = (tid >> 6) * 16; \
      const int p_ = (C) * 64 + r_; const int g_ = gs + (z ? (T - 1 - p_) : p_); \
      const float* pr_ = P.projABC + (size_t)g_ * NABC + 2080 + h * 64; \
      _Pragma("unroll") for (int e_ = 0; e_ < 4; ++e_) { nq[e_] = *(const float4*)(pr_ + sg_ + 4 * e_); nk[e_] = *(const float4*)(pr_ + 256 + sg_ + 4 * e_); nv[e_] = *(const float4*)(pr_ + 512 + sg_ + 4 * e_); \
        nq2[e_] = *(const float4*)(pr_ + (sg_ ^ 16) + 4 * e_); nk2[e_] = *(const float4*)(pr_ + 256 + (sg_ ^ 16) + 4 * e_); } }
#define RT_STAGE(C) { \
      bf16_t* sQ = RT_SET((C) & 1); bf16_t* sK = sQ + 64 * LDB; bf16_t* sKzt = sK + 64 * LDB; bf16_t* sVt = sKzt + 64 * LDB; \
      const int row = tid & 63, seg = (tid >> 6) * 16; \
      const int p = (C) * 64 + row; const int t = z ? (T - 1 - p) : p; \
      float q[16], k[16], v[16], q2[16], k2[16]; \
      _Pragma("unroll") for (int e = 0; e < 4; ++e) { q[4 * e] = nq[e].x; q[4 * e + 1] = nq[e].y; q[4 * e + 2] = nq[e].z; q[4 * e + 3] = nq[e].w; k[4 * e] = nk[e].x; k[4 * e + 1] = nk[e].y; k[4 * e + 2] = nk[e].z; k[4 * e + 3] = nk[e].w; \
        v[4 * e] = nv[e].x; v[4 * e + 1] = nv[e].y; v[4 * e + 2] = nv[e].z; v[4 * e + 3] = nv[e].w; \
        q2[4 * e] = nq2[e].x; q2[4 * e + 1] = nq2[e].y; q2[4 * e + 2] = nq2[e].z; q2[4 * e + 3] = nq2[e].w; k2[4 * e] = nk2[e].x; k2[4 * e + 1] = nk2[e].y; k2[4 * e + 2] = nk2[e].z; k2[4 * e + 3] = nk2[e].w; } \
      const float pos = (seg < 32) ? (float)(t >> 6) : (float)(t & 63); \
      const bool first = (seg & 16) == 0; \
      _Pragma("unroll") for (int e = 0; e < 16; ++e) { \
        const float inv = __expf(-(float)e * (9.210340371976184f / 16.f)); \
        const float sn = __sinf(pos * inv), cs = __cosf(pos * inv); \
        const float qs = first ? -q2[e] : q2[e], ks = first ? -k2[e] : k2[e]; \
        q[e] = (q[e] * cs + qs * sn) * 0.125f; k[e] = k[e] * cs + ks * sn; } \
      const float zeta = __expf((63.f - (float)row) * lg); \
      store_row16(sQ + row * LDB + seg, q); \
      store_row16(sK + row * LDB + seg, k); \
      _Pragma("unroll") for (int e = 0; e < 16; ++e) { sKzt[(seg + e) * LDB + row] = f2bf(k[e] * zeta); sVt[(seg + e) * LDB + row] = f2bf(v[e]); } }
    RT_PREFETCH(0)
    RT_STAGE(0)
    if (nch > 1) RT_PREFETCH(1)
    __syncthreads();
    for (int c = 0; c < nch; ++c) {
      if (c + 1 < nch) { RT_STAGE(c + 1) if (c + 2 < nch) RT_PREFETCH(c + 2) }
      __syncthreads(); __syncthreads(); __syncthreads();
    }
#undef RT_PREFETCH
#undef RT_STAGE
  } else {
    __builtin_amdgcn_s_setprio(3);
    const int tid = tid0;
    const int lane = tid & 63, w = tid >> 6, wr = w >> 1, wc = w & 1;
    const float gl = __expf(64.f * lg);
    f32x16 st = zero16();
    {
      const float* s0 = P.st_ret + ((size_t)(((seq - 16) * 2 + l) * 2 + z) * 4 + h) * 4096;
#pragma unroll
      for (int idx = 0; idx < 16; ++idx) st[idx] = s0[ACC_COL * 64 + ACC_ROW(idx)];
    }
#pragma unroll
    for (int idx = 0; idx < 16; ++idx) sSt[ACC_ROW(idx) * LDB + ACC_COL] = f2bf(st[idx]);
    __syncthreads();
    for (int c = 0; c < nch; ++c) {
      const bf16_t* sQ = RT_SET(c & 1); const bf16_t* sK = sQ + 64 * LDB; const bf16_t* sKzt = sK + 64 * LDB; const bf16_t* sVt = sKzt + 64 * LDB;
      f32x16 s = mm64(sQ, sK, wr, wc, lane, zero16());
#pragma unroll
      for (int idx = 0; idx < 16; ++idx) {
        const int i = ACC_ROW(idx), j = ACC_COL;
        const float val = (i >= j) ? s[idx] * __expf((float)(i - j) * lg) : 0.f;
        sP[i * LDB + j] = f2bf(val);
      }
      __syncthreads();
      f32x16 o1 = mm64(sP, sVt, wr, wc, lane, zero16());
      f32x16 o2 = mm64(sQ, sSt, wr, wc, lane, zero16());
#pragma unroll
      for (int idx = 0; idx < 16; ++idx) st[idx] *= gl;
      st = mm64(sVt, sKzt, wr, wc, lane, st);
#pragma unroll
      for (int idx = 0; idx < 16; ++idx) {
        const int i = ACC_ROW(idx), e = ACC_COL;
        const float xi = __expf((float)(i + 1) * lg);
        const int pp = c * 64 + i; const int tt = z ? (T - 1 - pp) : pp;
        P.hdir[((size_t)z * NTOK + gs + tt) * DM + 512 + h * 64 + e] = f2bf(o1[idx] + xi * o2[idx]);
      }
      __syncthreads();
#pragma unroll
      for (int idx = 0; idx < 16; ++idx) sSt[ACC_ROW(idx) * LDB + ACC_COL] = f2bf(st[idx]);
      __syncthreads();
    }
  }
  __builtin_amdgcn_s_setprio(0);
#undef RT_SET
}

DEV void mlstm_task(const Params& P, int l, int task, const int z, char* smem, const int tid_in, const bool active) {
  const int tid = opaque_i(tid_in);
  const int lane = tid & 63, w = tid >> 6, wr = w >> 1, wc = w & 1;
  int seq, h; bool sample; decode_chain(task, seq, h, sample);
  int gs, T; seq_base(seq, gs, T);
  if (!active) { for (int c = 0; c < T / 64; ++c) { __syncthreads(); __syncthreads(); __syncthreads(); } return; }
  bf16_t* sQ = (bf16_t*)smem; bf16_t* sK = sQ + 64 * LDB; bf16_t* sKt = sK + 64 * LDB; bf16_t* sVt = sKt + 64 * LDB; bf16_t* sP = sVt + 64 * LDB; bf16_t* sCt = sP + 64 * LDB;
  float* fs = (float*)(sCt + 64 * LDB);
  float* s_gate = fs; float* s_nn = fs + 640;
  const int sidx = sample ? ((((seq - 16) * 2 + l) * 2 + z) * 4 + h) : 0;
  f32x16 st = zero16();
  if (sample) {
    const float* c0 = P.st_C + (size_t)sidx * 4096;
#pragma unroll
    for (int idx = 0; idx < 16; ++idx) st[idx] = c0[ACC_COL * 64 + ACC_ROW(idx)];
  }
#pragma unroll
  for (int idx = 0; idx < 16; ++idx) sCt[ACC_ROW(idx) * LDB + ACC_COL] = f2bf(st[idx]);
  if (tid < 64) s_nn[tid] = sample ? P.st_n[sidx * 64 + tid] : 0.f;
  float m = sample ? P.st_m[sidx] : 0.f;
  const float ib = P.mlstm_i_bias[(l * 2 + z) * 4 + h], fb = P.mlstm_f_bias[(l * 2 + z) * 4 + h];
  const int nch = T / 64;
  const int tid_outer = tid;
  float4 nq[4], nk[4], nv[4]; float ngi, ngf;
#define MLSTM_PREFETCH(C) { \
    const int r_ = tid_outer & 63, sg_ = (tid_outer >> 6) * 16; \
    const int p_ = (C) * 64 + r_; const int g_ = gs + (z ? (T - 1 - p_) : p_); \
    const float* pr_ = P.projABC + (size_t)g_ * NABC + h * 64; \
    _Pragma("unroll") for (int e_ = 0; e_ < 4; ++e_) { nq[e_] = *(const float4*)(pr_ + sg_ + 4 * e_); nk[e_] = *(const float4*)(pr_ + 256 + sg_ + 4 * e_); nv[e_] = *(const float4*)(pr_ + 512 + sg_ + 4 * e_); } \
    const float* gp_ = P.projABC + (size_t)g_ * NABC + 1024 + z * 4 + h; ngi = gp_[0]; ngf = gp_[8]; }
  MLSTM_PREFETCH(0)
  for (int c = 0; c < nch; ++c) {
    const int tid = opaque_i(tid_outer);
    const int lane = tid & 63, w = tid >> 6, wr = w >> 1, wc = w & 1;
    const int row = tid & 63, seg = (tid >> 6) * 16;
    const int par = c & 1;
    float* s_a = s_gate + par * 320; float* s_b = s_a + 64; float* s_M = s_a + 128; float* s_ew = s_a + 192; float* s_dinv = s_a + 256;
    float* s_n = s_nn + par * 64; float* s_n2 = s_nn + (par ^ 1) * 64;
    float sp;
    {
      const float li = ngi + ib, lf = logsigmoidf_(ngf + fb);
      const float b = wave_incl_scan_add(lf, lane);
      const float a = li - b;
      const float cm = wave_incl_scan_max(a, lane);
      const float M = fmaxf(m, cm);
      const float M63 = __shfl(M, 63), bl = __shfl(b, 63);
      const float skj = __expf(a - M63);
      sp = __expf(m - M63);
      if (w == 0) { s_a[lane] = a; s_b[lane] = b; s_M[lane] = M; s_ew[lane] = __expf(m - M); }
      m = bl + M63;
      float q[16], k[16], v[16];
#pragma unroll
      for (int e = 0; e < 4; ++e) { q[4 * e] = nq[e].x; q[4 * e + 1] = nq[e].y; q[4 * e + 2] = nq[e].z; q[4 * e + 3] = nq[e].w;
        k[4 * e] = nk[e].x * 0.125f; k[4 * e + 1] = nk[e].y * 0.125f; k[4 * e + 2] = nk[e].z * 0.125f; k[4 * e + 3] = nk[e].w * 0.125f;
        v[4 * e] = nv[e].x; v[4 * e + 1] = nv[e].y; v[4 * e + 2] = nv[e].z; v[4 * e + 3] = nv[e].w; }
      store_row16(sQ + row * LDB + seg, q);
      store_row16(sK + row * LDB + seg, k);
#pragma unroll
      for (int e = 0; e < 16; ++e) { sKt[(seg + e) * LDB + row] = f2bf(k[e] * skj); sVt[(seg + e) * LDB + row] = f2bf(v[e]); }
    }
    __syncthreads();
    f32x16 s = mm64(sQ, sK, wr, wc, lane, zero16());
#pragma unroll
    for (int idx = 0; idx < 16; ++idx) {
      const int i = ACC_ROW(idx), j = ACC_COL;
      const float val = (i >= j) ? s[idx] * __expf(s_a[j] - s_M[i]) : 0.f;
      sP[i * LDB + j] = f2bf(val);
    }
    __syncthreads();
    if (c + 1 < nch) MLSTM_PREFETCH(c + 1)
    f32x16 o1 = mm64(sP, sVt, wr, wc, lane, zero16());
    f32x16 o2 = mm64(sQ, sCt, wr, wc, lane, zero16());
    {
      const int r4 = tid >> 2, sg4 = (tid & 3) * 16;
      float rs = 0.f, qn = 0.f;
#pragma unroll
      for (int e = 0; e < 16; ++e) { rs += bf2f(sP[r4 * LDB + sg4 + e]); qn += bf2f(sQ[r4 * LDB + sg4 + e]) * s_n[sg4 + e]; }
      rs = red4(rs); qn = red4(qn);
      const float den = rs + qn * s_ew[r4];
      const float mt = s_b[r4] + s_M[r4];
      if ((tid & 3) == 0) s_dinv[r4] = 1.f / fmaxf(fabsf(den), __expf(-mt));
    }
#pragma unroll
    for (int idx = 0; idx < 16; ++idx) st[idx] *= sp;
    st = mm64(sVt, sKt, wr, wc, lane, st);
    if (tid < 64) {
      float a = s_n[tid] * sp;
      for (int j = 0; j < 64; ++j) a += bf2f(sKt[tid * LDB + j]);
      s_n2[tid] = a;
    }
    __syncthreads();
#pragma unroll
    for (int idx = 0; idx < 16; ++idx) {
      const int i = ACC_ROW(idx), e = ACC_COL;
      const int pp = c * 64 + i; const int tt = z ? (T - 1 - pp) : pp;
      P.hdir[((size_t)z * NTOK + gs + tt) * DM + h * 64 + e] = f2bf((o1[idx] + s_ew[i] * o2[idx]) * s_dinv[i]);
    }
#pragma unroll
    for (int idx = 0; idx < 16; ++idx) sCt[ACC_ROW(idx) * LDB + ACC_COL] = f2bf(st[idx]);
  }
  if (!sample) {
    const int oi = ((seq * 2 + l) * 2 + z) * 4 + h;
    float* o = P.out + O_C + (size_t)oi * 4096;
#pragma unroll
    for (int idx = 0; idx < 16; ++idx) o[ACC_COL * 64 + ACC_ROW(idx)] = st[idx];
    __syncthreads();
    if (tid < 64) P.out[O_N + oi * 64 + tid] = s_nn[(nch & 1) * 64 + tid];
    if (tid == 0) P.out[O_M + oi] = m;
  }
}

DEV void mlstm_sample_task(const Params& P, int l, int task, const int z, char* smem0, const int tid_all_in) {
  const int tid_all = opaque_i(tid_all_in);
  const int half = tid_all >> 8, tid = tid_all & 255;
  int seq, h; bool sample; decode_chain(task, seq, h, sample);
  int gs, T; seq_base(seq, gs, T);
  const int nch = T / 64;
  const int sidx = (((seq - 16) * 2 + l) * 2 + z) * 4 + h;
#define ML_SET(B) ((bf16_t*)(smem0 + (B) * HALF_LDS))
#define ML_GATE(B) ((float*)(smem0 + (B) * HALF_LDS + 4 * 64 * LDB * 2))
  bf16_t* sP = (bf16_t*)(smem0 + 4 * 64 * LDB * 2 + 2048); bf16_t* sCt = sP + 64 * LDB;
  float* s_dinv = (float*)(sCt + 64 * LDB); float* s_nn = s_dinv + 64;
  if (half == 1) {
    const int lane = tid & 63, w = tid >> 6;
    float m = P.st_m[sidx];
    const float ib = P.mlstm_i_bias[(l * 2 + z) * 4 + h], fb = P.mlstm_f_bias[(l * 2 + z) * 4 + h];
    float4 nq[4], nk[4], nv[4]; float ngi, ngf;
#define ML_PREFETCH(C) { \
      const int r_ = tid & 63, sg_ = (tid >> 6) * 16; \
      const int p_ = (C) * 64 + r_; const int g_ = gs + (z ? (T - 1 - p_) : p_); \
      const float* pr_ = P.projABC + (size_t)g_ * NABC + h * 64; \
      _Pragma("unroll") for (int e_ = 0; e_ < 4; ++e_) { nq[e_] = *(const float4*)(pr_ + sg_ + 4 * e_); nk[e_] = *(const float4*)(pr_ + 256 + sg_ + 4 * e_); nv[e_] = *(const float4*)(pr_ + 512 + sg_ + 4 * e_); } \
      const float* gp_ = P.projABC + (size_t)g_ * NABC + 1024 + z * 4 + h; ngi = gp_[0]; ngf = gp_[8]; }
#define ML_STAGE(C) { \
      bf16_t* sQ = ML_SET((C) & 1); bf16_t* sK = sQ + 64 * LDB; bf16_t* sKt = sK + 64 * LDB; bf16_t* sVt = sKt + 64 * LDB; \
      float* gt_ = ML_GATE((C) & 1); \
      const int row = tid & 63, seg = (tid >> 6) * 16; \
      const float li = ngi + ib, lf = logsigmoidf_(ngf + fb); \
      const float b = wave_incl_scan_add(lf, lane); \
      const float a = li - b; \
      const float cm = wave_incl_scan_max(a, lane); \
      const float M = fmaxf(m, cm); \
      const float M63 = __shfl(M, 63), bl = __shfl(b, 63); \
      const float skj = __expf(a - M63); \
      if (w == 0) { gt_[lane] = a; gt_[64 + lane] = b; gt_[128 + lane] = M; gt_[192 + lane] = __expf(m - M); if (lane == 0) gt_[256] = __expf(m - M63); } \
      m = bl + M63; \
      float q[16], k[16], v[16]; \
      _Pragma("unroll") for (int e = 0; e < 4; ++e) { q[4 * e] = nq[e].x; q[4 * e + 1] = nq[e].y; q[4 * e + 2] = nq[e].z; q[4 * e + 3] = nq[e].w; \
        k[4 * e] = nk[e].x * 0.125f; k[4 * e + 1] = nk[e].y * 0.125f; k[4 * e + 2] = nk[e].z * 0.125f; k[4 * e + 3] = nk[e].w * 0.125f; \
        v[4 * e] = nv[e].x; v[4 * e + 1] = nv[e].y; v[4 * e + 2] = nv[e].z; v[4 * e + 3] = nv[e].w; } \
      store_row16(sQ + row * LDB + seg, q); \
      store_row16(sK + row * LDB + seg, k); \
      _Pragma("unroll") for (int e = 0; e < 16; ++e) { sKt[(seg + e) * LDB + row] = f2bf(k[e] * skj); sVt[(seg + e) * LDB + row] = f2bf(v[e]); } }
    ML_PREFETCH(0)
    ML_STAGE(0)
    if (nch > 1) ML_PREFETCH(1)
    __syncthreads();
    for (int c = 0; c < nch; ++c) {
      if (c + 1 < nch) { ML_STAGE(c + 1) if (c + 2 < nch) ML_PREFETCH(c + 2) }
      __syncthreads(); __syncthreads(); __syncthreads();
    }
#undef ML_PREFETCH
#undef ML_STAGE
  } else {
    __builtin_amdgcn_s_setprio(3);
    const int lane = tid & 63, w = tid >> 6, wr = w >> 1, wc = w & 1;
    f32x16 st = zero16();
    {
      const float* c0 = P.st_C + (size_t)sidx * 4096;
#pragma unroll
      for (int idx = 0; idx < 16; ++idx) st[idx] = c0[ACC_COL * 64 + ACC_ROW(idx)];
    }
#pragma unroll
    for (int idx = 0; idx < 16; ++idx) sCt[ACC_ROW(idx) * LDB + ACC_COL] = f2bf(st[idx]);
    if (tid < 64) s_nn[tid] = P.st_n[sidx * 64 + tid];
    __syncthreads();
    for (int c = 0; c < nch; ++c) {
      const bf16_t* sQ = ML_SET(c & 1); const bf16_t* sK = sQ + 64 * LDB; const bf16_t* sKt = sK + 64 * LDB; const bf16_t* sVt = sKt + 64 * LDB;
      const float* gt = ML_GATE(c & 1);
      const float* s_a = gt; const float* s_b = gt + 64; const float* s_M = gt + 128; const float* s_ew = gt + 192;
      const float sp = gt[256];
      const float* s_n = s_nn + (c & 1) * 64; float* s_n2 = s_nn + ((c & 1) ^ 1) * 64;
      f32x16 s = mm64(sQ, sK, wr, wc, lane, zero16());
#pragma unroll
      for (int idx = 0; idx < 16; ++idx) {
        const int i = ACC_ROW(idx), j = ACC_COL;
        const float val = (i >= j) ? s[idx] * __expf(s_a[j] - s_M[i]) : 0.f;
        sP[i * LDB + j] = f2bf(val);
      }
      __syncthreads();
      f32x16 o1 = mm64(sP, sVt, wr, wc, lane, zero16());
      f32x16 o2 = mm64(sQ, sCt, wr, wc, lane, zero16());
      {
        const int r4 = tid >> 2, sg4 = (tid & 3) * 16;
        float rs = 0.f, qn = 0.f;
#pragma unroll
        for (int e = 0; e < 16; ++e) { rs += bf2f(sP[r4 * LDB + sg4 + e]); qn += bf2f(sQ[r4 * LDB + sg4 + e]) * s_n[sg4 + e]; }
        rs = red4(rs); qn = red4(qn);
        const float den = rs + qn * s_ew[r4];
        const float mt = s_b[r4] + s_M[r4];
        if ((tid & 3) == 0) s_dinv[r4] = 1.f / fmaxf(fabsf(den), __expf(-mt));
      }
#pragma unroll
      for (int idx = 0; idx < 16; ++idx) st[idx] *= sp;
      st = mm64(sVt, sKt, wr, wc, lane, st);
      if (tid < 64) {
        float a = s_n[tid] * sp;
        for (int j = 0; j < 64; ++j) a += bf2f(sKt[tid * LDB + j]);
        s_n2[tid] = a;
      }
      __syncthreads();
#pragma unroll
      for (int idx = 0; idx < 16; ++idx) {
        const int i = ACC_ROW(idx), e = ACC_COL;
        const int pp = c * 64 + i; const int tt = z ? (T - 1 - pp) : pp;
        P.hdir[((size_t)z * NTOK + gs + tt) * DM + h * 64 + e] = f2bf((o1[idx] + s_ew[i] * o2[idx]) * s_dinv[i]);
      }
#pragma unroll
      for (int idx = 0; idx < 16; ++idx) sCt[ACC_ROW(idx) * LDB + ACC_COL] = f2bf(st[idx]);
      __syncthreads();
    }
  }
  __builtin_amdgcn_s_setprio(0);
#undef ML_SET
#undef ML_GATE
}

DEV void delta_T_item(const Params& P, int l, int item, char* smem, const int tid_in) {
  const int tid = opaque_i(tid_in);
  const int lane = tid & 63, w = tid >> 6, wr = w >> 1, wc = w & 1;
  const int tile = item & 127, zh = item >> 7, z = zh >> 2, h = zh & 3;
  int gs, T, ci; tok_info(tile * 64, gs, T, ci);
  float* sA = (float*)smem;
  float* s_beta = sA + 2016; float* s_gc = s_beta + 64;
  bf16_t* sK = (bf16_t*)(smem + 8576); bf16_t* sT = sK + 64 * LDB;
  const float aneg = -__expf(P.delta_a_log[(l * 2 + z) * 4 + h]), dtb = P.delta_dt_bias[(l * 2 + z) * 4 + h];
  {
    const int row = tid >> 2, seg = (tid & 3) * 16;
    const int g = tile * 64 + (z ? 63 - row : row);
    const bf16_t* src = P.ubuf + (size_t)g * 768 + 256 + h * 64 + seg;
    *(uint4*)(sK + row * LDB + seg) = *(const uint4*)src; *(uint4*)(sK + row * LDB + seg + 8) = *(const uint4*)(src + 8);
  }
  if (w == 0) {
    const int g = tile * 64 + (z ? 63 - lane : lane);
    const float* gp = P.projABC + (size_t)g * NABC + 2064 + z * 4 + h;
    const float beta = sigmoidf_(gp[0]);
    const float gj = aneg * softplusf_(gp[8] + dtb);
    const float gc = wave_incl_scan_add(gj, lane);
    s_beta[lane] = beta; s_gc[lane] = gc;
    P.dbeta[(size_t)zh * NTOK + g] = beta; P.dgc[(size_t)zh * NTOK + g] = gc;
  }
  __syncthreads();
  {
    f32x16 kkm = mm64(sK, sK, wr, wc, lane, zero16());
#pragma unroll
    for (int idx = 0; idx < 16; ++idx) {
      const int i = ACC_ROW(idx), j = ACC_COL;
      const float av = kkm[idx] * __expf(s_gc[i] - s_gc[j]) * s_beta[i];
      if (i > j) sA[i * (i - 1) / 2 + j] = av;
      if (w == 2) sT[i * LDB + j] = f2bf(av);
    }
  }
  __syncthreads();
  if (w < 2 && lane < 32) {
    const int o = w * 32;
    float x[32];
    const float flane = (float)lane;
#pragma unroll
    for (int i = 0; i < 32; ++i) {
      float a = fmaxf(0.f, 1.f - fabsf(flane - (float)i));
      const float* arow = sA + (o + i) * (o + i - 1) / 2 + o;
#pragma unroll
      for (int j = 0; j < i; ++j) a -= arow[j] * x[j];
      x[i] = a;
      sT[(o + i) * LDB + o + lane] = f2bf(a);
      if (w == 0) sT[lane * LDB + 32 + i] = f2bf(a);
    }
  }
  __syncthreads();
  if (w == 0) {
    const bf16_t* aA = sT + (32 + (lane & 31)) * LDB + (lane >> 5) * 8;
    const bf16_t* bT = sT + (lane & 31) * LDB + 32 + (lane >> 5) * 8;
    f32x16 m1 = zero16();
#pragma unroll
    for (int s2 = 0; s2 < 2; ++s2) m1 = __builtin_amdgcn_mfma_f32_32x32x16_bf16(*(const bf16x8*)(aA + s2 * 16), *(const bf16x8*)(bT + s2 * 16), m1, 0, 0, 0);
#pragma unroll
    for (int g4 = 0; g4 < 4; ++g4) {
      uint2 o2; o2.x = pack2(m1[4 * g4], m1[4 * g4 + 1]); o2.y = pack2(m1[4 * g4 + 2], m1[4 * g4 + 3]);
      *(uint2*)(sT + (lane & 31) * LDB + 32 + 8 * g4 + 4 * (lane >> 5)) = o2;
    }
    const bf16_t* a2 = sT + (32 + (lane & 31)) * LDB + 32 + (lane >> 5) * 8;
    f32x16 m2 = zero16();
#pragma unroll
    for (int s2 = 0; s2 < 2; ++s2) m2 = __builtin_amdgcn_mfma_f32_32x32x16_bf16(*(const bf16x8*)(a2 + s2 * 16), *(const bf16x8*)(bT + s2 * 16), m2, 0, 0, 0);
#pragma unroll
    for (int idx = 0; idx < 16; ++idx) sT[(32 + (idx & 3) + 8 * (idx >> 2) + 4 * (lane >> 5)) * LDB + (lane & 31)] = f2bf(-m2[idx]);
    *(uint4*)(sT + (lane & 31) * LDB + 32 + (lane >> 5) * 16) = make_uint4(0u, 0u, 0u, 0u);
    *(uint4*)(sT + (lane & 31) * LDB + 32 + (lane >> 5) * 16 + 8) = make_uint4(0u, 0u, 0u, 0u);
  }
  __syncthreads();
  {
    const int row = tid >> 2, seg = (tid & 3) * 16;
    bf16_t* dst = P.dT + ((size_t)item * 64 + row) * 64 + seg;
    *(uint4*)dst = *(const uint4*)(sT + row * LDB + seg); *(uint4*)(dst + 8) = *(const uint4*)(sT + row * LDB + seg + 8);
  }
  __syncthreads();
}

DEV void delta_task(const Params& P, int l, int task, const int z, char* smem, const int tid_in, const bool active) {
  const int tid = opaque_i(tid_in);
  const int lane = tid & 63, w = tid >> 6, wr = w >> 1, wc = w & 1;
  int seq, h; bool sample; decode_chain(task, seq, h, sample);
  int gs, T; seq_base(seq, gs, T);
  if (!active) { for (int c = 0; c < T / 64; ++c) { __syncthreads(); __syncthreads(); __syncthreads(); __syncthreads(); __syncthreads(); __syncthreads(); } return; }
  float* s_beta = (float*)smem; float* s_gc = s_beta + 64;
  bf16_t* sQ = (bf16_t*)(smem + 512); bf16_t* sK = sQ + 64 * LDB; bf16_t* sKbt = sK + 64 * LDB; bf16_t* sKgt = sKbt + 64 * LDB; bf16_t* sVbt = sKgt + 64 * LDB; bf16_t* sT = sVbt + 64 * LDB; bf16_t* sSt = sT + 64 * LDB;
  bf16_t* sW = sKbt; bf16_t* sVnt = sVbt; bf16_t* sP = sT;
  f32x16 st = zero16();
  if (sample) {
    const float* s0 = P.st_delta + ((size_t)(((seq - 16) * 2 + l) * 2 + z) * 4 + h) * 4096;
#pragma unroll
    for (int idx = 0; idx < 16; ++idx) st[idx] = s0[ACC_COL * 64 + ACC_ROW(idx)];
  }
#pragma unroll
  for (int idx = 0; idx < 16; ++idx) sSt[ACC_ROW(idx) * LDB + ACC_COL] = f2bf(st[idx]);
  const int nch = T / 64;
  const int tid_outer = tid;
  const int zh = z * 4 + h;
  uint4 nq0, nq1, nk0, nk1, nv0, nv1, nt0, nt1; float nbeta, ngc, nglast;
#define DELTA_PREFETCH(C) { \
    const int r_ = tid_outer & 63, sg_ = (tid_outer >> 6) * 16; \
    const int p_ = (C) * 64 + r_; const int g_ = gs + (z ? (T - 1 - p_) : p_); \
    const bf16_t* src_ = P.ubuf + (size_t)g_ * 768 + h * 64 + sg_; \
    nq0 = *(const uint4*)src_; nq1 = *(const uint4*)(src_ + 8); nk0 = *(const uint4*)(src_ + 256); nk1 = *(const uint4*)(src_ + 264); nv0 = *(const uint4*)(src_ + 512); nv1 = *(const uint4*)(src_ + 520); \
    const int tile_ = (gs >> 6) + (z ? (nch - 1 - (C)) : (C)); \
    const bf16_t* tsrc_ = P.dT + (((size_t)zh * 128 + tile_) * 64 + r_) * 64 + sg_; \
    nt0 = *(const uint4*)tsrc_; nt1 = *(const uint4*)(tsrc_ + 8); \
    nbeta = P.dbeta[(size_t)zh * NTOK + g_]; ngc = P.dgc[(size_t)zh * NTOK + g_]; \
    const int pl_ = (C) * 64 + 63; nglast = P.dgc[(size_t)zh * NTOK + gs + (z ? (T - 1 - pl_) : pl_)]; }
  DELTA_PREFETCH(0)
  for (int c = 0; c < nch; ++c) {
    const int tid = opaque_i(tid_outer);
    const int lane = tid & 63, w = tid >> 6, wr = w >> 1, wc = w & 1;
    const int row = tid & 63, seg = (tid >> 6) * 16;
    {
      const uint4 cq0 = nq0, cq1 = nq1, ck0 = nk0, ck1 = nk1, cv0 = nv0, cv1 = nv1, ct0 = nt0, ct1 = nt1;
      const float bj = nbeta, gcj = ngc, glast = nglast;
      float k[16], v[16];
      { const unsigned kw[8] = {ck0.x, ck0.y, ck0.z, ck0.w, ck1.x, ck1.y, ck1.z, ck1.w}, vw[8] = {cv0.x, cv0.y, cv0.z, cv0.w, cv1.x, cv1.y, cv1.z, cv1.w};
#pragma unroll
        for (int e = 0; e < 8; ++e) { k[2 * e] = __uint_as_float(kw[e] << 16); k[2 * e + 1] = __uint_as_float(kw[e] & 0xffff0000u); v[2 * e] = __uint_as_float(vw[e] << 16); v[2 * e + 1] = __uint_as_float(vw[e] & 0xffff0000u); } }
      if (w == 0) { s_beta[row] = bj; s_gc[row] = gcj; }
      const float f1 = bj * __expf(gcj), f2 = __expf(glast - gcj);
      *(uint4*)(sQ + row * LDB + seg) = cq0; *(uint4*)(sQ + row * LDB + seg + 8) = cq1;
      *(uint4*)(sK + row * LDB + seg) = ck0; *(uint4*)(sK + row * LDB + seg + 8) = ck1;
      *(uint4*)(sT + row * LDB + seg) = ct0; *(uint4*)(sT + row * LDB + seg + 8) = ct1;
#pragma unroll
      for (int e = 0; e < 16; ++e) {
        sKbt[(seg + e) * LDB + row] = f2bf(k[e] * f1);
        sKgt[(seg + e) * LDB + row] = f2bf(k[e] * f2);
        sVbt[(seg + e) * LDB + row] = f2bf(v[e] * bj);
      }
    }
    __syncthreads();
    if (c + 1 < nch) DELTA_PREFETCH(c + 1)
    f32x16 U = mm64(sT, sVbt, wr, wc, lane, zero16());
    f32x16 Wm = mm64(sT, sKbt, wr, wc, lane, zero16());
    f32x16 qk = mm64(sQ, sK, wr, wc, lane, zero16());
    __syncthreads();
#pragma unroll
    for (int idx = 0; idx < 16; ++idx) {
      const int i = ACC_ROW(idx), j = ACC_COL;
      sW[i * LDB + j] = f2bf(Wm[idx]);
      sP[i * LDB + j] = f2bf((i >= j) ? qk[idx] * __expf(s_gc[i] - s_gc[j]) : 0.f);
    }
    __syncthreads();
    {
      f32x16 ws = mm64(sW, sSt, wr, wc, lane, zero16());
#pragma unroll
      for (int g4 = 0; g4 < 4; ++g4) {
        const int e = ACC_COL, i0 = wr * 32 + 8 * g4 + 4 * (lane >> 5);
        uint2 o; o.x = pack2(U[4 * g4] - ws[4 * g4], U[4 * g4 + 1] - ws[4 * g4 + 1]); o.y = pack2(U[4 * g4 + 2] - ws[4 * g4 + 2], U[4 * g4 + 3] - ws[4 * g4 + 3]);
        *(uint2*)(sVnt + e * LDB + i0) = o;
      }
    }
    __syncthreads();
    f32x16 o1 = mm64(sP, sVnt, wr, wc, lane, zero16());
    f32x16 o2 = mm64(sQ, sSt, wr, wc, lane, zero16());
#pragma unroll
    for (int idx = 0; idx < 16; ++idx) {
      const int i = ACC_ROW(idx), e = ACC_COL;
      const int pp = c * 64 + i; const int tt = z ? (T - 1 - pp) : pp;
      P.hdir[((size_t)z * NTOK + gs + tt) * DM + 256 + h * 64 + e] = f2bf(o1[idx] + __expf(s_gc[i]) * o2[idx]);
    }
    const float egl = __expf(s_gc[63]);
#pragma unroll
    for (int idx = 0; idx < 16; ++idx) st[idx] *= egl;
    st = mm64(sVnt, sKgt, wr, wc, lane, st);
    __syncthreads();
#pragma unroll
    for (int idx = 0; idx < 16; ++idx) sSt[ACC_ROW(idx) * LDB + ACC_COL] = f2bf(st[idx]);
    __syncthreads();
  }
  if (!sample) {
    float* o = P.out + O_DELTA + ((size_t)((seq * 2 + l) * 2 + z) * 4 + h) * 4096;
#pragma unroll
    for (int idx = 0; idx < 16; ++idx) o[ACC_COL * 64 + ACC_ROW(idx)] = st[idx];
  }
}

DEV void delta_sample_task(const Params& P, int l, int task, const int z, char* smem0, const int tid_all_in) {
  const int tid_all = opaque_i(tid_all_in);
  const int half = tid_all >> 8, tid = tid_all & 255;
  int seq, h; bool sample; decode_chain(task, seq, h, sample);
  int gs, T; seq_base(seq, gs, T);
  const int nch = T / 64;
  const int zh = z * 4 + h;
#define DL_GATE(B) ((float*)(smem0 + (B) * HALF_LDS))
#define DL_SET(B) ((bf16_t*)(smem0 + (B) * HALF_LDS + 512))
  bf16_t* sSt = DL_SET(0) + 6 * 64 * LDB;
  if (half == 1) {
    uint4 nq0, nq1, nk0, nk1, nv0, nv1, nt0, nt1; float nbeta, ngc, nglast;
#define DL_PREFETCH(C) { \
      const int r_ = tid & 63, sg_ = (tid >> 6) * 16; \
      const int p_ = (C) * 64 + r_; const int g_ = gs + (z ? (T - 1 - p_) : p_); \
      const bf16_t* src_ = P.ubuf + (size_t)g_ * 768 + h * 64 + sg_; \
      nq0 = *(const uint4*)src_; nq1 = *(const uint4*)(src_ + 8); nk0 = *(const uint4*)(src_ + 256); nk1 = *(const uint4*)(src_ + 264); nv0 = *(const uint4*)(src_ + 512); nv1 = *(const uint4*)(src_ + 520); \
      const int tile_ = (gs >> 6) + (z ? (nch - 1 - (C)) : (C)); \
      const bf16_t* tsrc_ = P.dT + (((size_t)zh * 128 + tile_) * 64 + r_) * 64 + sg_; \
      nt0 = *(const uint4*)tsrc_; nt1 = *(const uint4*)(tsrc_ + 8); \
      nbeta = P.dbeta[(size_t)zh * NTOK + g_]; ngc = P.dgc[(size_t)zh * NTOK + g_]; \
      const int pl_ = (C) * 64 + 63; nglast = P.dgc[(size_t)zh * NTOK + gs + (z ? (T - 1 - pl_) : pl_)]; }
#define DL_STAGE(C) { \
      float* s_beta = DL_GATE((C) & 1); float* s_gc = s_beta + 64; \
      bf16_t* sQ = DL_SET((C) & 1); bf16_t* sK = sQ + 64 * LDB; bf16_t* sKbt = sK + 64 * LDB; bf16_t* sKgt = sKbt + 64 * LDB; bf16_t* sVbt = sKgt + 64 * LDB; bf16_t* sT = sVbt + 64 * LDB; \
      const int row = tid & 63, seg = (tid >> 6) * 16, w = tid >> 6; \
      const float bj = nbeta, gcj = ngc, glast = nglast; \
      float k[16], v[16]; \
      { const unsigned kw[8] = {nk0.x, nk0.y, nk0.z, nk0.w, nk1.x, nk1.y, nk1.z, nk1.w}, vw[8] = {nv0.x, nv0.y, nv0.z, nv0.w, nv1.x, nv1.y, nv1.z, nv1.w}; \
        _Pragma("unroll") for (int e = 0; e < 8; ++e) { k[2 * e] = __uint_as_float(kw[e] << 16); k[2 * e + 1] = __uint_as_float(kw[e] & 0xffff0000u); v[2 * e] = __uint_as_float(vw[e] << 16); v[2 * e + 1] = __uint_as_float(vw[e] & 0xffff0000u); } } \
      if (w == 0) { s_beta[row] = bj; s_gc[row] = gcj; } \
      const float f1 = bj * __expf(gcj), f2 = __expf(glast - gcj); \
      *(uint4*)(sQ + row * LDB + seg) = nq0; *(uint4*)(sQ + row * LDB + seg + 8) = nq1; \
      *(uint4*)(sK + row * LDB + seg) = nk0; *(uint4*)(sK + row * LDB + seg + 8) = nk1; \
      *(uint4*)(sT + row * LDB + seg) = nt0; *(uint4*)(sT + row * LDB + seg + 8) = nt1; \
      _Pragma("unroll") for (int e = 0; e < 16; ++e) { \
        sKbt[(seg + e) * LDB + row] = f2bf(k[e] * f1); \
        sKgt[(seg + e) * LDB + row] = f2bf(k[e] * f2); \
        sVbt[(seg + e) * LDB + row] = f2bf(v[e] * bj); } }
    DL_PREFETCH(0)
    DL_STAGE(0)
    if (nch > 1) DL_PREFETCH(1)
    __syncthreads();
    for (int c = 0; c < nch; ++c) {
      if (c + 1 < nch) { DL_STAGE(c + 1) if (c + 2 < nch) DL_PREFETCH(c + 2) }
      __syncthreads(); __syncthreads(); __syncthreads(); __syncthreads(); __syncthreads();
    }
#undef DL_PREFETCH
#undef DL_STAGE
  } else {
    __builtin_amdgcn_s_setprio(3);
    const int lane = tid & 63, w = tid >> 6, wr = w >> 1, wc = w & 1;
    f32x16 st = zero16();
    {
      const float* s0 = P.st_delta + ((size_t)(((seq - 16) * 2 + l) * 2 + z) * 4 + h) * 4096;
#pragma unroll
      for (int idx = 0; idx < 16; ++idx) st[idx] = s0[ACC_COL * 64 + ACC_ROW(idx)];
    }
#pragma unroll
    for (int idx = 0; idx < 16; ++idx) sSt[ACC_ROW(idx) * LDB + ACC_COL] = f2bf(st[idx]);
    __syncthreads();
    for (int c = 0; c < nch; ++c) {
      const float* s_gc = DL_GATE(c & 1) + 64;
      bf16_t* sQ = DL_SET(c & 1); bf16_t* sK = sQ + 64 * LDB; bf16_t* sKbt = sK + 64 * LDB; bf16_t* sKgt = sKbt + 64 * LDB; bf16_t* sVbt = sKgt + 64 * LDB; bf16_t* sT = sVbt + 64 * LDB;
      bf16_t* sW = sKbt; bf16_t* sVnt = sVbt; bf16_t* sP = sT;
      f32x16 U = mm64(sT, sVbt, wr, wc, lane, zero16());
      f32x16 Wm = mm64(sT, sKbt, wr, wc, lane, zero16());
      f32x16 qk = mm64(sQ, sK, wr, wc, lane, zero16());
      __syncthreads();
#pragma unroll
      for (int idx = 0; idx < 16; ++idx) {
        const int i = ACC_ROW(idx), j = ACC_COL;
        sW[i * LDB + j] = f2bf(Wm[idx]);
        sP[i * LDB + j] = f2bf((i >= j) ? qk[idx] * __expf(s_gc[i] - s_gc[j]) : 0.f);
      }
      __syncthreads();
      {
        f32x16 ws = mm64(sW, sSt, wr, wc, lane, zero16());
#pragma unroll
        for (int g4 = 0; g4 < 4; ++g4) {
          const int e = ACC_COL, i0 = wr * 32 + 8 * g4 + 4 * (lane >> 5);
          uint2 o; o.x = pack2(U[4 * g4] - ws[4 * g4], U[4 * g4 + 1] - ws[4 * g4 + 1]); o.y = pack2(U[4 * g4 + 2] - ws[4 * g4 + 2], U[4 * g4 + 3] - ws[4 * g4 + 3]);
          *(uint2*)(sVnt + e * LDB + i0) = o;
        }
      }
      __syncthreads();
      f32x16 o1 = mm64(sP, sVnt, wr, wc, lane, zero16());
      f32x16 o2 = mm64(sQ, sSt, wr, wc, lane, zero16());
#pragma unroll
      for (int idx = 0; idx < 16; ++idx) {
        const int i = ACC_ROW(idx), e = ACC_COL;
        const int pp = c * 64 + i; const int tt = z ? (T - 1 - pp) : pp;
        P.hdir[((size_t)z * NTOK + gs + tt) * DM + 256 + h * 64 + e] = f2bf(o1[idx] + __expf(s_gc[i]) * o2[idx]);
      }
      const float egl = __expf(s_gc[63]);
#pragma unroll
      for (int idx = 0; idx < 16; ++idx) st[idx] *= egl;
      st = mm64(sVnt, sKgt, wr, wc, lane, st);
      __syncthreads();
#pragma unroll
      for (int idx = 0; idx < 16; ++idx) sSt[ACC_ROW(idx) * LDB + ACC_COL] = f2bf(st[idx]);
      __syncthreads();
    }
  }
  __builtin_amdgcn_s_setprio(0);
#undef DL_GATE
#undef DL_SET
}

template <int RWAVES>
DEV void rwkv_task(const Params& P, int l, int task, const int z, char* smem, const int tid_in, const bool active) {
  const int tid = opaque_i(tid_in);
  constexpr int NR = 4 * RWAVES, NRB = 64 / NR;
  const int chain = task / NRB, rb = task % NRB;
  int seq, h; bool sample; decode_chain(chain, seq, h, sample);
  int gs, T; seq_base(seq, gs, T);
  if (!active) { for (int c = 0; c < T / 32; ++c) { __syncthreads(); __syncthreads(); } return; }
  float* s_kh = (float*)smem; float* s_w = s_kh + 2048; float* s_b = s_w + 2048; float* s_kt = s_b + 2048; float* s_r = s_kt + 2048; float* s_v = s_r + 2048; float* s_yp = s_v + 512;
  const int rl = tid >> 4, cg4 = (tid & 15) * 4;
  const int irow = rb * NR + (rl & (NR - 1));
  const bool rowthread = tid < 64 * RWAVES;
  float S0 = 0.f, S1 = 0.f, S2 = 0.f, S3 = 0.f;
  if (sample) {
    const float4 s4 = *(const float4*)(P.st_rwkv + ((size_t)(((seq - 16) * 2 + l) * 2 + z) * 4 + h) * 4096 + irow * 64 + cg4);
    S0 = s4.x; S1 = s4.y; S2 = s4.z; S3 = s4.w;
  }
  const int si = tid >> 3, sc = (tid & 7) * 8;
  float kkc[8], kac[8], rkc[8];
#pragma unroll
  for (int e = 0; e < 8; ++e) { kkc[e] = P.rwkv_kk[l * 256 + h * 64 + sc + e]; kac[e] = P.rwkv_ka[l * 256 + h * 64 + sc + e]; rkc[e] = P.rwkv_rk[(l * 4 + h) * 64 + sc + e]; }
  const int nch = T / 32;
  float4 pr0, pr1, pk0, pk1, pw0, pw1, pa0, pa1, pv_ = make_float4(0.f, 0.f, 0.f, 0.f); float pinv;
#define RWKV_PREFETCH(C) { \
    const int p_ = (C) * 32 + si; const int t_ = z ? (T - 1 - p_) : p_; const int g_ = gs + t_; \
    const float* rk_ = P.rkv + (size_t)g_ * 768 + h * 64 + sc; \
    pr0 = *(const float4*)rk_; pr1 = *(const float4*)(rk_ + 4); \
    pk0 = *(const float4*)(rk_ + 256); pk1 = *(const float4*)(rk_ + 260); \
    const float* wp_ = P.wa + ((size_t)(g_ * 2 + z) * 2) * 256 + h * 64 + sc; \
    pw0 = *(const float4*)wp_; pw1 = *(const float4*)(wp_ + 4); \
    pa0 = *(const float4*)(wp_ + 256); pa1 = *(const float4*)(wp_ + 260); \
    pinv = P.khinv[g_ * 4 + h]; \
    if (tid < 8 * NR) { \
      const int p2_ = (C) * 32 + (tid / (NR / 4)); const int t2_ = z ? (T - 1 - p2_) : p2_; \
      pv_ = *(const float4*)(P.rkv + (size_t)(gs + t2_) * 768 + 512 + h * 64 + rb * NR + (tid % (NR / 4)) * 4); \
    } }
  RWKV_PREFETCH(0)
  for (int c = 0; c < nch; ++c) {
    {
      const float rr[8] = {pr0.x, pr0.y, pr0.z, pr0.w, pr1.x, pr1.y, pr1.z, pr1.w};
      const float kk[8] = {pk0.x, pk0.y, pk0.z, pk0.w, pk1.x, pk1.y, pk1.z, pk1.w};
      const float aa[8] = {pa0.x, pa0.y, pa0.z, pa0.w, pa1.x, pa1.y, pa1.z, pa1.w};
      float bsum = 0.f;
      float okh[8], ob[8], okt[8];
#pragma unroll
      for (int e = 0; e < 8; ++e) {
        okh[e] = kk[e] * kkc[e] * pinv; ob[e] = aa[e] * okh[e]; okt[e] = kk[e] * (1.f + (aa[e] - 1.f) * kac[e]);
        bsum += rr[e] * okt[e] * rkc[e];
      }
      float* d;
      d = s_kh + si * 64 + sc; *(float4*)d = make_float4(okh[0], okh[1], okh[2], okh[3]); *(float4*)(d + 4) = make_float4(okh[4], okh[5], okh[6], okh[7]);
      d = s_w + si * 64 + sc; *(float4*)d = pw0; *(float4*)(d + 4) = pw1;
      d = s_b + si * 64 + sc; *(float4*)d = make_float4(ob[0], ob[1], ob[2], ob[3]); *(float4*)(d + 4) = make_float4(ob[4], ob[5], ob[6], ob[7]);
      d = s_kt + si * 64 + sc; *(float4*)d = make_float4(okt[0], okt[1], okt[2], okt[3]); *(float4*)(d + 4) = make_float4(okt[4], okt[5], okt[6], okt[7]);
      d = s_r + si * 64 + sc; *(float4*)d = pr0; *(float4*)(d + 4) = pr1;
      if (tid < 8 * NR) *(float4*)(s_v + (tid / (NR / 4)) * NR + (tid % (NR / 4)) * 4) = pv_;
      bsum += dppf<0xB1>(bsum); bsum += dppf<0x4E>(bsum); bsum += dppf<0x141>(bsum);
      if (rb == 0 && (tid & 7) == 0) {
        const int p = c * 32 + si; const int t = z ? (T - 1 - p) : p;
        P.bonus[((size_t)z * NTOK + gs + t) * 4 + h] = bsum;
      }
    }
    __syncthreads();
    if (c + 1 < nch) RWKV_PREFETCH(c + 1)
    if (rowthread) {
      typedef float v2f __attribute__((ext_vector_type(2)));
      typedef float v4f __attribute__((ext_vector_type(4)));
      v2f Sa = {S0, S1}, Sb = {S2, S3};
      v4f kh = *(const v4f*)(s_kh + cg4), ww = *(const v4f*)(s_w + cg4), bb = *(const v4f*)(s_b + cg4), kt = *(const v4f*)(s_kt + cg4), rr = *(const v4f*)(s_r + cg4);
      float vi = s_v[rl];
#pragma unroll 8
      for (int i = 0; i < 32; ++i) {
        const int in = (i + 1) & 31;
        const v4f kh_n = *(const v4f*)(s_kh + in * 64 + cg4);
        const v4f ww_n = *(const v4f*)(s_w + in * 64 + cg4);
        const v4f bb_n = *(const v4f*)(s_b + in * 64 + cg4);
        const v4f kt_n = *(const v4f*)(s_kt + in * 64 + cg4);
        const v4f rr_n = *(const v4f*)(s_r + in * 64 + cg4);
        const float vi_n = s_v[in * NR + rl];
        const v2f v2 = {vi, vi};
        const v2f pp = __builtin_elementwise_fma(Sb, kh.zw, Sa * kh.xy);
        const float sk = red16(pp.x + pp.y);
        const v2f sk2 = {sk, sk};
        Sa = __builtin_elementwise_fma(-sk2, bb.xy, __builtin_elementwise_fma(v2, kt.xy, Sa * ww.xy));
        Sb = __builtin_elementwise_fma(-sk2, bb.zw, __builtin_elementwise_fma(v2, kt.zw, Sb * ww.zw));
        const v2f qq = __builtin_elementwise_fma(Sb, rr.zw, Sa * rr.xy);
        s_yp[i * (64 * RWAVES) + tid] = qq.x + qq.y;
        kh = kh_n; ww = ww_n; bb = bb_n; kt = kt_n; rr = rr_n; vi = vi_n;
      }
      S0 = Sa.x; S1 = Sa.y; S2 = Sb.x; S3 = Sb.y;
    }
    __syncthreads();
    {
      const int i = tid >> 3, q2 = tid & 7;
      const int p = c * 32 + i; const int t = z ? (T - 1 - p) : p;
      if (NR == 16) {
        const float* y0 = s_yp + i * 256 + (2 * q2) * 16;
        float a0 = 0.f, a1 = 0.f;
#pragma unroll
        for (int e = 0; e < 16; e += 4) { const float4 u0 = *(const float4*)(y0 + e), u1 = *(const float4*)(y0 + 16 + e); a0 += (u0.x + u0.y) + (u0.z + u0.w); a1 += (u1.x + u1.y) + (u1.z + u1.w); }
        *(unsigned*)(P.hdir + ((size_t)z * NTOK + gs + t) * DM + 768 + h * 64 + rb * 16 + 2 * q2) = pack2(a0, a1);
      } else {
        const float* y0 = s_yp + i * (64 * RWAVES) + q2 * 16;
        float a0 = 0.f;
#pragma unroll
        for (int e = 0; e < 16; e += 4) { const float4 u0 = *(const float4*)(y0 + e); a0 += (u0.x + u0.y) + (u0.z + u0.w); }
        P.hdir[((size_t)z * NTOK + gs + t) * DM + 768 + h * 64 + rb * NR + q2] = f2bf(a0);
      }
    }
  }
  if (!sample && rowthread) {
    *(float4*)(P.out + O_RWKV + ((size_t)((seq * 2 + l) * 2 + z) * 4 + h) * 4096 + irow * 64 + cg4) = make_float4(S0, S1, S2, S3);
  }
}

DEV void rwkv_prompt_task(const Params& P, int l, int task, const int z, char* smem, const int tid_in) {
  const int tid = opaque_i(tid_in);
  const int chain = task >> 1, rb = task & 1;
  int seq, h; bool sample; decode_chain(chain, seq, h, sample);
  int gs, T; seq_base(seq, gs, T);
  float* s_kh = (float*)smem; float* s_w = s_kh + 2048; float* s_b = s_w + 2048; float* s_kt = s_b + 2048; float* s_r = s_kt + 2048; float* s_v = s_r + 2048; float* s_yp = s_v + 1024;
  const int rp = tid >> 4, cg4 = (tid & 15) * 4;
  const int irow = rb * 32 + 2 * rp;
  typedef float v2f __attribute__((ext_vector_type(2)));
  typedef float v4f __attribute__((ext_vector_type(4)));
  v2f Aa = {0.f, 0.f}, Ab = {0.f, 0.f}, Ba = {0.f, 0.f}, Bb = {0.f, 0.f};
  if (sample) {
    const float* sp0 = P.st_rwkv + ((size_t)(((seq - 16) * 2 + l) * 2 + z) * 4 + h) * 4096 + irow * 64 + cg4;
    const float4 a4 = *(const float4*)sp0, b4 = *(const float4*)(sp0 + 64);
    Aa.x = a4.x; Aa.y = a4.y; Ab.x = a4.z; Ab.y = a4.w; Ba.x = b4.x; Ba.y = b4.y; Bb.x = b4.z; Bb.y = b4.w;
  }
  const int si = tid >> 3, sc = (tid & 7) * 8;
  float kkc[8], kac[8], rkc[8];
#pragma unroll
  for (int e = 0; e < 8; ++e) { kkc[e] = P.rwkv_kk[l * 256 + h * 64 + sc + e]; kac[e] = P.rwkv_ka[l * 256 + h * 64 + sc + e]; rkc[e] = P.rwkv_rk[(l * 4 + h) * 64 + sc + e]; }
  const int nch = T / 32;
  float4 pr0, pr1, pk0, pk1, pw0, pw1, pa0, pa1, pv_; float pinv;
#define RP_PREFETCH(C) { \
    const int p_ = (C) * 32 + si; const int t_ = z ? (T - 1 - p_) : p_; const int g_ = gs + t_; \
    const float* rk_ = P.rkv + (size_t)g_ * 768 + h * 64 + sc; \
    pr0 = *(const float4*)rk_; pr1 = *(const float4*)(rk_ + 4); \
    pk0 = *(const float4*)(rk_ + 256); pk1 = *(const float4*)(rk_ + 260); \
    const float* wp_ = P.wa + ((size_t)(g_ * 2 + z) * 2) * 256 + h * 64 + sc; \
    pw0 = *(const float4*)wp_; pw1 = *(const float4*)(wp_ + 4); \
    pa0 = *(const float4*)(wp_ + 256); pa1 = *(const float4*)(wp_ + 260); \
    pinv = P.khinv[g_ * 4 + h]; \
    pv_ = *(const float4*)(P.rkv + (size_t)g_ * 768 + 512 + h * 64 + rb * 32 + (tid & 7) * 4); }
  RP_PREFETCH(0)
  for (int c = 0; c < nch; ++c) {
    {
      const float rr[8] = {pr0.x, pr0.y, pr0.z, pr0.w, pr1.x, pr1.y, pr1.z, pr1.w};
      const float kk[8] = {pk0.x, pk0.y, pk0.z, pk0.w, pk1.x, pk1.y, pk1.z, pk1.w};
      const float aa[8] = {pa0.x, pa0.y, pa0.z, pa0.w, pa1.x, pa1.y, pa1.z, pa1.w};
      float bsum = 0.f;
      float okh[8], ob[8], okt[8];
#pragma unroll
      for (int e = 0; e < 8; ++e) {
        okh[e] = kk[e] * kkc[e] * pinv; ob[e] = aa[e] * okh[e]; okt[e] = kk[e] * (1.f + (aa[e] - 1.f) * kac[e]);
        bsum += rr[e] * okt[e] * rkc[e];
      }
      float* d;
      d = s_kh + si * 64 + sc; *(float4*)d = make_float4(okh[0], okh[1], okh[2], okh[3]); *(float4*)(d + 4) = make_float4(okh[4], okh[5], okh[6], okh[7]);
      d = s_w + si * 64 + sc; *(float4*)d = pw0; *(float4*)(d + 4) = pw1;
      d = s_b + si * 64 + sc; *(float4*)d = make_float4(ob[0], ob[1], ob[2], ob[3]); *(float4*)(d + 4) = make_float4(ob[4], ob[5], ob[6], ob[7]);
      d = s_kt + si * 64 + sc; *(float4*)d = make_float4(okt[0], okt[1], okt[2], okt[3]); *(float4*)(d + 4) = make_float4(okt[4], okt[5], okt[6], okt[7]);
      d = s_r + si * 64 + sc; *(float4*)d = pr0; *(float4*)(d + 4) = pr1;
      *(float4*)(s_v + si * 32 + (tid & 7) * 4) = pv_;
      bsum += dppf<0xB1>(bsum); bsum += dppf<0x4E>(bsum); bsum += dppf<0x141>(bsum);
      if (rb == 0 && (tid & 7) == 0) {
        const int p = c * 32 + si; const int t = z ? (T - 1 - p) : p;
        P.bonus[((size_t)z * NTOK + gs + t) * 4 + h] = bsum;
      }
    }
    __syncthreads();
    if (c + 1 < nch) RP_PREFETCH(c + 1)
    {
      v4f kh = *(const v4f*)(s_kh + cg4), ww = *(const v4f*)(s_w + cg4), bb = *(const v4f*)(s_b + cg4), kt = *(const v4f*)(s_kt + cg4), rr = *(const v4f*)(s_r + cg4);
      v2f vv = *(const v2f*)(s_v + 2 * rp);
      float* ypw = s_yp + (2 * rp) * 4 + ((tid & 15) >> 2);
#pragma unroll 8
      for (int i = 0; i < 32; ++i) {
        const int in = (i + 1) & 31;
        const v4f kh_n = *(const v4f*)(s_kh + in * 64 + cg4);
        const v4f ww_n = *(const v4f*)(s_w + in * 64 + cg4);
        const v4f bb_n = *(const v4f*)(s_b + in * 64 + cg4);
        const v4f kt_n = *(const v4f*)(s_kt + in * 64 + cg4);
        const v4f rr_n = *(const v4f*)(s_r + in * 64 + cg4);
        const v2f vv_n = *(const v2f*)(s_v + in * 32 + 2 * rp);
        const v2f va = {vv.x, vv.x}, vb = {vv.y, vv.y};
        const v2f pa = __builtin_elementwise_fma(Ab, kh.zw, Aa * kh.xy), pb = __builtin_elementwise_fma(Bb, kh.zw, Ba * kh.xy);
        const float ska = red16(pa.x + pa.y), skb = red16(pb.x + pb.y);
        const v2f sa2 = {ska, ska}, sb2 = {skb, skb};
        Aa = __builtin_elementwise_fma(-sa2, bb.xy, __builtin_elementwise_fma(va, kt.xy, Aa * ww.xy));
        Ab = __builtin_elementwise_fma(-sa2, bb.zw, __builtin_elementwise_fma(va, kt.zw, Ab * ww.zw));
        Ba = __builtin_elementwise_fma(-sb2, bb.xy, __builtin_elementwise_fma(vb, kt.xy, Ba * ww.xy));
        Bb = __builtin_elementwise_fma(-sb2, bb.zw, __builtin_elementwise_fma(vb, kt.zw, Bb * ww.zw));
        const v2f qa = __builtin_elementwise_fma(Ab, rr.zw, Aa * rr.xy), qb = __builtin_elementwise_fma(Bb, rr.zw, Ba * rr.xy);
        const float ya = red4(qa.x + qa.y), yb = red4(qb.x + qb.y);
        if ((tid & 3) == 0) { ypw[i * 128] = ya; ypw[i * 128 + 4] = yb; }
        kh = kh_n; ww = ww_n; bb = bb_n; kt = kt_n; rr = rr_n; vv = vv_n;
      }
    }
    __syncthreads();
    {
      const int i = tid >> 3, r0 = (tid & 7) * 4;
      const int p = c * 32 + i; const int t = z ? (T - 1 - p) : p;
      const float* y0 = s_yp + i * 128 + r0 * 4;
      const float4 u0 = *(const float4*)y0, u1 = *(const float4*)(y0 + 4), u2 = *(const float4*)(y0 + 8), u3 = *(const float4*)(y0 + 12);
      uint2 o; o.x = pack2((u0.x + u0.y) + (u0.z + u0.w), (u1.x + u1.y) + (u1.z + u1.w)); o.y = pack2((u2.x + u2.y) + (u2.z + u2.w), (u3.x + u3.y) + (u3.z + u3.w));
      *(uint2*)(P.hdir + ((size_t)z * NTOK + gs + t) * DM + 768 + h * 64 + rb * 32 + r0) = o;
    }
  }
  if (!sample) {
    float* so = P.out + O_RWKV + ((size_t)((seq * 2 + l) * 2 + z) * 4 + h) * 4096 + irow * 64 + cg4;
    *(float4*)so = make_float4(Aa.x, Aa.y, Ab.x, Ab.y); *(float4*)(so + 64) = make_float4(Ba.x, Ba.y, Bb.x, Bb.y);
  }
#undef RP_PREFETCH
}

DEV void rwkv_sample_task(const Params& P, int l, int task, const int z, char* smem0, const int tid_all_in) {
  const int tid_all = opaque_i(tid_all_in);
  const int half = tid_all >> 8, tid = tid_all & 255;
  constexpr int NR = 8;
  const int chain = task >> 3, rb = task & 7;
  int seq, h; bool sample; decode_chain(chain, seq, h, sample);
  int gs, T; seq_base(seq, gs, T);
  const int nch = T / 32;
#define RS_BUF(B) ((float*)(smem0 + (B) * HALF_LDS))
  if (half == 1) {
    const int si = tid >> 3, sc = (tid & 7) * 8;
    float kkc[8], kac[8], rkc[8];
#pragma unroll
    for (int e = 0; e < 8; ++e) { kkc[e] = P.rwkv_kk[l * 256 + h * 64 + sc + e]; kac[e] = P.rwkv_ka[l * 256 + h * 64 + sc + e]; rkc[e] = P.rwkv_rk[(l * 4 + h) * 64 + sc + e]; }
    float4 pr0, pr1, pk0, pk1, pw0, pw1, pa0, pa1, pv_ = make_float4(0.f, 0.f, 0.f, 0.f); float pinv;
#define RS_PREFETCH(C) { \
      const int p_ = (C) * 32 + si; const int t_ = z ? (T - 1 - p_) : p_; const int g_ = gs + t_; \
      const float* rk_ = P.rkv + (size_t)g_ * 768 + h * 64 + sc; \
      pr0 = *(const float4*)rk_; pr1 = *(const float4*)(rk_ + 4); \
      pk0 = *(const float4*)(rk_ + 256); pk1 = *(const float4*)(rk_ + 260); \
      const float* wp_ = P.wa + ((size_t)(g_ * 2 + z) * 2) * 256 + h * 64 + sc; \
      pw0 = *(const float4*)wp_; pw1 = *(const float4*)(wp_ + 4); \
      pa0 = *(const float4*)(wp_ + 256); pa1 = *(const float4*)(wp_ + 260); \
      pinv = P.khinv[g_ * 4 + h]; \
      if (tid < 64) { \
        const int p2_ = (C) * 32 + (tid >> 1); const int t2_ = z ? (T - 1 - p2_) : p2_; \
        pv_ = *(const float4*)(P.rkv + (size_t)(gs + t2_) * 768 + 512 + h * 64 + rb * NR + (tid & 1) * 4); \
      } }
#define RS_STAGE(C) { \
      float* bf_ = RS_BUF((C) & 1); \
      float* s_kh = bf_; float* s_w = bf_ + 2048; float* s_b = bf_ + 4096; float* s_kt = bf_ + 6144; float* s_r = bf_ + 8192; float* s_v = bf_ + 10240; \
      const float rr[8] = {pr0.x, pr0.y, pr0.z, pr0.w, pr1.x, pr1.y, pr1.z, pr1.w}; \
      const float kk[8] = {pk0.x, pk0.y, pk0.z, pk0.w, pk1.x, pk1.y, pk1.z, pk1.w}; \
      const float aa[8] = {pa0.x, pa0.y, pa0.z, pa0.w, pa1.x, pa1.y, pa1.z, pa1.w}; \
      float bsum = 0.f; float okh[8], ob[8], okt[8]; \
      _Pragma("unroll") for (int e = 0; e < 8; ++e) { okh[e] = kk[e] * kkc[e] * pinv; ob[e] = aa[e] * okh[e]; okt[e] = kk[e] * (1.f + (aa[e] - 1.f) * kac[e]); bsum += rr[e] * okt[e] * rkc[e]; } \
      float* d_; \
      d_ = s_kh + si * 64 + sc; *(float4*)d_ = make_float4(okh[0], okh[1], okh[2], okh[3]); *(float4*)(d_ + 4) = make_float4(okh[4], okh[5], okh[6], okh[7]); \
      d_ = s_w + si * 64 + sc; *(float4*)d_ = pw0; *(float4*)(d_ + 4) = pw1; \
      d_ = s_b + si * 64 + sc; *(float4*)d_ = make_float4(ob[0], ob[1], ob[2], ob[3]); *(float4*)(d_ + 4) = make_float4(ob[4], ob[5], ob[6], ob[7]); \
      d_ = s_kt + si * 64 + sc; *(float4*)d_ = make_float4(okt[0], okt[1], okt[2], okt[3]); *(float4*)(d_ + 4) = make_float4(okt[4], okt[5], okt[6], okt[7]); \
      d_ = s_r + si * 64 + sc; *(float4*)d_ = pr0; *(float4*)(d_ + 4) = pr1; \
      if (tid < 64) *(float4*)(s_v + (tid >> 1) * NR + (tid & 1) * 4) = pv_; \
      bsum += dppf<0xB1>(bsum); bsum += dppf<0x4E>(bsum); bsum += dppf<0x141>(bsum); \
      if (rb == 0 && (tid & 7) == 0) { const int p_ = (C) * 32 + si; const int t_ = z ? (T - 1 - p_) : p_; P.bonus[((size_t)z * NTOK + gs + t_) * 4 + h] = bsum; } }
#define RS_OUT(C) { \
      const float* yp_ = RS_BUF((C) & 1) + 10240 + 256; \
      const int i_ = tid >> 3, q2_ = tid & 7; \
      const int p_ = (C) * 32 + i_; const int t_ = z ? (T - 1 - p_) : p_; \
      const float* y0_ = yp_ + i_ * 128 + q2_ * 16; \
      float a0_ = 0.f; \
      _Pragma("unroll") for (int e = 0; e < 16; e += 4) { const float4 u0_ = *(const float4*)(y0_ + e); a0_ += (u0_.x + u0_.y) + (u0_.z + u0_.w); } \
      P.hdir[((size_t)z * NTOK + gs + t_) * DM + 768 + h * 64 + rb * NR + q2_] = f2bf(a0_); }
    RS_PREFETCH(0)
    RS_STAGE(0)
    if (nch > 1) RS_PREFETCH(1)
    __syncthreads();
    for (int c = 0; c < nch; ++c) {
      if (c + 1 < nch) { RS_STAGE(c + 1) if (c + 2 < nch) RS_PREFETCH(c + 2) }
      if (c > 0) RS_OUT(c - 1)
      __syncthreads();
    }
    RS_OUT(nch - 1)
#undef RS_PREFETCH
#undef RS_STAGE
#undef RS_OUT
  } else {
    __builtin_amdgcn_s_setprio(3);
    const int rl = tid >> 4, cg4 = (tid & 15) * 4;
    const bool rowthread = tid < 128;
    typedef float v2f __attribute__((ext_vector_type(2)));
    typedef float v4f __attribute__((ext_vector_type(4)));
    v2f Sa = {0.f, 0.f}, Sb = {0.f, 0.f};
    if (sample && rowthread) {
      const float4 s4 = *(const float4*)(P.st_rwkv + ((size_t)(((seq - 16) * 2 + l) * 2 + z) * 4 + h) * 4096 + (rb * NR + rl) * 64 + cg4);
      Sa.x = s4.x; Sa.y = s4.y; Sb.x = s4.z; Sb.y = s4.w;
    }
    __syncthreads();
    for (int c = 0; c < nch; ++c) {
      if (rowthread) {
        const float* bf = RS_BUF(c & 1);
        const float* s_kh = bf; const float* s_w = bf + 2048; const float* s_b = bf + 4096; const float* s_kt = bf + 6144; const float* s_r = bf + 8192; const float* s_v = bf + 10240;
        float* s_yp = (float*)bf + 10240 + 256;
        v4f kh = *(const v4f*)(s_kh + cg4), ww = *(const v4f*)(s_w + cg4), bb = *(const v4f*)(s_b + cg4), kt = *(const v4f*)(s_kt + cg4), rr = *(const v4f*)(s_r + cg4);
        float vi = s_v[rl];
#pragma unroll 8
        for (int i = 0; i < 32; ++i) {
          const int in = (i + 1) & 31;
          const v4f kh_n = *(const v4f*)(s_kh + in * 64 + cg4);
          const v4f ww_n = *(const v4f*)(s_w + in * 64 + cg4);
          const v4f bb_n = *(const v4f*)(s_b + in * 64 + cg4);
          const v4f kt_n = *(const v4f*)(s_kt + in * 64 + cg4);
          const v4f rr_n = *(const v4f*)(s_r + in * 64 + cg4);
          const float vi_n = s_v[in * NR + rl];
          const v2f v2 = {vi, vi};
          const v2f pp = __builtin_elementwise_fma(Sb, kh.zw, Sa * kh.xy);
          const float sk = red16(pp.x + pp.y);
          const v2f sk2 = {sk, sk};
          Sa = __builtin_elementwise_fma(-sk2, bb.xy, __builtin_elementwise_fma(v2, kt.xy, Sa * ww.xy));
          Sb = __builtin_elementwise_fma(-sk2, bb.zw, __builtin_elementwise_fma(v2, kt.zw, Sb * ww.zw));
          const v2f qq = __builtin_elementwise_fma(Sb, rr.zw, Sa * rr.xy);
          s_yp[i * 128 + tid] = qq.x + qq.y;
          kh = kh_n; ww = ww_n; bb = bb_n; kt = kt_n; rr = rr_n; vi = vi_n;
        }
      }
      __syncthreads();
    }
  }
  __builtin_amdgcn_s_setprio(0);
#undef RS_BUF
}

DEV void phase_scan(const Params& P, int l, char* smem0, int ctr_idx, int cls) {
  __shared__ int4 s_task4;
  int& s_task = *(int*)&s_task4;
  const int ntask = 496;
  for (;;) {
    __syncthreads();
    if (threadIdx.x == 0) s_task = (int)atomicAdd(P.ctr + ctr_idx, 1u);
    __syncthreads();
    const int t = s_task;
    if (t >= ntask) break;
    const int tid_ = THREAD_ID; const int half = tid_ >> 8, tid = tid_ & 255;
    char* smem = smem0 + half * HALF_LDS;
    if (t < 128) { if (cls & 1) rwkv_sample_task(P, l, t >> 1, t & 1, smem0, tid_); }
    else if (t < 144) { if (cls & 2) delta_sample_task(P, l, (t - 128) >> 1, t & 1, smem0, tid_); }
    else if (t < 160) { if (cls & 4) mlstm_sample_task(P, l, (t - 144) >> 1, t & 1, smem0, tid_); }
    else if (t < 176) { if (cls & 8) ret_sample_task(P, l, (t - 160) >> 1, t & 1, smem0, tid_); }
    else if (t < 304) { if (cls & 1) rwkv_prompt_task(P, l, (t - 176) + 16, half, smem, tid); }
    else if (t < 368) { if (cls & 2) delta_task(P, l, (t - 304) + 8, half, smem, tid, true); }
    else if (t < 432) { if (cls & 4) mlstm_task(P, l, (t - 368) + 8, half, smem, tid, true); }
    else if (t < 496) { if (cls & 8) ret_task(P, l, (t - 432) + 8, half, smem, tid, true); }
    else { if (cls & 16) { if (l == 1) conv_ff_layer1_item(P, 2 * (t - 624) + half, smem, tid); else conv_inout_layer1_item(P, 2 * (t - 624) + half, smem, tid); } }
  }
}

DEV void phase_combine(const Params& P, int l) {
  const int tid_ = THREAD_ID;
  const int lane = tid_ & 63;
  const int wid = blockIdx.x * (NTHREADS / 64) + (tid_ >> 6), nw = gridDim.x * (NTHREADS / 64);
  for (int g = wid; g < NTOK; g += nw) {
   const int c = lane * 4, head = lane >> 4;
#pragma unroll
   for (int m = 0; m < 4; ++m) {
    const uint2 h0 = *(const uint2*)(P.hdir + (size_t)g * DM + m * 256 + c);
    const uint2 h1 = *(const uint2*)(P.hdir + ((size_t)NTOK + g) * DM + m * 256 + c);
    float y[4];
    y[0] = __uint_as_float(h0.x << 16) + __uint_as_float(h1.x << 16);
    y[1] = __uint_as_float(h0.x & 0xffff0000u) + __uint_as_float(h1.x & 0xffff0000u);
    y[2] = __uint_as_float(h0.y << 16) + __uint_as_float(h1.y << 16);
    y[3] = __uint_as_float(h0.y & 0xffff0000u) + __uint_as_float(h1.y & 0xffff0000u);
    if (m != 1) {
      const float mean = red16(y[0] + y[1] + y[2] + y[3]) * (1.f / 64.f);
#pragma unroll
      for (int e = 0; e < 4; ++e) y[e] -= mean;
    }
    const float var = red16(y[0] * y[0] + y[1] * y[1] + y[2] * y[2] + y[3] * y[3]) * (1.f / 64.f);
    const float rs = rsqrtf(var + LNEPS);
    const float* gn = (m == 0 ? P.mlstm_norm : m == 1 ? P.delta_norm : m == 2 ? P.ret_norm : P.rwkv_norm) + l * 256 + c;
    const float4 g4 = *(const float4*)gn;
    y[0] *= rs * g4.x; y[1] *= rs * g4.y; y[2] *= rs * g4.z; y[3] *= rs * g4.w;
    float o[4];
    if (m == 3) {
      const uint2 gg = *(const uint2*)(P.gbuf + (size_t)g * 256 + c);
      const float gt[4] = {__uint_as_float(gg.x << 16), __uint_as_float(gg.x & 0xffff0000u), __uint_as_float(gg.y << 16), __uint_as_float(gg.y & 0xffff0000u)};
      const float bn = P.bonus[(size_t)g * 4 + head] + P.bonus[((size_t)NTOK + g) * 4 + head];
      const float4 v4 = *(const float4*)(P.rkv + (size_t)g * 768 + 512 + c);
      o[0] = gt[0] * (y[0] + bn * v4.x); o[1] = gt[1] * (y[1] + bn * v4.y); o[2] = gt[2] * (y[2] + bn * v4.z); o[3] = gt[3] * (y[3] + bn * v4.w);
    } else {
      const int goff = (m == 0) ? 768 : (m == 1) ? 1808 : 2848;
      const float4 a4 = *(const float4*)(P.projABC + (size_t)g * NABC + goff + c);
      if (m == 0) { o[0] = sigmoidf_(a4.x) * y[0]; o[1] = sigmoidf_(a4.y) * y[1]; o[2] = sigmoidf_(a4.z) * y[2]; o[3] = sigmoidf_(a4.w) * y[3]; }
      else { o[0] = siluf_(a4.x) * y[0]; o[1] = siluf_(a4.y) * y[1]; o[2] = siluf_(a4.z) * y[2]; o[3] = siluf_(a4.w) * y[3]; }
    }
    uint2 ov; ov.x = pack2(o[0], o[1]); ov.y = pack2(o[2], o[3]);
    *(uint2*)(P.ubuf + (size_t)g * DM + m * 256 + c) = ov;
   }
  }
}

#define XB_TMO      128
#define XB_XCNT(j)  (256  + 64 * (j))
#define XB_XSUB(j)  (1280 + 64 * (j))
#define XB_XGEN(j)  (2304 + 64 * (j))
#define XB_TOP      3328
#define XB_TOPGEN   3392
#define XCD_BAR_WORDS 3456
#define XB_SPIN_CAP (1u << 18)
#define LAS __attribute__((address_space(3)))

__device__ __forceinline__ unsigned xb_ld(unsigned* p)              { return __hip_atomic_load(p, __ATOMIC_RELAXED, __HIP_MEMORY_SCOPE_AGENT); }
__device__ __forceinline__ unsigned xb_add(unsigned* p, unsigned v) { return __hip_atomic_fetch_add(p, v, __ATOMIC_RELAXED, __HIP_MEMORY_SCOPE_AGENT); }
__device__ __forceinline__ unsigned xb_xcc_id() { return (unsigned)__builtin_amdgcn_s_getreg((3 << 11) | 20) & 0xFu; }
#define XB_SPIN(cond, bar) do { unsigned _sp = 0; while (cond) { __builtin_amdgcn_s_sleep(1); \
    if ((++_sp & 255u) == 0u) { if (xb_ld(&(bar)[XB_TMO])) break; if (_sp > XB_SPIN_CAP) { atomicAdd(&(bar)[XB_TMO], 1u); break; } } } } while (0)

struct XcdBarrier {
    unsigned* bar; unsigned x;
    volatile LAS unsigned* st;
};

__device__ __forceinline__ XcdBarrier xcd_barrier_post(unsigned* bar, volatile LAS unsigned* st) {
    XcdBarrier b; b.bar = bar; b.x = xb_xcc_id(); b.st = st;
    if (threadIdx.x == 0) (void)xb_add(&bar[XB_XCNT(b.x)], 1u);
    return b;
}
__device__ __forceinline__ void xcd_barrier_complete(unsigned* bar, unsigned x, unsigned& nloc, unsigned& nx) {
    const unsigned G = gridDim.x * gridDim.y * gridDim.z;
    unsigned sum, cnt, mine, sp = 0u;
    for (;;) {
        sum = 0u; cnt = 0u; mine = 0u;
#pragma unroll
        for (unsigned j = 0; j < 16; ++j) { const unsigned c = xb_ld(&bar[XB_XCNT(j)]); sum += c; cnt += (c > 0u) ? 1u : 0u; mine = (j == x) ? c : mine; }
        if (sum == G) break;
        __builtin_amdgcn_s_sleep(1);
        if ((++sp & 255u) == 0u) { if (xb_ld(&bar[XB_TMO])) break; if (sp > XB_SPIN_CAP) { atomicAdd(&bar[XB_TMO], 1u); break; } }
    }
    nloc = mine > 0u ? mine : 1u; nx = cnt > 0u ? cnt : 1u;
}

__device__ __forceinline__ void xcd_barrier(const XcdBarrier& b) {
    asm volatile("s_waitcnt vmcnt(0)" ::: "memory");
    __syncthreads();
    if (threadIdx.x == 0) {
        unsigned* bar = b.bar;
        __builtin_amdgcn_s_waitcnt(0);
        unsigned nloc = b.st[0], nx = b.st[1];
        if (nloc == 0u) { xcd_barrier_complete(bar, b.x, nloc, nx); b.st[0] = nloc; b.st[1] = nx; }
        const unsigned old = xb_add(&bar[XB_XSUB(b.x)], 1u);
        const unsigned gen = old / nloc;
        if (old + 1u == (gen + 1u) * nloc) {
            __builtin_amdgcn_fence(__ATOMIC_RELEASE, "agent");
            asm volatile("s_waitcnt vmcnt(0)" ::: "memory");
            const unsigned og = xb_add(&bar[XB_TOP], 1u);
            const unsigned tg = og / nx;
            if (og + 1u == (tg + 1u) * nx) xb_add(&bar[XB_TOPGEN], 1u);
            else XB_SPIN(xb_ld(&bar[XB_TOPGEN]) == tg, bar);
            __builtin_amdgcn_fence(__ATOMIC_ACQUIRE, "agent");
            xb_add(&bar[XB_XGEN(b.x)], 1u);
            asm volatile("s_waitcnt vmcnt(0)" ::: "memory");
        } else {
            XB_SPIN(xb_ld(&bar[XB_XGEN(b.x)]) == gen, bar);
            __builtin_amdgcn_fence(__ATOMIC_ACQUIRE, "agent");
            asm volatile("s_waitcnt vmcnt(0)" ::: "memory");
        }
    }
    __syncthreads();
}

__global__ void __launch_bounds__(NTHREADS, 2) mega(Params P) {
  extern __shared__ __attribute__((aligned(16))) char smem[];
  cg::grid_group grid = cg::this_grid();
  __shared__ uint4 xb_words;
  if (threadIdx.x == 0) xb_words = make_uint4(0u, 0u, 0u, 0u);
  __syncthreads();
  XcdBarrier xb = xcd_barrier_post(P.bar, (volatile LAS unsigned*)&xb_words);
  for (int i = 0; i < PROBE_EXTRA_SYNCS; ++i) xcd_barrier(xb);
  for (int ph = (int)P.phase_lo; ph < (int)P.phase_hi; ++ph) {
   const int nrep = ((ph >= 2 && ((PROBE_DUP_MASK >> ((ph - 2) % 10)) & 1)) || (ph == 0 && PROBE_DUP_PRO)) ? 2 : 1;
   for (int rep = 0; rep < nrep; ++rep) {
    if (ph == 0) phase_prologue(P, smem, rep);
    else if (ph == 1) phase_ln(P, 0, 0);
    else {
      const int l = (ph - 2) / 10, s = (ph - 2) % 10;
      switch (s) {
        case 0: { EpiProj E; E.projABC = P.projABC; E.pdraw = P.pdraw; E.col0 = 0; phase_gemm(P.ubuf, P.wt_in + (size_t)l * PINP * DM, 4096, DM, E, smem); } break;
        case 1: { if (blockIdx.x < 32) { EpiProj E; E.projABC = P.projABC; E.pdraw = P.pdraw; E.col0 = 4096;
                    phase_gemm(P.ubuf, P.wt_in + (size_t)l * PINP * DM + (size_t)4096 * DM, 256, DM, E, smem, 0, 1 << 20, 32);
                    asm volatile("s_waitcnt vmcnt(0)" ::: "memory"); __syncthreads();
                    if (threadIdx.x == 0) { __threadfence(); atomicAdd(P.ctr + 16 + l * 2 + rep, 1u); } }
                  __shared__ int4 s_it4; int& s_it = *(int*)&s_it4;
                  for (;;) {
                    __syncthreads();
                    if (threadIdx.x == 0) s_it = (int)atomicAdd(P.ctr + 8 + l * 2 + rep, 1u);
                    __syncthreads();
                    const int it = s_it;
                    if (it >= 64 * 9) break;
                    const int tid_ = THREAD_ID; const int half = tid_ >> 8;
                    if (it < 64) rwkv_prep_item(P, l, 2 * it + half, 0, smem + half * HALF_LDS, tid_ & 255);
                    else if (it < 64 * 6) { const int j = it - 64; rwkv_prep_item(P, l, 2 * (j / 5) + half, 1 + j % 5, smem + half * HALF_LDS, tid_ & 255); }
                    else {
                      if (threadIdx.x == 0) { while (__hip_atomic_load(P.ctr + 16 + l * 2 + rep, __ATOMIC_RELAXED, __HIP_MEMORY_SCOPE_AGENT) < 32u) __builtin_amdgcn_s_sleep(2); }
                      __syncthreads();
                      const int j = it - 64 * 6; delta_prep_item(P, l, 2 * (j / 3) + half, j % 3, tid_ & 255); } } } break;
        case 2: { const int tid_ = THREAD_ID; const int half = tid_ >> 8;
                  for (int it = blockIdx.x; it < 512; it += gridDim.x) delta_T_item(P, l, 2 * it + half, smem + half * HALF_LDS, tid_ & 255); } break;
        case 3: phase_scan(P, l, smem, l + 2 * rep, rep == 0 ? 31 : PROBE_SCAN_CLASS); break;
        case 4: phase_combine(P, l); break;
        case 5: { EpiRes E; E.out = P.out; E.xp = (l == 0) ? P.x_prompt : P.out; E.xs = (l == 0) ? P.x_sample : P.out + (size_t)4096 * DM; E.gate = P.mod + (size_t)l * 3 * 6144 + 2048;
                  phase_gemm(P.ubuf, P.wt_out + (size_t)l * DM * DM, DM, DM, E, smem);
                  if (blockIdx.x >= 128) {
                    const int tid_ = THREAD_ID; const int half = tid_ >> 8, tid = tid_ & 255;
                    float* tile = (float*)(smem + half * HALF_LDS);
                    const int npair = (l == 1) ? 1024 : 672;
                    int j = blockIdx.x - 128;
                    ConvDesc d = deferred_conv_desc(P, l, 2 * j + half);
                    float4 a, b, c, e4; conv_tile_load(d, tid, a, b, c, e4);
                    while (j < npair) {
                      const int jn = j + 128;
                      ConvDesc dn = d; float4 an = a, bn = b, cn = c, en = e4;
                      if (jn < npair) { dn = deferred_conv_desc(P, l, 2 * jn + half); conv_tile_load(dn, tid, an, bn, cn, en); }
                      conv_tile_finish(d, tile, tid, a, b, c, e4);
                      d = dn; a = an; b = bn; c = cn; e4 = en; j = jn;
                    }
                  } } break;
        case 6: phase_ln(P, 1, l); break;
        case 7: { EpiFF1 E; E.hidden = P.hidden; phase_gemm(P.ubuf, P.wt_ff1, DFF, DM, E, smem); } break;
        case 8: { EpiResSplit E; E.out = P.out; E.tmp = P.ff2tmp; E.gate = P.mod + (size_t)l * 3 * 6144 + 5120;
                  phase_gemm(P.hidden, P.wt_ff2, 2 * DM, DFF / 2, E, smem, DFF, 4); } break;
        case 9: phase_ln(P, 2, l); break;
      }
    }
    if (ph + 1 < (int)P.phase_hi || rep + 1 < nrep) {
      if (P.phase_hi > 1000) grid.sync(); else xcd_barrier(xb);
    }
   }
  }
}

#ifndef MK_MULTI
#define MK_MULTI 0
#endif

extern "C" void kernel_launch(void* const* d_in, const int* in_sizes, int n_in, void* d_out, int out_size, void* d_ws, size_t ws_size, hipStream_t stream) {
  static int grid_blocks = 0;
  if (!grid_blocks) {
    int dev = 0, cus = 0, per_cu = 0;
    hipGetDevice(&dev);
    hipDeviceGetAttribute(&cus, hipDeviceAttributeMultiprocessorCount, dev);
    if (hipFuncSetAttribute((const void*)mega, hipFuncAttributeMaxDynamicSharedMemorySize, LDS_BYTES) != hipSuccess) fprintf(stderr, "hipFuncSetAttribute failed\n");
    hipOccupancyMaxActiveBlocksPerMultiprocessor(&per_cu, (const void*)mega, NTHREADS, LDS_BYTES);
    if (per_cu < 1) { fprintf(stderr, "occupancy query returned %d\n", per_cu); per_cu = 1; }
    if (per_cu > 1) per_cu = 1;
    grid_blocks = cus * per_cu;
    fprintf(stderr, "mega: cus %d per_cu %d grid %d ws %zu\n", cus, per_cu, grid_blocks, ws_size);
  }
  Params p{};
  const float** pin = (const float**)&p;
  for (int i = 0; i < 39; ++i) pin[i] = (const float*)d_in[i];
  p.out = (float*)d_out;
  char* ws = (char*)d_ws; size_t off = 0;
  auto take = [&](size_t bytes) { char* r = ws + off; off += (bytes + 255) & ~(size_t)255; return r; };
  p.ctr = (unsigned*)take(256);
  p.bar = (unsigned*)take(XCD_BAR_WORDS * 4);
  p.wt_in = (bf16_t*)take((size_t)2 * PINP * DM * 2);
  p.wt_out = (bf16_t*)take((size_t)2 * DM * DM * 2);
  p.wt_ff1 = (bf16_t*)take((size_t)DM * DFF * 2);
  p.wt_ff2 = (bf16_t*)take((size_t)DM * DFF * 2);
  p.ubuf = (bf16_t*)take((size_t)NTOK * DM * 2);
  p.projABC = (float*)take((size_t)NTOK * NABC * 4);
  p.hidden = (bf16_t*)p.projABC;
  p.ff2tmp = (float*)((char*)p.projABC + (size_t)NTOK * DFF * 2);
  p.pdraw = (float*)take((size_t)NTOK * NPD * 4);
  p.hdir = (bf16_t*)p.pdraw;
  p.rkv = (float*)take((size_t)NTOK * 768 * 4);
  p.wa = (float*)take((size_t)NTOK * 1024 * 4);
  p.gbuf = (bf16_t*)take((size_t)NTOK * 256 * 2);
  p.mod = (float*)take((size_t)2 * 3 * 6144 * 4);
  p.khinv = (float*)take((size_t)NTOK * 4 * 4);
  p.bonus = (float*)take((size_t)2 * NTOK * 4 * 4);
  p.dbeta = (float*)take((size_t)8 * NTOK * 4);
  p.dgc = (float*)take((size_t)8 * NTOK * 4);
  p.dT = (bf16_t*)take((size_t)1024 * 4096 * 2);
  p.w2t = (bf16_t*)take((size_t)4 * 256 * 64 * 2);
  p.a2t = (bf16_t*)take((size_t)4 * 256 * 64 * 2);
  p.g2t = (bf16_t*)take((size_t)2 * 256 * 128 * 2);
  if (off > ws_size) { fprintf(stderr, "workspace too small: need %zu have %zu\n", off, ws_size); return; }
  hipMemsetAsync(p.ctr, 0, 256 + ((XCD_BAR_WORDS * 4 + 255) & ~255), stream);
  const int nph = 2 + 10 * 2;
#if MK_MULTI
  for (int ph = 0; ph < nph; ++ph) {
    p.phase_lo = ph; p.phase_hi = ph + 1;
    void* args[] = {&p};
    hipLaunchCooperativeKernel((const void*)mega, dim3(grid_blocks), dim3(NTHREADS), args, LDS_BYTES, stream);
  }
#else
  p.phase_lo = 0; p.phase_hi = nph;
  void* args[] = {&p};
  hipError_t e = hipLaunchCooperativeKernel((const void*)mega, dim3(grid_blocks), dim3(NTHREADS), args, LDS_BYTES, stream);
  if (e != hipSuccess) fprintf(stderr, "cooperative launch failed: %s (grid %d)\n", hipGetErrorString(e), grid_blocks);
#endif
}
```

```cpp
#include <hip/hip_runtime.h>
#include <hip/hip_cooperative_groups.h>
#include <cstdio>
#include <cstdint>
namespace cg = cooperative_groups;

typedef unsigned short bf16_t;
typedef short bf16x8 __attribute__((ext_vector_type(8)));
typedef float f32x16 __attribute__((ext_vector_type(16)));
typedef float f32x4 __attribute__((ext_vector_type(4)));
#define DEV __device__ __forceinline__

#ifndef PROBE_SCAN_CLASS
#define PROBE_SCAN_CLASS 31
#endif
#ifndef PROBE_DUP_PRO
#define PROBE_DUP_PRO 0
#endif
#ifndef PROBE_EXTRA_SYNCS
#define PROBE_EXTRA_SYNCS 0
#endif
#ifndef PROBE_DUP_MASK
#define PROBE_DUP_MASK 0
#endif
constexpr int NTOK = 8192, DM = 1024, PIN = 4256, PINP = 4352, NABC = 3104, NPD = 1152, DFF = 4096;
constexpr float ALPHA = 1.41421356237f, LNEPS = 1e-5f;
constexpr int LDB = 72;
constexpr int TILE_B = 64 * LDB * 2;
constexpr int HALF_LDS = 77824;
constexpr int LDS_BYTES = 2 * HALF_LDS;
constexpr int NTHREADS = 512;
constexpr size_t O_C = 8388608, O_N = 9437184, O_M = 9453568, O_DELTA = 9453824, O_RET = 10502400, O_RWKV = 11550976;

struct Params {
  const float *x_prompt, *x_sample, *c, *st_C, *st_n, *st_m, *st_delta, *st_ret, *st_rwkv, *c_ctx;
  const float *w_mod, *b_mod, *w_in, *w_out, *ln1_g, *ln1_b, *ln2_g, *ln2_b, *w_ff1, *w_ff2;
  const float *mlstm_i_bias, *mlstm_f_bias, *mlstm_norm, *delta_conv, *delta_a_log, *delta_dt_bias, *delta_norm;
  const float *ret_decay, *ret_norm, *rwkv_mu, *rwkv_w0, *rwkv_w2, *rwkv_a0, *rwkv_a2, *rwkv_g2, *rwkv_kk, *rwkv_ka, *rwkv_rk, *rwkv_norm;
  float* out;
  bf16_t *wt_in, *wt_out, *wt_ff1, *wt_ff2, *ubuf, *hdir, *gbuf, *hidden;
  float *mod, *projABC, *pdraw, *rkv, *wa, *khinv, *bonus, *dbeta, *dgc, *ff2tmp;
  bf16_t *dT, *w2t, *a2t, *g2t;
  unsigned* ctr; unsigned* bar;
  long long phase_lo, phase_hi;
};

DEV int opaque_i(int v) { asm volatile("" : "+v"(v)); return v; }
#define THREAD_ID opaque_i((int)threadIdx.x)
typedef float f32x2_t __attribute__((ext_vector_type(2)));
typedef __bf16 bf16x2_t __attribute__((ext_vector_type(2)));
DEV unsigned pack2(float a, float b) { f32x2_t v = {a, b}; bf16x2_t r = __builtin_convertvector(v, bf16x2_t); return __builtin_bit_cast(unsigned, r); }
DEV bf16_t f2bf(float f) { return (bf16_t)pack2(f, f); }
DEV float bf2f(bf16_t h) { return __uint_as_float(((unsigned)h) << 16); }
DEV float sigmoidf_(float x) { return 1.f / (1.f + __expf(-x)); }
DEV float siluf_(float x) { return x / (1.f + __expf(-x)); }
DEV float softplusf_(float x) { return x > 20.f ? x : log1pf(__expf(x)); }
DEV float logsigmoidf_(float x) { return -softplusf_(-x); }
template <int CTRL> DEV float dppf(float x) { return __builtin_bit_cast(float, __builtin_amdgcn_mov_dpp(__builtin_bit_cast(int, x), CTRL, 0xf, 0xf, true)); }
DEV float red4(float x) { x += dppf<0xB1>(x); x += dppf<0x4E>(x); return x; }
DEV float red16(float x) { x = red4(x); x += dppf<0x141>(x); x += dppf<0x128>(x); return x; }
DEV float wave_sum(float x) { x = red16(x); x += __shfl_xor(x, 16); x += __shfl_xor(x, 32); return x; }
DEV void tok_info(int g, int& gs, int& T, int& ci) {
  if (g < 4096) { gs = g & ~255; T = 256; ci = 0; } else { int b = (g - 4096) >> 11; gs = 4096 + (b << 11); T = 2048; ci = 1 + b; }
}
DEV const float* xin_row(const Params& P, int g) { return g < 4096 ? P.x_prompt + (size_t)g * DM : P.x_sample + (size_t)(g - 4096) * DM; }

DEV f32x16 mm64(const bf16_t* A, const bf16_t* Bt, int wr, int wc, int lane, f32x16 acc) {
  const bf16_t* ap = A + (wr * 32 + (lane & 31)) * LDB + (lane >> 5) * 8;
  const bf16_t* bp = Bt + (wc * 32 + (lane & 31)) * LDB + (lane >> 5) * 8;
#pragma unroll
  for (int s = 0; s < 4; ++s) {
    bf16x8 a = *(const bf16x8*)(ap + s * 16);
    bf16x8 b = *(const bf16x8*)(bp + s * 16);
    acc = __builtin_amdgcn_mfma_f32_32x32x16_bf16(a, b, acc, 0, 0, 0);
  }
  return acc;
}
DEV f32x16 zero16() { f32x16 z; for (int i = 0; i < 16; ++i) z[i] = 0.f; return z; }
#define ACC_ROW(idx) (wr * 32 + ((idx) & 3) + 8 * ((idx) >> 2) + 4 * (lane >> 5))
#define ACC_COL (wc * 32 + (lane & 31))

DEV void conv_tile(const float* __restrict__ src, bf16_t* __restrict__ dst, int K, int N, int tk, int tn, float* tile, const int tid_in, const int dst_row_shift = 0) {
  const int tid = opaque_i(tid_in);
  const int k0 = tk * 64, n0 = tn * 64;
  { const int r = tid >> 2, cs = (tid & 3) * 16;
#pragma unroll
    for (int e = 0; e < 16; e += 4) {
      const int n = n0 + cs + e;
      float4 v = make_float4(0.f, 0.f, 0.f, 0.f);
      if (n < N) v = *(const float4*)(src + (size_t)(k0 + r) * N + n);
      tile[r * 65 + cs + e] = v.x; tile[r * 65 + cs + e + 1] = v.y; tile[r * 65 + cs + e + 2] = v.z; tile[r * 65 + cs + e + 3] = v.w;
    } }
  __syncthreads();
  { const int nl = tid >> 2, ks = (tid & 3) * 16;
    unsigned pk[8];
#pragma unroll
    for (int e = 0; e < 8; ++e) pk[e] = pack2(tile[(ks + 2 * e) * 65 + nl], tile[(ks + 2 * e + 1) * 65 + nl]);
    uint4* d = (uint4*)(dst + (size_t)(n0 + nl + dst_row_shift) * K + k0 + ks);
    d[0] = make_uint4(pk[0], pk[1], pk[2], pk[3]); d[1] = make_uint4(pk[4], pk[5], pk[6], pk[7]); }
  __syncthreads();
}

DEV void mod_gemv_item(const Params& P, int item, float* red, const int tid) {
  const int j0 = item * 64, l = j0 / 6144, jj = j0 % 6144;
  const int cq = tid & 15, kg = tid >> 4;
  const float* W = P.w_mod + (size_t)l * DM * 6144 + jj + cq * 4;
  float a0[4] = {0, 0, 0, 0}, a1[4] = {0, 0, 0, 0}, a2[4] = {0, 0, 0, 0};
  for (int kk = 0; kk < 64; ++kk) {
    const int k = kg * 64 + kk;
    const float4 w = *(const float4*)(W + (size_t)k * 6144);
    const float s0 = siluf_(P.c_ctx[k]), s1 = siluf_(P.c[k]), s2 = siluf_(P.c[DM + k]);
    a0[0] += s0 * w.x; a0[1] += s0 * w.y; a0[2] += s0 * w.z; a0[3] += s0 * w.w;
    a1[0] += s1 * w.x; a1[1] += s1 * w.y; a1[2] += s1 * w.z; a1[3] += s1 * w.w;
    a2[0] += s2 * w.x; a2[1] += s2 * w.y; a2[2] += s2 * w.z; a2[3] += s2 * w.w;
  }
#pragma unroll
  for (int e = 0; e < 4; ++e) { red[(kg * 3 + 0) * 64 + cq * 4 + e] = a0[e]; red[(kg * 3 + 1) * 64 + cq * 4 + e] = a1[e]; red[(kg * 3 + 2) * 64 + cq * 4 + e] = a2[e]; }
  __syncthreads();
  if (tid < 192) {
    const int ci = tid >> 6, col = tid & 63;
    float s = P.b_mod[l * 6144 + jj + col];
    for (int g = 0; g < 16; ++g) s += red[(g * 3 + ci) * 64 + col];
    P.mod[(size_t)(l * 3 + ci) * 6144 + jj + col] = s;
  }
  __syncthreads();
}

DEV void prologue_item(const Params& P, int t, float* tile, const int tid) {
  const int n_in = 16 * 68, n_out = 16 * 16, n_ff = 1024;
  const int total = 192 + 48 + n_in + n_out + 2 * n_ff;
  if (t >= total) { __syncthreads(); __syncthreads(); return; }
  if (t < 192) { mod_gemv_item(P, t, tile, tid); return; }
  if (t < 240) {
    const int v = t - 192;
    if (v < 32) { const int m = v >> 2, tn = v & 3, lz = m >> 1, kind = m & 1;
      conv_tile((kind == 0 ? P.rwkv_w2 : P.rwkv_a2) + (size_t)lz * 64 * 256, (kind == 0 ? P.w2t : P.a2t) + (size_t)lz * 256 * 64, 64, 256, 0, tn, tile, tid); }
    else { const int m = (v - 32) >> 3, r = (v - 32) & 7; conv_tile(P.rwkv_g2 + (size_t)m * 128 * 256, P.g2t + (size_t)m * 256 * 128, 128, 256, r >> 2, r & 3, tile, tid); }
    return;
  }
  int u = t - 240;
  if (u < n_in) { const int tn = u % 68; conv_tile(P.w_in, P.wt_in, DM, PIN, u / 68, tn, tile, tid, tn < 12 ? 0 : (tn < 16 ? 3328 : -256)); return; }
  u -= n_in;
  if (u < n_out) { conv_tile(P.w_out, P.wt_out, DM, DM, u / 16, u % 16, tile, tid); return; }
  u -= n_out;
  if (u < n_ff) { conv_tile(P.w_ff1, P.wt_ff1, DM, DFF, u / 64, u % 64, tile, tid); return; }
  u -= n_ff;
  { const int tk = u / 16, kh = tk >> 5; conv_tile(P.w_ff2 + (size_t)kh * 2048 * DM, P.wt_ff2 + (size_t)kh * DM * 2048, 2048, DM, tk & 31, u % 16, tile, tid); }
}
DEV void phase_prologue(const Params& P, char* smem, int rep) {
  const int tid_ = THREAD_ID; const int half = tid_ >> 8, tid = tid_ & 255;
  float* tile = (float*)(smem + half * HALF_LDS);
  const int total = 192 + 48 + 16 * 68 + 256 + 2 * 1024;
  __shared__ int4 s_pj4; int& s_pj = *(int*)&s_pj4;
  for (;;) {
    __syncthreads();
    if (threadIdx.x == 0) s_pj = (int)atomicAdd(P.ctr + 6 + rep, 1u);
    __syncthreads();
    const int j = s_pj;
    if (2 * j >= total) break;
    prologue_item(P, 2 * j + half, tile, tid);
  }
}
struct ConvDesc { const float* src; bf16_t* dst; int K, N, tk, tn, shift; };
DEV void conv_tile_load(const ConvDesc& d, const int tid, float4& a, float4& b, float4& c, float4& e4) {
  const int r = tid >> 2, cs = (tid & 3) * 16;
  const float* p = d.src + (size_t)(d.tk * 64 + r) * d.N + d.tn * 64 + cs;
  const float4 z4 = make_float4(0.f, 0.f, 0.f, 0.f);
  const int n = d.tn * 64 + cs;
  a = z4; b = z4; c = z4; e4 = z4;
  if (n < d.N) a = *(const float4*)p;
  if (n + 4 < d.N) b = *(const float4*)(p + 4);
  if (n + 8 < d.N) c = *(const float4*)(p + 8);
  if (n + 12 < d.N) e4 = *(const float4*)(p + 12);
}
DEV void conv_tile_finish(const ConvDesc& d, float* tile, const int tid, const float4 a, const float4 b, const float4 c, const float4 e4) {
  { const int r = tid >> 2, cs = (tid & 3) * 16;
    float* t = tile + r * 65 + cs;
    t[0] = a.x; t[1] = a.y; t[2] = a.z; t[3] = a.w; t[4] = b.x; t[5] = b.y; t[6] = b.z; t[7] = b.w;
    t[8] = c.x; t[9] = c.y; t[10] = c.z; t[11] = c.w; t[12] = e4.x; t[13] = e4.y; t[14] = e4.z; t[15] = e4.w; }
  __syncthreads();
  { const int nl = tid >> 2, ks = (tid & 3) * 16;
    unsigned pk[8];
#pragma unroll
    for (int e = 0; e < 8; ++e) pk[e] = pack2(tile[(ks + 2 * e) * 65 + nl], tile[(ks + 2 * e + 1) * 65 + nl]);
    uint4* o = (uint4*)(d.dst + (size_t)(d.tn * 64 + nl + d.shift) * d.K + d.tk * 64 + ks);
    o[0] = make_uint4(pk[0], pk[1], pk[2], pk[3]); o[1] = make_uint4(pk[4], pk[5], pk[6], pk[7]); }
  __syncthreads();
}
DEV ConvDesc deferred_conv_desc(const Params& P, int l, int u) {
  ConvDesc d; d.shift = 0;
  if (l == 1) {
    if (u < 1024) { d.src = P.w_ff1 + (size_t)DM * DFF; d.dst = P.wt_ff1; d.K = DM; d.N = DFF; d.tk = u / 64; d.tn = u % 64; }
    else { u -= 1024; const int tk = u / 16, kh = tk >> 5; d.src = P.w_ff2 + (size_t)DM * DFF + (size_t)kh * 2048 * DM; d.dst = P.wt_ff2 + (size_t)kh * DM * 2048; d.K = 2048; d.N = DM; d.tk = tk & 31; d.tn = u % 16; }
  } else {
    if (u < 1088) { const int tn = u % 68; d.src = P.w_in + (size_t)DM * PIN; d.dst = P.wt_in + (size_t)PINP * DM; d.K = DM; d.N = PIN; d.tk = u / 68; d.tn = tn; d.shift = tn < 12 ? 0 : (tn < 16 ? 3328 : -256); }
    else { u -= 1088; d.src = P.w_out + (size_t)DM * DM; d.dst = P.wt_out + (size_t)DM * DM; d.K = DM; d.N = DM; d.tk = u / 16; d.tn = u % 16; }
  }
  return d;
}
DEV void conv_inout_layer1_item(const Params& P, int u, char* smem, const int tid) {
  float* tile = (float*)smem;
  if (u < 1088) { const int tn = u % 68; conv_tile(P.w_in + (size_t)DM * PIN, P.wt_in + (size_t)PINP * DM, DM, PIN, u / 68, tn, tile, tid, tn < 12 ? 0 : (tn < 16 ? 3328 : -256)); }
  else { u -= 1088; conv_tile(P.w_out + (size_t)DM * DM, P.wt_out + (size_t)DM * DM, DM, DM, u / 16, u % 16, tile, tid); }
}
DEV void conv_ff_layer1_item(const Params& P, int u, char* smem, const int tid) {
  float* tile = (float*)smem;
  if (u < 1024) conv_tile(P.w_ff1 + (size_t)DM * DFF, P.wt_ff1, DM, DFF, u / 64, u % 64, tile, tid);
  else { u -= 1024; const int tk = u / 16, kh = tk >> 5; conv_tile(P.w_ff2 + (size_t)DM * DFF + (size_t)kh * 2048 * DM, P.wt_ff2 + (size_t)kh * DM * 2048, 2048, DM, tk & 31, u % 16, tile, tid); }
}

DEV void phase_ln(const Params& P, int mode, int l) {
  const int tid_ = THREAD_ID;
  const int lane = tid_ & 63;
  const int wid = blockIdx.x * (NTHREADS / 64) + (tid_ >> 6), nw = gridDim.x * (NTHREADS / 64);
  float4 nx0, nx1, nx2, nx3, nt0, nt1, nt2, nt3;
  nt0 = nt1 = nt2 = nt3 = make_float4(0.f, 0.f, 0.f, 0.f);
#define LN_LOAD(G) { const float* src_ = (mode == 0) ? xin_row(P, (G)) : (P.out + (size_t)(G) * DM); \
    nx0 = *(const float4*)(src_ + lane * 4); nx1 = *(const float4*)(src_ + 256 + lane * 4); nx2 = *(const float4*)(src_ + 512 + lane * 4); nx3 = *(const float4*)(src_ + 768 + lane * 4); \
    if (mode == 2) { const float* t_ = P.ff2tmp + (size_t)(G) * DM + lane * 4; nt0 = *(const float4*)t_; nt1 = *(const float4*)(t_ + 256); nt2 = *(const float4*)(t_ + 512); nt3 = *(const float4*)(t_ + 768); } }
  if (wid < NTOK) LN_LOAD(wid)
  for (int g = wid; g < NTOK; g += nw) {
    int gs, T, ci; tok_info(g, gs, T, ci);
    float v[16];
    { const float4 xs[4] = {nx0, nx1, nx2, nx3};
#pragma unroll
      for (int k = 0; k < 4; ++k) { v[4 * k] = xs[k].x; v[4 * k + 1] = xs[k].y; v[4 * k + 2] = xs[k].z; v[4 * k + 3] = xs[k].w; } }
    if (mode == 2) {
      const float* gt = P.mod + (size_t)(l * 3 + ci) * 6144 + 5120;
      const float4 ts[4] = {nt0, nt1, nt2, nt3};
#pragma unroll
      for (int k = 0; k < 4; ++k) { const float4 t = ts[k], g4 = *(const float4*)(gt + k * 256 + lane * 4);
        v[4 * k] += g4.x * t.x; v[4 * k + 1] += g4.y * t.y; v[4 * k + 2] += g4.z * t.z; v[4 * k + 3] += g4.w * t.w; }
    }
    if (g + nw < NTOK) LN_LOAD(g + nw)
    float s = 0.f;
#pragma unroll
    for (int i = 0; i < 16; ++i) s += v[i];
    float mu = wave_sum(s) * (1.f / DM);
    float q = 0.f;
#pragma unroll
    for (int i = 0; i < 16; ++i) { v[i] -= mu; q += v[i] * v[i]; }
    float rstd = rsqrtf(wave_sum(q) * (1.f / DM) + LNEPS);
#pragma unroll
    for (int i = 0; i < 16; ++i) v[i] *= rstd;
    int lm = l, shoff = 0, scoff = 1024;
    bool write_u = true;
    if (mode != 0) {
      const float* gg = (mode == 1 ? P.ln1_g : P.ln2_g) + l * DM;
      const float* bb = (mode == 1 ? P.ln1_b : P.ln2_b) + l * DM;
#pragma unroll
      for (int k = 0; k < 4; ++k) {
        const float4 g4 = *(const float4*)(gg + k * 256 + lane * 4), b4 = *(const float4*)(bb + k * 256 + lane * 4);
        v[4 * k] = v[4 * k] * g4.x + b4.x; v[4 * k + 1] = v[4 * k + 1] * g4.y + b4.y; v[4 * k + 2] = v[4 * k + 2] * g4.z + b4.z; v[4 * k + 3] = v[4 * k + 3] * g4.w + b4.w;
        *(float4*)(P.out + (size_t)g * DM + k * 256 + lane * 4) = make_float4(v[4 * k], v[4 * k + 1], v[4 * k + 2], v[4 * k + 3]);
      }
      if (mode == 1) { shoff = 3072; scoff = 4096; } else { lm = l + 1; write_u = (l == 0); }
      if (write_u) {
        s = 0.f;
#pragma unroll
        for (int i = 0; i < 16; ++i) s += v[i];
        mu = wave_sum(s) * (1.f / DM);
        q = 0.f;
#pragma unroll
        for (int i = 0; i < 16; ++i) { v[i] -= mu; q += v[i] * v[i]; }
        rstd = rsqrtf(wave_sum(q) * (1.f / DM) + LNEPS);
#pragma unroll
        for (int i = 0; i < 16; ++i) v[i] *= rstd;
      }
    }
    if (write_u) {
      const float* md = P.mod + (size_t)(lm * 3 + ci) * 6144;
#pragma unroll
      for (int k = 0; k < 4; ++k) {
        const float4 sh = *(const float4*)(md + shoff + k * 256 + lane * 4), sc = *(const float4*)(md + scoff + k * 256 + lane * 4);
        uint2 o;
        o.x = pack2(v[4 * k] * (1.f + sc.x) + sh.x, v[4 * k + 1] * (1.f + sc.y) + sh.y);
        o.y = pack2(v[4 * k + 2] * (1.f + sc.z) + sh.z, v[4 * k + 3] * (1.f + sc.w) + sh.w);
        *(uint2*)(P.ubuf + (size_t)g * DM + k * 256 + lane * 4) = o;
      }
    }
  }
}

namespace pg8 {
#define PG8_LAS __attribute__((address_space(3)))
typedef unsigned short bf16_t;
typedef short bf16x8 __attribute__((ext_vector_type(8)));
typedef float f32x4 __attribute__((ext_vector_type(4)));
typedef unsigned u32x4 __attribute__((ext_vector_type(4)));
constexpr int BM = 256, BK = 64, HALF = 128, HTB = HALF * BK * 2  , STAGE_BYTES = 8 * HTB, NXCD = 8, WGM = 8;

__host__ __device__ __forceinline__ int lds_byte(int r, int c) { const int st = (r >> 4) * 2 + (c >> 5), rr = r & 15, cc = c & 31, ob = rr * 64 + cc * 2; return st * 1024 + (ob ^ (((ob >> 9) & 1) << 5)); }
__host__ __device__ __forceinline__ void stage_rc(int b, int& R, int& C) { const int st = b / 1024, sb = b % 1024, swz = sb ^ (((sb >> 9) & 1) << 5); R = (st >> 1) * 16 + swz / 64; C = (st & 1) * 32 + (swz % 64) / 2; }
__host__ __device__ __forceinline__ int perm32(int rho) { const int n = rho >> 4, i = rho & 15; return 8 * (i >> 2) + 4 * n + (i & 3); }

struct Unit { int pm, pn; };
struct Gemm { const bf16_t* A; const bf16_t* Bt; int M, N, K; int lda; int nsplit; };

struct StaticOrder {
    int nM, nN, nwg, G, c;
    __host__ __device__ void init(int M, int N, int G_, int c_) { nM = M / BM; nN = N / BM; nwg = nM * nN; G = G_; c = c_; }
    __host__ __device__ bool next(int i, Unit& u) const {
        const long L = (long)i * G + c; if (L >= nwg) return false;
        int wgid = (int)L; { const int q = nwg / NXCD, r = nwg % NXCD, xcd = wgid % NXCD, off = wgid / NXCD; wgid = (xcd < r ? xcd * (q + 1) : r * (q + 1) + (xcd - r) * q) + off; }
        const int nig = WGM * nN, gid = wgid / nig, fm = gid * WGM, gsz = (nM - fm) < WGM ? (nM - fm) : WGM;
        u.pm = fm + ((wgid % nig) % gsz); u.pn = (wgid % nig) / gsz; return true;
    }
    __device__ __forceinline__ void a_ready(const Unit&) const {}
    __device__ __forceinline__ void done(const Unit&) const {}
};
__device__ __forceinline__ unsigned cvt_pk_bf16(float lo, float hi) { unsigned r; asm volatile("v_cvt_pk_bf16_f32 %0, %1, %2" : "=v"(r) : "v"(lo), "v"(hi)); return r; }
template <class Epi, class Sched, bool STAMP = false>
__device__ __forceinline__ void gemm_phase(PG8_LAS unsigned char* lds, const Gemm g, const Sched& S, const Epi& E, unsigned long long* stamps) {
    const int tid = THREAD_ID, wid = __builtin_amdgcn_readfirstlane(tid >> 6), lane = tid & 63, wr = wid >> 2, wc = wid & 3, fr = lane & 15, fq = lane >> 4;
    const int K = g.K, nt = K / BK;
    int ts_lo = 0, ts_hi = 0, nts = 0; const unsigned long long rt_entry = STAMP ? (unsigned long long)wall_clock64() : 0ull;
#define PG8_STAMP() do { if (STAMP && wid == 0 && nts < 64) { const unsigned long long _c = (unsigned long long)clock64(); \
        ts_lo = (lane == nts) ? (int)(unsigned)_c : ts_lo; ts_hi = (lane == nts) ? (int)(unsigned)(_c >> 32) : ts_hi; ++nts; } } while (0)
    PG8_STAMP();
    unsigned voffA[2], voffB[2];
#pragma unroll
    for (int i = 0; i < 2; ++i) { int R, C; stage_rc(tid * 16 + i * 8192, R, C); const int Rb = Epi::PERM ? ((R & ~31) + perm32(R & 31)) : R;
        voffA[i] = (unsigned)(R * g.lda + C) * 2u; voffB[i] = (unsigned)(Rb * K + C) * 2u; }
    const size_t kstep = (size_t)(BK * 2);
    const size_t hstep = (size_t)HALF * K * 2, hstepA = (size_t)HALF * g.lda * 2;
    const size_t tstep = 2 * hstep, tstepA = 2 * hstepA;
    const size_t ksplitA = (size_t)K * 2;
    const unsigned ldsw = (unsigned)wid * 1024u;
    const int aoff = lds_byte(wr * 64 + fr, fq * 8), boff = lds_byte(wc * 32 + fr, fq * 8);
#define PG8_SA(b, h) (((b) * 2 + (h)) * HTB)
#define PG8_SB(b, h) ((4 + (b) * 2 + (h)) * HTB)
#define PG8_STAGE(bufoff, gbase, voff) do { _Pragma("unroll") for (int _i = 0; _i < 2; ++_i) \
        __builtin_amdgcn_global_load_lds((const unsigned*)((const char*)(gbase) + (voff)[_i]), (PG8_LAS unsigned*)(lds + (bufoff) + ldsw + _i * 8192), 16, 0, 0); } while (0)
#define PG8_LDA(dst, b, h) do { _Pragma("unroll") for (int m = 0; m < 4; ++m) _Pragma("unroll") for (int k = 0; k < 2; ++k) dst[m][k] = *(const PG8_LAS bf16x8*)(lds + PG8_SA(b, h) + aoff + m * 2048 + k * 1024); } while (0)
#define PG8_LDB(dst, b, h) do { _Pragma("unroll") for (int n = 0; n < 2; ++n) _Pragma("unroll") for (int k = 0; k < 2; ++k) dst[n][k] = *(const PG8_LAS bf16x8*)(lds + PG8_SB(b, h) + boff + n * 2048 + k * 1024); } while (0)
#define PG8_MMA(ai, bj, At, Bt) do { __builtin_amdgcn_s_setprio(1); _Pragma("unroll") for (int m = 0; m < 4; ++m) _Pragma("unroll") for (int n = 0; n < 2; ++n) _Pragma("unroll") for (int k = 0; k < 2; ++k) \
        acc[ai][bj][m][n] = __builtin_amdgcn_mfma_f32_16x16x32_bf16(Bt[n][k], At[m][k], acc[ai][bj][m][n], 0, 0, 0); __builtin_amdgcn_s_setprio(0); } while (0)
#define PG8_WAIT_V(n) asm volatile("s_waitcnt vmcnt(" #n ")" ::: "memory")
#define PG8_WAIT_L(n) asm volatile("s_waitcnt lgkmcnt(" #n ")" ::: "memory")
#define PG8_BAR __builtin_amdgcn_s_barrier()
#define PG8_SCHED __builtin_amdgcn_sched_barrier(0)
    Unit cur, nxt; int ui = 0;
    if (!S.next(0, cur)) return;
    f32x4 acc[2][2][4][2];
#pragma unroll
    for (int a = 0; a < 2; ++a)
#pragma unroll
        for (int b = 0; b < 2; ++b)
#pragma unroll
            for (int m = 0; m < 4; ++m)
#pragma unroll
                for (int n = 0; n < 2; ++n) acc[a][b][m][n] = (f32x4){0.f, 0.f, 0.f, 0.f};
    bf16x8 At[4][2], B0[2][2], B1[2][2];
    const char* cA = (const char*)g.A + (size_t)cur.pm * tstepA + (cur.pn >= g.nsplit ? ksplitA : 0); const char* cB = (const char*)g.Bt + (size_t)cur.pn * tstep;
    S.a_ready(cur);
    PG8_STAGE(PG8_SB(0, 0), cB, voffB); PG8_STAGE(PG8_SA(0, 0), cA, voffA); PG8_STAGE(PG8_SB(0, 1), cB + hstep, voffB); PG8_STAGE(PG8_SA(0, 1), cA + hstepA, voffA);
    if (wr == 1) PG8_BAR;
    PG8_WAIT_V(4); PG8_BAR;
    PG8_STAGE(PG8_SB(1, 0), cB + kstep, voffB); PG8_STAGE(PG8_SA(1, 0), cA + kstep, voffA); PG8_STAGE(PG8_SB(1, 1), cB + hstep + kstep, voffB);
    PG8_WAIT_V(6); PG8_BAR;
    PG8_STAMP();
    for (;;) {
        const bool has_next = S.next(ui + 1, nxt);
        const char* nA = has_next ? (const char*)g.A + (size_t)nxt.pm * tstepA + (nxt.pn >= g.nsplit ? ksplitA : 0) : cA; const char* nB = has_next ? (const char*)g.Bt + (size_t)nxt.pn * tstep : cB;
        for (int t = 0; t < nt; t += 2) {
            const bool last = (t == nt - 2);
            const char* a1 = cA + (size_t)(t + 1) * kstep;
            const char* a2 = last ? nA : cA + (size_t)(t + 2) * kstep; const char* b2 = last ? nB : cB + (size_t)(t + 2) * kstep;
            const char* a3 = a2 + kstep; const char* b3 = b2 + kstep;
            if (last && has_next) S.a_ready(nxt);
            PG8_LDB(B0, 0, 0); PG8_SCHED; PG8_LDA(At, 0, 0); PG8_STAGE(PG8_SA(1, 1), a1 + hstepA, voffA);
            PG8_WAIT_L(8); PG8_BAR; PG8_WAIT_L(0); PG8_MMA(0, 0, At, B0); PG8_BAR; PG8_SCHED;
            PG8_LDB(B1, 0, 1); PG8_STAGE(PG8_SB(0, 0), b2, voffB);
            PG8_BAR; PG8_WAIT_L(0); PG8_MMA(0, 1, At, B1); PG8_BAR;
            PG8_LDA(At, 0, 1); PG8_STAGE(PG8_SA(0, 0), a2, voffA);
            PG8_BAR; PG8_WAIT_L(0); PG8_MMA(1, 0, At, B0); PG8_BAR; PG8_SCHED;
            PG8_STAGE(PG8_SB(0, 1), b2 + hstep, voffB);
            PG8_WAIT_V(6); PG8_BAR; PG8_MMA(1, 1, At, B1); PG8_BAR;
            PG8_LDB(B0, 1, 0); PG8_SCHED; PG8_LDA(At, 1, 0); PG8_STAGE(PG8_SA(0, 1), a2 + hstepA, voffA);
            PG8_WAIT_L(8); PG8_BAR; PG8_WAIT_L(0); PG8_MMA(0, 0, At, B0); PG8_BAR; PG8_SCHED;
            PG8_LDB(B1, 1, 1); PG8_STAGE(PG8_SB(1, 0), b3, voffB);
            PG8_BAR; PG8_WAIT_L(0); PG8_MMA(0, 1, At, B1); PG8_BAR;
            PG8_LDA(At, 1, 1); PG8_STAGE(PG8_SA(1, 0), a3, voffA);
            PG8_BAR; PG8_WAIT_L(0); PG8_MMA(1, 0, At, B0); PG8_BAR; PG8_SCHED;
            PG8_STAGE(PG8_SB(1, 1), b3 + hstep, voffB);
            PG8_WAIT_V(6); PG8_BAR; PG8_MMA(1, 1, At, B1); PG8_BAR;
        }
        PG8_STAMP();
        if constexpr (!Epi::AFTER_DRAIN) { E(acc, cur, wr, wc, fr, fq); S.done(cur); }
        PG8_STAMP();
        if (!has_next) break;
#pragma unroll
        for (int a = 0; a < 2; ++a)
#pragma unroll
            for (int b = 0; b < 2; ++b)
#pragma unroll
                for (int m = 0; m < 4; ++m)
#pragma unroll
                    for (int n = 0; n < 2; ++n) acc[a][b][m][n] = (f32x4){0.f, 0.f, 0.f, 0.f};
        cur = nxt; cA = nA; cB = nB; ++ui;
    }
    PG8_WAIT_V(0);
    if (wr == 0) PG8_BAR;
    PG8_BAR;
    if constexpr (Epi::AFTER_DRAIN) { E.fused(acc, cur, wr, wc, fr, fq, lds, wid, lane); S.done(cur); }
    PG8_STAMP();
    if (STAMP && wid == 0) { stamps[lane] = lane < nts ? (((unsigned long long)(unsigned)ts_hi << 32) | (unsigned)ts_lo) : 0ull;
        if (lane == 62) stamps[62] = rt_entry; if (lane == 63) stamps[63] = (unsigned long long)wall_clock64(); }
#undef PG8_STAMP
#undef PG8_SA
#undef PG8_SB
#undef PG8_STAGE
#undef PG8_LDA
#undef PG8_LDB
#undef PG8_MMA
#undef PG8_WAIT_V
#undef PG8_WAIT_L
#undef PG8_BAR
#undef PG8_SCHED
}
}
struct EpiProj {
  static constexpr bool PERM = false, AFTER_DRAIN = false;
  float* projABC; float* pdraw; int col0;
  __device__ __forceinline__ void operator()(const pg8::f32x4 (&acc)[2][2][4][2], const pg8::Unit& u, int wr, int wc, int fr, int fq) const {
#pragma unroll
    for (int ai = 0; ai < 2; ++ai)
#pragma unroll
      for (int m = 0; m < 4; ++m) {
        const int r = u.pm * 256 + ai * 128 + wr * 64 + m * 16 + fr;
#pragma unroll
        for (int bj = 0; bj < 2; ++bj)
#pragma unroll
          for (int n = 0; n < 2; ++n) {
            const int cp = col0 + u.pn * 256 + bj * 128 + wc * 32 + n * 16 + fq * 4;
            const int c = cp < 768 ? cp : (cp < 4000 ? cp + 256 : (cp < 4096 ? PIN : cp - 3328));
            if (c < NABC) *(pg8::f32x4*)(projABC + (size_t)r * NABC + c) = acc[ai][bj][m][n];
            else if (c < PIN) *(pg8::f32x4*)(pdraw + (size_t)r * NPD + (c - NABC)) = acc[ai][bj][m][n];
          }
      }
  }
};
struct EpiRes {
  static constexpr bool PERM = false, AFTER_DRAIN = false;
  float* out; const float* xp; const float* xs; const float* gate;
  __device__ __forceinline__ void operator()(const pg8::f32x4 (&acc)[2][2][4][2], const pg8::Unit& u, int wr, int wc, int fr, int fq) const {
#pragma unroll
    for (int ai = 0; ai < 2; ++ai)
#pragma unroll
      for (int m = 0; m < 4; ++m) {
        const int r = u.pm * 256 + ai * 128 + wr * 64 + m * 16 + fr;
        int gs, T, ci; tok_info(r, gs, T, ci);
        const float* xr = (r < 4096) ? xp + (size_t)r * DM : xs + (size_t)(r - 4096) * DM;
        const float* gr = gate + (size_t)ci * 6144;
#pragma unroll
        for (int bj = 0; bj < 2; ++bj)
#pragma unroll
          for (int n = 0; n < 2; ++n) {
            const int c = u.pn * 256 + bj * 128 + wc * 32 + n * 16 + fq * 4;
            const pg8::f32x4 x = *(const pg8::f32x4*)(xr + c), g = *(const pg8::f32x4*)(gr + c);
            *(pg8::f32x4*)(out + (size_t)r * DM + c) = x * ALPHA + g * acc[ai][bj][m][n];
          }
      }
  }
};
struct EpiResSplit {
  static constexpr bool PERM = false, AFTER_DRAIN = false;
  float* out; float* tmp; const float* gate;
  __device__ __forceinline__ void operator()(const pg8::f32x4 (&acc)[2][2][4][2], const pg8::Unit& u, int wr, int wc, int fr, int fq) const {
    const bool second = u.pn >= 4; const int pn = u.pn & 3;
#pragma unroll
    for (int ai = 0; ai < 2; ++ai)
#pragma unroll
      for (int m = 0; m < 4; ++m) {
        const int r = u.pm * 256 + ai * 128 + wr * 64 + m * 16 + fr;
        int gs, T, ci; tok_info(r, gs, T, ci);
        const float* gr = gate + (size_t)ci * 6144;
#pragma unroll
        for (int bj = 0; bj < 2; ++bj)
#pragma unroll
          for (int n = 0; n < 2; ++n) {
            const int c = pn * 256 + bj * 128 + wc * 32 + n * 16 + fq * 4;
            if (second) *(pg8::f32x4*)(tmp + (size_t)r * DM + c) = acc[ai][bj][m][n];
            else { const pg8::f32x4 x = *(const pg8::f32x4*)(out + (size_t)r * DM + c), g4 = *(const pg8::f32x4*)(gr + c);
                   *(pg8::f32x4*)(out + (size_t)r * DM + c) = x * ALPHA + g4 * acc[ai][bj][m][n]; }
          }
      }
  }
};
struct EpiFF1 {
  static constexpr bool PERM = true, AFTER_DRAIN = false;
  bf16_t* hidden;
  __device__ __forceinline__ void operator()(const pg8::f32x4 (&acc)[2][2][4][2], const pg8::Unit& u, int wr, int wc, int fr, int fq) const {
#pragma unroll
    for (int ai = 0; ai < 2; ++ai)
#pragma unroll
      for (int m = 0; m < 4; ++m) {
        const int r = u.pm * 256 + ai * 128 + wr * 64 + m * 16 + fr;
#pragma unroll
        for (int bj = 0; bj < 2; ++bj) {
          const int c = u.pn * 256 + bj * 128 + wc * 32 + fq * 8;
          pg8::f32x4 v0 = acc[ai][bj][m][0], v1 = acc[ai][bj][m][1];
#pragma unroll
          for (int e = 0; e < 4; ++e) { v0[e] = fmaxf(v0[e], 0.f); v0[e] *= v0[e]; v1[e] = fmaxf(v1[e], 0.f); v1[e] *= v1[e]; }
          uint4 o; o.x = pack2(v0[0], v0[1]); o.y = pack2(v0[2], v0[3]); o.z = pack2(v1[0], v1[1]); o.w = pack2(v1[2], v1[3]);
          *(uint4*)(hidden + (size_t)r * DFF + c) = o;
        }
      }
  }
};
template <class Epi>
DEV void phase_gemm(const bf16_t* A, const bf16_t* Bt, int N, int K, const Epi& E, char* smem, int lda = 0, int nsplit = 1 << 20, int G = 0) {
  pg8::Gemm g; g.A = A; g.Bt = Bt; g.M = NTOK; g.N = N; g.K = K; g.lda = lda ? lda : K; g.nsplit = nsplit;
  pg8::StaticOrder S; S.init(NTOK, N, G ? G : (int)gridDim.x, (int)blockIdx.x);
  pg8::gemm_phase<Epi, pg8::StaticOrder, false>((PG8_LAS unsigned char*)smem, g, S, E, nullptr);
}

DEV float shiftmix(const float* __restrict__ pd, int g, int col, bool hp, bool hn, float mu) {
  const float x = pd[(size_t)g * NPD + col];
  const float xp = hp ? pd[(size_t)(g - 1) * NPD + col] : 0.f;
  const float xn = hn ? pd[(size_t)(g + 1) * NPD + col] : 0.f;
  return x + mu * (0.5f * (xp + xn) - x);
}
DEV void rwkv_prep_item(const Params& P, int l, int tile, int part, char* smem, const int tid_in) {
  const int tid = opaque_i(tid_in);
  const int lane = tid & 63, w = tid >> 6;
  const int g0 = tile * 64;
  int gs, T, ci; tok_info(g0, gs, T, ci);
  const float* mu = P.rwkv_mu + l * NPD;
  const float* __restrict__ pd = P.pdraw;
  float* __restrict__ rkvp = P.rkv;
  if (part == 0) {
#pragma unroll 4
    for (int idx = tid; idx < 64 * 128; idx += 256) {
      const int row = idx >> 7, c4 = (idx & 127) * 4;
      const int col = c4 < 256 ? c4 : (c4 + 256);
      const int g = g0 + row; const bool hp = g > gs, hn = g + 1 < gs + T;
      const float4 x = *(const float4*)(pd + (size_t)g * NPD + col);
      float4 xp = make_float4(0, 0, 0, 0), xn = make_float4(0, 0, 0, 0);
      if (hp) xp = *(const float4*)(pd + (size_t)(g - 1) * NPD + col);
      if (hn) xn = *(const float4*)(pd + (size_t)(g + 1) * NPD + col);
      const float4 m4 = *(const float4*)(mu + col);
      float4 o;
      o.x = x.x + m4.x * (0.5f * (xp.x + xn.x) - x.x); o.y = x.y + m4.y * (0.5f * (xp.y + xn.y) - x.y);
      o.z = x.z + m4.z * (0.5f * (xp.z + xn.z) - x.z); o.w = x.w + m4.w * (0.5f * (xp.w + xn.w) - x.w);
      *(float4*)(rkvp + (size_t)g * 768 + col) = o;
    }
    { const int cgk = tid & 63, qt = tid >> 6; const int col = 256 + cgk * 4;
      const float4 m4 = *(const float4*)(mu + col);
      const float4 kk = *(const float4*)(P.rwkv_kk + l * 256 + cgk * 4);
#pragma unroll 4
      for (int i = 0; i < 16; ++i) {
        const int g = g0 + qt * 16 + i; const bool hp = g > gs, hn = g + 1 < gs + T;
        const float4 x = *(const float4*)(pd + (size_t)g * NPD + col);
        float4 xp = make_float4(0, 0, 0, 0), xn = make_float4(0, 0, 0, 0);
        if (hp) xp = *(const float4*)(pd + (size_t)(g - 1) * NPD + col);
        if (hn) xn = *(const float4*)(pd + (size_t)(g + 1) * NPD + col);
        float4 o;
        o.x = x.x + m4.x * (0.5f * (xp.x + xn.x) - x.x); o.y = x.y + m4.y * (0.5f * (xp.y + xn.y) - x.y);
        o.z = x.z + m4.z * (0.5f * (xp.z + xn.z) - x.z); o.w = x.w + m4.w * (0.5f * (xp.w + xn.w) - x.w);
        *(float4*)(rkvp + (size_t)g * 768 + col) = o;
        const float ss = red16((o.x * kk.x) * (o.x * kk.x) + (o.y * kk.y) * (o.y * kk.y) + (o.z * kk.z) * (o.z * kk.z) + (o.w * kk.w) * (o.w * kk.w));
        if ((cgk & 15) == 0) P.khinv[g * 4 + (cgk >> 4)] = rsqrtf(ss + 1e-6f);
      }
    }
    return;
  }
  const bool isg = part == 5;
  const int KK = isg ? 128 : 64;
  const int lda = KK + 8;
  int z = 0, kind = 0;
  if (!isg) { const int p = part - 1; z = p >> 1; kind = p & 1; }
  const int acol0 = isg ? 1024 : (768 + kind * 128 + z * 64);
  bf16_t* sA = (bf16_t*)smem;
  {
    const int nq = KK >> 2;
    for (int idx = tid; idx < 64 * nq; idx += 256) {
      const int row = idx / nq, r = (idx % nq) * 4; const int g = g0 + row;
      const bool hp = g > gs, hn = g + 1 < gs + T;
      const float* px = pd + (size_t)g * NPD + acol0 + r;
      const float4 x = *(const float4*)px;
      float4 xp = make_float4(0, 0, 0, 0), xn = make_float4(0, 0, 0, 0);
      if (hp) xp = *(const float4*)(px - NPD);
      if (hn) xn = *(const float4*)(px + NPD);
      const float4 m4 = *(const float4*)(mu + acol0 + r);
      float v0 = x.x + m4.x * (0.5f * (xp.x + xn.x) - x.x), v1 = x.y + m4.y * (0.5f * (xp.y + xn.y) - x.y);
      float v2 = x.z + m4.z * (0.5f * (xp.z + xn.z) - x.z), v3 = x.w + m4.w * (0.5f * (xp.w + xn.w) - x.w);
      if (isg) { v0 = sigmoidf_(v0); v1 = sigmoidf_(v1); v2 = sigmoidf_(v2); v3 = sigmoidf_(v3); }
      else if (kind == 0) { v0 = tanhf(v0); v1 = tanhf(v1); v2 = tanhf(v2); v3 = tanhf(v3); }
      uint2 o; o.x = pack2(v0, v1); o.y = pack2(v2, v3);
      *(uint2*)(sA + row * lda + r) = o;
    }
  }
  const bf16_t* Bt = isg ? (P.g2t + (size_t)l * 256 * 128) : ((kind == 0 ? P.w2t : P.a2t) + (size_t)(l * 2 + z) * 256 * 64);
  __syncthreads();
#pragma unroll 1
  for (int half = 0; half < 2; ++half) {
  const bf16_t* bp = Bt + (size_t)(half * 128 + w * 32 + (lane & 31)) * KK + (lane >> 5) * 8;
  f32x16 acc[2] = {zero16(), zero16()};
  for (int s = 0; s < KK / 16; ++s) {
    const bf16x8 b = *(const bf16x8*)(bp + s * 16);
#pragma unroll
    for (int mi = 0; mi < 2; ++mi) {
      const bf16x8 a = *(const bf16x8*)(sA + (mi * 32 + (lane & 31)) * lda + s * 16 + (lane >> 5) * 8);
      acc[mi] = __builtin_amdgcn_mfma_f32_32x32x16_bf16(a, b, acc[mi], 0, 0, 0);
    }
  }
  const int c = half * 128 + w * 32 + (lane & 31);
  float bias = 0.f;
  if (!isg) bias = (kind == 0 ? P.rwkv_w0 : P.rwkv_a0)[(l * 2 + z) * 256 + c];
#pragma unroll
  for (int mi = 0; mi < 2; ++mi)
#pragma unroll
    for (int idx = 0; idx < 16; ++idx) {
      const int row = mi * 32 + (idx & 3) + 8 * (idx >> 2) + 4 * (lane >> 5);
      const int g = g0 + row;
      const float v = acc[mi][idx];
      if (isg) P.gbuf[(size_t)g * 256 + c] = f2bf(v);
      else {
        const float sg = sigmoidf_(v + bias);
        P.wa[((size_t)(g * 2 + z) * 2 + kind) * 256 + c] = (kind == 0) ? __expf(-0.60653065971f * sg) : sg;
      }
    }
  }
  __syncthreads();
}

DEV float4 dp_load(const float* base, int g, int gs, int T) { float4 r = make_float4(0.f, 0.f, 0.f, 0.f); if (g >= gs && g < gs + T) r = *(const float4*)(base + (size_t)g * NABC); return r; }
DEV void delta_prep_item(const Params& P, int l, int tile, int X, const int tid_in) {
  const int tid = opaque_i(tid_in);
  const int cg = tid & 63, qt = tid >> 6;
  const int g0 = tile * 64 + qt * 16;
  int gs, T, ci; tok_info(g0, gs, T, ci);
  const int col = X * 256 + cg * 4;
  const float* cw = P.delta_conv + (size_t)l * 5 * 768 + col;
  const float4 w0 = *(const float4*)cw, w1 = *(const float4*)(cw + 768), w2 = *(const float4*)(cw + 2 * 768), w3 = *(const float4*)(cw + 3 * 768), w4 = *(const float4*)(cw + 4 * 768);
  const float* base = P.projABC + 1040 + col;
#define DP_LOAD(G) dp_load(base, (G), gs, T)
  float4 xm2 = DP_LOAD(g0 - 2), xm1 = DP_LOAD(g0 - 1), x0 = DP_LOAD(g0), xp1 = DP_LOAD(g0 + 1);
#pragma unroll 4
  for (int i = 0; i < 16; ++i) {
    const int g = g0 + i;
    const float4 xp2 = DP_LOAD(g + 2);
    float4 a;
    a.x = xm2.x * w0.x + xm1.x * w1.x + x0.x * w2.x + xp1.x * w3.x + xp2.x * w4.x;
    a.y = xm2.y * w0.y + xm1.y * w1.y + x0.y * w2.y + xp1.y * w3.y + xp2.y * w4.y;
    a.z = xm2.z * w0.z + xm1.z * w1.z + x0.z * w2.z + xp1.z * w3.z + xp2.z * w4.z;
    a.w = xm2.w * w0.w + xm1.w * w1.w + x0.w * w2.w + xp1.w * w3.w + xp2.w * w4.w;
    a.x = siluf_(a.x); a.y = siluf_(a.y); a.z = siluf_(a.z); a.w = siluf_(a.w);
    float sc = 1.f;
    if (X < 2) { const float ss = red16(a.x * a.x + a.y * a.y + a.z * a.z + a.w * a.w); sc = rsqrtf(ss + 1e-6f) * (X == 0 ? 0.125f : 1.f); }
    uint2 o; o.x = pack2(a.x * sc, a.y * sc); o.y = pack2(a.z * sc, a.w * sc);
    *(uint2*)(P.ubuf + (size_t)g * 768 + col) = o;
    xm2 = xm1; xm1 = x0; x0 = xp1; xp1 = xp2;
  }
#undef DP_LOAD
}

DEV void load16(const float* __restrict__ p, float* v) {
#pragma unroll
  for (int e = 0; e < 4; ++e) { const float4 t = *(const float4*)(p + 4 * e); v[4 * e] = t.x; v[4 * e + 1] = t.y; v[4 * e + 2] = t.z; v[4 * e + 3] = t.w; }
}
DEV void store_row16(bf16_t* dst, const float* v) {
  uint4 a, b;
  a.x = pack2(v[0], v[1]); a.y = pack2(v[2], v[3]); a.z = pack2(v[4], v[5]); a.w = pack2(v[6], v[7]);
  b.x = pack2(v[8], v[9]); b.y = pack2(v[10], v[11]); b.z = pack2(v[12], v[13]); b.w = pack2(v[14], v[15]);
  *(uint4*)dst = a; *(uint4*)(dst + 8) = b;
}
DEV void decode_chain(int task, int& seq, int& h, bool& sample) {
  if (task < 8) { sample = true; seq = 16 + (task >> 2); h = task & 3; }
  else { const int t = task - 8; sample = false; seq = t >> 2; h = t & 3; }
}
DEV void seq_base(int seq, int& gs, int& T) { if (seq < 16) { gs = seq * 256; T = 256; } else { gs = 4096 + (seq - 16) * 2048; T = 2048; } }
DEV float wave_incl_scan_add(float x, int lane) {
#pragma unroll
  for (int o = 1; o < 64; o <<= 1) { const float y = __shfl_up(x, o); if (lane >= o) x += y; }
  return x;
}
DEV float wave_incl_scan_max(float x, int lane) {
#pragma unroll
  for (int o = 1; o < 64; o <<= 1) { const float y = __shfl_up(x, o); if (lane >= o) x = fmaxf(x, y); }
  return x;
}

DEV void ret_task(const Params& P, int l, int task, const int z, char* smem, const int tid_in, const bool active) {
  const int tid = opaque_i(tid_in);
  const int lane = tid & 63, w = tid >> 6, wr = w >> 1, wc = w & 1;
  int seq, h; bool sample; decode_chain(task, seq, h, sample);
  int gs, T; seq_base(seq, gs, T);
  if (!active) { for (int c = 0; c < T / 64; ++c) { __syncthreads(); __syncthreads(); __syncthreads(); } return; }
  bf16_t* sQ = (bf16_t*)smem; bf16_t* sK = sQ + 64 * LDB; bf16_t* sKzt = sK + 64 * LDB; bf16_t* sVt = sKzt + 64 * LDB; bf16_t* sP = sVt + 64 * LDB; bf16_t* sSt = sP + 64 * LDB;
  const float lg = -__expf(P.ret_decay[(l * 2 + z) * 4 + h]);
  const float gl = __expf(64.f * lg);
  f32x16 st = zero16();
  if (sample) {
    const float* s0 = P.st_ret + ((size_t)(((seq - 16) * 2 + l) * 2 + z) * 4 + h) * 4096;
#pragma unroll
    for (int idx = 0; idx < 16; ++idx) st[idx] = s0[ACC_COL * 64 + ACC_ROW(idx)];
  }
#pragma unroll
  for (int idx = 0; idx < 16; ++idx) sSt[ACC_ROW(idx) * LDB + ACC_COL] = f2bf(st[idx]);
  const int nch = T / 64;
  const int tid_outer = tid;
  float4 nq[4], nk[4], nv[4], nq2[4], nk2[4];
#define RET_PREFETCH(C) { \
    const int r_ = tid_outer & 63, sg_ = (tid_outer >> 6) * 16; \
    const int p_ = (C) * 64 + r_; const int g_ = gs + (z ? (T - 1 - p_) : p_); \
    const float* pr_ = P.projABC + (size_t)g_ * NABC + 2080 + h * 64; \
    _Pragma("unroll") for (int e_ = 0; e_ < 4; ++e_) { nq[e_] = *(const float4*)(pr_ + sg_ + 4 * e_); nk[e_] = *(const float4*)(pr_ + 256 + sg_ + 4 * e_); nv[e_] = *(const float4*)(pr_ + 512 + sg_ + 4 * e_); } \
    if (sample) { _Pragma("unroll") for (int e_ = 0; e_ < 4; ++e_) { nq2[e_] = *(const float4*)(pr_ + (sg_ ^ 16) + 4 * e_); nk2[e_] = *(const float4*)(pr_ + 256 + (sg_ ^ 16) + 4 * e_); } } }
  RET_PREFETCH(0)
  for (int c = 0; c < nch; ++c) {
    const int tid = opaque_i(tid_outer);
    const int lane = tid & 63, w = tid >> 6, wr = w >> 1, wc = w & 1;
    const int row = tid & 63, seg = (tid >> 6) * 16;
    {
      const int p = c * 64 + row; const int t = z ? (T - 1 - p) : p;
      float q[16], k[16], v[16];
#pragma unroll
      for (int e = 0; e < 4; ++e) { q[4 * e] = nq[e].x; q[4 * e + 1] = nq[e].y; q[4 * e + 2] = nq[e].z; q[4 * e + 3] = nq[e].w; k[4 * e] = nk[e].x; k[4 * e + 1] = nk[e].y; k[4 * e + 2] = nk[e].z; k[4 * e + 3] = nk[e].w;
        v[4 * e] = nv[e].x; v[4 * e + 1] = nv[e].y; v[4 * e + 2] = nv[e].z; v[4 * e + 3] = nv[e].w; }
      if (sample) {
        float q2[16], k2[16];
#pragma unroll
        for (int e = 0; e < 4; ++e) { q2[4 * e] = nq2[e].x; q2[4 * e + 1] = nq2[e].y; q2[4 * e + 2] = nq2[e].z; q2[4 * e + 3] = nq2[e].w; k2[4 * e] = nk2[e].x; k2[4 * e + 1] = nk2[e].y; k2[4 * e + 2] = nk2[e].z; k2[4 * e + 3] = nk2[e].w; }
        const float pos = (seg < 32) ? (float)(t >> 6) : (float)(t & 63);
        const bool first = (seg & 16) == 0;
#pragma unroll
        for (int e = 0; e < 16; ++e) {
          const float inv = __expf(-(float)e * (9.210340371976184f / 16.f));
          const float sn = __sinf(pos * inv), cs = __cosf(pos * inv);
          const float qs = first ? -q2[e] : q2[e], ks = first ? -k2[e] : k2[e];
          q[e] = q[e] * cs + qs * sn; k[e] = k[e] * cs + ks * sn;
        }
      }
      const float zeta = __expf((63.f - (float)row) * lg);
      float qq[16];
#pragma unroll
      for (int e = 0; e < 16; ++e) qq[e] = q[e] * 0.125f;
      store_row16(sQ + row * LDB + seg, qq);
      store_row16(sK + row * LDB + seg, k);
#pragma unroll
      for (int e = 0; e < 16; ++e) { sKzt[(seg + e) * LDB + row] = f2bf(k[e] * zeta); sVt[(seg + e) * LDB + row] = f2bf(v[e]); }
    }
    __syncthreads();
    if (c + 1 < nch) RET_PREFETCH(c + 1)
    f32x16 s = mm64(sQ, sK, wr, wc, lane, zero16());
#pragma unroll
    for (int idx = 0; idx < 16; ++idx) {
      const int i = ACC_ROW(idx), j = ACC_COL;
      const float val = (i >= j) ? s[idx] * __expf((float)(i - j) * lg) : 0.f;
      sP[i * LDB + j] = f2bf(val);
    }
    __syncthreads();
    f32x16 o1 = mm64(sP, sVt, wr, wc, lane, zero16());
    f32x16 o2 = mm64(sQ, sSt, wr, wc, lane, zero16());
#pragma unroll
    for (int idx = 0; idx < 16; ++idx) st[idx] *= gl;
    st = mm64(sVt, sKzt, wr, wc, lane, st);
#pragma unroll
    for (int idx = 0; idx < 16; ++idx) {
      const int i = ACC_ROW(idx), e = ACC_COL;
      const float xi = __expf((float)(i + 1) * lg);
      const int pp = c * 64 + i; const int tt = z ? (T - 1 - pp) : pp;
      P.hdir[((size_t)z * NTOK + gs + tt) * DM + 512 + h * 64 + e] = f2bf(o1[idx] + xi * o2[idx]);
    }
    __syncthreads();
#pragma unroll
    for (int idx = 0; idx < 16; ++idx) sSt[ACC_ROW(idx) * LDB + ACC_COL] = f2bf(st[idx]);
  }
  if (!sample) {
    float* o = P.out + O_RET + ((size_t)((seq * 2 + l) * 2 + z) * 4 + h) * 4096;
#pragma unroll
    for (int idx = 0; idx < 16; ++idx) o[ACC_COL * 64 + ACC_ROW(idx)] = st[idx];
  }
}

DEV void ret_sample_task(const Params& P, int l, int task, const int z, char* smem0, const int tid_all_in) {
  const int tid_all = opaque_i(tid_all_in);
  const int half = tid_all >> 8, tid0 = tid_all & 255;
  int seq, h; bool sample; decode_chain(task, seq, h, sample);
  int gs, T; seq_base(seq, gs, T);
  const int nch = T / 64;
  const float lg = -__expf(P.ret_decay[(l * 2 + z) * 4 + h]);
#define RT_SET(B) ((bf16_t*)(smem0 + (B) * HALF_LDS))
  bf16_t* sP = RT_SET(0) + 4 * 64 * LDB; bf16_t* sSt = sP + 64 * LDB;
  if (half == 1) {
    const int tid = tid0;
    float4 nq[4], nk[4], nv[4], nq2[4], nk2[4];
#define RT_PREFETCH(C) { \
      const int r_ = tid & 63, sg_ = (tid >> 6) * 16; \
      const int p_ = (C) * 64 + r_; const int g_ = gs + (z ? (T - 1 - p_) : p_); \
      const float* pr_ = P.projABC + (size_t)g_ * NABC + 2080 + h * 64; \
      _Pragma("unroll") for (int e_ = 0; e_ < 4; ++e_) { nq[e_] = *(const float4*)(pr_ + sg_ + 4 * e_); nk[e_] = *(const float4*)(pr_ + 256 + sg_ + 4 * e_); nv[e_] = *(const float4*)(pr_ + 512 + sg_ + 4 * e_); \
        nq2[e_] = *(const float4*)(pr_ + (sg_ ^ 16) + 4 * e_); nk2[e_] = *(const float4*)(pr_ + 256 + (sg_ ^ 16) + 4 * e_); } }
#define RT_STAGE(C) { \
      bf16_t* sQ = RT_SET((C) & 1); bf16_t* sK = sQ + 64 * LDB; bf16_t* sKzt = sK + 64 * LDB; bf16_t* sVt = sKzt + 64 * LDB; \
      const int row = tid & 63, seg = (tid >> 6) * 16; \
      const int p = (C) * 64 + row; const int t = z ? (T - 1 - p) : p; \
      float q[16], k[16], v[16], q2[16], k2[16]; \
      _Pragma("unroll") for (int e = 0; e < 4; ++e) { q[4 * e] = nq[e].x; q[4 * e + 1] = nq[e].y; q[4 * e + 2] = nq[e].z; q[4 * e + 3] = nq[e].w; k[4 * e] = nk[e].x; k[4 * e + 1] = nk[e].y; k[4 * e + 2] = nk[e].z; k[4 * e + 3] = nk[e].w; \
        v[4 * e] = nv[e].x; v[4 * e + 1] = nv[e].y; v[4 * e + 2] = nv[e].z; v[4 * e + 3] = nv[e].w; \
        q2[4 * e] = nq2[e].x; q2[4 * e + 1] = nq2[e].y; q2[4 * e + 2] = nq2[e].z; q2[4 * e + 3] = nq2[e].w; k2[4 * e] = nk2[e].x; k2[4 * e + 1] = nk2[e].y; k2[4 * e + 2] = nk2[e].z; k2[4 * e + 3] = nk2[e].w; } \
      const float pos = (seg < 32) ? (float)(t >> 6) : (float)(t & 63); \
      const bool first = (seg & 16) == 0; \
      _Pragma("unroll") for (int e = 0; e < 16; ++e) { \
        const float inv = __expf(-(float)e * (9.210340371976184f / 16.f)); \
        const float sn = __sinf(pos * inv), cs = __cosf(pos * inv); \
        const float qs = first ? -q2[e] : q2[e], ks = first ? -k2[e] : k2[e]; \
        q[e] = (q[e] * cs + qs * sn) * 0.125f; k[e] = k[e] * cs + ks * sn; } \
      const float zeta = __expf((63.f - (float)row) * lg); \
      store_row16(sQ + row * LDB + seg, q); \
      store_row16(sK + row * LDB + seg, k); \
      _Pragma("unroll") for (int e = 0; e < 16; ++e) { sKzt[(seg + e) * LDB + row] = f2bf(k[e] * zeta); sVt[(seg + e) * LDB + row] = f2bf(v[e]); } }
    RT_PREFETCH(0)
    RT_STAGE(0)
    if (nch > 1) RT_PREFETCH(1)
    __syncthreads();
    for (int c = 0; c < nch; ++c) {
      if (c + 1 < nch) { RT_STAGE(c + 1) if (c + 2 < nch) RT_PREFETCH(c + 2) }
      __syncthreads(); __syncthreads(); __syncthreads();
    }
#undef RT_PREFETCH
#undef RT_STAGE
  } else {
    const int tid = tid0;
    const int lane = tid & 63, w = tid >> 6, wr = w >> 1, wc = w & 1;
    const float gl = __expf(64.f * lg);
    f32x16 st = zero16();
    {
      const float* s0 = P.st_ret + ((size_t)(((seq - 16) * 2 + l) * 2 + z) * 4 + h) * 4096;
#pragma unroll
      for (int idx = 0; idx < 16; ++idx) st[idx] = s0[ACC_COL * 64 + ACC_ROW(idx)];
    }
#pragma unroll
    for (int idx = 0; idx < 16; ++idx) sSt[ACC_ROW(idx) * LDB + ACC_COL] = f2bf(st[idx]);
    __syncthreads();
    for (int c = 0; c < nch; ++c) {
      const bf16_t* sQ = RT_SET(c & 1); const bf16_t* sK = sQ + 64 * LDB; const bf16_t* sKzt = sK + 64 * LDB; const bf16_t* sVt = sKzt + 64 * LDB;
      f32x16 s = mm64(sQ, sK, wr, wc, lane, zero16());
#pragma unroll
      for (int idx = 0; idx < 16; ++idx) {
        const int i = ACC_ROW(idx), j = ACC_COL;
        const float val = (i >= j) ? s[idx] * __expf((float)(i - j) * lg) : 0.f;
        sP[i * LDB + j] = f2bf(val);
      }
      __syncthreads();
      f32x16 o1 = mm64(sP, sVt, wr, wc, lane, zero16());
      f32x16 o2 = mm64(sQ, sSt, wr, wc, lane, zero16());
#pragma unroll
      for (int idx = 0; idx < 16; ++idx) st[idx] *= gl;
      st = mm64(sVt, sKzt, wr, wc, lane, st);
#pragma unroll
      for (int idx = 0; idx < 16; ++idx) {
        const int i = ACC_ROW(idx), e = ACC_COL;
        const float xi = __expf((float)(i + 1) * lg);
        const int pp = c * 64 + i; const int tt = z ? (T - 1 - pp) : pp;
        P.hdir[((size_t)z * NTOK + gs + tt) * DM + 512 + h * 64 + e] = f2bf(o1[idx] + xi * o2[idx]);
      }
      __syncthreads();
#pragma unroll
      for (int idx = 0; idx < 16; ++idx) sSt[ACC_ROW(idx) * LDB + ACC_COL] = f2bf(st[idx]);
      __syncthreads();
    }
  }
#undef RT_SET
}

DEV void mlstm_task(const Params& P, int l, int task, const int z, char* smem, const int tid_in, const bool active) {
  const int tid = opaque_i(tid_in);
  const int lane = tid & 63, w = tid >> 6, wr = w >> 1, wc = w & 1;
  int seq, h; bool sample; decode_chain(task, seq, h, sample);
  int gs, T; seq_base(seq, gs, T);
  if (!active) { for (int c = 0; c < T / 64; ++c) { __syncthreads(); __syncthreads(); __syncthreads(); } return; }
  bf16_t* sQ = (bf16_t*)smem; bf16_t* sK = sQ + 64 * LDB; bf16_t* sKt = sK + 64 * LDB; bf16_t* sVt = sKt + 64 * LDB; bf16_t* sP = sVt + 64 * LDB; bf16_t* sCt = sP + 64 * LDB;
  float* fs = (float*)(sCt + 64 * LDB);
  float* s_gate = fs; float* s_nn = fs + 640;
  const int sidx = sample ? ((((seq - 16) * 2 + l) * 2 + z) * 4 + h) : 0;
  f32x16 st = zero16();
  if (sample) {
    const float* c0 = P.st_C + (size_t)sidx * 4096;
#pragma unroll
    for (int idx = 0; idx < 16; ++idx) st[idx] = c0[ACC_COL * 64 + ACC_ROW(idx)];
  }
#pragma unroll
  for (int idx = 0; idx < 16; ++idx) sCt[ACC_ROW(idx) * LDB + ACC_COL] = f2bf(st[idx]);
  if (tid < 64) s_nn[tid] = sample ? P.st_n[sidx * 64 + tid] : 0.f;
  float m = sample ? P.st_m[sidx] : 0.f;
  const float ib = P.mlstm_i_bias[(l * 2 + z) * 4 + h], fb = P.mlstm_f_bias[(l * 2 + z) * 4 + h];
  const int nch = T / 64;
  const int tid_outer = tid;
  float4 nq[4], nk[4], nv[4]; float ngi, ngf;
#define MLSTM_PREFETCH(C) { \
    const int r_ = tid_outer & 63, sg_ = (tid_outer >> 6) * 16; \
    const int p_ = (C) * 64 + r_; const int g_ = gs + (z ? (T - 1 - p_) : p_); \
    const float* pr_ = P.projABC + (size_t)g_ * NABC + h * 64; \
    _Pragma("unroll") for (int e_ = 0; e_ < 4; ++e_) { nq[e_] = *(const float4*)(pr_ + sg_ + 4 * e_); nk[e_] = *(const float4*)(pr_ + 256 + sg_ + 4 * e_); nv[e_] = *(const float4*)(pr_ + 512 + sg_ + 4 * e_); } \
    const float* gp_ = P.projABC + (size_t)g_ * NABC + 1024 + z * 4 + h; ngi = gp_[0]; ngf = gp_[8]; }
  MLSTM_PREFETCH(0)
  for (int c = 0; c < nch; ++c) {
    const int tid = opaque_i(tid_outer);
    const int lane = tid & 63, w = tid >> 6, wr = w >> 1, wc = w & 1;
    const int row = tid & 63, seg = (tid >> 6) * 16;
    const int par = c & 1;
    float* s_a = s_gate + par * 320; float* s_b = s_a + 64; float* s_M = s_a + 128; float* s_ew = s_a + 192; float* s_dinv = s_a + 256;
    float* s_n = s_nn + par * 64; float* s_n2 = s_nn + (par ^ 1) * 64;
    float sp;
    {
      const float li = ngi + ib, lf = logsigmoidf_(ngf + fb);
      const float b = wave_incl_scan_add(lf, lane);
      const float a = li - b;
      const float cm = wave_incl_scan_max(a, lane);
      const float M = fmaxf(m, cm);
      const float M63 = __shfl(M, 63), bl = __shfl(b, 63);
      const float skj = __expf(a - M63);
      sp = __expf(m - M63);
      if (w == 0) { s_a[lane] = a; s_b[lane] = b; s_M[lane] = M; s_ew[lane] = __expf(m - M); }
      m = bl + M63;
      float q[16], k[16], v[16];
#pragma unroll
      for (int e = 0; e < 4; ++e) { q[4 * e] = nq[e].x; q[4 * e + 1] = nq[e].y; q[4 * e + 2] = nq[e].z; q[4 * e + 3] = nq[e].w;
        k[4 * e] = nk[e].x * 0.125f; k[4 * e + 1] = nk[e].y * 0.125f; k[4 * e + 2] = nk[e].z * 0.125f; k[4 * e + 3] = nk[e].w * 0.125f;
        v[4 * e] = nv[e].x; v[4 * e + 1] = nv[e].y; v[4 * e + 2] = nv[e].z; v[4 * e + 3] = nv[e].w; }
      store_row16(sQ + row * LDB + seg, q);
      store_row16(sK + row * LDB + seg, k);
#pragma unroll
      for (int e = 0; e < 16; ++e) { sKt[(seg + e) * LDB + row] = f2bf(k[e] * skj); sVt[(seg + e) * LDB + row] = f2bf(v[e]); }
    }
    __syncthreads();
    f32x16 s = mm64(sQ, sK, wr, wc, lane, zero16());
#pragma unroll
    for (int idx = 0; idx < 16; ++idx) {
      const int i = ACC_ROW(idx), j = ACC_COL;
      const float val = (i >= j) ? s[idx] * __expf(s_a[j] - s_M[i]) : 0.f;
      sP[i * LDB + j] = f2bf(val);
    }
    __syncthreads();
    if (c + 1 < nch) MLSTM_PREFETCH(c + 1)
    f32x16 o1 = mm64(sP, sVt, wr, wc, lane, zero16());
    f32x16 o2 = mm64(sQ, sCt, wr, wc, lane, zero16());
    {
      const int r4 = tid >> 2, sg4 = (tid & 3) * 16;
      float rs = 0.f, qn = 0.f;
#pragma unroll
      for (int e = 0; e < 16; ++e) { rs += bf2f(sP[r4 * LDB + sg4 + e]); qn += bf2f(sQ[r4 * LDB + sg4 + e]) * s_n[sg4 + e]; }
      rs = red4(rs); qn = red4(qn);
      const float den = rs + qn * s_ew[r4];
      const float mt = s_b[r4] + s_M[r4];
      if ((tid & 3) == 0) s_dinv[r4] = 1.f / fmaxf(fabsf(den), __expf(-mt));
    }
#pragma unroll
    for (int idx = 0; idx < 16; ++idx) st[idx] *= sp;
    st = mm64(sVt, sKt, wr, wc, lane, st);
    if (tid < 64) {
      float a = s_n[tid] * sp;
      for (int j = 0; j < 64; ++j) a += bf2f(sKt[tid * LDB + j]);
      s_n2[tid] = a;
    }
    __syncthreads();
#pragma unroll
    for (int idx = 0; idx < 16; ++idx) {
      const int i = ACC_ROW(idx), e = ACC_COL;
      const int pp = c * 64 + i; const int tt = z ? (T - 1 - pp) : pp;
      P.hdir[((size_t)z * NTOK + gs + tt) * DM + h * 64 + e] = f2bf((o1[idx] + s_ew[i] * o2[idx]) * s_dinv[i]);
    }
#pragma unroll
    for (int idx = 0; idx < 16; ++idx) sCt[ACC_ROW(idx) * LDB + ACC_COL] = f2bf(st[idx]);
  }
  if (!sample) {
    const int oi = ((seq * 2 + l) * 2 + z) * 4 + h;
    float* o = P.out + O_C + (size_t)oi * 4096;
#pragma unroll
    for (int idx = 0; idx < 16; ++idx) o[ACC_COL * 64 + ACC_ROW(idx)] = st[idx];
    __syncthreads();
    if (tid < 64) P.out[O_N + oi * 64 + tid] = s_nn[(nch & 1) * 64 + tid];
    if (tid == 0) P.out[O_M + oi] = m;
  }
}

DEV void mlstm_sample_task(const Params& P, int l, int task, const int z, char* smem0, const int tid_all_in) {
  const int tid_all = opaque_i(tid_all_in);
  const int half = tid_all >> 8, tid = tid_all & 255;
  int seq, h; bool sample; decode_chain(task, seq, h, sample);
  int gs, T; seq_base(seq, gs, T);
  const int nch = T / 64;
  const int sidx = (((seq - 16) * 2 + l) * 2 + z) * 4 + h;
#define ML_SET(B) ((bf16_t*)(smem0 + (B) * HALF_LDS))
#define ML_GATE(B) ((float*)(smem0 + (B) * HALF_LDS + 4 * 64 * LDB * 2))
  bf16_t* sP = (bf16_t*)(smem0 + 4 * 64 * LDB * 2 + 2048); bf16_t* sCt = sP + 64 * LDB;
  float* s_dinv = (float*)(sCt + 64 * LDB); float* s_nn = s_dinv + 64;
  if (half == 1) {
    const int lane = tid & 63, w = tid >> 6;
    float m = P.st_m[sidx];
    const float ib = P.mlstm_i_bias[(l * 2 + z) * 4 + h], fb = P.mlstm_f_bias[(l * 2 + z) * 4 + h];
    float4 nq[4], nk[4], nv[4]; float ngi, ngf;
#define ML_PREFETCH(C) { \
      const int r_ = tid & 63, sg_ = (tid >> 6) * 16; \
      const int p_ = (C) * 64 + r_; const int g_ = gs + (z ? (T - 1 - p_) : p_); \
      const float* pr_ = P.projABC + (size_t)g_ * NABC + h * 64; \
      _Pragma("unroll") for (int e_ = 0; e_ < 4; ++e_) { nq[e_] = *(const float4*)(pr_ + sg_ + 4 * e_); nk[e_] = *(const float4*)(pr_ + 256 + sg_ + 4 * e_); nv[e_] = *(const float4*)(pr_ + 512 + sg_ + 4 * e_); } \
      const float* gp_ = P.projABC + (size_t)g_ * NABC + 1024 + z * 4 + h; ngi = gp_[0]; ngf = gp_[8]; }
#define ML_STAGE(C) { \
      bf16_t* sQ = ML_SET((C) & 1); bf16_t* sK = sQ + 64 * LDB; bf16_t* sKt = sK + 64 * LDB; bf16_t* sVt = sKt + 64 * LDB; \
      float* gt_ = ML_GATE((C) & 1); \
      const int row = tid & 63, seg = (tid >> 6) * 16; \
      const float li = ngi + ib, lf = logsigmoidf_(ngf + fb); \
      const float b = wave_incl_scan_add(lf, lane); \
      const float a = li - b; \
      const float cm = wave_incl_scan_max(a, lane); \
      const float M = fmaxf(m, cm); \
      const float M63 = __shfl(M, 63), bl = __shfl(b, 63); \
      const float skj = __expf(a - M63); \
      if (w == 0) { gt_[lane] = a; gt_[64 + lane] = b; gt_[128 + lane] = M; gt_[192 + lane] = __expf(m - M); if (lane == 0) gt_[256] = __expf(m - M63); } \
      m = bl + M63; \
      float q[16], k[16], v[16]; \
      _Pragma("unroll") for (int e = 0; e < 4; ++e) { q[4 * e] = nq[e].x; q[4 * e + 1] = nq[e].y; q[4 * e + 2] = nq[e].z; q[4 * e + 3] = nq[e].w; \
        k[4 * e] = nk[e].x * 0.125f; k[4 * e + 1] = nk[e].y * 0.125f; k[4 * e + 2] = nk[e].z * 0.125f; k[4 * e + 3] = nk[e].w * 0.125f; \
        v[4 * e] = nv[e].x; v[4 * e + 1] = nv[e].y; v[4 * e + 2] = nv[e].z; v[4 * e + 3] = nv[e].w; } \
      store_row16(sQ + row * LDB + seg, q); \
      store_row16(sK + row * LDB + seg, k); \
      _Pragma("unroll") for (int e = 0; e < 16; ++e) { sKt[(seg + e) * LDB + row] = f2bf(k[e] * skj); sVt[(seg + e) * LDB + row] = f2bf(v[e]); } }
    ML_PREFETCH(0)
    ML_STAGE(0)
    if (nch > 1) ML_PREFETCH(1)
    __syncthreads();
    for (int c = 0; c < nch; ++c) {
      if (c + 1 < nch) { ML_STAGE(c + 1) if (c + 2 < nch) ML_PREFETCH(c + 2) }
      __syncthreads(); __syncthreads(); __syncthreads();
    }
#undef ML_PREFETCH
#undef ML_STAGE
  } else {
    const int lane = tid & 63, w = tid >> 6, wr = w >> 1, wc = w & 1;
    f32x16 st = zero16();
    {
      const float* c0 = P.st_C + (size_t)sidx * 4096;
#pragma unroll
      for (int idx = 0; idx < 16; ++idx) st[idx] = c0[ACC_COL * 64 + ACC_ROW(idx)];
    }
#pragma unroll
    for (int idx = 0; idx < 16; ++idx) sCt[ACC_ROW(idx) * LDB + ACC_COL] = f2bf(st[idx]);
    if (tid < 64) s_nn[tid] = P.st_n[sidx * 64 + tid];
    __syncthreads();
    for (int c = 0; c < nch; ++c) {
      const bf16_t* sQ = ML_SET(c & 1); const bf16_t* sK = sQ + 64 * LDB; const bf16_t* sKt = sK + 64 * LDB; const bf16_t* sVt = sKt + 64 * LDB;
      const float* gt = ML_GATE(c & 1);
      const float* s_a = gt; const float* s_b = gt + 64; const float* s_M = gt + 128; const float* s_ew = gt + 192;
      const float sp = gt[256];
      const float* s_n = s_nn + (c & 1) * 64; float* s_n2 = s_nn + ((c & 1) ^ 1) * 64;
      f32x16 s = mm64(sQ, sK, wr, wc, lane, zero16());
#pragma unroll
      for (int idx = 0; idx < 16; ++idx) {
        const int i = ACC_ROW(idx), j = ACC_COL;
        const float val = (i >= j) ? s[idx] * __expf(s_a[j] - s_M[i]) : 0.f;
        sP[i * LDB + j] = f2bf(val);
      }
      __syncthreads();
      f32x16 o1 = mm64(sP, sVt, wr, wc, lane, zero16());
      f32x16 o2 = mm64(sQ, sCt, wr, wc, lane, zero16());
      {
        const int r4 = tid >> 2, sg4 = (tid & 3) * 16;
        float rs = 0.f, qn = 0.f;
#pragma unroll
        for (int e = 0; e < 16; ++e) { rs += bf2f(sP[r4 * LDB + sg4 + e]); qn += bf2f(sQ[r4 * LDB + sg4 + e]) * s_n[sg4 + e]; }
        rs = red4(rs); qn = red4(qn);
        const float den = rs + qn * s_ew[r4];
        const float mt = s_b[r4] + s_M[r4];
        if ((tid & 3) == 0) s_dinv[r4] = 1.f / fmaxf(fabsf(den), __expf(-mt));
      }
#pragma unroll
      for (int idx = 0; idx < 16; ++idx) st[idx] *= sp;
      st = mm64(sVt, sKt, wr, wc, lane, st);
      if (tid < 64) {
        float a = s_n[tid] * sp;
        for (int j = 0; j < 64; ++j) a += bf2f(sKt[tid * LDB + j]);
        s_n2[tid] = a;
      }
      __syncthreads();
#pragma unroll
      for (int idx = 0; idx < 16; ++idx) {
        const int i = ACC_ROW(idx), e = ACC_COL;
        const int pp = c * 64 + i; const int tt = z ? (T - 1 - pp) : pp;
        P.hdir[((size_t)z * NTOK + gs + tt) * DM + h * 64 + e] = f2bf((o1[idx] + s_ew[i] * o2[idx]) * s_dinv[i]);
      }
#pragma unroll
      for (int idx = 0; idx < 16; ++idx) sCt[ACC_ROW(idx) * LDB + ACC_COL] = f2bf(st[idx]);
      __syncthreads();
    }
  }
#undef ML_SET
#undef ML_GATE
}

DEV void delta_T_item(const Params& P, int l, int item, char* smem, const int tid_in) {
  const int tid = opaque_i(tid_in);
  const int lane = tid & 63, w = tid >> 6, wr = w >> 1, wc = w & 1;
  const int tile = item & 127, zh = item >> 7, z = zh >> 2, h = zh & 3;
  int gs, T, ci; tok_info(tile * 64, gs, T, ci);
  float* sA = (float*)smem;
  float* s_beta = sA + 2016; float* s_gc = s_beta + 64;
  bf16_t* sK = (bf16_t*)(smem + 8576); bf16_t* sT = sK + 64 * LDB;
  const float aneg = -__expf(P.delta_a_log[(l * 2 + z) * 4 + h]), dtb = P.delta_dt_bias[(l * 2 + z) * 4 + h];
  {
    const int row = tid >> 2, seg = (tid & 3) * 16;
    const int g = tile * 64 + (z ? 63 - row : row);
    const bf16_t* src = P.ubuf + (size_t)g * 768 + 256 + h * 64 + seg;
    *(uint4*)(sK + row * LDB + seg) = *(const uint4*)src; *(uint4*)(sK + row * LDB + seg + 8) = *(const uint4*)(src + 8);
  }
  if (w == 0) {
    const int g = tile * 64 + (z ? 63 - lane : lane);
    const float* gp = P.projABC + (size_t)g * NABC + 2064 + z * 4 + h;
    const float beta = sigmoidf_(gp[0]);
    const float gj = aneg * softplusf_(gp[8] + dtb);
    const float gc = wave_incl_scan_add(gj, lane);
    s_beta[lane] = beta; s_gc[lane] = gc;
    P.dbeta[(size_t)zh * NTOK + g] = beta; P.dgc[(size_t)zh * NTOK + g] = gc;
  }
  __syncthreads();
  {
    f32x16 kkm = mm64(sK, sK, wr, wc, lane, zero16());
#pragma unroll
    for (int idx = 0; idx < 16; ++idx) {
      const int i = ACC_ROW(idx), j = ACC_COL;
      const float av = kkm[idx] * __expf(s_gc[i] - s_gc[j]) * s_beta[i];
      if (i > j) sA[i * (i - 1) / 2 + j] = av;
      if (w == 2) sT[i * LDB + j] = f2bf(av);
    }
  }
  __syncthreads();
  if (w < 2 && lane < 32) {
    const int o = w * 32;
    float x[32];
    const float flane = (float)lane;
#pragma unroll
    for (int i = 0; i < 32; ++i) {
      float a = fmaxf(0.f, 1.f - fabsf(flane - (float)i));
      const float* arow = sA + (o + i) * (o + i - 1) / 2 + o;
#pragma unroll
      for (int j = 0; j < i; ++j) a -= arow[j] * x[j];
      x[i] = a;
      sT[(o + i) * LDB + o + lane] = f2bf(a);
      if (w == 0) sT[lane * LDB + 32 + i] = f2bf(a);
    }
  }
  __syncthreads();
  if (w == 0) {
    const bf16_t* aA = sT + (32 + (lane & 31)) * LDB + (lane >> 5) * 8;
    const bf16_t* bT = sT + (lane & 31) * LDB + 32 + (lane >> 5) * 8;
    f32x16 m1 = zero16();
#pragma unroll
    for (int s2 = 0; s2 < 2; ++s2) m1 = __builtin_amdgcn_mfma_f32_32x32x16_bf16(*(const bf16x8*)(aA + s2 * 16), *(const bf16x8*)(bT + s2 * 16), m1, 0, 0, 0);
#pragma unroll
    for (int g4 = 0; g4 < 4; ++g4) {
      uint2 o2; o2.x = pack2(m1[4 * g4], m1[4 * g4 + 1]); o2.y = pack2(m1[4 * g4 + 2], m1[4 * g4 + 3]);
      *(uint2*)(sT + (lane & 31) * LDB + 32 + 8 * g4 + 4 * (lane >> 5)) = o2;
    }
    const bf16_t* a2 = sT + (32 + (lane & 31)) * LDB + 32 + (lane >> 5) * 8;
    f32x16 m2 = zero16();
#pragma unroll
    for (int s2 = 0; s2 < 2; ++s2) m2 = __builtin_amdgcn_mfma_f32_32x32x16_bf16(*(const bf16x8*)(a2 + s2 * 16), *(const bf16x8*)(bT + s2 * 16), m2, 0, 0, 0);
#pragma unroll
    for (int idx = 0; idx < 16; ++idx) sT[(32 + (idx & 3) + 8 * (idx >> 2) + 4 * (lane >> 5)) * LDB + (lane & 31)] = f2bf(-m2[idx]);
    *(uint4*)(sT + (lane & 31) * LDB + 32 + (lane >> 5) * 16) = make_uint4(0u, 0u, 0u, 0u);
    *(uint4*)(sT + (lane & 31) * LDB + 32 + (lane >> 5) * 16 + 8) = make_uint4(0u, 0u, 0u, 0u);
  }
  __syncthreads();
  {
    const int row = tid >> 2, seg = (tid & 3) * 16;
    bf16_t* dst = P.dT + ((size_t)item * 64 + row) * 64 + seg;
    *(uint4*)dst = *(const uint4*)(sT + row * LDB + seg); *(uint4*)(dst + 8) = *(const uint4*)(sT + row * LDB + seg + 8);
  }
  __syncthreads();
}

DEV void delta_task(const Params& P, int l, int task, const int z, char* smem, const int tid_in, const bool active) {
  const int tid = opaque_i(tid_in);
  const int lane = tid & 63, w = tid >> 6, wr = w >> 1, wc = w & 1;
  int seq, h; bool sample; decode_chain(task, seq, h, sample);
  int gs, T; seq_base(seq, gs, T);
  if (!active) { for (int c = 0; c < T / 64; ++c) { __syncthreads(); __syncthreads(); __syncthreads(); __syncthreads(); __syncthreads(); __syncthreads(); } return; }
  float* s_beta = (float*)smem; float* s_gc = s_beta + 64;
  bf16_t* sQ = (bf16_t*)(smem + 512); bf16_t* sK = sQ + 64 * LDB; bf16_t* sKbt = sK + 64 * LDB; bf16_t* sKgt = sKbt + 64 * LDB; bf16_t* sVbt = sKgt + 64 * LDB; bf16_t* sT = sVbt + 64 * LDB; bf16_t* sSt = sT + 64 * LDB;
  bf16_t* sW = sKbt; bf16_t* sVnt = sVbt; bf16_t* sP = sT;
  f32x16 st = zero16();
  if (sample) {
    const float* s0 = P.st_delta + ((size_t)(((seq - 16) * 2 + l) * 2 + z) * 4 + h) * 4096;
#pragma unroll
    for (int idx = 0; idx < 16; ++idx) st[idx] = s0[ACC_COL * 64 + ACC_ROW(idx)];
  }
#pragma unroll
  for (int idx = 0; idx < 16; ++idx) sSt[ACC_ROW(idx) * LDB + ACC_COL] = f2bf(st[idx]);
  const int nch = T / 64;
  const int tid_outer = tid;
  const int zh = z * 4 + h;
  uint4 nq0, nq1, nk0, nk1, nv0, nv1, nt0, nt1; float nbeta, ngc, nglast;
#define DELTA_PREFETCH(C) { \
    const int r_ = tid_outer & 63, sg_ = (tid_outer >> 6) * 16; \
    const int p_ = (C) * 64 + r_; const int g_ = gs + (z ? (T - 1 - p_) : p_); \
    const bf16_t* src_ = P.ubuf + (size_t)g_ * 768 + h * 64 + sg_; \
    nq0 = *(const uint4*)src_; nq1 = *(const uint4*)(src_ + 8); nk0 = *(const uint4*)(src_ + 256); nk1 = *(const uint4*)(src_ + 264); nv0 = *(const uint4*)(src_ + 512); nv1 = *(const uint4*)(src_ + 520); \
    const int tile_ = (gs >> 6) + (z ? (nch - 1 - (C)) : (C)); \
    const bf16_t* tsrc_ = P.dT + (((size_t)zh * 128 + tile_) * 64 + r_) * 64 + sg_; \
    nt0 = *(const uint4*)tsrc_; nt1 = *(const uint4*)(tsrc_ + 8); \
    nbeta = P.dbeta[(size_t)zh * NTOK + g_]; ngc = P.dgc[(size_t)zh * NTOK + g_]; \
    const int pl_ = (C) * 64 + 63; nglast = P.dgc[(size_t)zh * NTOK + gs + (z ? (T - 1 - pl_) : pl_)]; }
  DELTA_PREFETCH(0)
  for (int c = 0; c < nch; ++c) {
    const int tid = opaque_i(tid_outer);
    const int lane = tid & 63, w = tid >> 6, wr = w >> 1, wc = w & 1;
    const int row = tid & 63, seg = (tid >> 6) * 16;
    {
      const uint4 cq0 = nq0, cq1 = nq1, ck0 = nk0, ck1 = nk1, cv0 = nv0, cv1 = nv1, ct0 = nt0, ct1 = nt1;
      const float bj = nbeta, gcj = ngc, glast = nglast;
      float k[16], v[16];
      { const unsigned kw[8] = {ck0.x, ck0.y, ck0.z, ck0.w, ck1.x, ck1.y, ck1.z, ck1.w}, vw[8] = {cv0.x, cv0.y, cv0.z, cv0.w, cv1.x, cv1.y, cv1.z, cv1.w};
#pragma unroll
        for (int e = 0; e < 8; ++e) { k[2 * e] = __uint_as_float(kw[e] << 16); k[2 * e + 1] = __uint_as_float(kw[e] & 0xffff0000u); v[2 * e] = __uint_as_float(vw[e] << 16); v[2 * e + 1] = __uint_as_float(vw[e] & 0xffff0000u); } }
      if (w == 0) { s_beta[row] = bj; s_gc[row] = gcj; }
      const float f1 = bj * __expf(gcj), f2 = __expf(glast - gcj);
      *(uint4*)(sQ + row * LDB + seg) = cq0; *(uint4*)(sQ + row * LDB + seg + 8) = cq1;
      *(uint4*)(sK + row * LDB + seg) = ck0; *(uint4*)(sK + row * LDB + seg + 8) = ck1;
      *(uint4*)(sT + row * LDB + seg) = ct0; *(uint4*)(sT + row * LDB + seg + 8) = ct1;
#pragma unroll
      for (int e = 0; e < 16; ++e) {
        sKbt[(seg + e) * LDB + row] = f2bf(k[e] * f1);
        sKgt[(seg + e) * LDB + row] = f2bf(k[e] * f2);
        sVbt[(seg + e) * LDB + row] = f2bf(v[e] * bj);
      }
    }
    __syncthreads();
    if (c + 1 < nch) DELTA_PREFETCH(c + 1)
    f32x16 U = mm64(sT, sVbt, wr, wc, lane, zero16());
    f32x16 Wm = mm64(sT, sKbt, wr, wc, lane, zero16());
    f32x16 qk = mm64(sQ, sK, wr, wc, lane, zero16());
    __syncthreads();
#pragma unroll
    for (int idx = 0; idx < 16; ++idx) {
      const int i = ACC_ROW(idx), j = ACC_COL;
      sW[i * LDB + j] = f2bf(Wm[idx]);
      sP[i * LDB + j] = f2bf((i >= j) ? qk[idx] * __expf(s_gc[i] - s_gc[j]) : 0.f);
    }
    __syncthreads();
    {
      f32x16 ws = mm64(sW, sSt, wr, wc, lane, zero16());
#pragma unroll
      for (int g4 = 0; g4 < 4; ++g4) {
        const int e = ACC_COL, i0 = wr * 32 + 8 * g4 + 4 * (lane >> 5);
        uint2 o; o.x = pack2(U[4 * g4] - ws[4 * g4], U[4 * g4 + 1] - ws[4 * g4 + 1]); o.y = pack2(U[4 * g4 + 2] - ws[4 * g4 + 2], U[4 * g4 + 3] - ws[4 * g4 + 3]);
        *(uint2*)(sVnt + e * LDB + i0) = o;
      }
    }
    __syncthreads();
    f32x16 o1 = mm64(sP, sVnt, wr, wc, lane, zero16());
    f32x16 o2 = mm64(sQ, sSt, wr, wc, lane, zero16());
#pragma unroll
    for (int idx = 0; idx < 16; ++idx) {
      const int i = ACC_ROW(idx), e = ACC_COL;
      const int pp = c * 64 + i; const int tt = z ? (T - 1 - pp) : pp;
      P.hdir[((size_t)z * NTOK + gs + tt) * DM + 256 + h * 64 + e] = f2bf(o1[idx] + __expf(s_gc[i]) * o2[idx]);
    }
    const float egl = __expf(s_gc[63]);
#pragma unroll
    for (int idx = 0; idx < 16; ++idx) st[idx] *= egl;
    st = mm64(sVnt, sKgt, wr, wc, lane, st);
    __syncthreads();
#pragma unroll
    for (int idx = 0; idx < 16; ++idx) sSt[ACC_ROW(idx) * LDB + ACC_COL] = f2bf(st[idx]);
    __syncthreads();
  }
  if (!sample) {
    float* o = P.out + O_DELTA + ((size_t)((seq * 2 + l) * 2 + z) * 4 + h) * 4096;
#pragma unroll
    for (int idx = 0; idx < 16; ++idx) o[ACC_COL * 64 + ACC_ROW(idx)] = st[idx];
  }
}

DEV void delta_sample_task(const Params& P, int l, int task, const int z, char* smem0, const int tid_all_in) {
  const int tid_all = opaque_i(tid_all_in);
  const int half = tid_all >> 8, tid = tid_all & 255;
  int seq, h; bool sample; decode_chain(task, seq, h, sample);
  int gs, T; seq_base(seq, gs, T);
  const int nch = T / 64;
  const int zh = z * 4 + h;
#define DL_GATE(B) ((float*)(smem0 + (B) * HALF_LDS))
#define DL_SET(B) ((bf16_t*)(smem0 + (B) * HALF_LDS + 512))
  bf16_t* sSt = DL_SET(0) + 6 * 64 * LDB;
  if (half == 1) {
    uint4 nq0, nq1, nk0, nk1, nv0, nv1, nt0, nt1; float nbeta, ngc, nglast;
#define DL_PREFETCH(C) { \
      const int r_ = tid & 63, sg_ = (tid >> 6) * 16; \
      const int p_ = (C) * 64 + r_; const int g_ = gs + (z ? (T - 1 - p_) : p_); \
      const bf16_t* src_ = P.ubuf + (size_t)g_ * 768 + h * 64 + sg_; \
      nq0 = *(const uint4*)src_; nq1 = *(const uint4*)(src_ + 8); nk0 = *(const uint4*)(src_ + 256); nk1 = *(const uint4*)(src_ + 264); nv0 = *(const uint4*)(src_ + 512); nv1 = *(const uint4*)(src_ + 520); \
      const int tile_ = (gs >> 6) + (z ? (nch - 1 - (C)) : (C)); \
      const bf16_t* tsrc_ = P.dT + (((size_t)zh * 128 + tile_) * 64 + r_) * 64 + sg_; \
      nt0 = *(const uint4*)tsrc_; nt1 = *(const uint4*)(tsrc_ + 8); \
      nbeta = P.dbeta[(size_t)zh * NTOK + g_]; ngc = P.dgc[(size_t)zh * NTOK + g_]; \
      const int pl_ = (C) * 64 + 63; nglast = P.dgc[(size_t)zh * NTOK + gs + (z ? (T - 1 - pl_) : pl_)]; }
#define DL_STAGE(C) { \
      float* s_beta = DL_GATE((C) & 1); float* s_gc = s_beta + 64; \
      bf16_t* sQ = DL_SET((C) & 1); bf16_t* sK = sQ + 64 * LDB; bf16_t* sKbt = sK + 64 * LDB; bf16_t* sKgt = sKbt + 64 * LDB; bf16_t* sVbt = sKgt + 64 * LDB; bf16_t* sT = sVbt + 64 * LDB; \
      const int row = tid & 63, seg = (tid >> 6) * 16, w = tid >> 6; \
      const float bj = nbeta, gcj = ngc, glast = nglast; \
      float k[16], v[16]; \
      { const unsigned kw[8] = {nk0.x, nk0.y, nk0.z, nk0.w, nk1.x, nk1.y, nk1.z, nk1.w}, vw[8] = {nv0.x, nv0.y, nv0.z, nv0.w, nv1.x, nv1.y, nv1.z, nv1.w}; \
        _Pragma("unroll") for (int e = 0; e < 8; ++e) { k[2 * e] = __uint_as_float(kw[e] << 16); k[2 * e + 1] = __uint_as_float(kw[e] & 0xffff0000u); v[2 * e] = __uint_as_float(vw[e] << 16); v[2 * e + 1] = __uint_as_float(vw[e] & 0xffff0000u); } } \
      if (w == 0) { s_beta[row] = bj; s_gc[row] = gcj; } \
      const float f1 = bj * __expf(gcj), f2 = __expf(glast - gcj); \
      *(uint4*)(sQ + row * LDB + seg) = nq0; *(uint4*)(sQ + row * LDB + seg + 8) = nq1; \
      *(uint4*)(sK + row * LDB + seg) = nk0; *(uint4*)(sK + row * LDB + seg + 8) = nk1; \
      *(uint4*)(sT + row * LDB + seg) = nt0; *(uint4*)(sT + row * LDB + seg + 8) = nt1; \
      _Pragma("unroll") for (int e = 0; e < 16; ++e) { \
        sKbt[(seg + e) * LDB + row] = f2bf(k[e] * f1); \
        sKgt[(seg + e) * LDB + row] = f2bf(k[e] * f2); \
        sVbt[(seg + e) * LDB + row] = f2bf(v[e] * bj); } }
    DL_PREFETCH(0)
    DL_STAGE(0)
    if (nch > 1) DL_PREFETCH(1)
    __syncthreads();
    for (int c = 0; c < nch; ++c) {
      if (c + 1 < nch) { DL_STAGE(c + 1) if (c + 2 < nch) DL_PREFETCH(c + 2) }
      __syncthreads(); __syncthreads(); __syncthreads(); __syncthreads(); __syncthreads();
    }
#undef DL_PREFETCH
#undef DL_STAGE
  } else {
    const int lane = tid & 63, w = tid >> 6, wr = w >> 1, wc = w & 1;
    f32x16 st = zero16();
    {
      const float* s0 = P.st_delta + ((size_t)(((seq - 16) * 2 + l) * 2 + z) * 4 + h) * 4096;
#pragma unroll
      for (int idx = 0; idx < 16; ++idx) st[idx] = s0[ACC_COL * 64 + ACC_ROW(idx)];
    }
#pragma unroll
    for (int idx = 0; idx < 16; ++idx) sSt[ACC_ROW(idx) * LDB + ACC_COL] = f2bf(st[idx]);
    __syncthreads();
    for (int c = 0; c < nch; ++c) {
      const float* s_gc = DL_GATE(c & 1) + 64;
      bf16_t* sQ = DL_SET(c & 1); bf16_t* sK = sQ + 64 * LDB; bf16_t* sKbt = sK + 64 * LDB; bf16_t* sKgt = sKbt + 64 * LDB; bf16_t* sVbt = sKgt + 64 * LDB; bf16_t* sT = sVbt + 64 * LDB;
      bf16_t* sW = sKbt; bf16_t* sVnt = sVbt; bf16_t* sP = sT;
      f32x16 U = mm64(sT, sVbt, wr, wc, lane, zero16());
      f32x16 Wm = mm64(sT, sKbt, wr, wc, lane, zero16());
      f32x16 qk = mm64(sQ, sK, wr, wc, lane, zero16());
      __syncthreads();
#pragma unroll
      for (int idx = 0; idx < 16; ++idx) {
        const int i = ACC_ROW(idx), j = ACC_COL;
        sW[i * LDB + j] = f2bf(Wm[idx]);
        sP[i * LDB + j] = f2bf((i >= j) ? qk[idx] * __expf(s_gc[i] - s_gc[j]) : 0.f);
      }
      __syncthreads();
      {
        f32x16 ws = mm64(sW, sSt, wr, wc, lane, zero16());
#pragma unroll
        for (int g4 = 0; g4 < 4; ++g4) {
          const int e = ACC_COL, i0 = wr * 32 + 8 * g4 + 4 * (lane >> 5);
          uint2 o; o.x = pack2(U[4 * g4] - ws[4 * g4], U[4 * g4 + 1] - ws[4 * g4 + 1]); o.y = pack2(U[4 * g4 + 2] - ws[4 * g4 + 2], U[4 * g4 + 3] - ws[4 * g4 + 3]);
          *(uint2*)(sVnt + e * LDB + i0) = o;
        }
      }
      __syncthreads();
      f32x16 o1 = mm64(sP, sVnt, wr, wc, lane, zero16());
      f32x16 o2 = mm64(sQ, sSt, wr, wc, lane, zero16());
#pragma unroll
      for (int idx = 0; idx < 16; ++idx) {
        const int i = ACC_ROW(idx), e = ACC_COL;
        const int pp = c * 64 + i; const int tt = z ? (T - 1 - pp) : pp;
        P.hdir[((size_t)z * NTOK + gs + tt) * DM + 256 + h * 64 + e] = f2bf(o1[idx] + __expf(s_gc[i]) * o2[idx]);
      }
      const float egl = __expf(s_gc[63]);
#pragma unroll
      for (int idx = 0; idx < 16; ++idx) st[idx] *= egl;
      st = mm64(sVnt, sKgt, wr, wc, lane, st);
      __syncthreads();
#pragma unroll
      for (int idx = 0; idx < 16; ++idx) sSt[ACC_ROW(idx) * LDB + ACC_COL] = f2bf(st[idx]);
      __syncthreads();
    }
  }
#undef DL_GATE
#undef DL_SET
}

template <int RWAVES>
DEV void rwkv_task(const Params& P, int l, int task, const int z, char* smem, const int tid_in, const bool active) {
  const int tid = opaque_i(tid_in);
  constexpr int NR = 4 * RWAVES, NRB = 64 / NR;
  const int chain = task / NRB, rb = task % NRB;
  int seq, h; bool sample; decode_chain(chain, seq, h, sample);
  int gs, T; seq_base(seq, gs, T);
  if (!active) { for (int c = 0; c < T / 32; ++c) { __syncthreads(); __syncthreads(); } return; }
  float* s_kh = (float*)smem; float* s_w = s_kh + 2048; float* s_b = s_w + 2048; float* s_kt = s_b + 2048; float* s_r = s_kt + 2048; float* s_v = s_r + 2048; float* s_yp = s_v + 512;
  const int rl = tid >> 4, cg4 = (tid & 15) * 4;
  const int irow = rb * NR + (rl & (NR - 1));
  const bool rowthread = tid < 64 * RWAVES;
  float S0 = 0.f, S1 = 0.f, S2 = 0.f, S3 = 0.f;
  if (sample) {
    const float4 s4 = *(const float4*)(P.st_rwkv + ((size_t)(((seq - 16) * 2 + l) * 2 + z) * 4 + h) * 4096 + irow * 64 + cg4);
    S0 = s4.x; S1 = s4.y; S2 = s4.z; S3 = s4.w;
  }
  const int si = tid >> 3, sc = (tid & 7) * 8;
  float kkc[8], kac[8], rkc[8];
#pragma unroll
  for (int e = 0; e < 8; ++e) { kkc[e] = P.rwkv_kk[l * 256 + h * 64 + sc + e]; kac[e] = P.rwkv_ka[l * 256 + h * 64 + sc + e]; rkc[e] = P.rwkv_rk[(l * 4 + h) * 64 + sc + e]; }
  const int nch = T / 32;
  float4 pr0, pr1, pk0, pk1, pw0, pw1, pa0, pa1, pv_ = make_float4(0.f, 0.f, 0.f, 0.f); float pinv;
#define RWKV_PREFETCH(C) { \
    const int p_ = (C) * 32 + si; const int t_ = z ? (T - 1 - p_) : p_; const int g_ = gs + t_; \
    const float* rk_ = P.rkv + (size_t)g_ * 768 + h * 64 + sc; \
    pr0 = *(const float4*)rk_; pr1 = *(const float4*)(rk_ + 4); \
    pk0 = *(const float4*)(rk_ + 256); pk1 = *(const float4*)(rk_ + 260); \
    const float* wp_ = P.wa + ((size_t)(g_ * 2 + z) * 2) * 256 + h * 64 + sc; \
    pw0 = *(const float4*)wp_; pw1 = *(const float4*)(wp_ + 4); \
    pa0 = *(const float4*)(wp_ + 256); pa1 = *(const float4*)(wp_ + 260); \
    pinv = P.khinv[g_ * 4 + h]; \
    if (tid < 8 * NR) { \
      const int p2_ = (C) * 32 + (tid / (NR / 4)); const int t2_ = z ? (T - 1 - p2_) : p2_; \
      pv_ = *(const float4*)(P.rkv + (size_t)(gs + t2_) * 768 + 512 + h * 64 + rb * NR + (tid % (NR / 4)) * 4); \
    } }
  RWKV_PREFETCH(0)
  for (int c = 0; c < nch; ++c) {
    {
      const float rr[8] = {pr0.x, pr0.y, pr0.z, pr0.w, pr1.x, pr1.y, pr1.z, pr1.w};
      const float kk[8] = {pk0.x, pk0.y, pk0.z, pk0.w, pk1.x, pk1.y, pk1.z, pk1.w};
      const float aa[8] = {pa0.x, pa0.y, pa0.z, pa0.w, pa1.x, pa1.y, pa1.z, pa1.w};
      float bsum = 0.f;
      float okh[8], ob[8], okt[8];
#pragma unroll
      for (int e = 0; e < 8; ++e) {
        okh[e] = kk[e] * kkc[e] * pinv; ob[e] = aa[e] * okh[e]; okt[e] = kk[e] * (1.f + (aa[e] - 1.f) * kac[e]);
        bsum += rr[e] * okt[e] * rkc[e];
      }
      float* d;
      d = s_kh + si * 64 + sc; *(float4*)d = make_float4(okh[0], okh[1], okh[2], okh[3]); *(float4*)(d + 4) = make_float4(okh[4], okh[5], okh[6], okh[7]);
      d = s_w + si * 64 + sc; *(float4*)d = pw0; *(float4*)(d + 4) = pw1;
      d = s_b + si * 64 + sc; *(float4*)d = make_float4(ob[0], ob[1], ob[2], ob[3]); *(float4*)(d + 4) = make_float4(ob[4], ob[5], ob[6], ob[7]);
      d = s_kt + si * 64 + sc; *(float4*)d = make_float4(okt[0], okt[1], okt[2], okt[3]); *(float4*)(d + 4) = make_float4(okt[4], okt[5], okt[6], okt[7]);
      d = s_r + si * 64 + sc; *(float4*)d = pr0; *(float4*)(d + 4) = pr1;
      if (tid < 8 * NR) *(float4*)(s_v + (tid / (NR / 4)) * NR + (tid % (NR / 4)) * 4) = pv_;
      bsum += dppf<0xB1>(bsum); bsum += dppf<0x4E>(bsum); bsum += dppf<0x141>(bsum);
      if (rb == 0 && (tid & 7) == 0) {
        const int p = c * 32 + si; const int t = z ? (T - 1 - p) : p;
        P.bonus[((size_t)z * NTOK + gs + t) * 4 + h] = bsum;
      }
    }
    __syncthreads();
    if (c + 1 < nch) RWKV_PREFETCH(c + 1)
    if (rowthread) {
      typedef float v2f __attribute__((ext_vector_type(2)));
      typedef float v4f __attribute__((ext_vector_type(4)));
      v2f Sa = {S0, S1}, Sb = {S2, S3};
      v4f kh = *(const v4f*)(s_kh + cg4), ww = *(const v4f*)(s_w + cg4), bb = *(const v4f*)(s_b + cg4), kt = *(const v4f*)(s_kt + cg4), rr = *(const v4f*)(s_r + cg4);
      float vi = s_v[rl];
#pragma unroll 8
      for (int i = 0; i < 32; ++i) {
        const int in = (i + 1) & 31;
        const v4f kh_n = *(const v4f*)(s_kh + in * 64 + cg4);
        const v4f ww_n = *(const v4f*)(s_w + in * 64 + cg4);
        const v4f bb_n = *(const v4f*)(s_b + in * 64 + cg4);
        const v4f kt_n = *(const v4f*)(s_kt + in * 64 + cg4);
        const v4f rr_n = *(const v4f*)(s_r + in * 64 + cg4);
        const float vi_n = s_v[in * NR + rl];
        const v2f v2 = {vi, vi};
        const v2f pp = __builtin_elementwise_fma(Sb, kh.zw, Sa * kh.xy);
        const float sk = red16(pp.x + pp.y);
        const v2f sk2 = {sk, sk};
        Sa = __builtin_elementwise_fma(-sk2, bb.xy, __builtin_elementwise_fma(v2, kt.xy, Sa * ww.xy));
        Sb = __builtin_elementwise_fma(-sk2, bb.zw, __builtin_elementwise_fma(v2, kt.zw, Sb * ww.zw));
        const v2f qq = __builtin_elementwise_fma(Sb, rr.zw, Sa * rr.xy);
        s_yp[i * (64 * RWAVES) + tid] = qq.x + qq.y;
        kh = kh_n; ww = ww_n; bb = bb_n; kt = kt_n; rr = rr_n; vi = vi_n;
      }
      S0 = Sa.x; S1 = Sa.y; S2 = Sb.x; S3 = Sb.y;
    }
    __syncthreads();
    {
      const int i = tid >> 3, q2 = tid & 7;
      const int p = c * 32 + i; const int t = z ? (T - 1 - p) : p;
      if (NR == 16) {
        const float* y0 = s_yp + i * 256 + (2 * q2) * 16;
        float a0 = 0.f, a1 = 0.f;
#pragma unroll
        for (int e = 0; e < 16; e += 4) { const float4 u0 = *(const float4*)(y0 + e), u1 = *(const float4*)(y0 + 16 + e); a0 += (u0.x + u0.y) + (u0.z + u0.w); a1 += (u1.x + u1.y) + (u1.z + u1.w); }
        *(unsigned*)(P.hdir + ((size_t)z * NTOK + gs + t) * DM + 768 + h * 64 + rb * 16 + 2 * q2) = pack2(a0, a1);
      } else {
        const float* y0 = s_yp + i * (64 * RWAVES) + q2 * 16;
        float a0 = 0.f;
#pragma unroll
        for (int e = 0; e < 16; e += 4) { const float4 u0 = *(const float4*)(y0 + e); a0 += (u0.x + u0.y) + (u0.z + u0.w); }
        P.hdir[((size_t)z * NTOK + gs + t) * DM + 768 + h * 64 + rb * NR + q2] = f2bf(a0);
      }
    }
  }
  if (!sample && rowthread) {
    *(float4*)(P.out + O_RWKV + ((size_t)((seq * 2 + l) * 2 + z) * 4 + h) * 4096 + irow * 64 + cg4) = make_float4(S0, S1, S2, S3);
  }
}

DEV void rwkv_prompt_task(const Params& P, int l, int task, const int z, char* smem, const int tid_in) {
  const int tid = opaque_i(tid_in);
  const int chain = task >> 1, rb = task & 1;
  int seq, h; bool sample; decode_chain(chain, seq, h, sample);
  int gs, T; seq_base(seq, gs, T);
  float* s_kh = (float*)smem; float* s_w = s_kh + 2048; float* s_b = s_w + 2048; float* s_kt = s_b + 2048; float* s_r = s_kt + 2048; float* s_v = s_r + 2048; float* s_yp = s_v + 1024;
  const int rp = tid >> 4, cg4 = (tid & 15) * 4;
  const int irow = rb * 32 + 2 * rp;
  typedef float v2f __attribute__((ext_vector_type(2)));
  typedef float v4f __attribute__((ext_vector_type(4)));
  v2f Aa = {0.f, 0.f}, Ab = {0.f, 0.f}, Ba = {0.f, 0.f}, Bb = {0.f, 0.f};
  if (sample) {
    const float* sp0 = P.st_rwkv + ((size_t)(((seq - 16) * 2 + l) * 2 + z) * 4 + h) * 4096 + irow * 64 + cg4;
    const float4 a4 = *(const float4*)sp0, b4 = *(const float4*)(sp0 + 64);
    Aa.x = a4.x; Aa.y = a4.y; Ab.x = a4.z; Ab.y = a4.w; Ba.x = b4.x; Ba.y = b4.y; Bb.x = b4.z; Bb.y = b4.w;
  }
  const int si = tid >> 3, sc = (tid & 7) * 8;
  float kkc[8], kac[8], rkc[8];
#pragma unroll
  for (int e = 0; e < 8; ++e) { kkc[e] = P.rwkv_kk[l * 256 + h * 64 + sc + e]; kac[e] = P.rwkv_ka[l * 256 + h * 64 + sc + e]; rkc[e] = P.rwkv_rk[(l * 4 + h) * 64 + sc + e]; }
  const int nch = T / 32;
  float4 pr0, pr1, pk0, pk1, pw0, pw1, pa0, pa1, pv_; float pinv;
#define RP_PREFETCH(C) { \
    const int p_ = (C) * 32 + si; const int t_ = z ? (T - 1 - p_) : p_; const int g_ = gs + t_; \
    const float* rk_ = P.rkv + (size_t)g_ * 768 + h * 64 + sc; \
    pr0 = *(const float4*)rk_; pr1 = *(const float4*)(rk_ + 4); \
    pk0 = *(const float4*)(rk_ + 256); pk1 = *(const float4*)(rk_ + 260); \
    const float* wp_ = P.wa + ((size_t)(g_ * 2 + z) * 2) * 256 + h * 64 + sc; \
    pw0 = *(const float4*)wp_; pw1 = *(const float4*)(wp_ + 4); \
    pa0 = *(const float4*)(wp_ + 256); pa1 = *(const float4*)(wp_ + 260); \
    pinv = P.khinv[g_ * 4 + h]; \
    pv_ = *(const float4*)(P.rkv + (size_t)g_ * 768 + 512 + h * 64 + rb * 32 + (tid & 7) * 4); }
  RP_PREFETCH(0)
  for (int c = 0; c < nch; ++c) {
    {
      const float rr[8] = {pr0.x, pr0.y, pr0.z, pr0.w, pr1.x, pr1.y, pr1.z, pr1.w};
      const float kk[8] = {pk0.x, pk0.y, pk0.z, pk0.w, pk1.x, pk1.y, pk1.z, pk1.w};
      const float aa[8] = {pa0.x, pa0.y, pa0.z, pa0.w, pa1.x, pa1.y, pa1.z, pa1.w};
      float bsum = 0.f;
      float okh[8], ob[8], okt[8];
#pragma unroll
      for (int e = 0; e < 8; ++e) {
        okh[e] = kk[e] * kkc[e] * pinv; ob[e] = aa[e] * okh[e]; okt[e] = kk[e] * (1.f + (aa[e] - 1.f) * kac[e]);
        bsum += rr[e] * okt[e] * rkc[e];
      }
      float* d;
      d = s_kh + si * 64 + sc; *(float4*)d = make_float4(okh[0], okh[1], okh[2], okh[3]); *(float4*)(d + 4) = make_float4(okh[4], okh[5], okh[6], okh[7]);
      d = s_w + si * 64 + sc; *(float4*)d = pw0; *(float4*)(d + 4) = pw1;
      d = s_b + si * 64 + sc; *(float4*)d = make_float4(ob[0], ob[1], ob[2], ob[3]); *(float4*)(d + 4) = make_float4(ob[4], ob[5], ob[6], ob[7]);
      d = s_kt + si * 64 + sc; *(float4*)d = make_float4(okt[0], okt[1], okt[2], okt[3]); *(float4*)(d + 4) = make_float4(okt[4], okt[5], okt[6], okt[7]);
      d = s_r + si * 64 + sc; *(float4*)d = pr0; *(float4*)(d + 4) = pr1;
      *(float4*)(s_v + si * 32 + (tid & 7) * 4) = pv_;
      bsum += dppf<0xB1>(bsum); bsum += dppf<0x4E>(bsum); bsum += dppf<0x141>(bsum);
      if (rb == 0 && (tid & 7) == 0) {
        const int p = c * 32 + si; const int t = z ? (T - 1 - p) : p;
        P.bonus[((size_t)z * NTOK + gs + t) * 4 + h] = bsum;
      }
    }
    __syncthreads();
    if (c + 1 < nch) RP_PREFETCH(c + 1)
    {
      v4f kh = *(const v4f*)(s_kh + cg4), ww = *(const v4f*)(s_w + cg4), bb = *(const v4f*)(s_b + cg4), kt = *(const v4f*)(s_kt + cg4), rr = *(const v4f*)(s_r + cg4);
      v2f vv = *(const v2f*)(s_v + 2 * rp);
      float* ypw = s_yp + (2 * rp) * 4 + ((tid & 15) >> 2);
#pragma unroll 8
      for (int i = 0; i < 32; ++i) {
        const int in = (i + 1) & 31;
        const v4f kh_n = *(const v4f*)(s_kh + in * 64 + cg4);
        const v4f ww_n = *(const v4f*)(s_w + in * 64 + cg4);
        const v4f bb_n = *(const v4f*)(s_b + in * 64 + cg4);
        const v4f kt_n = *(const v4f*)(s_kt + in * 64 + cg4);
        const v4f rr_n = *(const v4f*)(s_r + in * 64 + cg4);
        const v2f vv_n = *(const v2f*)(s_v + in * 32 + 2 * rp);
        const v2f va = {vv.x, vv.x}, vb = {vv.y, vv.y};
        const v2f pa = __builtin_elementwise_fma(Ab, kh.zw, Aa * kh.xy), pb = __builtin_elementwise_fma(Bb, kh.zw, Ba * kh.xy);
        const float ska = red16(pa.x + pa.y), skb = red16(pb.x + pb.y);
        const v2f sa2 = {ska, ska}, sb2 = {skb, skb};
        Aa = __builtin_elementwise_fma(-sa2, bb.xy, __builtin_elementwise_fma(va, kt.xy, Aa * ww.xy));
        Ab = __builtin_elementwise_fma(-sa2, bb.zw, __builtin_elementwise_fma(va, kt.zw, Ab * ww.zw));
        Ba = __builtin_elementwise_fma(-sb2, bb.xy, __builtin_elementwise_fma(vb, kt.xy, Ba * ww.xy));
        Bb = __builtin_elementwise_fma(-sb2, bb.zw, __builtin_elementwise_fma(vb, kt.zw, Bb * ww.zw));
        const v2f qa = __builtin_elementwise_fma(Ab, rr.zw, Aa * rr.xy), qb = __builtin_elementwise_fma(Bb, rr.zw, Ba * rr.xy);
        const float ya = red4(qa.x + qa.y), yb = red4(qb.x + qb.y);
        if ((tid & 3) == 0) { ypw[i * 128] = ya; ypw[i * 128 + 4] = yb; }
        kh = kh_n; ww = ww_n; bb = bb_n; kt = kt_n; rr = rr_n; vv = vv_n;
      }
    }
    __syncthreads();
    {
      const int i = tid >> 3, r0 = (tid & 7) * 4;
      const int p = c * 32 + i; const int t = z ? (T - 1 - p) : p;
      const float* y0 = s_yp + i * 128 + r0 * 4;
      const float4 u0 = *(const float4*)y0, u1 = *(const float4*)(y0 + 4), u2 = *(const float4*)(y0 + 8), u3 = *(const float4*)(y0 + 12);
      uint2 o; o.x = pack2((u0.x + u0.y) + (u0.z + u0.w), (u1.x + u1.y) + (u1.z + u1.w)); o.y = pack2((u2.x + u2.y) + (u2.z + u2.w), (u3.x + u3.y) + (u3.z + u3.w));
      *(uint2*)(P.hdir + ((size_t)z * NTOK + gs + t) * DM + 768 + h * 64 + rb * 32 + r0) = o;
    }
  }
  if (!sample) {
    float* so = P.out + O_RWKV + ((size_t)((seq * 2 + l) * 2 + z) * 4 + h) * 4096 + irow * 64 + cg4;
    *(float4*)so = make_float4(Aa.x, Aa.y, Ab.x, Ab.y); *(float4*)(so + 64) = make_float4(Ba.x, Ba.y, Bb.x, Bb.y);
  }
#undef RP_PREFETCH
}

DEV void rwkv_sample_task(const Params& P, int l, int task, const int z, char* smem0, const int tid_all_in) {
  const int tid_all = opaque_i(tid_all_in);
  const int half = tid_all >> 8, tid = tid_all & 255;
  constexpr int NR = 8;
  const int chain = task >> 3, rb = task & 7;
  int seq, h; bool sample; decode_chain(chain, seq, h, sample);
  int gs, T; seq_base(seq, gs, T);
  const int nch = T / 32;
#define RS_BUF(B) ((float*)(smem0 + (B) * HALF_LDS))
  if (half == 1) {
    const int si = tid >> 3, sc = (tid & 7) * 8;
    float kkc[8], kac[8], rkc[8];
#pragma unroll
    for (int e = 0; e < 8; ++e) { kkc[e] = P.rwkv_kk[l * 256 + h * 64 + sc + e]; kac[e] = P.rwkv_ka[l * 256 + h * 64 + sc + e]; rkc[e] = P.rwkv_rk[(l * 4 + h) * 64 + sc + e]; }
    float4 pr0, pr1, pk0, pk1, pw0, pw1, pa0, pa1, pv_ = make_float4(0.f, 0.f, 0.f, 0.f); float pinv;
#define RS_PREFETCH(C) { \
      const int p_ = (C) * 32 + si; const int t_ = z ? (T - 1 - p_) : p_; const int g_ = gs + t_; \
      const float* rk_ = P.rkv + (size_t)g_ * 768 + h * 64 + sc; \
      pr0 = *(const float4*)rk_; pr1 = *(const float4*)(rk_ + 4); \
      pk0 = *(const float4*)(rk_ + 256); pk1 = *(const float4*)(rk_ + 260); \
      const float* wp_ = P.wa + ((size_t)(g_ * 2 + z) * 2) * 256 + h * 64 + sc; \
      pw0 = *(const float4*)wp_; pw1 = *(const float4*)(wp_ + 4); \
      pa0 = *(const float4*)(wp_ + 256); pa1 = *(const float4*)(wp_ + 260); \
      pinv = P.khinv[g_ * 4 + h]; \
      if (tid < 64) { \
        const int p2_ = (C) * 32 + (tid >> 1); const int t2_ = z ? (T - 1 - p2_) : p2_; \
        pv_ = *(const float4*)(P.rkv + (size_t)(gs + t2_) * 768 + 512 + h * 64 + rb * NR + (tid & 1) * 4); \
      } }
#define RS_STAGE(C) { \
      float* bf_ = RS_BUF((C) & 1); \
      float* s_kh = bf_; float* s_w = bf_ + 2048; float* s_b = bf_ + 4096; float* s_kt = bf_ + 6144; float* s_r = bf_ + 8192; float* s_v = bf_ + 10240; \
      const float rr[8] = {pr0.x, pr0.y, pr0.z, pr0.w, pr1.x, pr1.y, pr1.z, pr1.w}; \
      const float kk[8] = {pk0.x, pk0.y, pk0.z, pk0.w, pk1.x, pk1.y, pk1.z, pk1.w}; \
      const float aa[8] = {pa0.x, pa0.y, pa0.z, pa0.w, pa1.x, pa1.y, pa1.z, pa1.w}; \
      float bsum = 0.f; float okh[8], ob[8], okt[8]; \
      _Pragma("unroll") for (int e = 0; e < 8; ++e) { okh[e] = kk[e] * kkc[e] * pinv; ob[e] = aa[e] * okh[e]; okt[e] = kk[e] * (1.f + (aa[e] - 1.f) * kac[e]); bsum += rr[e] * okt[e] * rkc[e]; } \
      float* d_; \
      d_ = s_kh + si * 64 + sc; *(float4*)d_ = make_float4(okh[0], okh[1], okh[2], okh[3]); *(float4*)(d_ + 4) = make_float4(okh[4], okh[5], okh[6], okh[7]); \
      d_ = s_w + si * 64 + sc; *(float4*)d_ = pw0; *(float4*)(d_ + 4) = pw1; \
      d_ = s_b + si * 64 + sc; *(float4*)d_ = make_float4(ob[0], ob[1], ob[2], ob[3]); *(float4*)(d_ + 4) = make_float4(ob[4], ob[5], ob[6], ob[7]); \
      d_ = s_kt + si * 64 + sc; *(float4*)d_ = make_float4(okt[0], okt[1], okt[2], okt[3]); *(float4*)(d_ + 4) = make_float4(okt[4], okt[5], okt[6], okt[7]); \
      d_ = s_r + si * 64 + sc; *(float4*)d_ = pr0; *(float4*)(d_ + 4) = pr1; \
      if (tid < 64) *(float4*)(s_v + (tid >> 1) * NR + (tid & 1) * 4) = pv_; \
      bsum += dppf<0xB1>(bsum); bsum += dppf<0x4E>(bsum); bsum += dppf<0x141>(bsum); \
      if (rb == 0 && (tid & 7) == 0) { const int p_ = (C) * 32 + si; const int t_ = z ? (T - 1 - p_) : p_; P.bonus[((size_t)z * NTOK + gs + t_) * 4 + h] = bsum; } }
#define RS_OUT(C) { \
      const float* yp_ = RS_BUF((C) & 1) + 10240 + 256; \
      const int i_ = tid >> 3, q2_ = tid & 7; \
      const int p_ = (C) * 32 + i_; const int t_ = z ? (T - 1 - p_) : p_; \
      const float* y0_ = yp_ + i_ * 128 + q2_ * 16; \
      float a0_ = 0.f; \
      _Pragma("unroll") for (int e = 0; e < 16; e += 4) { const float4 u0_ = *(const float4*)(y0_ + e); a0_ += (u0_.x + u0_.y) + (u0_.z + u0_.w); } \
      P.hdir[((size_t)z * NTOK + gs + t_) * DM + 768 + h * 64 + rb * NR + q2_] = f2bf(a0_); }
    RS_PREFETCH(0)
    RS_STAGE(0)
    if (nch > 1) RS_PREFETCH(1)
    __syncthreads();
    for (int c = 0; c < nch; ++c) {
      if (c + 1 < nch) { RS_STAGE(c + 1) if (c + 2 < nch) RS_PREFETCH(c + 2) }
      if (c > 0) RS_OUT(c - 1)
      __syncthreads();
    }
    RS_OUT(nch - 1)
#undef RS_PREFETCH
#undef RS_STAGE
#undef RS_OUT
  } else {
    const int rl = tid >> 4, cg4 = (tid & 15) * 4;
    const bool rowthread = tid < 128;
    typedef float v2f __attribute__((ext_vector_type(2)));
    typedef float v4f __attribute__((ext_vector_type(4)));
    v2f Sa = {0.f, 0.f}, Sb = {0.f, 0.f};
    if (sample && rowthread) {
      const float4 s4 = *(const float4*)(P.st_rwkv + ((size_t)(((seq - 16) * 2 + l) * 2 + z) * 4 + h) * 4096 + (rb * NR + rl) * 64 + cg4);
      Sa.x = s4.x; Sa.y = s4.y; Sb.x = s4.z; Sb.y = s4.w;
    }
    __syncthreads();
    for (int c = 0; c < nch; ++c) {
      if (rowthread) {
        const float* bf = RS_BUF(c & 1);
        const float* s_kh = bf; const float* s_w = bf + 2048; const float* s_b = bf + 4096; const float* s_kt = bf + 6144; const float* s_r = bf + 8192; const float* s_v = bf + 10240;
        float* s_yp = (float*)bf + 10240 + 256;
        v4f kh = *(const v4f*)(s_kh + cg4), ww = *(const v4f*)(s_w + cg4), bb = *(const v4f*)(s_b + cg4), kt = *(const v4f*)(s_kt + cg4), rr = *(const v4f*)(s_r + cg4);
        float vi = s_v[rl];
#pragma unroll 8
        for (int i = 0; i < 32; ++i) {
          const int in = (i + 1) & 31;
          const v4f kh_n = *(const v4f*)(s_kh + in * 64 + cg4);
          const v4f ww_n = *(const v4f*)(s_w + in * 64 + cg4);
          const v4f bb_n = *(const v4f*)(s_b + in * 64 + cg4);
          const v4f kt_n = *(const v4f*)(s_kt + in * 64 + cg4);
          const v4f rr_n = *(const v4f*)(s_r + in * 64 + cg4);
          const float vi_n = s_v[in * NR + rl];
          const v2f v2 = {vi, vi};
          const v2f pp = __builtin_elementwise_fma(Sb, kh.zw, Sa * kh.xy);
          const float sk = red16(pp.x + pp.y);
          const v2f sk2 = {sk, sk};
          Sa = __builtin_elementwise_fma(-sk2, bb.xy, __builtin_elementwise_fma(v2, kt.xy, Sa * ww.xy));
          Sb = __builtin_elementwise_fma(-sk2, bb.zw, __builtin_elementwise_fma(v2, kt.zw, Sb * ww.zw));
          const v2f qq = __builtin_elementwise_fma(Sb, rr.zw, Sa * rr.xy);
          s_yp[i * 128 + tid] = qq.x + qq.y;
          kh = kh_n; ww = ww_n; bb = bb_n; kt = kt_n; rr = rr_n; vi = vi_n;
        }
      }
      __syncthreads();
    }
  }
#undef RS_BUF
}

DEV void phase_scan(const Params& P, int l, char* smem0, int ctr_idx, int cls) {
  __shared__ int4 s_task4;
  int& s_task = *(int*)&s_task4;
  const int ntask = 560;
  for (;;) {
    __syncthreads();
    if (threadIdx.x == 0) s_task = (int)atomicAdd(P.ctr + ctr_idx, 1u);
    __syncthreads();
    const int t = s_task;
    if (t >= ntask) break;
    const int tid_ = THREAD_ID; const int half = tid_ >> 8, tid = tid_ & 255;
    char* smem = smem0 + half * HALF_LDS;
    if (t < 128) { if (cls & 1) rwkv_sample_task(P, l, t >> 1, t & 1, smem0, tid_); }
    else if (t < 144) { if (cls & 2) delta_sample_task(P, l, (t - 128) >> 1, t & 1, smem0, tid_); }
    else if (t < 160) { if (cls & 4) mlstm_sample_task(P, l, (t - 144) >> 1, t & 1, smem0, tid_); }
    else if (t < 176) { if (cls & 8) ret_sample_task(P, l, (t - 160) >> 1, t & 1, smem0, tid_); }
    else if (t < 304) { if (cls & 1) rwkv_prompt_task(P, l, (t - 176) + 16, half, smem, tid); }
    else if (t < 368) { if (cls & 2) delta_task(P, l, (t - 304) + 8, half, smem, tid, true); }
    else if (t < 432) { if (cls & 4) mlstm_task(P, l, (t - 368) + 8, half, smem, tid, true); }
    else if (t < 560) { if (cls & 8) ret_task(P, l, ((t - 432) >> 1) + 8, t & 1, smem, tid, half == 0); }
    else { if (cls & 16) { if (l == 1) conv_ff_layer1_item(P, 2 * (t - 624) + half, smem, tid); else conv_inout_layer1_item(P, 2 * (t - 624) + half, smem, tid); } }
  }
}

DEV void phase_combine(const Params& P, int l) {
  const int tid_ = THREAD_ID;
  const int lane = tid_ & 63;
  const int wid = blockIdx.x * (NTHREADS / 64) + (tid_ >> 6), nw = gridDim.x * (NTHREADS / 64);
  for (int g = wid; g < NTOK; g += nw) {
   const int c = lane * 4, head = lane >> 4;
#pragma unroll
   for (int m = 0; m < 4; ++m) {
    const uint2 h0 = *(const uint2*)(P.hdir + (size_t)g * DM + m * 256 + c);
    const uint2 h1 = *(const uint2*)(P.hdir + ((size_t)NTOK + g) * DM + m * 256 + c);
    float y[4];
    y[0] = __uint_as_float(h0.x << 16) + __uint_as_float(h1.x << 16);
    y[1] = __uint_as_float(h0.x & 0xffff0000u) + __uint_as_float(h1.x & 0xffff0000u);
    y[2] = __uint_as_float(h0.y << 16) + __uint_as_float(h1.y << 16);
    y[3] = __uint_as_float(h0.y & 0xffff0000u) + __uint_as_float(h1.y & 0xffff0000u);
    if (m != 1) {
      const float mean = red16(y[0] + y[1] + y[2] + y[3]) * (1.f / 64.f);
#pragma unroll
      for (int e = 0; e < 4; ++e) y[e] -= mean;
    }
    const float var = red16(y[0] * y[0] + y[1] * y[1] + y[2] * y[2] + y[3] * y[3]) * (1.f / 64.f);
    const float rs = rsqrtf(var + LNEPS);
    const float* gn = (m == 0 ? P.mlstm_norm : m == 1 ? P.delta_norm : m == 2 ? P.ret_norm : P.rwkv_norm) + l * 256 + c;
    const float4 g4 = *(const float4*)gn;
    y[0] *= rs * g4.x; y[1] *= rs * g4.y; y[2] *= rs * g4.z; y[3] *= rs * g4.w;
    float o[4];
    if (m == 3) {
      const uint2 gg = *(const uint2*)(P.gbuf + (size_t)g * 256 + c);
      const float gt[4] = {__uint_as_float(gg.x << 16), __uint_as_float(gg.x & 0xffff0000u), __uint_as_float(gg.y << 16), __uint_as_float(gg.y & 0xffff0000u)};
      const float bn = P.bonus[(size_t)g * 4 + head] + P.bonus[((size_t)NTOK + g) * 4 + head];
      const float4 v4 = *(const float4*)(P.rkv + (size_t)g * 768 + 512 + c);
      o[0] = gt[0] * (y[0] + bn * v4.x); o[1] = gt[1] * (y[1] + bn * v4.y); o[2] = gt[2] * (y[2] + bn * v4.z); o[3] = gt[3] * (y[3] + bn * v4.w);
    } else {
      const int goff = (m == 0) ? 768 : (m == 1) ? 1808 : 2848;
      const float4 a4 = *(const float4*)(P.projABC + (size_t)g * NABC + goff + c);
      if (m == 0) { o[0] = sigmoidf_(a4.x) * y[0]; o[1] = sigmoidf_(a4.y) * y[1]; o[2] = sigmoidf_(a4.z) * y[2]; o[3] = sigmoidf_(a4.w) * y[3]; }
      else { o[0] = siluf_(a4.x) * y[0]; o[1] = siluf_(a4.y) * y[1]; o[2] = siluf_(a4.z) * y[2]; o[3] = siluf_(a4.w) * y[3]; }
    }
    uint2 ov; ov.x = pack2(o[0], o[1]); ov.y = pack2(o[2], o[3]);
    *(uint2*)(P.ubuf + (size_t)g * DM + m * 256 + c) = ov;
   }
  }
}

#define XB_TMO      128
#define XB_XCNT(j)  (256  + 64 * (j))
#define XB_XSUB(j)  (1280 + 64 * (j))
#define XB_XGEN(j)  (2304 + 64 * (j))
#define XB_TOP      3328
#define XB_TOPGEN   3392
#define XCD_BAR_WORDS 3456
#define XB_SPIN_CAP (1u << 18)
#define LAS __attribute__((address_space(3)))

__device__ __forceinline__ unsigned xb_ld(unsigned* p)              { return __hip_atomic_load(p, __ATOMIC_RELAXED, __HIP_MEMORY_SCOPE_AGENT); }
__device__ __forceinline__ unsigned xb_add(unsigned* p, unsigned v) { return __hip_atomic_fetch_add(p, v, __ATOMIC_RELAXED, __HIP_MEMORY_SCOPE_AGENT); }
__device__ __forceinline__ unsigned xb_xcc_id() { return (unsigned)__builtin_amdgcn_s_getreg((3 << 11) | 20) & 0xFu; }
#define XB_SPIN(cond, bar) do { unsigned _sp = 0; while (cond) { __builtin_amdgcn_s_sleep(1); \
    if ((++_sp & 255u) == 0u) { if (xb_ld(&(bar)[XB_TMO])) break; if (_sp > XB_SPIN_CAP) { atomicAdd(&(bar)[XB_TMO], 1u); break; } } } } while (0)

struct XcdBarrier {
    unsigned* bar; unsigned x;
    volatile LAS unsigned* st;
};

__device__ __forceinline__ XcdBarrier xcd_barrier_post(unsigned* bar, volatile LAS unsigned* st) {
    XcdBarrier b; b.bar = bar; b.x = xb_xcc_id(); b.st = st;
    if (threadIdx.x == 0) (void)xb_add(&bar[XB_XCNT(b.x)], 1u);
    return b;
}
__device__ __forceinline__ void xcd_barrier_complete(unsigned* bar, unsigned x, unsigned& nloc, unsigned& nx) {
    const unsigned G = gridDim.x * gridDim.y * gridDim.z;
    unsigned sum, cnt, mine, sp = 0u;
    for (;;) {
        sum = 0u; cnt = 0u; mine = 0u;
#pragma unroll
        for (unsigned j = 0; j < 16; ++j) { const unsigned c = xb_ld(&bar[XB_XCNT(j)]); sum += c; cnt += (c > 0u) ? 1u : 0u; mine = (j == x) ? c : mine; }
        if (sum == G) break;
        __builtin_amdgcn_s_sleep(1);
        if ((++sp & 255u) == 0u) { if (xb_ld(&bar[XB_TMO])) break; if (sp > XB_SPIN_CAP) { atomicAdd(&bar[XB_TMO], 1u); break; } }
    }
    nloc = mine > 0u ? mine : 1u; nx = cnt > 0u ? cnt : 1u;
}

__device__ __forceinline__ void xcd_barrier(const XcdBarrier& b) {
    asm volatile("s_waitcnt vmcnt(0)" ::: "memory");
    __syncthreads();
    if (threadIdx.x == 0) {
        unsigned* bar = b.bar;
        __builtin_amdgcn_s_waitcnt(0);
        unsigned nloc = b.st[0], nx = b.st[1];
        if (nloc == 0u) { xcd_barrier_complete(bar, b.x, nloc, nx); b.st[0] = nloc; b.st[1] = nx; }
        const unsigned old = xb_add(&bar[XB_XSUB(b.x)], 1u);
        const unsigned gen = old / nloc;
        if (old + 1u == (gen + 1u) * nloc) {
            __builtin_amdgcn_fence(__ATOMIC_RELEASE, "agent");
            asm volatile("s_waitcnt vmcnt(0)" ::: "memory");
            const unsigned og = xb_add(&bar[XB_TOP], 1u);
            const unsigned tg = og / nx;
            if (og + 1u == (tg + 1u) * nx) xb_add(&bar[XB_TOPGEN], 1u);
            else XB_SPIN(xb_ld(&bar[XB_TOPGEN]) == tg, bar);
            __builtin_amdgcn_fence(__ATOMIC_ACQUIRE, "agent");
            xb_add(&bar[XB_XGEN(b.x)], 1u);
            asm volatile("s_waitcnt vmcnt(0)" ::: "memory");
        } else {
            XB_SPIN(xb_ld(&bar[XB_XGEN(b.x)]) == gen, bar);
            __builtin_amdgcn_fence(__ATOMIC_ACQUIRE, "agent");
            asm volatile("s_waitcnt vmcnt(0)" ::: "memory");
        }
    }
    __syncthreads();
}

__global__ void __launch_bounds__(NTHREADS, 2) mega(Params P) {
  extern __shared__ __attribute__((aligned(16))) char smem[];
  cg::grid_group grid = cg::this_grid();
  __shared__ uint4 xb_words;
  if (threadIdx.x == 0) xb_words = make_uint4(0u, 0u, 0u, 0u);
  __syncthreads();
  XcdBarrier xb = xcd_barrier_post(P.bar, (volatile LAS unsigned*)&xb_words);
  for (int i = 0; i < PROBE_EXTRA_SYNCS; ++i) xcd_barrier(xb);
  for (int ph = (int)P.phase_lo; ph < (int)P.phase_hi; ++ph) {
   const int nrep = ((ph >= 2 && ((PROBE_DUP_MASK >> ((ph - 2) % 10)) & 1)) || (ph == 0 && PROBE_DUP_PRO)) ? 2 : 1;
   for (int rep = 0; rep < nrep; ++rep) {
    if (ph == 0) phase_prologue(P, smem, rep);
    else if (ph == 1) phase_ln(P, 0, 0);
    else {
      const int l = (ph - 2) / 10, s = (ph - 2) % 10;
      switch (s) {
        case 0: { EpiProj E; E.projABC = P.projABC; E.pdraw = P.pdraw; E.col0 = 0; phase_gemm(P.ubuf, P.wt_in + (size_t)l * PINP * DM, 4096, DM, E, smem); } break;
        case 1: { if (blockIdx.x < 32) { EpiProj E; E.projABC = P.projABC; E.pdraw = P.pdraw; E.col0 = 4096;
                    phase_gemm(P.ubuf, P.wt_in + (size_t)l * PINP * DM + (size_t)4096 * DM, 256, DM, E, smem, 0, 1 << 20, 32);
                    asm volatile("s_waitcnt vmcnt(0)" ::: "memory"); __syncthreads();
                    if (threadIdx.x == 0) { __threadfence(); atomicAdd(P.ctr + 16 + l * 2 + rep, 1u); } }
                  __shared__ int4 s_it4; int& s_it = *(int*)&s_it4;
                  for (;;) {
                    __syncthreads();
                    if (threadIdx.x == 0) s_it = (int)atomicAdd(P.ctr + 8 + l * 2 + rep, 1u);
                    __syncthreads();
                    const int it = s_it;
                    if (it >= 64 * 9) break;
                    const int tid_ = THREAD_ID; const int half = tid_ >> 8;
                    if (it < 64) rwkv_prep_item(P, l, 2 * it + half, 0, smem + half * HALF_LDS, tid_ & 255);
                    else if (it < 64 * 6) { const int j = it - 64; rwkv_prep_item(P, l, 2 * (j / 5) + half, 1 + j % 5, smem + half * HALF_LDS, tid_ & 255); }
                    else {
                      if (threadIdx.x == 0) { while (__hip_atomic_load(P.ctr + 16 + l * 2 + rep, __ATOMIC_RELAXED, __HIP_MEMORY_SCOPE_AGENT) < 32u) __builtin_amdgcn_s_sleep(2); }
                      __syncthreads();
                      const int j = it - 64 * 6; delta_prep_item(P, l, 2 * (j / 3) + half, j % 3, tid_ & 255); } } } break;
        case 2: { const int tid_ = THREAD_ID; const int half = tid_ >> 8;
                  for (int it = blockIdx.x; it < 512; it += gridDim.x) delta_T_item(P, l, 2 * it + half, smem + half * HALF_LDS, tid_ & 255); } break;
        case 3: phase_scan(P, l, smem, l + 2 * rep, rep == 0 ? 31 : PROBE_SCAN_CLASS); break;
        case 4: phase_combine(P, l); break;
        case 5: { EpiRes E; E.out = P.out; E.xp = (l == 0) ? P.x_prompt : P.out; E.xs = (l == 0) ? P.x_sample : P.out + (size_t)4096 * DM; E.gate = P.mod + (size_t)l * 3 * 6144 + 2048;
                  phase_gemm(P.ubuf, P.wt_out + (size_t)l * DM * DM, DM, DM, E, smem);
                  if (blockIdx.x >= 128) {
                    const int tid_ = THREAD_ID; const int half = tid_ >> 8, tid = tid_ & 255;
                    float* tile = (float*)(smem + half * HALF_LDS);
                    const int npair = (l == 1) ? 1024 : 672;
                    int j = blockIdx.x - 128;
                    ConvDesc d = deferred_conv_desc(P, l, 2 * j + half);
                    float4 a, b, c, e4; conv_tile_load(d, tid, a, b, c, e4);
                    while (j < npair) {
                      const int jn = j + 128;
                      ConvDesc dn = d; float4 an = a, bn = b, cn = c, en = e4;
                      if (jn < npair) { dn = deferred_conv_desc(P, l, 2 * jn + half); conv_tile_load(dn, tid, an, bn, cn, en); }
                      conv_tile_finish(d, tile, tid, a, b, c, e4);
                      d = dn; a = an; b = bn; c = cn; e4 = en; j = jn;
                    }
                  } } break;
        case 6: phase_ln(P, 1, l); break;
        case 7: { EpiFF1 E; E.hidden = P.hidden; phase_gemm(P.ubuf, P.wt_ff1, DFF, DM, E, smem); } break;
        case 8: { EpiResSplit E; E.out = P.out; E.tmp = P.ff2tmp; E.gate = P.mod + (size_t)l * 3 * 6144 + 5120;
                  phase_gemm(P.hidden, P.wt_ff2, 2 * DM, DFF / 2, E, smem, DFF, 4); } break;
        case 9: phase_ln(P, 2, l); break;
      }
    }
    if (ph + 1 < (int)P.phase_hi || rep + 1 < nrep) {
      if (P.phase_hi > 1000) grid.sync(); else xcd_barrier(xb);
    }
   }
  }
}

#ifndef MK_MULTI
#define MK_MULTI 0
#endif

extern "C" void kernel_launch(void* const* d_in, const int* in_sizes, int n_in, void* d_out, int out_size, void* d_ws, size_t ws_size, hipStream_t stream) {
  static int grid_blocks = 0;
  if (!grid_blocks) {
    int dev = 0, cus = 0, per_cu = 0;
    hipGetDevice(&dev);
    hipDeviceGetAttribute(&cus, hipDeviceAttributeMultiprocessorCount, dev);
    if (hipFuncSetAttribute((const void*)mega, hipFuncAttributeMaxDynamicSharedMemorySize, LDS_BYTES) != hipSuccess) fprintf(stderr, "hipFuncSetAttribute failed\n");
    hipOccupancyMaxActiveBlocksPerMultiprocessor(&per_cu, (const void*)mega, NTHREADS, LDS_BYTES);
    if (per_cu < 1) { fprintf(stderr, "occupancy query returned %d\n", per_cu); per_cu = 1; }
    if (per_cu > 1) per_cu = 1;
    grid_blocks = cus * per_cu;
    fprintf(stderr, "mega: cus %d per_cu %d grid %d ws %zu\n", cus, per_cu, grid_blocks, ws_size);
  }
  Params p{};
  const float** pin = (const float**)&p;
  for (int i = 0; i < 39; ++i) pin[i] = (const float*)d_in[i];
  p.out = (float*)d_out;
  char* ws = (char*)d_ws; size_t off = 0;
  auto take = [&](size_t bytes) { char* r = ws + off; off += (bytes + 255) & ~(size_t)255; return r; };
  p.ctr = (unsigned*)take(256);
  p.bar = (unsigned*)take(XCD_BAR_WORDS * 4);
  p.wt_in = (bf16_t*)take((size_t)2 * PINP * DM * 2);
  p.wt_out = (bf16_t*)take((size_t)2 * DM * DM * 2);
  p.wt_ff1 = (bf16_t*)take((size_t)DM * DFF * 2);
  p.wt_ff2 = (bf16_t*)take((size_t)DM * DFF * 2);
  p.ubuf = (bf16_t*)take((size_t)NTOK * DM * 2);
  p.projABC = (float*)take((size_t)NTOK * NABC * 4);
  p.hidden = (bf16_t*)p.projABC;
  p.ff2tmp = (float*)((char*)p.projABC + (size_t)NTOK * DFF * 2);
  p.pdraw = (float*)take((size_t)NTOK * NPD * 4);
  p.hdir = (bf16_t*)p.pdraw;
  p.rkv = (float*)take((size_t)NTOK * 768 * 4);
  p.wa = (float*)take((size_t)NTOK * 1024 * 4);
  p.gbuf = (bf16_t*)take((size_t)NTOK * 256 * 2);
  p.mod = (float*)take((size_t)2 * 3 * 6144 * 4);
  p.khinv = (float*)take((size_t)NTOK * 4 * 4);
  p.bonus = (float*)take((size_t)2 * NTOK * 4 * 4);
  p.dbeta = (float*)take((size_t)8 * NTOK * 4);
  p.dgc = (float*)take((size_t)8 * NTOK * 4);
  p.dT = (bf16_t*)take((size_t)1024 * 4096 * 2);
  p.w2t = (bf16_t*)take((size_t)4 * 256 * 64 * 2);
  p.a2t = (bf16_t*)take((size_t)4 * 256 * 64 * 2);
  p.g2t = (bf16_t*)take((size_t)2 * 256 * 128 * 2);
  if (off > ws_size) { fprintf(stderr, "workspace too small: need %zu have %zu\n", off, ws_size); return; }
  hipMemsetAsync(p.ctr, 0, 256 + ((XCD_BAR_WORDS * 4 + 255) & ~255), stream);
  const int nph = 2 + 10 * 2;
#if MK_MULTI
  for (int ph = 0; ph < nph; ++ph) {
    p.phase_lo = ph; p.phase_hi = ph + 1;
    void* args[] = {&p};
    hipLaunchCooperativeKernel((const void*)mega, dim3(grid_blocks), dim3(NTHREADS), args, LDS_BYTES, stream);
  }
#else
  p.phase_lo = 0; p.phase_hi = nph;
  void* args[] = {&p};
  hipError_t e = hipLaunchCooperativeKernel((const void*)mega, dim3(grid_blocks), dim3(NTHREADS), args, LDS_BYTES, stream);
  if (e != hipSuccess) fprintf(stderr, "cooperative launch failed: %s (grid %d)\n", hipGetErrorString(e), grid_blocks);
#endif
}
```

```cpp
#include <hip/hip_runtime.h>
#include <hip/hip_cooperative_groups.h>
#include <cstdio>
#include <cstdint>
namespace cg = cooperative_groups;

typedef unsigned short bf16_t;
typedef short bf16x8 __attribute__((ext_vector_type(8)));
typedef float f32x16 __attribute__((ext_vector_type(16)));
typedef float f32x4 __attribute__((ext_vector_type(4)));
#define DEV __device__ __forceinline__

#ifndef PROBE_SCAN_CLASS
#define PROBE_SCAN_CLASS 31
#endif
#ifndef PROBE_DUP_PRO
#define PROBE_DUP_PRO 0
#endif
#ifndef PROBE_EXTRA_SYNCS
#define PROBE_EXTRA_SYNCS 0
#endif
#ifndef PROBE_DUP_MASK
#define PROBE_DUP_MASK 0
#endif
constexpr int NTOK = 8192, DM = 1024, PIN = 4256, PINP = 4352, NABC = 3104, NPD = 1152, DFF = 4096;
constexpr float ALPHA = 1.41421356237f, LNEPS = 1e-5f;
constexpr int LDB = 72;
constexpr int TILE_B = 64 * LDB * 2;
constexpr int HALF_LDS = 77824;
constexpr int LDS_BYTES = 2 * HALF_LDS;
constexpr int NTHREADS = 512;
constexpr size_t O_C = 8388608, O_N = 9437184, O_M = 9453568, O_DELTA = 9453824, O_RET = 10502400, O_RWKV = 11550976;

struct Params {
  const float *x_prompt, *x_sample, *c, *st_C, *st_n, *st_m, *st_delta, *st_ret, *st_rwkv, *c_ctx;
  const float *w_mod, *b_mod, *w_in, *w_out, *ln1_g, *ln1_b, *ln2_g, *ln2_b, *w_ff1, *w_ff2;
  const float *mlstm_i_bias, *mlstm_f_bias, *mlstm_norm, *delta_conv, *delta_a_log, *delta_dt_bias, *delta_norm;
  const float *ret_decay, *ret_norm, *rwkv_mu, *rwkv_w0, *rwkv_w2, *rwkv_a0, *rwkv_a2, *rwkv_g2, *rwkv_kk, *rwkv_ka, *rwkv_rk, *rwkv_norm;
  float* out;
  bf16_t *wt_in, *wt_out, *wt_ff1, *wt_ff2, *ubuf, *hdir, *gbuf, *hidden;
  float *mod, *projABC, *pdraw, *rkv, *wa, *khinv, *bonus, *dbeta, *dgc, *ff2tmp;
  bf16_t *dT, *w2t, *a2t, *g2t;
  unsigned* ctr; unsigned* bar;
  long long phase_lo, phase_hi;
};

DEV int opaque_i(int v) { asm volatile("" : "+v"(v)); return v; }
#define THREAD_ID opaque_i((int)threadIdx.x)
typedef float f32x2_t __attribute__((ext_vector_type(2)));
typedef __bf16 bf16x2_t __attribute__((ext_vector_type(2)));
DEV unsigned pack2(float a, float b) { f32x2_t v = {a, b}; bf16x2_t r = __builtin_convertvector(v, bf16x2_t); return __builtin_bit_cast(unsigned, r); }
DEV bf16_t f2bf(float f) { return (bf16_t)pack2(f, f); }
DEV float bf2f(bf16_t h) { return __uint_as_float(((unsigned)h) << 16); }
DEV float sigmoidf_(float x) { return 1.f / (1.f + __expf(-x)); }
DEV float siluf_(float x) { return x / (1.f + __expf(-x)); }
DEV float softplusf_(float x) { return x > 20.f ? x : log1pf(__expf(x)); }
DEV float logsigmoidf_(float x) { return -softplusf_(-x); }
template <int CTRL> DEV float dppf(float x) { return __builtin_bit_cast(float, __builtin_amdgcn_mov_dpp(__builtin_bit_cast(int, x), CTRL, 0xf, 0xf, true)); }
DEV float red4(float x) { x += dppf<0xB1>(x); x += dppf<0x4E>(x); return x; }
DEV float red16(float x) { x = red4(x); x += dppf<0x141>(x); x += dppf<0x128>(x); return x; }
DEV float wave_sum(float x) { x = red16(x); x += __shfl_xor(x, 16); x += __shfl_xor(x, 32); return x; }
DEV void tok_info(int g, int& gs, int& T, int& ci) {
  if (g < 4096) { gs = g & ~255; T = 256; ci = 0; } else { int b = (g - 4096) >> 11; gs = 4096 + (b << 11); T = 2048; ci = 1 + b; }
}
DEV const float* xin_row(const Params& P, int g) { return g < 4096 ? P.x_prompt + (size_t)g * DM : P.x_sample + (size_t)(g - 4096) * DM; }

DEV f32x16 mm64(const bf16_t* A, const bf16_t* Bt, int wr, int wc, int lane, f32x16 acc) {
  const bf16_t* ap = A + (wr * 32 + (lane & 31)) * LDB + (lane >> 5) * 8;
  const bf16_t* bp = Bt + (wc * 32 + (lane & 31)) * LDB + (lane >> 5) * 8;
#pragma unroll
  for (int s = 0; s < 4; ++s) {
    bf16x8 a = *(const bf16x8*)(ap + s * 16);
    bf16x8 b = *(const bf16x8*)(bp + s * 16);
    acc = __builtin_amdgcn_mfma_f32_32x32x16_bf16(a, b, acc, 0, 0, 0);
  }
  return acc;
}
DEV f32x16 zero16() { f32x16 z; for (int i = 0; i < 16; ++i) z[i] = 0.f; return z; }
#define ACC_ROW(idx) (wr * 32 + ((idx) & 3) + 8 * ((idx) >> 2) + 4 * (lane >> 5))
#define ACC_COL (wc * 32 + (lane & 31))

DEV void conv_tile(const float* __restrict__ src, bf16_t* __restrict__ dst, int K, int N, int tk, int tn, float* tile, const int tid_in, const int dst_row_shift = 0) {
  const int tid = opaque_i(tid_in);
  const int k0 = tk * 64, n0 = tn * 64;
  { const int r = tid >> 2, cs = (tid & 3) * 16;
#pragma unroll
    for (int e = 0; e < 16; e += 4) {
      const int n = n0 + cs + e;
      float4 v = make_float4(0.f, 0.f, 0.f, 0.f);
      if (n < N) v = *(const float4*)(src + (size_t)(k0 + r) * N + n);
      tile[r * 65 + cs + e] = v.x; tile[r * 65 + cs + e + 1] = v.y; tile[r * 65 + cs + e + 2] = v.z; tile[r * 65 + cs + e + 3] = v.w;
    } }
  __syncthreads();
  { const int nl = tid >> 2, ks = (tid & 3) * 16;
    unsigned pk[8];
#pragma unroll
    for (int e = 0; e < 8; ++e) pk[e] = pack2(tile[(ks + 2 * e) * 65 + nl], tile[(ks + 2 * e + 1) * 65 + nl]);
    uint4* d = (uint4*)(dst + (size_t)(n0 + nl + dst_row_shift) * K + k0 + ks);
    d[0] = make_uint4(pk[0], pk[1], pk[2], pk[3]); d[1] = make_uint4(pk[4], pk[5], pk[6], pk[7]); }
  __syncthreads();
}

DEV void mod_gemv_item(const Params& P, int item, float* red, const int tid) {
  const int j0 = item * 64, l = j0 / 6144, jj = j0 % 6144;
  const int cq = tid & 15, kg = tid >> 4;
  const float* W = P.w_mod + (size_t)l * DM * 6144 + jj + cq * 4;
  float a0[4] = {0, 0, 0, 0}, a1[4] = {0, 0, 0, 0}, a2[4] = {0, 0, 0, 0};
  for (int kk = 0; kk < 64; ++kk) {
    const int k = kg * 64 + kk;
    const float4 w = *(const float4*)(W + (size_t)k * 6144);
    const float s0 = siluf_(P.c_ctx[k]), s1 = siluf_(P.c[k]), s2 = siluf_(P.c[DM + k]);
    a0[0] += s0 * w.x; a0[1] += s0 * w.y; a0[2] += s0 * w.z; a0[3] += s0 * w.w;
    a1[0] += s1 * w.x; a1[1] += s1 * w.y; a1[2] += s1 * w.z; a1[3] += s1 * w.w;
    a2[0] += s2 * w.x; a2[1] += s2 * w.y; a2[2] += s2 * w.z; a2[3] += s2 * w.w;
  }
#pragma unroll
  for (int e = 0; e < 4; ++e) { red[(kg * 3 + 0) * 64 + cq * 4 + e] = a0[e]; red[(kg * 3 + 1) * 64 + cq * 4 + e] = a1[e]; red[(kg * 3 + 2) * 64 + cq * 4 + e] = a2[e]; }
  __syncthreads();
  if (tid < 192) {
    const int ci = tid >> 6, col = tid & 63;
    float s = P.b_mod[l * 6144 + jj + col];
    for (int g = 0; g < 16; ++g) s += red[(g * 3 + ci) * 64 + col];
    P.mod[(size_t)(l * 3 + ci) * 6144 + jj + col] = s;
  }
  __syncthreads();
}

DEV void prologue_item(const Params& P, int t, float* tile, const int tid) {
  const int n_in = 16 * 68, n_out = 16 * 16, n_ff = 1024;
  const int total = 192 + 48 + n_in + n_out + 2 * n_ff;
  if (t >= total) { __syncthreads(); __syncthreads(); return; }
  if (t < 192) { mod_gemv_item(P, t, tile, tid); return; }
  if (t < 240) {
    const int v = t - 192;
    if (v < 32) { const int m = v >> 2, tn = v & 3, lz = m >> 1, kind = m & 1;
      conv_tile((kind == 0 ? P.rwkv_w2 : P.rwkv_a2) + (size_t)lz * 64 * 256, (kind == 0 ? P.w2t : P.a2t) + (size_t)lz * 256 * 64, 64, 256, 0, tn, tile, tid); }
    else { const int m = (v - 32) >> 3, r = (v - 32) & 7; conv_tile(P.rwkv_g2 + (size_t)m * 128 * 256, P.g2t + (size_t)m * 256 * 128, 128, 256, r >> 2, r & 3, tile, tid); }
    return;
  }
  int u = t - 240;
  if (u < n_in) { const int tn = u % 68; conv_tile(P.w_in, P.wt_in, DM, PIN, u / 68, tn, tile, tid, tn < 12 ? 0 : (tn < 16 ? 3328 : -256)); return; }
  u -= n_in;
  if (u < n_out) { conv_tile(P.w_out, P.wt_out, DM, DM, u / 16, u % 16, tile, tid); return; }
  u -= n_out;
  if (u < n_ff) { conv_tile(P.w_ff1, P.wt_ff1, DM, DFF, u / 64, u % 64, tile, tid); return; }
  u -= n_ff;
  { const int tk = u / 16, kh = tk >> 5; conv_tile(P.w_ff2 + (size_t)kh * 2048 * DM, P.wt_ff2 + (size_t)kh * DM * 2048, 2048, DM, tk & 31, u % 16, tile, tid); }
}
DEV void phase_prologue(const Params& P, char* smem, int rep) {
  const int tid_ = THREAD_ID; const int half = tid_ >> 8, tid = tid_ & 255;
  float* tile = (float*)(smem + half * HALF_LDS);
  const int total = 192 + 48 + 16 * 68 + 256 + 2 * 1024;
  __shared__ int4 s_pj4; int& s_pj = *(int*)&s_pj4;
  for (;;) {
    __syncthreads();
    if (threadIdx.x == 0) s_pj = (int)atomicAdd(P.ctr + 6 + rep, 1u);
    __syncthreads();
    const int j = s_pj;
    if (2 * j >= total) break;
    prologue_item(P, 2 * j + half, tile, tid);
  }
}
struct ConvDesc { const float* src; bf16_t* dst; int K, N, tk, tn, shift; };
DEV void conv_tile_load(const ConvDesc& d, const int tid, float4& a, float4& b, float4& c, float4& e4) {
  const int r = tid >> 2, cs = (tid & 3) * 16;
  const float* p = d.src + (size_t)(d.tk * 64 + r) * d.N + d.tn * 64 + cs;
  const float4 z4 = make_float4(0.f, 0.f, 0.f, 0.f);
  const int n = d.tn * 64 + cs;
  a = z4; b = z4; c = z4; e4 = z4;
  if (n < d.N) a = *(const float4*)p;
  if (n + 4 < d.N) b = *(const float4*)(p + 4);
  if (n + 8 < d.N) c = *(const float4*)(p + 8);
  if (n + 12 < d.N) e4 = *(const float4*)(p + 12);
}
DEV void conv_tile_finish(const ConvDesc& d, float* tile, const int tid, const float4 a, const float4 b, const float4 c, const float4 e4) {
  { const int r = tid >> 2, cs = (tid & 3) * 16;
    float* t = tile + r * 65 + cs;
    t[0] = a.x; t[1] = a.y; t[2] = a.z; t[3] = a.w; t[4] = b.x; t[5] = b.y; t[6] = b.z; t[7] = b.w;
    t[8] = c.x; t[9] = c.y; t[10] = c.z; t[11] = c.w; t[12] = e4.x; t[13] = e4.y; t[14] = e4.z; t[15] = e4.w; }
  __syncthreads();
  { const int nl = tid >> 2, ks = (tid & 3) * 16;
    unsigned pk[8];
#pragma unroll
    for (int e = 0; e < 8; ++e) pk[e] = pack2(tile[(ks + 2 * e) * 65 + nl], tile[(ks + 2 * e + 1) * 65 + nl]);
    uint4* o = (uint4*)(d.dst + (size_t)(d.tn * 64 + nl + d.shift) * d.K + d.tk * 64 + ks);
    o[0] = make_uint4(pk[0], pk[1], pk[2], pk[3]); o[1] = make_uint4(pk[4], pk[5], pk[6], pk[7]); }
  __syncthreads();
}
DEV ConvDesc deferred_conv_desc(const Params& P, int l, int u) {
  ConvDesc d; d.shift = 0;
  if (l == 1) {
    if (u < 1024) { d.src = P.w_ff1 + (size_t)DM * DFF; d.dst = P.wt_ff1; d.K = DM; d.N = DFF; d.tk = u / 64; d.tn = u % 64; }
    else { u -= 1024; const int tk = u / 16, kh = tk >> 5; d.src = P.w_ff2 + (size_t)DM * DFF + (size_t)kh * 2048 * DM; d.dst = P.wt_ff2 + (size_t)kh * DM * 2048; d.K = 2048; d.N = DM; d.tk = tk & 31; d.tn = u % 16; }
  } else {
    if (u < 1088) { const int tn = u % 68; d.src = P.w_in + (size_t)DM * PIN; d.dst = P.wt_in + (size_t)PINP * DM; d.K = DM; d.N = PIN; d.tk = u / 68; d.tn = tn; d.shift = tn < 12 ? 0 : (tn < 16 ? 3328 : -256); }
    else { u -= 1088; d.src = P.w_out + (size_t)DM * DM; d.dst = P.wt_out + (size_t)DM * DM; d.K = DM; d.N = DM; d.tk = u / 16; d.tn = u % 16; }
  }
  return d;
}
DEV void conv_inout_layer1_item(const Params& P, int u, char* smem, const int tid) {
  float* tile = (float*)smem;
  if (u < 1088) { const int tn = u % 68; conv_tile(P.w_in + (size_t)DM * PIN, P.wt_in + (size_t)PINP * DM, DM, PIN, u / 68, tn, tile, tid, tn < 12 ? 0 : (tn < 16 ? 3328 : -256)); }
  else { u -= 1088; conv_tile(P.w_out + (size_t)DM * DM, P.wt_out + (size_t)DM * DM, DM, DM, u / 16, u % 16, tile, tid); }
}
DEV void conv_ff_layer1_item(const Params& P, int u, char* smem, const int tid) {
  float* tile = (float*)smem;
  if (u < 1024) conv_tile(P.w_ff1 + (size_t)DM * DFF, P.wt_ff1, DM, DFF, u / 64, u % 64, tile, tid);
  else { u -= 1024; const int tk = u / 16, kh = tk >> 5; conv_tile(P.w_ff2 + (size_t)DM * DFF + (size_t)kh * 2048 * DM, P.wt_ff2 + (size_t)kh * DM * 2048, 2048, DM, tk & 31, u % 16, tile, tid); }
}

DEV void phase_ln(const Params& P, int mode, int l) {
  const int tid_ = THREAD_ID;
  const int lane = tid_ & 63;
  const int wid = blockIdx.x * (NTHREADS / 64) + (tid_ >> 6), nw = gridDim.x * (NTHREADS / 64);
  float4 nx0, nx1, nx2, nx3, nt0, nt1, nt2, nt3;
  nt0 = nt1 = nt2 = nt3 = make_float4(0.f, 0.f, 0.f, 0.f);
#define LN_LOAD(G) { const float* src_ = (mode == 0) ? xin_row(P, (G)) : (P.out + (size_t)(G) * DM); \
    nx0 = *(const float4*)(src_ + lane * 4); nx1 = *(const float4*)(src_ + 256 + lane * 4); nx2 = *(const float4*)(src_ + 512 + lane * 4); nx3 = *(const float4*)(src_ + 768 + lane * 4); \
    if (mode == 2) { const float* t_ = P.ff2tmp + (size_t)(G) * DM + lane * 4; nt0 = *(const float4*)t_; nt1 = *(const float4*)(t_ + 256); nt2 = *(const float4*)(t_ + 512); nt3 = *(const float4*)(t_ + 768); } }
  if (wid < NTOK) LN_LOAD(wid)
  for (int g = wid; g < NTOK; g += nw) {
    int gs, T, ci; tok_info(g, gs, T, ci);
    float v[16];
    { const float4 xs[4] = {nx0, nx1, nx2, nx3};
#pragma unroll
      for (int k = 0; k < 4; ++k) { v[4 * k] = xs[k].x; v[4 * k + 1] = xs[k].y; v[4 * k + 2] = xs[k].z; v[4 * k + 3] = xs[k].w; } }
    if (mode == 2) {
      const float* gt = P.mod + (size_t)(l * 3 + ci) * 6144 + 5120;
      const float4 ts[4] = {nt0, nt1, nt2, nt3};
#pragma unroll
      for (int k = 0; k < 4; ++k) { const float4 t = ts[k], g4 = *(const float4*)(gt + k * 256 + lane * 4);
        v[4 * k] += g4.x * t.x; v[4 * k + 1] += g4.y * t.y; v[4 * k + 2] += g4.z * t.z; v[4 * k + 3] += g4.w * t.w; }
    }
    if (g + nw < NTOK) LN_LOAD(g + nw)
    float s = 0.f;
#pragma unroll
    for (int i = 0; i < 16; ++i) s += v[i];
    float mu = wave_sum(s) * (1.f / DM);
    float q = 0.f;
#pragma unroll
    for (int i = 0; i < 16; ++i) { v[i] -= mu; q += v[i] * v[i]; }
    float rstd = rsqrtf(wave_sum(q) * (1.f / DM) + LNEPS);
#pragma unroll
    for (int i = 0; i < 16; ++i) v[i] *= rstd;
    int lm = l, shoff = 0, scoff = 1024;
    bool write_u = true;
    if (mode != 0) {
      const float* gg = (mode == 1 ? P.ln1_g : P.ln2_g) + l * DM;
      const float* bb = (mode == 1 ? P.ln1_b : P.ln2_b) + l * DM;
#pragma unroll
      for (int k = 0; k < 4; ++k) {
        const float4 g4 = *(const float4*)(gg + k * 256 + lane * 4), b4 = *(const float4*)(bb + k * 256 + lane * 4);
        v[4 * k] = v[4 * k] * g4.x + b4.x; v[4 * k + 1] = v[4 * k + 1] * g4.y + b4.y; v[4 * k + 2] = v[4 * k + 2] * g4.z + b4.z; v[4 * k + 3] = v[4 * k + 3] * g4.w + b4.w;
        *(float4*)(P.out + (size_t)g * DM + k * 256 + lane * 4) = make_float4(v[4 * k], v[4 * k + 1], v[4 * k + 2], v[4 * k + 3]);
      }
      if (mode == 1) { shoff = 3072; scoff = 4096; } else { lm = l + 1; write_u = (l == 0); }
      if (write_u) {
        s = 0.f;
#pragma unroll
        for (int i = 0; i < 16; ++i) s += v[i];
        mu = wave_sum(s) * (1.f / DM);
        q = 0.f;
#pragma unroll
        for (int i = 0; i < 16; ++i) { v[i] -= mu; q += v[i] * v[i]; }
        rstd = rsqrtf(wave_sum(q) * (1.f / DM) + LNEPS);
#pragma unroll
        for (int i = 0; i < 16; ++i) v[i] *= rstd;
      }
    }
    if (write_u) {
      const float* md = P.mod + (size_t)(lm * 3 + ci) * 6144;
#pragma unroll
      for (int k = 0; k < 4; ++k) {
        const float4 sh = *(const float4*)(md + shoff + k * 256 + lane * 4), sc = *(const float4*)(md + scoff + k * 256 + lane * 4);
        uint2 o;
        o.x = pack2(v[4 * k] * (1.f + sc.x) + sh.x, v[4 * k + 1] * (1.f + sc.y) + sh.y);
        o.y = pack2(v[4 * k + 2] * (1.f + sc.z) + sh.z, v[4 * k + 3] * (1.f + sc.w) + sh.w);
        *(uint2*)(P.ubuf + (size_t)g * DM + k * 256 + lane * 4) = o;
      }
    }
  }
}

namespace pg8 {
#define PG8_LAS __attribute__((address_space(3)))
typedef unsigned short bf16_t;
typedef short bf16x8 __attribute__((ext_vector_type(8)));
typedef float f32x4 __attribute__((ext_vector_type(4)));
typedef unsigned u32x4 __attribute__((ext_vector_type(4)));
constexpr int BM = 256, BK = 64, HALF = 128, HTB = HALF * BK * 2  , STAGE_BYTES = 8 * HTB, NXCD = 8, WGM = 8;

__host__ __device__ __forceinline__ int lds_byte(int r, int c) { const int st = (r >> 4) * 2 + (c >> 5), rr = r & 15, cc = c & 31, ob = rr * 64 + cc * 2; return st * 1024 + (ob ^ (((ob >> 9) & 1) << 5)); }
__host__ __device__ __forceinline__ void stage_rc(int b, int& R, int& C) { const int st = b / 1024, sb = b % 1024, swz = sb ^ (((sb >> 9) & 1) << 5); R = (st >> 1) * 16 + swz / 64; C = (st & 1) * 32 + (swz % 64) / 2; }
__host__ __device__ __forceinline__ int perm32(int rho) { const int n = rho >> 4, i = rho & 15; return 8 * (i >> 2) + 4 * n + (i & 3); }

struct Unit { int pm, pn; };
struct Gemm { const bf16_t* A; const bf16_t* Bt; int M, N, K; int lda; int nsplit; };

struct StaticOrder {
    int nM, nN, nwg, G, c;
    __host__ __device__ void init(int M, int N, int G_, int c_) { nM = M / BM; nN = N / BM; nwg = nM * nN; G = G_; c = c_; }
    __host__ __device__ bool next(int i, Unit& u) const {
        const long L = (long)i * G + c; if (L >= nwg) return false;
        int wgid = (int)L; { const int q = nwg / NXCD, r = nwg % NXCD, xcd = wgid % NXCD, off = wgid / NXCD; wgid = (xcd < r ? xcd * (q + 1) : r * (q + 1) + (xcd - r) * q) + off; }
        const int nig = WGM * nN, gid = wgid / nig, fm = gid * WGM, gsz = (nM - fm) < WGM ? (nM - fm) : WGM;
        u.pm = fm + ((wgid % nig) % gsz); u.pn = (wgid % nig) / gsz; return true;
    }
    __device__ __forceinline__ void a_ready(const Unit&) const {}
    __device__ __forceinline__ void done(const Unit&) const {}
};
__device__ __forceinline__ unsigned cvt_pk_bf16(float lo, float hi) { unsigned r; asm volatile("v_cvt_pk_bf16_f32 %0, %1, %2" : "=v"(r) : "v"(lo), "v"(hi)); return r; }
template <class Epi, class Sched, bool STAMP = false>
__device__ __forceinline__ void gemm_phase(PG8_LAS unsigned char* lds, const Gemm g, const Sched& S, const Epi& E, unsigned long long* stamps) {
    const int tid = THREAD_ID, wid = __builtin_amdgcn_readfirstlane(tid >> 6), lane = tid & 63, wr = wid >> 2, wc = wid & 3, fr = lane & 15, fq = lane >> 4;
    const int K = g.K, nt = K / BK;
    int ts_lo = 0, ts_hi = 0, nts = 0; const unsigned long long rt_entry = STAMP ? (unsigned long long)wall_clock64() : 0ull;
#define PG8_STAMP() do { if (STAMP && wid == 0 && nts < 64) { const unsigned long long _c = (unsigned long long)clock64(); \
        ts_lo = (lane == nts) ? (int)(unsigned)_c : ts_lo; ts_hi = (lane == nts) ? (int)(unsigned)(_c >> 32) : ts_hi; ++nts; } } while (0)
    PG8_STAMP();
    unsigned voffA[2], voffB[2];
#pragma unroll
    for (int i = 0; i < 2; ++i) { int R, C; stage_rc(tid * 16 + i * 8192, R, C); const int Rb = Epi::PERM ? ((R & ~31) + perm32(R & 31)) : R;
        voffA[i] = (unsigned)(R * g.lda + C) * 2u; voffB[i] = (unsigned)(Rb * K + C) * 2u; }
    const size_t kstep = (size_t)(BK * 2);
    const size_t hstep = (size_t)HALF * K * 2, hstepA = (size_t)HALF * g.lda * 2;
    const size_t tstep = 2 * hstep, tstepA = 2 * hstepA;
    const size_t ksplitA = (size_t)K * 2;
    const unsigned ldsw = (unsigned)wid * 1024u;
    const int aoff = lds_byte(wr * 64 + fr, fq * 8), boff = lds_byte(wc * 32 + fr, fq * 8);
#define PG8_SA(b, h) (((b) * 2 + (h)) * HTB)
#define PG8_SB(b, h) ((4 + (b) * 2 + (h)) * HTB)
#define PG8_STAGE(bufoff, gbase, voff) do { _Pragma("unroll") for (int _i = 0; _i < 2; ++_i) \
        __builtin_amdgcn_global_load_lds((const unsigned*)((const char*)(gbase) + (voff)[_i]), (PG8_LAS unsigned*)(lds + (bufoff) + ldsw + _i * 8192), 16, 0, 0); } while (0)
#define PG8_LDA(dst, b, h) do { _Pragma("unroll") for (int m = 0; m < 4; ++m) _Pragma("unroll") for (int k = 0; k < 2; ++k) dst[m][k] = *(const PG8_LAS bf16x8*)(lds + PG8_SA(b, h) + aoff + m * 2048 + k * 1024); } while (0)
#define PG8_LDB(dst, b, h) do { _Pragma("unroll") for (int n = 0; n < 2; ++n) _Pragma("unroll") for (int k = 0; k < 2; ++k) dst[n][k] = *(const PG8_LAS bf16x8*)(lds + PG8_SB(b, h) + boff + n * 2048 + k * 1024); } while (0)
#define PG8_MMA(ai, bj, At, Bt) do { __builtin_amdgcn_s_setprio(1); _Pragma("unroll") for (int m = 0; m < 4; ++m) _Pragma("unroll") for (int n = 0; n < 2; ++n) _Pragma("unroll") for (int k = 0; k < 2; ++k) \
        acc[ai][bj][m][n] = __builtin_amdgcn_mfma_f32_16x16x32_bf16(Bt[n][k], At[m][k], acc[ai][bj][m][n], 0, 0, 0); __builtin_amdgcn_s_setprio(0); } while (0)
#define PG8_WAIT_V(n) asm volatile("s_waitcnt vmcnt(" #n ")" ::: "memory")
#define PG8_WAIT_L(n) asm volatile("s_waitcnt lgkmcnt(" #n ")" ::: "memory")
#define PG8_BAR __builtin_amdgcn_s_barrier()
#define PG8_SCHED __builtin_amdgcn_sched_barrier(0)
    Unit cur, nxt; int ui = 0;
    if (!S.next(0, cur)) return;
    f32x4 acc[2][2][4][2];
#pragma unroll
    for (int a = 0; a < 2; ++a)
#pragma unroll
        for (int b = 0; b < 2; ++b)
#pragma unroll
            for (int m = 0; m < 4; ++m)
#pragma unroll
                for (int n = 0; n < 2; ++n) acc[a][b][m][n] = (f32x4){0.f, 0.f, 0.f, 0.f};
    bf16x8 At[4][2], B0[2][2], B1[2][2];
    const char* cA = (const char*)g.A + (size_t)cur.pm * tstepA + (cur.pn >= g.nsplit ? ksplitA : 0); const char* cB = (const char*)g.Bt + (size_t)cur.pn * tstep;
    S.a_ready(cur);
    PG8_STAGE(PG8_SB(0, 0), cB, voffB); PG8_STAGE(PG8_SA(0, 0), cA, voffA); PG8_STAGE(PG8_SB(0, 1), cB + hstep, voffB); PG8_STAGE(PG8_SA(0, 1), cA + hstepA, voffA);
    if (wr == 1) PG8_BAR;
    PG8_WAIT_V(4); PG8_BAR;
    PG8_STAGE(PG8_SB(1, 0), cB + kstep, voffB); PG8_STAGE(PG8_SA(1, 0), cA + kstep, voffA); PG8_STAGE(PG8_SB(1, 1), cB + hstep + kstep, voffB);
    PG8_WAIT_V(6); PG8_BAR;
    PG8_STAMP();
    for (;;) {
        const bool has_next = S.next(ui + 1, nxt);
        const char* nA = has_next ? (const char*)g.A + (size_t)nxt.pm * tstepA + (nxt.pn >= g.nsplit ? ksplitA : 0) : cA; const char* nB = has_next ? (const char*)g.Bt + (size_t)nxt.pn * tstep : cB;
        for (int t = 0; t < nt; t += 2) {
            const bool last = (t == nt - 2);
            const char* a1 = cA + (size_t)(t + 1) * kstep;
            const char* a2 = last ? nA : cA + (size_t)(t + 2) * kstep; const char* b2 = last ? nB : cB + (size_t)(t + 2) * kstep;
            const char* a3 = a2 + kstep; const char* b3 = b2 + kstep;
            if (last && has_next) S.a_ready(nxt);
            PG8_LDB(B0, 0, 0); PG8_SCHED; PG8_LDA(At, 0, 0); PG8_STAGE(PG8_SA(1, 1), a1 + hstepA, voffA);
            PG8_WAIT_L(8); PG8_BAR; PG8_WAIT_L(0); PG8_MMA(0, 0, At, B0); PG8_BAR; PG8_SCHED;
            PG8_LDB(B1, 0, 1); PG8_STAGE(PG8_SB(0, 0), b2, voffB);
            PG8_BAR; PG8_WAIT_L(0); PG8_MMA(0, 1, At, B1); PG8_BAR;
            PG8_LDA(At, 0, 1); PG8_STAGE(PG8_SA(0, 0), a2, voffA);
            PG8_BAR; PG8_WAIT_L(0); PG8_MMA(1, 0, At, B0); PG8_BAR; PG8_SCHED;
            PG8_STAGE(PG8_SB(0, 1), b2 + hstep, voffB);
            PG8_WAIT_V(6); PG8_BAR; PG8_MMA(1, 1, At, B1); PG8_BAR;
            PG8_LDB(B0, 1, 0); PG8_SCHED; PG8_LDA(At, 1, 0); PG8_STAGE(PG8_SA(0, 1), a2 + hstepA, voffA);
            PG8_WAIT_L(8); PG8_BAR; PG8_WAIT_L(0); PG8_MMA(0, 0, At, B0); PG8_BAR; PG8_SCHED;
            PG8_LDB(B1, 1, 1); PG8_STAGE(PG8_SB(1, 0), b3, voffB);
            PG8_BAR; PG8_WAIT_L(0); PG8_MMA(0, 1, At, B1); PG8_BAR;
            PG8_LDA(At, 1, 1); PG8_STAGE(PG8_SA(1, 0), a3, voffA);
            PG8_BAR; PG8_WAIT_L(0); PG8_MMA(1, 0, At, B0); PG8_BAR; PG8_SCHED;
            PG8_STAGE(PG8_SB(1, 1), b3 + hstep, voffB);
            PG8_WAIT_V(6); PG8_BAR; PG8_MMA(1, 1, At, B1); PG8_BAR;
        }
        PG8_STAMP();
        if constexpr (!Epi::AFTER_DRAIN) { E(acc, cur, wr, wc, fr, fq); S.done(cur); }
        PG8_STAMP();
        if (!has_next) break;
#pragma unroll
        for (int a = 0; a < 2; ++a)
#pragma unroll
            for (int b = 0; b < 2; ++b)
#pragma unroll
                for (int m = 0; m < 4; ++m)
#pragma unroll
                    for (int n = 0; n < 2; ++n) acc[a][b][m][n] = (f32x4){0.f, 0.f, 0.f, 0.f};
        cur = nxt; cA = nA; cB = nB; ++ui;
    }
    PG8_WAIT_V(0);
    if (wr == 0) PG8_BAR;
    PG8_BAR;
    if constexpr (Epi::AFTER_DRAIN) { E.fused(acc, cur, wr, wc, fr, fq, lds, wid, lane); S.done(cur); }
    PG8_STAMP();
    if (STAMP && wid == 0) { stamps[lane] = lane < nts ? (((unsigned long long)(unsigned)ts_hi << 32) | (unsigned)ts_lo) : 0ull;
        if (lane == 62) stamps[62] = rt_entry; if (lane == 63) stamps[63] = (unsigned long long)wall_clock64(); }
#undef PG8_STAMP
#undef PG8_SA
#undef PG8_SB
#undef PG8_STAGE
#undef PG8_LDA
#undef PG8_LDB
#undef PG8_MMA
#undef PG8_WAIT_V
#undef PG8_WAIT_L
#undef PG8_BAR
#undef PG8_SCHED
}
}
struct EpiProj {
  static constexpr bool PERM = false, AFTER_DRAIN = false;
  float* projABC; float* pdraw; int col0;
  __device__ __forceinline__ void operator()(const pg8::f32x4 (&acc)[2][2][4][2], const pg8::Unit& u, int wr, int wc, int fr, int fq) const {
#pragma unroll
    for (int ai = 0; ai < 2; ++ai)
#pragma unroll
      for (int m = 0; m < 4; ++m) {
        const int r = u.pm * 256 + ai * 128 + wr * 64 + m * 16 + fr;
#pragma unroll
        for (int bj = 0; bj < 2; ++bj)
#pragma unroll
          for (int n = 0; n < 2; ++n) {
            const int cp = col0 + u.pn * 256 + bj * 128 + wc * 32 + n * 16 + fq * 4;
            const int c = cp < 768 ? cp : (cp < 4000 ? cp + 256 : (cp < 4096 ? PIN : cp - 3328));
            if (c < NABC) *(pg8::f32x4*)(projABC + (size_t)r * NABC + c) = acc[ai][bj][m][n];
            else if (c < PIN) *(pg8::f32x4*)(pdraw + (size_t)r * NPD + (c - NABC)) = acc[ai][bj][m][n];
          }
      }
  }
};
struct EpiRes {
  static constexpr bool PERM = false, AFTER_DRAIN = false;
  float* out; const float* xp; const float* xs; const float* gate;
  __device__ __forceinline__ void operator()(const pg8::f32x4 (&acc)[2][2][4][2], const pg8::Unit& u, int wr, int wc, int fr, int fq) const {
#pragma unroll
    for (int ai = 0; ai < 2; ++ai)
#pragma unroll
      for (int m = 0; m < 4; ++m) {
        const int r = u.pm * 256 + ai * 128 + wr * 64 + m * 16 + fr;
        int gs, T, ci; tok_info(r, gs, T, ci);
        const float* xr = (r < 4096) ? xp + (size_t)r * DM : xs + (size_t)(r - 4096) * DM;
        const float* gr = gate + (size_t)ci * 6144;
#pragma unroll
        for (int bj = 0; bj < 2; ++bj)
#pragma unroll
          for (int n = 0; n < 2; ++n) {
            const int c = u.pn * 256 + bj * 128 + wc * 32 + n * 16 + fq * 4;
            const pg8::f32x4 x = *(const pg8::f32x4*)(xr + c), g = *(const pg8::f32x4*)(gr + c);
            *(pg8::f32x4*)(out + (size_t)r * DM + c) = x * ALPHA + g * acc[ai][bj][m][n];
          }
      }
  }
};
struct EpiResSplit {
  static constexpr bool PERM = false, AFTER_DRAIN = false;
  float* out; float* tmp; const float* gate;
  __device__ __forceinline__ void operator()(const pg8::f32x4 (&acc)[2][2][4][2], const pg8::Unit& u, int wr, int wc, int fr, int fq) const {
    const bool second = u.pn >= 4; const int pn = u.pn & 3;
#pragma unroll
    for (int ai = 0; ai < 2; ++ai)
#pragma unroll
      for (int m = 0; m < 4; ++m) {
        const int r = u.pm * 256 + ai * 128 + wr * 64 + m * 16 + fr;
        int gs, T, ci; tok_info(r, gs, T, ci);
        const float* gr = gate + (size_t)ci * 6144;
#pragma unroll
        for (int bj = 0; bj < 2; ++bj)
#pragma unroll
          for (int n = 0; n < 2; ++n) {
            const int c = pn * 256 + bj * 128 + wc * 32 + n * 16 + fq * 4;
            if (second) *(pg8::f32x4*)(tmp + (size_t)r * DM + c) = acc[ai][bj][m][n];
            else { const pg8::f32x4 x = *(const pg8::f32x4*)(out + (size_t)r * DM + c), g4 = *(const pg8::f32x4*)(gr + c);
                   *(pg8::f32x4*)(out + (size_t)r * DM + c) = x * ALPHA + g4 * acc[ai][bj][m][n]; }
          }
      }
  }
};
struct EpiFF1 {
  static constexpr bool PERM = true, AFTER_DRAIN = false;
  bf16_t* hidden;
  __device__ __forceinline__ void operator()(const pg8::f32x4 (&acc)[2][2][4][2], const pg8::Unit& u, int wr, int wc, int fr, int fq) const {
#pragma unroll
    for (int ai = 0; ai < 2; ++ai)
#pragma unroll
      for (int m = 0; m < 4; ++m) {
        const int r = u.pm * 256 + ai * 128 + wr * 64 + m * 16 + fr;
#pragma unroll
        for (int bj = 0; bj < 2; ++bj) {
          const int c = u.pn * 256 + bj * 128 + wc * 32 + fq * 8;
          pg8::f32x4 v0 = acc[ai][bj][m][0], v1 = acc[ai][bj][m][1];
#pragma unroll
          for (int e = 0; e < 4; ++e) { v0[e] = fmaxf(v0[e], 0.f); v0[e] *= v0[e]; v1[e] = fmaxf(v1[e], 0.f); v1[e] *= v1[e]; }
          uint4 o; o.x = pack2(v0[0], v0[1]); o.y = pack2(v0[2], v0[3]); o.z = pack2(v1[0], v1[1]); o.w = pack2(v1[2], v1[3]);
          *(uint4*)(hidden + (size_t)r * DFF + c) = o;
        }
      }
  }
};
template <class Epi>
DEV void phase_gemm(const bf16_t* A, const bf16_t* Bt, int N, int K, const Epi& E, char* smem, int lda = 0, int nsplit = 1 << 20, int G = 0) {
  pg8::Gemm g; g.A = A; g.Bt = Bt; g.M = NTOK; g.N = N; g.K = K; g.lda = lda ? lda : K; g.nsplit = nsplit;
  pg8::StaticOrder S; S.init(NTOK, N, G ? G : (int)gridDim.x, (int)blockIdx.x);
  pg8::gemm_phase<Epi, pg8::StaticOrder, false>((PG8_LAS unsigned char*)smem, g, S, E, nullptr);
}

DEV float shiftmix(const float* __restrict__ pd, int g, int col, bool hp, bool hn, float mu) {
  const float x = pd[(size_t)g * NPD + col];
  const float xp = hp ? pd[(size_t)(g - 1) * NPD + col] : 0.f;
  const float xn = hn ? pd[(size_t)(g + 1) * NPD + col] : 0.f;
  return x + mu * (0.5f * (xp + xn) - x);
}
DEV void rwkv_prep_item(const Params& P, int l, int tile, int part, char* smem, const int tid_in) {
  const int tid = opaque_i(tid_in);
  const int lane = tid & 63, w = tid >> 6;
  const int g0 = tile * 64;
  int gs, T, ci; tok_info(g0, gs, T, ci);
  const float* mu = P.rwkv_mu + l * NPD;
  const float* __restrict__ pd = P.pdraw;
  float* __restrict__ rkvp = P.rkv;
  if (part == 0) {
#pragma unroll 4
    for (int idx = tid; idx < 64 * 128; idx += 256) {
      const int row = idx >> 7, c4 = (idx & 127) * 4;
      const int col = c4 < 256 ? c4 : (c4 + 256);
      const int g = g0 + row; const bool hp = g > gs, hn = g + 1 < gs + T;
      const float4 x = *(const float4*)(pd + (size_t)g * NPD + col);
      float4 xp = make_float4(0, 0, 0, 0), xn = make_float4(0, 0, 0, 0);
      if (hp) xp = *(const float4*)(pd + (size_t)(g - 1) * NPD + col);
      if (hn) xn = *(const float4*)(pd + (size_t)(g + 1) * NPD + col);
      const float4 m4 = *(const float4*)(mu + col);
      float4 o;
      o.x = x.x + m4.x * (0.5f * (xp.x + xn.x) - x.x); o.y = x.y + m4.y * (0.5f * (xp.y + xn.y) - x.y);
      o.z = x.z + m4.z * (0.5f * (xp.z + xn.z) - x.z); o.w = x.w + m4.w * (0.5f * (xp.w + xn.w) - x.w);
      *(float4*)(rkvp + (size_t)g * 768 + col) = o;
    }
    { const int cgk = tid & 63, qt = tid >> 6; const int col = 256 + cgk * 4;
      const float4 m4 = *(const float4*)(mu + col);
      const float4 kk = *(const float4*)(P.rwkv_kk + l * 256 + cgk * 4);
#pragma unroll 4
      for (int i = 0; i < 16; ++i) {
        const int g = g0 + qt * 16 + i; const bool hp = g > gs, hn = g + 1 < gs + T;
        const float4 x = *(const float4*)(pd + (size_t)g * NPD + col);
        float4 xp = make_float4(0, 0, 0, 0), xn = make_float4(0, 0, 0, 0);
        if (hp) xp = *(const float4*)(pd + (size_t)(g - 1) * NPD + col);
        if (hn) xn = *(const float4*)(pd + (size_t)(g + 1) * NPD + col);
        float4 o;
        o.x = x.x + m4.x * (0.5f * (xp.x + xn.x) - x.x); o.y = x.y + m4.y * (0.5f * (xp.y + xn.y) - x.y);
        o.z = x.z + m4.z * (0.5f * (xp.z + xn.z) - x.z); o.w = x.w + m4.w * (0.5f * (xp.w + xn.w) - x.w);
        *(float4*)(rkvp + (size_t)g * 768 + col) = o;
        const float ss = red16((o.x * kk.x) * (o.x * kk.x) + (o.y * kk.y) * (o.y * kk.y) + (o.z * kk.z) * (o.z * kk.z) + (o.w * kk.w) * (o.w * kk.w));
        if ((cgk & 15) == 0) P.khinv[g * 4 + (cgk >> 4)] = rsqrtf(ss + 1e-6f);
      }
    }
    return;
  }
  const bool isg = part == 5;
  const int KK = isg ? 128 : 64;
  const int lda = KK + 8;
  int z = 0, kind = 0;
  if (!isg) { const int p = part - 1; z = p >> 1; kind = p & 1; }
  const int acol0 = isg ? 1024 : (768 + kind * 128 + z * 64);
  bf16_t* sA = (bf16_t*)smem;
  {
    const int nq = KK >> 2;
    for (int idx = tid; idx < 64 * nq; idx += 256) {
      const int row = idx / nq, r = (idx % nq) * 4; const int g = g0 + row;
      const bool hp = g > gs, hn = g + 1 < gs + T;
      const float* px = pd + (size_t)g * NPD + acol0 + r;
      const float4 x = *(const float4*)px;
      float4 xp = make_float4(0, 0, 0, 0), xn = make_float4(0, 0, 0, 0);
      if (hp) xp = *(const float4*)(px - NPD);
      if (hn) xn = *(const float4*)(px + NPD);
      const float4 m4 = *(const float4*)(mu + acol0 + r);
      float v0 = x.x + m4.x * (0.5f * (xp.x + xn.x) - x.x), v1 = x.y + m4.y * (0.5f * (xp.y + xn.y) - x.y);
      float v2 = x.z + m4.z * (0.5f * (xp.z + xn.z) - x.z), v3 = x.w + m4.w * (0.5f * (xp.w + xn.w) - x.w);
      if (isg) { v0 = sigmoidf_(v0); v1 = sigmoidf_(v1); v2 = sigmoidf_(v2); v3 = sigmoidf_(v3); }
      else if (kind == 0) { v0 = tanhf(v0); v1 = tanhf(v1); v2 = tanhf(v2); v3 = tanhf(v3); }
      uint2 o; o.x = pack2(v0, v1); o.y = pack2(v2, v3);
      *(uint2*)(sA + row * lda + r) = o;
    }
  }
  const bf16_t* Bt = isg ? (P.g2t + (size_t)l * 256 * 128) : ((kind == 0 ? P.w2t : P.a2t) + (size_t)(l * 2 + z) * 256 * 64);
  __syncthreads();
#pragma unroll 1
  for (int half = 0; half < 2; ++half) {
  const bf16_t* bp = Bt + (size_t)(half * 128 + w * 32 + (lane & 31)) * KK + (lane >> 5) * 8;
  f32x16 acc[2] = {zero16(), zero16()};
  for (int s = 0; s < KK / 16; ++s) {
    const bf16x8 b = *(const bf16x8*)(bp + s * 16);
#pragma unroll
    for (int mi = 0; mi < 2; ++mi) {
      const bf16x8 a = *(const bf16x8*)(sA + (mi * 32 + (lane & 31)) * lda + s * 16 + (lane >> 5) * 8);
      acc[mi] = __builtin_amdgcn_mfma_f32_32x32x16_bf16(a, b, acc[mi], 0, 0, 0);
    }
  }
  const int c = half * 128 + w * 32 + (lane & 31);
  float bias = 0.f;
  if (!isg) bias = (kind == 0 ? P.rwkv_w0 : P.rwkv_a0)[(l * 2 + z) * 256 + c];
#pragma unroll
  for (int mi = 0; mi < 2; ++mi)
#pragma unroll
    for (int idx = 0; idx < 16; ++idx) {
      const int row = mi * 32 + (idx & 3) + 8 * (idx >> 2) + 4 * (lane >> 5);
      const int g = g0 + row;
      const float v = acc[mi][idx];
      if (isg) P.gbuf[(size_t)g * 256 + c] = f2bf(v);
      else {
        const float sg = sigmoidf_(v + bias);
        P.wa[((size_t)(g * 2 + z) * 2 + kind) * 256 + c] = (kind == 0) ? __expf(-0.60653065971f * sg) : sg;
      }
    }
  }
  __syncthreads();
}

DEV float4 dp_load(const float* base, int g, int gs, int T) { float4 r = make_float4(0.f, 0.f, 0.f, 0.f); if (g >= gs && g < gs + T) r = *(const float4*)(base + (size_t)g * NABC); return r; }
DEV void delta_prep_item(const Params& P, int l, int tile, int X, const int tid_in) {
  const int tid = opaque_i(tid_in);
  const int cg = tid & 63, qt = tid >> 6;
  const int g0 = tile * 64 + qt * 16;
  int gs, T, ci; tok_info(g0, gs, T, ci);
  const int col = X * 256 + cg * 4;
  const float* cw = P.delta_conv + (size_t)l * 5 * 768 + col;
  const float4 w0 = *(const float4*)cw, w1 = *(const float4*)(cw + 768), w2 = *(const float4*)(cw + 2 * 768), w3 = *(const float4*)(cw + 3 * 768), w4 = *(const float4*)(cw + 4 * 768);
  const float* base = P.projABC + 1040 + col;
#define DP_LOAD(G) dp_load(base, (G), gs, T)
  float4 xm2 = DP_LOAD(g0 - 2), xm1 = DP_LOAD(g0 - 1), x0 = DP_LOAD(g0), xp1 = DP_LOAD(g0 + 1);
#pragma unroll 4
  for (int i = 0; i < 16; ++i) {
    const int g = g0 + i;
    const float4 xp2 = DP_LOAD(g + 2);
    float4 a;
    a.x = xm2.x * w0.x + xm1.x * w1.x + x0.x * w2.x + xp1.x * w3.x + xp2.x * w4.x;
    a.y = xm2.y * w0.y + xm1.y * w1.y + x0.y * w2.y + xp1.y * w3.y + xp2.y * w4.y;
    a.z = xm2.z * w0.z + xm1.z * w1.z + x0.z * w2.z + xp1.z * w3.z + xp2.z * w4.z;
    a.w = xm2.w * w0.w + xm1.w * w1.w + x0.w * w2.w + xp1.w * w3.w + xp2.w * w4.w;
    a.x = siluf_(a.x); a.y = siluf_(a.y); a.z = siluf_(a.z); a.w = siluf_(a.w);
    float sc = 1.f;
    if (X < 2) { const float ss = red16(a.x * a.x + a.y * a.y + a.z * a.z + a.w * a.w); sc = rsqrtf(ss + 1e-6f) * (X == 0 ? 0.125f : 1.f); }
    uint2 o; o.x = pack2(a.x * sc, a.y * sc); o.y = pack2(a.z * sc, a.w * sc);
    *(uint2*)(P.ubuf + (size_t)g * 768 + col) = o;
    xm2 = xm1; xm1 = x0; x0 = xp1; xp1 = xp2;
  }
#undef DP_LOAD
}

DEV void load16(const float* __restrict__ p, float* v) {
#pragma unroll
  for (int e = 0; e < 4; ++e) { const float4 t = *(const float4*)(p + 4 * e); v[4 * e] = t.x; v[4 * e + 1] = t.y; v[4 * e + 2] = t.z; v[4 * e + 3] = t.w; }
}
DEV void store_row16(bf16_t* dst, const float* v) {
  uint4 a, b;
  a.x = pack2(v[0], v[1]); a.y = pack2(v[2], v[3]); a.z = pack2(v[4], v[5]); a.w = pack2(v[6], v[7]);
  b.x = pack2(v[8], v[9]); b.y = pack2(v[10], v[11]); b.z = pack2(v[12], v[13]); b.w = pack2(v[14], v[15]);
  *(uint4*)dst = a; *(uint4*)(dst + 8) = b;
}
DEV void decode_chain(int task, int& seq, int& h, bool& sample) {
  if (task < 8) { sample = true; seq = 16 + (task >> 2); h = task & 3; }
  else { const int t = task - 8; sample = false; seq = t >> 2; h = t & 3; }
}
DEV void seq_base(int seq, int& gs, int& T) { if (seq < 16) { gs = seq * 256; T = 256; } else { gs = 4096 + (seq - 16) * 2048; T = 2048; } }
DEV float wave_incl_scan_add(float x, int lane) {
#pragma unroll
  for (int o = 1; o < 64; o <<= 1) { const float y = __shfl_up(x, o); if (lane >= o) x += y; }
  return x;
}
DEV float wave_incl_scan_max(float x, int lane) {
#pragma unroll
  for (int o = 1; o < 64; o <<= 1) { const float y = __shfl_up(x, o); if (lane >= o) x = fmaxf(x, y); }
  return x;
}

DEV void ret_task(const Params& P, int l, int task, const int z, char* smem, const int tid_in, const bool active) {
  const int tid = opaque_i(tid_in);
  const int lane = tid & 63, w = tid >> 6, wr = w >> 1, wc = w & 1;
  int seq, h; bool sample; decode_chain(task, seq, h, sample);
  int gs, T; seq_base(seq, gs, T);
  if (!active) { for (int c = 0; c < T / 64; ++c) { __syncthreads(); __syncthreads(); __syncthreads(); } return; }
  bf16_t* sQ = (bf16_t*)smem; bf16_t* sK = sQ + 64 * LDB; bf16_t* sKzt = sK + 64 * LDB; bf16_t* sVt = sKzt + 64 * LDB; bf16_t* sP = sVt + 64 * LDB; bf16_t* sSt = sP + 64 * LDB;
  const float lg = -__expf(P.ret_decay[(l * 2 + z) * 4 + h]);
  const float gl = __expf(64.f * lg);
  f32x16 st = zero16();
  if (sample) {
    const float* s0 = P.st_ret + ((size_t)(((seq - 16) * 2 + l) * 2 + z) * 4 + h) * 4096;
#pragma unroll
    for (int idx = 0; idx < 16; ++idx) st[idx] = s0[ACC_COL * 64 + ACC_ROW(idx)];
  }
#pragma unroll
  for (int idx = 0; idx < 16; ++idx) sSt[ACC_ROW(idx) * LDB + ACC_COL] = f2bf(st[idx]);
  const int nch = T / 64;
  const int tid_outer = tid;
  float4 nq[4], nk[4], nv[4], nq2[4], nk2[4];
#define RET_PREFETCH(C) { \
    const int r_ = tid_outer & 63, sg_ = (tid_outer >> 6) * 16; \
    const int p_ = (C) * 64 + r_; const int g_ = gs + (z ? (T - 1 - p_) : p_); \
    const float* pr_ = P.projABC + (size_t)g_ * NABC + 2080 + h * 64; \
    _Pragma("unroll") for (int e_ = 0; e_ < 4; ++e_) { nq[e_] = *(const float4*)(pr_ + sg_ + 4 * e_); nk[e_] = *(const float4*)(pr_ + 256 + sg_ + 4 * e_); nv[e_] = *(const float4*)(pr_ + 512 + sg_ + 4 * e_); } \
    if (sample) { _Pragma("unroll") for (int e_ = 0; e_ < 4; ++e_) { nq2[e_] = *(const float4*)(pr_ + (sg_ ^ 16) + 4 * e_); nk2[e_] = *(const float4*)(pr_ + 256 + (sg_ ^ 16) + 4 * e_); } } }
  RET_PREFETCH(0)
  for (int c = 0; c < nch; ++c) {
    const int tid = opaque_i(tid_outer);
    const int lane = tid & 63, w = tid >> 6, wr = w >> 1, wc = w & 1;
    const int row = tid & 63, seg = (tid >> 6) * 16;
    {
      const int p = c * 64 + row; const int t = z ? (T - 1 - p) : p;
      float q[16], k[16], v[16];
#pragma unroll
      for (int e = 0; e < 4; ++e) { q[4 * e] = nq[e].x; q[4 * e + 1] = nq[e].y; q[4 * e + 2] = nq[e].z; q[4 * e + 3] = nq[e].w; k[4 * e] = nk[e].x; k[4 * e + 1] = nk[e].y; k[4 * e + 2] = nk[e].z; k[4 * e + 3] = nk[e].w;
        v[4 * e] = nv[e].x; v[4 * e + 1] = nv[e].y; v[4 * e + 2] = nv[e].z; v[4 * e + 3] = nv[e].w; }
      if (sample) {
        float q2[16], k2[16];
#pragma unroll
        for (int e = 0; e < 4; ++e) { q2[4 * e] = nq2[e].x; q2[4 * e + 1] = nq2[e].y; q2[4 * e + 2] = nq2[e].z; q2[4 * e + 3] = nq2[e].w; k2[4 * e] = nk2[e].x; k2[4 * e + 1] = nk2[e].y; k2[4 * e + 2] = nk2[e].z; k2[4 * e + 3] = nk2[e].w; }
        const float pos = (seg < 32) ? (float)(t >> 6) : (float)(t & 63);
        const bool first = (seg & 16) == 0;
#pragma unroll
        for (int e = 0; e < 16; ++e) {
          const float inv = __expf(-(float)e * (9.210340371976184f / 16.f));
          const float sn = __sinf(pos * inv), cs = __cosf(pos * inv);
          const float qs = first ? -q2[e] : q2[e], ks = first ? -k2[e] : k2[e];
          q[e] = q[e] * cs + qs * sn; k[e] = k[e] * cs + ks * sn;
        }
      }
      const float zeta = __expf((63.f - (float)row) * lg);
      float qq[16];
#pragma unroll
      for (int e = 0; e < 16; ++e) qq[e] = q[e] * 0.125f;
      store_row16(sQ + row * LDB + seg, qq);
      store_row16(sK + row * LDB + seg, k);
#pragma unroll
      for (int e = 0; e < 16; ++e) { sKzt[(seg + e) * LDB + row] = f2bf(k[e] * zeta); sVt[(seg + e) * LDB + row] = f2bf(v[e]); }
    }
    __syncthreads();
    if (c + 1 < nch) RET_PREFETCH(c + 1)
    f32x16 s = mm64(sQ, sK, wr, wc, lane, zero16());
#pragma unroll
    for (int idx = 0; idx < 16; ++idx) {
      const int i = ACC_ROW(idx), j = ACC_COL;
      const float val = (i >= j) ? s[idx] * __expf((float)(i - j) * lg) : 0.f;
      sP[i * LDB + j] = f2bf(val);
    }
    __syncthreads();
    f32x16 o1 = mm64(sP, sVt, wr, wc, lane, zero16());
    f32x16 o2 = mm64(sQ, sSt, wr, wc, lane, zero16());
#pragma unroll
    for (int idx = 0; idx < 16; ++idx) st[idx] *= gl;
    st = mm64(sVt, sKzt, wr, wc, lane, st);
#pragma unroll
    for (int idx = 0; idx < 16; ++idx) {
      const int i = ACC_ROW(idx), e = ACC_COL;
      const float xi = __expf((float)(i + 1) * lg);
      const int pp = c * 64 + i; const int tt = z ? (T - 1 - pp) : pp;
      P.hdir[((size_t)z * NTOK + gs + tt) * DM + 512 + h * 64 + e] = f2bf(o1[idx] + xi * o2[idx]);
    }
    __syncthreads();
#pragma unroll
    for (int idx = 0; idx < 16; ++idx) sSt[ACC_ROW(idx) * LDB + ACC_COL] = f2bf(st[idx]);
  }
  if (!sample) {
    float* o = P.out + O_RET + ((size_t)((seq * 2 + l) * 2 + z) * 4 + h) * 4096;
#pragma unroll
    for (int idx = 0; idx < 16; ++idx) o[ACC_COL * 64 + ACC_ROW(idx)] = st[idx];
  }
}

DEV void ret_sample_task(const Params& P, int l, int task, const int z, char* smem0, const int tid_all_in) {
  const int tid_all = opaque_i(tid_all_in);
  const int half = tid_all >> 8, tid0 = tid_all & 255;
  int seq, h; bool sample; decode_chain(task, seq, h, sample);
  int gs, T; seq_base(seq, gs, T);
  const int nch = T / 64;
  const float lg = -__expf(P.ret_decay[(l * 2 + z) * 4 + h]);
#define RT_SET(B) ((bf16_t*)(smem0 + (B) * HALF_LDS))
  bf16_t* sP = RT_SET(0) + 4 * 64 * LDB; bf16_t* sSt = sP + 64 * LDB;
  if (half == 1) {
    const int tid = tid0;
    float4 nq[4], nk[4], nv[4], nq2[4], nk2[4];
#pragma unroll
    for (int e = 0; e < 4; ++e) { nq2[e] = make_float4(0.f, 0.f, 0.f, 0.f); nk2[e] = nq2[e]; }
#define RT_PREFETCH(C) { \
      const int r_ = tid & 63, sg_ = (tid >> 6) * 16; \
      const int p_ = (C) * 64 + r_; const int g_ = gs + (z ? (T - 1 - p_) : p_); \
      const float* pr_ = P.projABC + (size_t)g_ * NABC + 2080 + h * 64; \
      _Pragma("unroll") for (int e_ = 0; e_ < 4; ++e_) { nq[e_] = *(const float4*)(pr_ + sg_ + 4 * e_); nk[e_] = *(const float4*)(pr_ + 256 + sg_ + 4 * e_); nv[e_] = *(const float4*)(pr_ + 512 + sg_ + 4 * e_); \
        if (sample) { nq2[e_] = *(const float4*)(pr_ + (sg_ ^ 16) + 4 * e_); nk2[e_] = *(const float4*)(pr_ + 256 + (sg_ ^ 16) + 4 * e_); } } }
#define RT_STAGE(C) { \
      bf16_t* sQ = RT_SET((C) & 1); bf16_t* sK = sQ + 64 * LDB; bf16_t* sKzt = sK + 64 * LDB; bf16_t* sVt = sKzt + 64 * LDB; \
      const int row = tid & 63, seg = (tid >> 6) * 16; \
      const int p = (C) * 64 + row; const int t = z ? (T - 1 - p) : p; \
      float q[16], k[16], v[16], q2[16], k2[16]; \
      _Pragma("unroll") for (int e = 0; e < 4; ++e) { q[4 * e] = nq[e].x; q[4 * e + 1] = nq[e].y; q[4 * e + 2] = nq[e].z; q[4 * e + 3] = nq[e].w; k[4 * e] = nk[e].x; k[4 * e + 1] = nk[e].y; k[4 * e + 2] = nk[e].z; k[4 * e + 3] = nk[e].w; \
        v[4 * e] = nv[e].x; v[4 * e + 1] = nv[e].y; v[4 * e + 2] = nv[e].z; v[4 * e + 3] = nv[e].w; \
        q2[4 * e] = nq2[e].x; q2[4 * e + 1] = nq2[e].y; q2[4 * e + 2] = nq2[e].z; q2[4 * e + 3] = nq2[e].w; k2[4 * e] = nk2[e].x; k2[4 * e + 1] = nk2[e].y; k2[4 * e + 2] = nk2[e].z; k2[4 * e + 3] = nk2[e].w; } \
      const float pos = (seg < 32) ? (float)(t >> 6) : (float)(t & 63); \
      const bool first = (seg & 16) == 0; \
      if (sample) { _Pragma("unroll") for (int e = 0; e < 16; ++e) { \
        const float inv = __expf(-(float)e * (9.210340371976184f / 16.f)); \
        const float sn = __sinf(pos * inv), cs = __cosf(pos * inv); \
        const float qs = first ? -q2[e] : q2[e], ks = first ? -k2[e] : k2[e]; \
        q[e] = (q[e] * cs + qs * sn) * 0.125f; k[e] = k[e] * cs + ks * sn; } } \
      else { _Pragma("unroll") for (int e = 0; e < 16; ++e) q[e] *= 0.125f; } \
      const float zeta = __expf((63.f - (float)row) * lg); \
      store_row16(sQ + row * LDB + seg, q); \
      store_row16(sK + row * LDB + seg, k); \
      _Pragma("unroll") for (int e = 0; e < 16; ++e) { sKzt[(seg + e) * LDB + row] = f2bf(k[e] * zeta); sVt[(seg + e) * LDB + row] = f2bf(v[e]); } }
    RT_PREFETCH(0)
    RT_STAGE(0)
    if (nch > 1) RT_PREFETCH(1)
    __syncthreads();
    for (int c = 0; c < nch; ++c) {
      if (c + 1 < nch) { RT_STAGE(c + 1) if (c + 2 < nch) RT_PREFETCH(c + 2) }
      __syncthreads(); __syncthreads(); __syncthreads();
    }
#undef RT_PREFETCH
#undef RT_STAGE
  } else {
    const int tid = tid0;
    const int lane = tid & 63, w = tid >> 6, wr = w >> 1, wc = w & 1;
    const float gl = __expf(64.f * lg);
    f32x16 st = zero16();
    if (sample) {
      const float* s0 = P.st_ret + ((size_t)(((seq - 16) * 2 + l) * 2 + z) * 4 + h) * 4096;
#pragma unroll
      for (int idx = 0; idx < 16; ++idx) st[idx] = s0[ACC_COL * 64 + ACC_ROW(idx)];
    }
#pragma unroll
    for (int idx = 0; idx < 16; ++idx) sSt[ACC_ROW(idx) * LDB + ACC_COL] = f2bf(st[idx]);
    __syncthreads();
    for (int c = 0; c < nch; ++c) {
      const bf16_t* sQ = RT_SET(c & 1); const bf16_t* sK = sQ + 64 * LDB; const bf16_t* sKzt = sK + 64 * LDB; const bf16_t* sVt = sKzt + 64 * LDB;
      f32x16 s = mm64(sQ, sK, wr, wc, lane, zero16());
#pragma unroll
      for (int idx = 0; idx < 16; ++idx) {
        const int i = ACC_ROW(idx), j = ACC_COL;
        const float val = (i >= j) ? s[idx] * __expf((float)(i - j) * lg) : 0.f;
        sP[i * LDB + j] = f2bf(val);
      }
      __syncthreads();
      f32x16 o1 = mm64(sP, sVt, wr, wc, lane, zero16());
      f32x16 o2 = mm64(sQ, sSt, wr, wc, lane, zero16());
#pragma unroll
      for (int idx = 0; idx < 16; ++idx) st[idx] *= gl;
      st = mm64(sVt, sKzt, wr, wc, lane, st);
#pragma unroll
      for (int idx = 0; idx < 16; ++idx) {
        const int i = ACC_ROW(idx), e = ACC_COL;
        const float xi = __expf((float)(i + 1) * lg);
        const int pp = c * 64 + i; const int tt = z ? (T - 1 - pp) : pp;
        P.hdir[((size_t)z * NTOK + gs + tt) * DM + 512 + h * 64 + e] = f2bf(o1[idx] + xi * o2[idx]);
      }
      __syncthreads();
#pragma unroll
      for (int idx = 0; idx < 16; ++idx) sSt[ACC_ROW(idx) * LDB + ACC_COL] = f2bf(st[idx]);
      __syncthreads();
    }
    if (!sample) {
      float* o = P.out + O_RET + ((size_t)((seq * 2 + l) * 2 + z) * 4 + h) * 4096;
#pragma unroll
      for (int idx = 0; idx < 16; ++idx) o[ACC_COL * 64 + ACC_ROW(idx)] = st[idx];
    }
  }
#undef RT_SET
}

DEV void mlstm_task(const Params& P, int l, int task, const int z, char* smem, const int tid_in, const bool active) {
  const int tid = opaque_i(tid_in);
  const int lane = tid & 63, w = tid >> 6, wr = w >> 1, wc = w & 1;
  int seq, h; bool sample; decode_chain(task, seq, h, sample);
  int gs, T; seq_base(seq, gs, T);
  if (!active) { for (int c = 0; c < T / 64; ++c) { __syncthreads(); __syncthreads(); __syncthreads(); } return; }
  bf16_t* sQ = (bf16_t*)smem; bf16_t* sK = sQ + 64 * LDB; bf16_t* sKt = sK + 64 * LDB; bf16_t* sVt = sKt + 64 * LDB; bf16_t* sP = sVt + 64 * LDB; bf16_t* sCt = sP + 64 * LDB;
  float* fs = (float*)(sCt + 64 * LDB);
  float* s_gate = fs; float* s_nn = fs + 640;
  const int sidx = sample ? ((((seq - 16) * 2 + l) * 2 + z) * 4 + h) : 0;
  f32x16 st = zero16();
  if (sample) {
    const float* c0 = P.st_C + (size_t)sidx * 4096;
#pragma unroll
    for (int idx = 0; idx < 16; ++idx) st[idx] = c0[ACC_COL * 64 + ACC_ROW(idx)];
  }
#pragma unroll
  for (int idx = 0; idx < 16; ++idx) sCt[ACC_ROW(idx) * LDB + ACC_COL] = f2bf(st[idx]);
  if (tid < 64) s_nn[tid] = sample ? P.st_n[sidx * 64 + tid] : 0.f;
  float m = sample ? P.st_m[sidx] : 0.f;
  const float ib = P.mlstm_i_bias[(l * 2 + z) * 4 + h], fb = P.mlstm_f_bias[(l * 2 + z) * 4 + h];
  const int nch = T / 64;
  const int tid_outer = tid;
  float4 nq[4], nk[4], nv[4]; float ngi, ngf;
#define MLSTM_PREFETCH(C) { \
    const int r_ = tid_outer & 63, sg_ = (tid_outer >> 6) * 16; \
    const int p_ = (C) * 64 + r_; const int g_ = gs + (z ? (T - 1 - p_) : p_); \
    const float* pr_ = P.projABC + (size_t)g_ * NABC + h * 64; \
    _Pragma("unroll") for (int e_ = 0; e_ < 4; ++e_) { nq[e_] = *(const float4*)(pr_ + sg_ + 4 * e_); nk[e_] = *(const float4*)(pr_ + 256 + sg_ + 4 * e_); nv[e_] = *(const float4*)(pr_ + 512 + sg_ + 4 * e_); } \
    const float* gp_ = P.projABC + (size_t)g_ * NABC + 1024 + z * 4 + h; ngi = gp_[0]; ngf = gp_[8]; }
  MLSTM_PREFETCH(0)
  for (int c = 0; c < nch; ++c) {
    const int tid = opaque_i(tid_outer);
    const int lane = tid & 63, w = tid >> 6, wr = w >> 1, wc = w & 1;
    const int row = tid & 63, seg = (tid >> 6) * 16;
    const int par = c & 1;
    float* s_a = s_gate + par * 320; float* s_b = s_a + 64; float* s_M = s_a + 128; float* s_ew = s_a + 192; float* s_dinv = s_a + 256;
    float* s_n = s_nn + par * 64; float* s_n2 = s_nn + (par ^ 1) * 64;
    float sp;
    {
      const float li = ngi + ib, lf = logsigmoidf_(ngf + fb);
      const float b = wave_incl_scan_add(lf, lane);
      const float a = li - b;
      const float cm = wave_incl_scan_max(a, lane);
      const float M = fmaxf(m, cm);
      const float M63 = __shfl(M, 63), bl = __shfl(b, 63);
      const float skj = __expf(a - M63);
      sp = __expf(m - M63);
      if (w == 0) { s_a[lane] = a; s_b[lane] = b; s_M[lane] = M; s_ew[lane] = __expf(m - M); }
      m = bl + M63;
      float q[16], k[16], v[16];
#pragma unroll
      for (int e = 0; e < 4; ++e) { q[4 * e] = nq[e].x; q[4 * e + 1] = nq[e].y; q[4 * e + 2] = nq[e].z; q[4 * e + 3] = nq[e].w;
        k[4 * e] = nk[e].x * 0.125f; k[4 * e + 1] = nk[e].y * 0.125f; k[4 * e + 2] = nk[e].z * 0.125f; k[4 * e + 3] = nk[e].w * 0.125f;
        v[4 * e] = nv[e].x; v[4 * e + 1] = nv[e].y; v[4 * e + 2] = nv[e].z; v[4 * e + 3] = nv[e].w; }
      store_row16(sQ + row * LDB + seg, q);
      store_row16(sK + row * LDB + seg, k);
#pragma unroll
      for (int e = 0; e < 16; ++e) { sKt[(seg + e) * LDB + row] = f2bf(k[e] * skj); sVt[(seg + e) * LDB + row] = f2bf(v[e]); }
    }
    __syncthreads();
    f32x16 s = mm64(sQ, sK, wr, wc, lane, zero16());
#pragma unroll
    for (int idx = 0; idx < 16; ++idx) {
      const int i = ACC_ROW(idx), j = ACC_COL;
      const float val = (i >= j) ? s[idx] * __expf(s_a[j] - s_M[i]) : 0.f;
      sP[i * LDB + j] = f2bf(val);
    }
    __syncthreads();
    if (c + 1 < nch) MLSTM_PREFETCH(c + 1)
    f32x16 o1 = mm64(sP, sVt, wr, wc, lane, zero16());
    f32x16 o2 = mm64(sQ, sCt, wr, wc, lane, zero16());
    {
      const int r4 = tid >> 2, sg4 = (tid & 3) * 16;
      float rs = 0.f, qn = 0.f;
#pragma unroll
      for (int e = 0; e < 16; ++e) { rs += bf2f(sP[r4 * LDB + sg4 + e]); qn += bf2f(sQ[r4 * LDB + sg4 + e]) * s_n[sg4 + e]; }
      rs = red4(rs); qn = red4(qn);
      const float den = rs + qn * s_ew[r4];
      const float mt = s_b[r4] + s_M[r4];
      if ((tid & 3) == 0) s_dinv[r4] = 1.f / fmaxf(fabsf(den), __expf(-mt));
    }
#pragma unroll
    for (int idx = 0; idx < 16; ++idx) st[idx] *= sp;
    st = mm64(sVt, sKt, wr, wc, lane, st);
    if (tid < 64) {
      float a = s_n[tid] * sp;
      for (int j = 0; j < 64; ++j) a += bf2f(sKt[tid * LDB + j]);
      s_n2[tid] = a;
    }
    __syncthreads();
#pragma unroll
    for (int idx = 0; idx < 16; ++idx) {
      const int i = ACC_ROW(idx), e = ACC_COL;
      const int pp = c * 64 + i; const int tt = z ? (T - 1 - pp) : pp;
      P.hdir[((size_t)z * NTOK + gs + tt) * DM + h * 64 + e] = f2bf((o1[idx] + s_ew[i] * o2[idx]) * s_dinv[i]);
    }
#pragma unroll
    for (int idx = 0; idx < 16; ++idx) sCt[ACC_ROW(idx) * LDB + ACC_COL] = f2bf(st[idx]);
  }
  if (!sample) {
    const int oi = ((seq * 2 + l) * 2 + z) * 4 + h;
    float* o = P.out + O_C + (size_t)oi * 4096;
#pragma unroll
    for (int idx = 0; idx < 16; ++idx) o[ACC_COL * 64 + ACC_ROW(idx)] = st[idx];
    __syncthreads();
    if (tid < 64) P.out[O_N + oi * 64 + tid] = s_nn[(nch & 1) * 64 + tid];
    if (tid == 0) P.out[O_M + oi] = m;
  }
}

DEV void mlstm_sample_task(const Params& P, int l, int task, const int z, char* smem0, const int tid_all_in) {
  const int tid_all = opaque_i(tid_all_in);
  const int half = tid_all >> 8, tid = tid_all & 255;
  int seq, h; bool sample; decode_chain(task, seq, h, sample);
  int gs, T; seq_base(seq, gs, T);
  const int nch = T / 64;
  const int sidx = (((seq - 16) * 2 + l) * 2 + z) * 4 + h;
#define ML_SET(B) ((bf16_t*)(smem0 + (B) * HALF_LDS))
#define ML_GATE(B) ((float*)(smem0 + (B) * HALF_LDS + 4 * 64 * LDB * 2))
  bf16_t* sP = (bf16_t*)(smem0 + 4 * 64 * LDB * 2 + 2048); bf16_t* sCt = sP + 64 * LDB;
  float* s_dinv = (float*)(sCt + 64 * LDB); float* s_nn = s_dinv + 64;
  if (half == 1) {
    const int lane = tid & 63, w = tid >> 6;
    float m = P.st_m[sidx];
    const float ib = P.mlstm_i_bias[(l * 2 + z) * 4 + h], fb = P.mlstm_f_bias[(l * 2 + z) * 4 + h];
    float4 nq[4], nk[4], nv[4]; float ngi, ngf;
#define ML_PREFETCH(C) { \
      const int r_ = tid & 63, sg_ = (tid >> 6) * 16; \
      const int p_ = (C) * 64 + r_; const int g_ = gs + (z ? (T - 1 - p_) : p_); \
      const float* pr_ = P.projABC + (size_t)g_ * NABC + h * 64; \
      _Pragma("unroll") for (int e_ = 0; e_ < 4; ++e_) { nq[e_] = *(const float4*)(pr_ + sg_ + 4 * e_); nk[e_] = *(const float4*)(pr_ + 256 + sg_ + 4 * e_); nv[e_] = *(const float4*)(pr_ + 512 + sg_ + 4 * e_); } \
      const float* gp_ = P.projABC + (size_t)g_ * NABC + 1024 + z * 4 + h; ngi = gp_[0]; ngf = gp_[8]; }
#define ML_STAGE(C) { \
      bf16_t* sQ = ML_SET((C) & 1); bf16_t* sK = sQ + 64 * LDB; bf16_t* sKt = sK + 64 * LDB; bf16_t* sVt = sKt + 64 * LDB; \
      float* gt_ = ML_GATE((C) & 1); \
      const int row = tid & 63, seg = (tid >> 6) * 16; \
      const float li = ngi + ib, lf = logsigmoidf_(ngf + fb); \
      const float b = wave_incl_scan_add(lf, lane); \
      const float a = li - b; \
      const float cm = wave_incl_scan_max(a, lane); \
      const float M = fmaxf(m, cm); \
      const float M63 = __shfl(M, 63), bl = __shfl(b, 63); \
      const float skj = __expf(a - M63); \
      if (w == 0) { gt_[lane] = a; gt_[64 + lane] = b; gt_[128 + lane] = M; gt_[192 + lane] = __expf(m - M); if (lane == 0) gt_[256] = __expf(m - M63); } \
      m = bl + M63; \
      float q[16], k[16], v[16]; \
      _Pragma("unroll") for (int e = 0; e < 4; ++e) { q[4 * e] = nq[e].x; q[4 * e + 1] = nq[e].y; q[4 * e + 2] = nq[e].z; q[4 * e + 3] = nq[e].w; \
        k[4 * e] = nk[e].x * 0.125f; k[4 * e + 1] = nk[e].y * 0.125f; k[4 * e + 2] = nk[e].z * 0.125f; k[4 * e + 3] = nk[e].w * 0.125f; \
        v[4 * e] = nv[e].x; v[4 * e + 1] = nv[e].y; v[4 * e + 2] = nv[e].z; v[4 * e + 3] = nv[e].w; } \
      store_row16(sQ + row * LDB + seg, q); \
      store_row16(sK + row * LDB + seg, k); \
      _Pragma("unroll") for (int e = 0; e < 16; ++e) { sKt[(seg + e) * LDB + row] = f2bf(k[e] * skj); sVt[(seg + e) * LDB + row] = f2bf(v[e]); } }
    ML_PREFETCH(0)
    ML_STAGE(0)
    if (nch > 1) ML_PREFETCH(1)
    __syncthreads();
    for (int c = 0; c < nch; ++c) {
      if (c + 1 < nch) { ML_STAGE(c + 1) if (c + 2 < nch) ML_PREFETCH(c + 2) }
      __syncthreads(); __syncthreads(); __syncthreads();
    }
#undef ML_PREFETCH
#undef ML_STAGE
  } else {
    const int lane = tid & 63, w = tid >> 6, wr = w >> 1, wc = w & 1;
    f32x16 st = zero16();
    {
      const float* c0 = P.st_C + (size_t)sidx * 4096;
#pragma unroll
      for (int idx = 0; idx < 16; ++idx) st[idx] = c0[ACC_COL * 64 + ACC_ROW(idx)];
    }
#pragma unroll
    for (int idx = 0; idx < 16; ++idx) sCt[ACC_ROW(idx) * LDB + ACC_COL] = f2bf(st[idx]);
    if (tid < 64) s_nn[tid] = P.st_n[sidx * 64 + tid];
    __syncthreads();
    for (int c = 0; c < nch; ++c) {
      const bf16_t* sQ = ML_SET(c & 1); const bf16_t* sK = sQ + 64 * LDB; const bf16_t* sKt = sK + 64 * LDB; const bf16_t* sVt = sKt + 64 * LDB;
      const float* gt = ML_GATE(c & 1);
      const float* s_a = gt; const float* s_b = gt + 64; const float* s_M = gt + 128; const float* s_ew = gt + 192;
      const float sp = gt[256];
      const float* s_n = s_nn + (c & 1) * 64; float* s_n2 = s_nn + ((c & 1) ^ 1) * 64;
      f32x16 s = mm64(sQ, sK, wr, wc, lane, zero16());
#pragma unroll
      for (int idx = 0; idx < 16; ++idx) {
        const int i = ACC_ROW(idx), j = ACC_COL;
        const float val = (i >= j) ? s[idx] * __expf(s_a[j] - s_M[i]) : 0.f;
        sP[i * LDB + j] = f2bf(val);
      }
      __syncthreads();
      f32x16 o1 = mm64(sP, sVt, wr, wc, lane, zero16());
      f32x16 o2 = mm64(sQ, sCt, wr, wc, lane, zero16());
      {
        const int r4 = tid >> 2, sg4 = (tid & 3) * 16;
        float rs = 0.f, qn = 0.f;
#pragma unroll
        for (int e = 0; e < 16; ++e) { rs += bf2f(sP[r4 * LDB + sg4 + e]); qn += bf2f(sQ[r4 * LDB + sg4 + e]) * s_n[sg4 + e]; }
        rs = red4(rs); qn = red4(qn);
        const float den = rs + qn * s_ew[r4];
        const float mt = s_b[r4] + s_M[r4];
        if ((tid & 3) == 0) s_dinv[r4] = 1.f / fmaxf(fabsf(den), __expf(-mt));
      }
#pragma unroll
      for (int idx = 0; idx < 16; ++idx) st[idx] *= sp;
      st = mm64(sVt, sKt, wr, wc, lane, st);
      if (tid < 64) {
        float a = s_n[tid] * sp;
        for (int j = 0; j < 64; ++j) a += bf2f(sKt[tid * LDB + j]);
        s_n2[tid] = a;
      }
      __syncthreads();
#pragma unroll
      for (int idx = 0; idx < 16; ++idx) {
        const int i = ACC_ROW(idx), e = ACC_COL;
        const int pp = c * 64 + i; const int tt = z ? (T - 1 - pp) : pp;
        P.hdir[((size_t)z * NTOK + gs + tt) * DM + h * 64 + e] = f2bf((o1[idx] + s_ew[i] * o2[idx]) * s_dinv[i]);
      }
#pragma unroll
      for (int idx = 0; idx < 16; ++idx) sCt[ACC_ROW(idx) * LDB + ACC_COL] = f2bf(st[idx]);
      __syncthreads();
    }
  }
#undef ML_SET
#undef ML_GATE
}

DEV void delta_T_item(const Params& P, int l, int item, char* smem, const int tid_in) {
  const int tid = opaque_i(tid_in);
  const int lane = tid & 63, w = tid >> 6, wr = w >> 1, wc = w & 1;
  const int tile = item & 127, zh = item >> 7, z = zh >> 2, h = zh & 3;
  int gs, T, ci; tok_info(tile * 64, gs, T, ci);
  float* sA = (float*)smem;
  float* s_beta = sA + 2016; float* s_gc = s_beta + 64;
  bf16_t* sK = (bf16_t*)(smem + 8576); bf16_t* sT = sK + 64 * LDB;
  const float aneg = -__expf(P.delta_a_log[(l * 2 + z) * 4 + h]), dtb = P.delta_dt_bias[(l * 2 + z) * 4 + h];
  {
    const int row = tid >> 2, seg = (tid & 3) * 16;
    const int g = tile * 64 + (z ? 63 - row : row);
    const bf16_t* src = P.ubuf + (size_t)g * 768 + 256 + h * 64 + seg;
    *(uint4*)(sK + row * LDB + seg) = *(const uint4*)src; *(uint4*)(sK + row * LDB + seg + 8) = *(const uint4*)(src + 8);
  }
  if (w == 0) {
    const int g = tile * 64 + (z ? 63 - lane : lane);
    const float* gp = P.projABC + (size_t)g * NABC + 2064 + z * 4 + h;
    const float beta = sigmoidf_(gp[0]);
    const float gj = aneg * softplusf_(gp[8] + dtb);
    const float gc = wave_incl_scan_add(gj, lane);
    s_beta[lane] = beta; s_gc[lane] = gc;
    P.dbeta[(size_t)zh * NTOK + g] = beta; P.dgc[(size_t)zh * NTOK + g] = gc;
  }
  __syncthreads();
  {
    f32x16 kkm = mm64(sK, sK, wr, wc, lane, zero16());
#pragma unroll
    for (int idx = 0; idx < 16; ++idx) {
      const int i = ACC_ROW(idx), j = ACC_COL;
      const float av = kkm[idx] * __expf(s_gc[i] - s_gc[j]) * s_beta[i];
      if (i > j) sA[i * (i - 1) / 2 + j] = av;
      if (w == 2) sT[i * LDB + j] = f2bf(av);
    }
  }
  __syncthreads();
  if (w < 2 && lane < 32) {
    const int o = w * 32;
    float x[32];
    const float flane = (float)lane;
#pragma unroll
    for (int i = 0; i < 32; ++i) {
      float a = fmaxf(0.f, 1.f - fabsf(flane - (float)i));
      const float* arow = sA + (o + i) * (o + i - 1) / 2 + o;
#pragma unroll
      for (int j = 0; j < i; ++j) a -= arow[j] * x[j];
      x[i] = a;
      sT[(o + i) * LDB + o + lane] = f2bf(a);
      if (w == 0) sT[lane * LDB + 32 + i] = f2bf(a);
    }
  }
  __syncthreads();
  if (w == 0) {
    const bf16_t* aA = sT + (32 + (lane & 31)) * LDB + (lane >> 5) * 8;
    const bf16_t* bT = sT + (lane & 31) * LDB + 32 + (lane >> 5) * 8;
    f32x16 m1 = zero16();
#pragma unroll
    for (int s2 = 0; s2 < 2; ++s2) m1 = __builtin_amdgcn_mfma_f32_32x32x16_bf16(*(const bf16x8*)(aA + s2 * 16), *(const bf16x8*)(bT + s2 * 16), m1, 0, 0, 0);
#pragma unroll
    for (int g4 = 0; g4 < 4; ++g4) {
      uint2 o2; o2.x = pack2(m1[4 * g4], m1[4 * g4 + 1]); o2.y = pack2(m1[4 * g4 + 2], m1[4 * g4 + 3]);
      *(uint2*)(sT + (lane & 31) * LDB + 32 + 8 * g4 + 4 * (lane >> 5)) = o2;
    }
    const bf16_t* a2 = sT + (32 + (lane & 31)) * LDB + 32 + (lane >> 5) * 8;
    f32x16 m2 = zero16();
#pragma unroll
    for (int s2 = 0; s2 < 2; ++s2) m2 = __builtin_amdgcn_mfma_f32_32x32x16_bf16(*(const bf16x8*)(a2 + s2 * 16), *(const bf16x8*)(bT + s2 * 16), m2, 0, 0, 0);
#pragma unroll
    for (int idx = 0; idx < 16; ++idx) sT[(32 + (idx & 3) + 8 * (idx >> 2) + 4 * (lane >> 5)) * LDB + (lane & 31)] = f2bf(-m2[idx]);
    *(uint4*)(sT + (lane & 31) * LDB + 32 + (lane >> 5) * 16) = make_uint4(0u, 0u, 0u, 0u);
    *(uint4*)(sT + (lane & 31) * LDB + 32 + (lane >> 5) * 16 + 8) = make_uint4(0u, 0u, 0u, 0u);
  }
  __syncthreads();
  {
    const int row = tid >> 2, seg = (tid & 3) * 16;
    bf16_t* dst = P.dT + ((size_t)item * 64 + row) * 64 + seg;
    *(uint4*)dst = *(const uint4*)(sT + row * LDB + seg); *(uint4*)(dst + 8) = *(const uint4*)(sT + row * LDB + seg + 8);
  }
  __syncthreads();
}

DEV void delta_task(const Params& P, int l, int task, const int z, char* smem, const int tid_in, const bool active) {
  const int tid = opaque_i(tid_in);
  const int lane = tid & 63, w = tid >> 6, wr = w >> 1, wc = w & 1;
  int seq, h; bool sample; decode_chain(task, seq, h, sample);
  int gs, T; seq_base(seq, gs, T);
  if (!active) { for (int c = 0; c < T / 64; ++c) { __syncthreads(); __syncthreads(); __syncthreads(); __syncthreads(); __syncthreads(); __syncthreads(); } return; }
  float* s_beta = (float*)smem; float* s_gc = s_beta + 64;
  bf16_t* sQ = (bf16_t*)(smem + 512); bf16_t* sK = sQ + 64 * LDB; bf16_t* sKbt = sK + 64 * LDB; bf16_t* sKgt = sKbt + 64 * LDB; bf16_t* sVbt = sKgt + 64 * LDB; bf16_t* sT = sVbt + 64 * LDB; bf16_t* sSt = sT + 64 * LDB;
  bf16_t* sW = sKbt; bf16_t* sVnt = sVbt; bf16_t* sP = sT;
  f32x16 st = zero16();
  if (sample) {
    const float* s0 = P.st_delta + ((size_t)(((seq - 16) * 2 + l) * 2 + z) * 4 + h) * 4096;
#pragma unroll
    for (int idx = 0; idx < 16; ++idx) st[idx] = s0[ACC_COL * 64 + ACC_ROW(idx)];
  }
#pragma unroll
  for (int idx = 0; idx < 16; ++idx) sSt[ACC_ROW(idx) * LDB + ACC_COL] = f2bf(st[idx]);
  const int nch = T / 64;
  const int tid_outer = tid;
  const int zh = z * 4 + h;
  uint4 nq0, nq1, nk0, nk1, nv0, nv1, nt0, nt1; float nbeta, ngc, nglast;
#define DELTA_PREFETCH(C) { \
    const int r_ = tid_outer & 63, sg_ = (tid_outer >> 6) * 16; \
    const int p_ = (C) * 64 + r_; const int g_ = gs + (z ? (T - 1 - p_) : p_); \
    const bf16_t* src_ = P.ubuf + (size_t)g_ * 768 + h * 64 + sg_; \
    nq0 = *(const uint4*)src_; nq1 = *(const uint4*)(src_ + 8); nk0 = *(const uint4*)(src_ + 256); nk1 = *(const uint4*)(src_ + 264); nv0 = *(const uint4*)(src_ + 512); nv1 = *(const uint4*)(src_ + 520); \
    const int tile_ = (gs >> 6) + (z ? (nch - 1 - (C)) : (C)); \
    const bf16_t* tsrc_ = P.dT + (((size_t)zh * 128 + tile_) * 64 + r_) * 64 + sg_; \
    nt0 = *(const uint4*)tsrc_; nt1 = *(const uint4*)(tsrc_ + 8); \
    nbeta = P.dbeta[(size_t)zh * NTOK + g_]; ngc = P.dgc[(size_t)zh * NTOK + g_]; \
    const int pl_ = (C) * 64 + 63; nglast = P.dgc[(size_t)zh * NTOK + gs + (z ? (T - 1 - pl_) : pl_)]; }
  DELTA_PREFETCH(0)
  for (int c = 0; c < nch; ++c) {
    const int tid = opaque_i(tid_outer);
    const int lane = tid & 63, w = tid >> 6, wr = w >> 1, wc = w & 1;
    const int row = tid & 63, seg = (tid >> 6) * 16;
    {
      const uint4 cq0 = nq0, cq1 = nq1, ck0 = nk0, ck1 = nk1, cv0 = nv0, cv1 = nv1, ct0 = nt0, ct1 = nt1;
      const float bj = nbeta, gcj = ngc, glast = nglast;
      float k[16], v[16];
      { const unsigned kw[8] = {ck0.x, ck0.y, ck0.z, ck0.w, ck1.x, ck1.y, ck1.z, ck1.w}, vw[8] = {cv0.x, cv0.y, cv0.z, cv0.w, cv1.x, cv1.y, cv1.z, cv1.w};
#pragma unroll
        for (int e = 0; e < 8; ++e) { k[2 * e] = __uint_as_float(kw[e] << 16); k[2 * e + 1] = __uint_as_float(kw[e] & 0xffff0000u); v[2 * e] = __uint_as_float(vw[e] << 16); v[2 * e + 1] = __uint_as_float(vw[e] & 0xffff0000u); } }
      if (w == 0) { s_beta[row] = bj; s_gc[row] = gcj; }
      const float f1 = bj * __expf(gcj), f2 = __expf(glast - gcj);
      *(uint4*)(sQ + row * LDB + seg) = cq0; *(uint4*)(sQ + row * LDB + seg + 8) = cq1;
      *(uint4*)(sK + row * LDB + seg) = ck0; *(uint4*)(sK + row * LDB + seg + 8) = ck1;
      *(uint4*)(sT + row * LDB + seg) = ct0; *(uint4*)(sT + row * LDB + seg + 8) = ct1;
#pragma unroll
      for (int e = 0; e < 16; ++e) {
        sKbt[(seg + e) * LDB + row] = f2bf(k[e] * f1);
        sKgt[(seg + e) * LDB + row] = f2bf(k[e] * f2);
        sVbt[(seg + e) * LDB + row] = f2bf(v[e] * bj);
      }
    }
    __syncthreads();
    if (c + 1 < nch) DELTA_PREFETCH(c + 1)
    f32x16 U = mm64(sT, sVbt, wr, wc, lane, zero16());
    f32x16 Wm = mm64(sT, sKbt, wr, wc, lane, zero16());
    f32x16 qk = mm64(sQ, sK, wr, wc, lane, zero16());
    __syncthreads();
#pragma unroll
    for (int idx = 0; idx < 16; ++idx) {
      const int i = ACC_ROW(idx), j = ACC_COL;
      sW[i * LDB + j] = f2bf(Wm[idx]);
      sP[i * LDB + j] = f2bf((i >= j) ? qk[idx] * __expf(s_gc[i] - s_gc[j]) : 0.f);
    }
    __syncthreads();
    {
      f32x16 ws = mm64(sW, sSt, wr, wc, lane, zero16());
#pragma unroll
      for (int g4 = 0; g4 < 4; ++g4) {
        const int e = ACC_COL, i0 = wr * 32 + 8 * g4 + 4 * (lane >> 5);
        uint2 o; o.x = pack2(U[4 * g4] - ws[4 * g4], U[4 * g4 + 1] - ws[4 * g4 + 1]); o.y = pack2(U[4 * g4 + 2] - ws[4 * g4 + 2], U[4 * g4 + 3] - ws[4 * g4 + 3]);
        *(uint2*)(sVnt + e * LDB + i0) = o;
      }
    }
    __syncthreads();
    f32x16 o1 = mm64(sP, sVnt, wr, wc, lane, zero16());
    f32x16 o2 = mm64(sQ, sSt, wr, wc, lane, zero16());
#pragma unroll
    for (int idx = 0; idx < 16; ++idx) {
      const int i = ACC_ROW(idx), e = ACC_COL;
      const int pp = c * 64 + i; const int tt = z ? (T - 1 - pp) : pp;
      P.hdir[((size_t)z * NTOK + gs + tt) * DM + 256 + h * 64 + e] = f2bf(o1[idx] + __expf(s_gc[i]) * o2[idx]);
    }
    const float egl = __expf(s_gc[63]);
#pragma unroll
    for (int idx = 0; idx < 16; ++idx) st[idx] *= egl;
    st = mm64(sVnt, sKgt, wr, wc, lane, st);
    __syncthreads();
#pragma unroll
    for (int idx = 0; idx < 16; ++idx) sSt[ACC_ROW(idx) * LDB + ACC_COL] = f2bf(st[idx]);
    __syncthreads();
  }
  if (!sample) {
    float* o = P.out + O_DELTA + ((size_t)((seq * 2 + l) * 2 + z) * 4 + h) * 4096;
#pragma unroll
    for (int idx = 0; idx < 16; ++idx) o[ACC_COL * 64 + ACC_ROW(idx)] = st[idx];
  }
}

DEV void delta_sample_task(const Params& P, int l, int task, const int z, char* smem0, const int tid_all_in) {
  const int tid_all = opaque_i(tid_all_in);
  const int half = tid_all >> 8, tid = tid_all & 255;
  int seq, h; bool sample; decode_chain(task, seq, h, sample);
  int gs, T; seq_base(seq, gs, T);
  const int nch = T / 64;
  const int zh = z * 4 + h;
#define DL_GATE(B) ((float*)(smem0 + (B) * HALF_LDS))
#define DL_SET(B) ((bf16_t*)(smem0 + (B) * HALF_LDS + 512))
  bf16_t* sSt = DL_SET(0) + 6 * 64 * LDB;
  if (half == 1) {
    uint4 nq0, nq1, nk0, nk1, nv0, nv1, nt0, nt1; float nbeta, ngc, nglast;
#define DL_PREFETCH(C) { \
      const int r_ = tid & 63, sg_ = (tid >> 6) * 16; \
      const int p_ = (C) * 64 + r_; const int g_ = gs + (z ? (T - 1 - p_) : p_); \
      const bf16_t* src_ = P.ubuf + (size_t)g_ * 768 + h * 64 + sg_; \
      nq0 = *(const uint4*)src_; nq1 = *(const uint4*)(src_ + 8); nk0 = *(const uint4*)(src_ + 256); nk1 = *(const uint4*)(src_ + 264); nv0 = *(const uint4*)(src_ + 512); nv1 = *(const uint4*)(src_ + 520); \
      const int tile_ = (gs >> 6) + (z ? (nch - 1 - (C)) : (C)); \
      const bf16_t* tsrc_ = P.dT + (((size_t)zh * 128 + tile_) * 64 + r_) * 64 + sg_; \
      nt0 = *(const uint4*)tsrc_; nt1 = *(const uint4*)(tsrc_ + 8); \
      nbeta = P.dbeta[(size_t)zh * NTOK + g_]; ngc = P.dgc[(size_t)zh * NTOK + g_]; \
      const int pl_ = (C) * 64 + 63; nglast = P.dgc[(size_t)zh * NTOK + gs + (z ? (T - 1 - pl_) : pl_)]; }
#define DL_STAGE(C) { \
      float* s_beta = DL_GATE((C) & 1); float* s_gc = s_beta + 64; \
      bf16_t* sQ = DL_SET((C) & 1); bf16_t* sK = sQ + 64 * LDB; bf16_t* sKbt = sK + 64 * LDB; bf16_t* sKgt = sKbt + 64 * LDB; bf16_t* sVbt = sKgt + 64 * LDB; bf16_t* sT = sVbt + 64 * LDB; \
      const int row = tid & 63, seg = (tid >> 6) * 16, w = tid >> 6; \
      const float bj = nbeta, gcj = ngc, glast = nglast; \
      float k[16], v[16]; \
      { const unsigned kw[8] = {nk0.x, nk0.y, nk0.z, nk0.w, nk1.x, nk1.y, nk1.z, nk1.w}, vw[8] = {nv0.x, nv0.y, nv0.z, nv0.w, nv1.x, nv1.y, nv1.z, nv1.w}; \
        _Pragma("unroll") for (int e = 0; e < 8; ++e) { k[2 * e] = __uint_as_float(kw[e] << 16); k[2 * e + 1] = __uint_as_float(kw[e] & 0xffff0000u); v[2 * e] = __uint_as_float(vw[e] << 16); v[2 * e + 1] = __uint_as_float(vw[e] & 0xffff0000u); } } \
      if (w == 0) { s_beta[row] = bj; s_gc[row] = gcj; } \
      const float f1 = bj * __expf(gcj), f2 = __expf(glast - gcj); \
      *(uint4*)(sQ + row * LDB + seg) = nq0; *(uint4*)(sQ + row * LDB + seg + 8) = nq1; \
      *(uint4*)(sK + row * LDB + seg) = nk0; *(uint4*)(sK + row * LDB + seg + 8) = nk1; \
      *(uint4*)(sT + row * LDB + seg) = nt0; *(uint4*)(sT + row * LDB + seg + 8) = nt1; \
      _Pragma("unroll") for (int e = 0; e < 16; ++e) { \
        sKbt[(seg + e) * LDB + row] = f2bf(k[e] * f1); \
        sKgt[(seg + e) * LDB + row] = f2bf(k[e] * f2); \
        sVbt[(seg + e) * LDB + row] = f2bf(v[e] * bj); } }
    DL_PREFETCH(0)
    DL_STAGE(0)
    if (nch > 1) DL_PREFETCH(1)
    __syncthreads();
    for (int c = 0; c < nch; ++c) {
      if (c + 1 < nch) { DL_STAGE(c + 1) if (c + 2 < nch) DL_PREFETCH(c + 2) }
      __syncthreads(); __syncthreads(); __syncthreads(); __syncthreads(); __syncthreads();
    }
#undef DL_PREFETCH
#undef DL_STAGE
  } else {
    const int lane = tid & 63, w = tid >> 6, wr = w >> 1, wc = w & 1;
    f32x16 st = zero16();
    {
      const float* s0 = P.st_delta + ((size_t)(((seq - 16) * 2 + l) * 2 + z) * 4 + h) * 4096;
#pragma unroll
      for (int idx = 0; idx < 16; ++idx) st[idx] = s0[ACC_COL * 64 + ACC_ROW(idx)];
    }
#pragma unroll
    for (int idx = 0; idx < 16; ++idx) sSt[ACC_ROW(idx) * LDB + ACC_COL] = f2bf(st[idx]);
    __syncthreads();
    for (int c = 0; c < nch; ++c) {
      const float* s_gc = DL_GATE(c & 1) + 64;
      bf16_t* sQ = DL_SET(c & 1); bf16_t* sK = sQ + 64 * LDB; bf16_t* sKbt = sK + 64 * LDB; bf16_t* sKgt = sKbt + 64 * LDB; bf16_t* sVbt = sKgt + 64 * LDB; bf16_t* sT = sVbt + 64 * LDB;
      bf16_t* sW = sKbt; bf16_t* sVnt = sVbt; bf16_t* sP = sT;
      f32x16 U = mm64(sT, sVbt, wr, wc, lane, zero16());
      f32x16 Wm = mm64(sT, sKbt, wr, wc, lane, zero16());
      f32x16 qk = mm64(sQ, sK, wr, wc, lane, zero16());
      __syncthreads();
#pragma unroll
      for (int idx = 0; idx < 16; ++idx) {
        const int i = ACC_ROW(idx), j = ACC_COL;
        sW[i * LDB + j] = f2bf(Wm[idx]);
        sP[i * LDB + j] = f2bf((i >= j) ? qk[idx] * __expf(s_gc[i] - s_gc[j]) : 0.f);
      }
      __syncthreads();
      {
        f32x16 ws = mm64(sW, sSt, wr, wc, lane, zero16());
#pragma unroll
        for (int g4 = 0; g4 < 4; ++g4) {
          const int e = ACC_COL, i0 = wr * 32 + 8 * g4 + 4 * (lane >> 5);
          uint2 o; o.x = pack2(U[4 * g4] - ws[4 * g4], U[4 * g4 + 1] - ws[4 * g4 + 1]); o.y = pack2(U[4 * g4 + 2] - ws[4 * g4 + 2], U[4 * g4 + 3] - ws[4 * g4 + 3]);
          *(uint2*)(sVnt + e * LDB + i0) = o;
        }
      }
      __syncthreads();
      f32x16 o1 = mm64(sP, sVnt, wr, wc, lane, zero16());
      f32x16 o2 = mm64(sQ, sSt, wr, wc, lane, zero16());
#pragma unroll
      for (int idx = 0; idx < 16; ++idx) {
        const int i = ACC_ROW(idx), e = ACC_COL;
        const int pp = c * 64 + i; const int tt = z ? (T - 1 - pp) : pp;
        P.hdir[((size_t)z * NTOK + gs + tt) * DM + 256 + h * 64 + e] = f2bf(o1[idx] + __expf(s_gc[i]) * o2[idx]);
      }
      const float egl = __expf(s_gc[63]);
#pragma unroll
      for (int idx = 0; idx < 16; ++idx) st[idx] *= egl;
      st = mm64(sVnt, sKgt, wr, wc, lane, st);
      __syncthreads();
#pragma unroll
      for (int idx = 0; idx < 16; ++idx) sSt[ACC_ROW(idx) * LDB + ACC_COL] = f2bf(st[idx]);
      __syncthreads();
    }
  }
#undef DL_GATE
#undef DL_SET
}

template <int RWAVES>
DEV void rwkv_task(const Params& P, int l, int task, const int z, char* smem, const int tid_in, const bool active) {
  const int tid = opaque_i(tid_in);
  constexpr int NR = 4 * RWAVES, NRB = 64 / NR;
  const int chain = task / NRB, rb = task % NRB;
  int seq, h; bool sample; decode_chain(chain, seq, h, sample);
  int gs, T; seq_base(seq, gs, T);
  if (!active) { for (int c = 0; c < T / 32; ++c) { __syncthreads(); __syncthreads(); } return; }
  float* s_kh = (float*)smem; float* s_w = s_kh + 2048; float* s_b = s_w + 2048; float* s_kt = s_b + 2048; float* s_r = s_kt + 2048; float* s_v = s_r + 2048; float* s_yp = s_v + 512;
  const int rl = tid >> 4, cg4 = (tid & 15) * 4;
  const int irow = rb * NR + (rl & (NR - 1));
  const bool rowthread = tid < 64 * RWAVES;
  float S0 = 0.f, S1 = 0.f, S2 = 0.f, S3 = 0.f;
  if (sample) {
    const float4 s4 = *(const float4*)(P.st_rwkv + ((size_t)(((seq - 16) * 2 + l) * 2 + z) * 4 + h) * 4096 + irow * 64 + cg4);
    S0 = s4.x; S1 = s4.y; S2 = s4.z; S3 = s4.w;
  }
  const int si = tid >> 3, sc = (tid & 7) * 8;
  float kkc[8], kac[8], rkc[8];
#pragma unroll
  for (int e = 0; e < 8; ++e) { kkc[e] = P.rwkv_kk[l * 256 + h * 64 + sc + e]; kac[e] = P.rwkv_ka[l * 256 + h * 64 + sc + e]; rkc[e] = P.rwkv_rk[(l * 4 + h) * 64 + sc + e]; }
  const int nch = T / 32;
  float4 pr0, pr1, pk0, pk1, pw0, pw1, pa0, pa1, pv_ = make_float4(0.f, 0.f, 0.f, 0.f); float pinv;
#define RWKV_PREFETCH(C) { \
    const int p_ = (C) * 32 + si; const int t_ = z ? (T - 1 - p_) : p_; const int g_ = gs + t_; \
    const float* rk_ = P.rkv + (size_t)g_ * 768 + h * 64 + sc; \
    pr0 = *(const float4*)rk_; pr1 = *(const float4*)(rk_ + 4); \
    pk0 = *(const float4*)(rk_ + 256); pk1 = *(const float4*)(rk_ + 260); \
    const float* wp_ = P.wa + ((size_t)(g_ * 2 + z) * 2) * 256 + h * 64 + sc; \
    pw0 = *(const float4*)wp_; pw1 = *(const float4*)(wp_ + 4); \
    pa0 = *(const float4*)(wp_ + 256); pa1 = *(const float4*)(wp_ + 260); \
    pinv = P.khinv[g_ * 4 + h]; \
    if (tid < 8 * NR) { \
      const int p2_ = (C) * 32 + (tid / (NR / 4)); const int t2_ = z ? (T - 1 - p2_) : p2_; \
      pv_ = *(const float4*)(P.rkv + (size_t)(gs + t2_) * 768 + 512 + h * 64 + rb * NR + (tid % (NR / 4)) * 4); \
    } }
  RWKV_PREFETCH(0)
  for (int c = 0; c < nch; ++c) {
    {
      const float rr[8] = {pr0.x, pr0.y, pr0.z, pr0.w, pr1.x, pr1.y, pr1.z, pr1.w};
      const float kk[8] = {pk0.x, pk0.y, pk0.z, pk0.w, pk1.x, pk1.y, pk1.z, pk1.w};
      const float aa[8] = {pa0.x, pa0.y, pa0.z, pa0.w, pa1.x, pa1.y, pa1.z, pa1.w};
      float bsum = 0.f;
      float okh[8], ob[8], okt[8];
#pragma unroll
      for (int e = 0; e < 8; ++e) {
        okh[e] = kk[e] * kkc[e] * pinv; ob[e] = aa[e] * okh[e]; okt[e] = kk[e] * (1.f + (aa[e] - 1.f) * kac[e]);
        bsum += rr[e] * okt[e] * rkc[e];
      }
      float* d;
      d = s_kh + si * 64 + sc; *(float4*)d = make_float4(okh[0], okh[1], okh[2], okh[3]); *(float4*)(d + 4) = make_float4(okh[4], okh[5], okh[6], okh[7]);
      d = s_w + si * 64 + sc; *(float4*)d = pw0; *(float4*)(d + 4) = pw1;
      d = s_b + si * 64 + sc; *(float4*)d = make_float4(ob[0], ob[1], ob[2], ob[3]); *(float4*)(d + 4) = make_float4(ob[4], ob[5], ob[6], ob[7]);
      d = s_kt + si * 64 + sc; *(float4*)d = make_float4(okt[0], okt[1], okt[2], okt[3]); *(float4*)(d + 4) = make_float4(okt[4], okt[5], okt[6], okt[7]);
      d = s_r + si * 64 + sc; *(float4*)d = pr0; *(float4*)(d + 4) = pr1;
      if (tid < 8 * NR) *(float4*)(s_v + (tid / (NR / 4)) * NR + (tid % (NR / 4)) * 4) = pv_;
      bsum += dppf<0xB1>(bsum); bsum += dppf<0x4E>(bsum); bsum += dppf<0x141>(bsum);
      if (rb == 0 && (tid & 7) == 0) {
        const int p = c * 32 + si; const int t = z ? (T - 1 - p) : p;
        P.bonus[((size_t)z * NTOK + gs + t) * 4 + h] = bsum;
      }
    }
    __syncthreads();
    if (c + 1 < nch) RWKV_PREFETCH(c + 1)
    if (rowthread) {
      typedef float v2f __attribute__((ext_vector_type(2)));
      typedef float v4f __attribute__((ext_vector_type(4)));
      v2f Sa = {S0, S1}, Sb = {S2, S3};
      v4f kh = *(const v4f*)(s_kh + cg4), ww = *(const v4f*)(s_w + cg4), bb = *(const v4f*)(s_b + cg4), kt = *(const v4f*)(s_kt + cg4), rr = *(const v4f*)(s_r + cg4);
      float vi = s_v[rl];
#pragma unroll 8
      for (int i = 0; i < 32; ++i) {
        const int in = (i + 1) & 31;
        const v4f kh_n = *(const v4f*)(s_kh + in * 64 + cg4);
        const v4f ww_n = *(const v4f*)(s_w + in * 64 + cg4);
        const v4f bb_n = *(const v4f*)(s_b + in * 64 + cg4);
        const v4f kt_n = *(const v4f*)(s_kt + in * 64 + cg4);
        const v4f rr_n = *(const v4f*)(s_r + in * 64 + cg4);
        const float vi_n = s_v[in * NR + rl];
        const v2f v2 = {vi, vi};
        const v2f pp = __builtin_elementwise_fma(Sb, kh.zw, Sa * kh.xy);
        const float sk = red16(pp.x + pp.y);
        const v2f sk2 = {sk, sk};
        Sa = __builtin_elementwise_fma(-sk2, bb.xy, __builtin_elementwise_fma(v2, kt.xy, Sa * ww.xy));
        Sb = __builtin_elementwise_fma(-sk2, bb.zw, __builtin_elementwise_fma(v2, kt.zw, Sb * ww.zw));
        const v2f qq = __builtin_elementwise_fma(Sb, rr.zw, Sa * rr.xy);
        s_yp[i * (64 * RWAVES) + tid] = qq.x + qq.y;
        kh = kh_n; ww = ww_n; bb = bb_n; kt = kt_n; rr = rr_n; vi = vi_n;
      }
      S0 = Sa.x; S1 = Sa.y; S2 = Sb.x; S3 = Sb.y;
    }
    __syncthreads();
    {
      const int i = tid >> 3, q2 = tid & 7;
      const int p = c * 32 + i; const int t = z ? (T - 1 - p) : p;
      if (NR == 16) {
        const float* y0 = s_yp + i * 256 + (2 * q2) * 16;
        float a0 = 0.f, a1 = 0.f;
#pragma unroll
        for (int e = 0; e < 16; e += 4) { const float4 u0 = *(const float4*)(y0 + e), u1 = *(const float4*)(y0 + 16 + e); a0 += (u0.x + u0.y) + (u0.z + u0.w); a1 += (u1.x + u1.y) + (u1.z + u1.w); }
        *(unsigned*)(P.hdir + ((size_t)z * NTOK + gs + t) * DM + 768 + h * 64 + rb * 16 + 2 * q2) = pack2(a0, a1);
      } else {
        const float* y0 = s_yp + i * (64 * RWAVES) + q2 * 16;
        float a0 = 0.f;
#pragma unroll
        for (int e = 0; e < 16; e += 4) { const float4 u0 = *(const float4*)(y0 + e); a0 += (u0.x + u0.y) + (u0.z + u0.w); }
        P.hdir[((size_t)z * NTOK + gs + t) * DM + 768 + h * 64 + rb * NR + q2] = f2bf(a0);
      }
    }
  }
  if (!sample && rowthread) {
    *(float4*)(P.out + O_RWKV + ((size_t)((seq * 2 + l) * 2 + z) * 4 + h) * 4096 + irow * 64 + cg4) = make_float4(S0, S1, S2, S3);
  }
}

DEV void rwkv_prompt_task(const Params& P, int l, int task, const int z, char* smem, const int tid_in) {
  const int tid = opaque_i(tid_in);
  const int chain = task >> 1, rb = task & 1;
  int seq, h; bool sample; decode_chain(chain, seq, h, sample);
  int gs, T; seq_base(seq, gs, T);
  float* s_kh = (float*)smem; float* s_w = s_kh + 2048; float* s_b = s_w + 2048; float* s_kt = s_b + 2048; float* s_r = s_kt + 2048; float* s_v = s_r + 2048; float* s_yp = s_v + 1024;
  const int rp = tid >> 4, cg4 = (tid & 15) * 4;
  const int irow = rb * 32 + 2 * rp;
  typedef float v2f __attribute__((ext_vector_type(2)));
  typedef float v4f __attribute__((ext_vector_type(4)));
  v2f Aa = {0.f, 0.f}, Ab = {0.f, 0.f}, Ba = {0.f, 0.f}, Bb = {0.f, 0.f};
  if (sample) {
    const float* sp0 = P.st_rwkv + ((size_t)(((seq - 16) * 2 + l) * 2 + z) * 4 + h) * 4096 + irow * 64 + cg4;
    const float4 a4 = *(const float4*)sp0, b4 = *(const float4*)(sp0 + 64);
    Aa.x = a4.x; Aa.y = a4.y; Ab.x = a4.z; Ab.y = a4.w; Ba.x = b4.x; Ba.y = b4.y; Bb.x = b4.z; Bb.y = b4.w;
  }
  const int si = tid >> 3, sc = (tid & 7) * 8;
  float kkc[8], kac[8], rkc[8];
#pragma unroll
  for (int e = 0; e < 8; ++e) { kkc[e] = P.rwkv_kk[l * 256 + h * 64 + sc + e]; kac[e] = P.rwkv_ka[l * 256 + h * 64 + sc + e]; rkc[e] = P.rwkv_rk[(l * 4 + h) * 64 + sc + e]; }
  const int nch = T / 32;
  float4 pr0, pr1, pk0, pk1, pw0, pw1, pa0, pa1, pv_; float pinv;
#define RP_PREFETCH(C) { \
    const int p_ = (C) * 32 + si; const int t_ = z ? (T - 1 - p_) : p_; const int g_ = gs + t_; \
    const float* rk_ = P.rkv + (size_t)g_ * 768 + h * 64 + sc; \
    pr0 = *(const float4*)rk_; pr1 = *(const float4*)(rk_ + 4); \
    pk0 = *(const float4*)(rk_ + 256); pk1 = *(const float4*)(rk_ + 260); \
    const float* wp_ = P.wa + ((size_t)(g_ * 2 + z) * 2) * 256 + h * 64 + sc; \
    pw0 = *(const float4*)wp_; pw1 = *(const float4*)(wp_ + 4); \
    pa0 = *(const float4*)(wp_ + 256); pa1 = *(const float4*)(wp_ + 260); \
    pinv = P.khinv[g_ * 4 + h]; \
    pv_ = *(const float4*)(P.rkv + (size_t)g_ * 768 + 512 + h * 64 + rb * 32 + (tid & 7) * 4); }
  RP_PREFETCH(0)
  for (int c = 0; c < nch; ++c) {
    {
      const float rr[8] = {pr0.x, pr0.y, pr0.z, pr0.w, pr1.x, pr1.y, pr1.z, pr1.w};
      const float kk[8] = {pk0.x, pk0.y, pk0.z, pk0.w, pk1.x, pk1.y, pk1.z, pk1.w};
      const float aa[8] = {pa0.x, pa0.y, pa0.z, pa0.w, pa1.x, pa1.y, pa1.z, pa1.w};
      float bsum = 0.f;
      float okh[8], ob[8], okt[8];
#pragma unroll
      for (int e = 0; e < 8; ++e) {
        okh[e] = kk[e] * kkc[e] * pinv; ob[e] = aa[e] * okh[e]; okt[e] = kk[e] * (1.f + (aa[e] - 1.f) * kac[e]);
        bsum += rr[e] * okt[e] * rkc[e];
      }
      float* d;
      d = s_kh + si * 64 + sc; *(float4*)d = make_float4(okh[0], okh[1], okh[2], okh[3]); *(float4*)(d + 4) = make_float4(okh[4], okh[5], okh[6], okh[7]);
      d = s_w + si * 64 + sc; *(float4*)d = pw0; *(float4*)(d + 4) = pw1;
      d = s_b + si * 64 + sc; *(float4*)d = make_float4(ob[0], ob[1], ob[2], ob[3]); *(float4*)(d + 4) = make_float4(ob[4], ob[5], ob[6], ob[7]);
      d = s_kt + si * 64 + sc; *(float4*)d = make_float4(okt[0], okt[1], okt[2], okt[3]); *(float4*)(d + 4) = make_float4(okt[4], okt[5], okt[6], okt[7]);
      d = s_r + si * 64 + sc; *(float4*)d = pr0; *(float4*)(d + 4) = pr1;
      *(float4*)(s_v + si * 32 + (tid & 7) * 4) = pv_;
      bsum += dppf<0xB1>(bsum); bsum += dppf<0x4E>(bsum); bsum += dppf<0x141>(bsum);
      if (rb == 0 && (tid & 7) == 0) {
        const int p = c * 32 + si; const int t = z ? (T - 1 - p) : p;
        P.bonus[((size_t)z * NTOK + gs + t) * 4 + h] = bsum;
      }
    }
    __syncthreads();
    if (c + 1 < nch) RP_PREFETCH(c + 1)
    {
      v4f kh = *(const v4f*)(s_kh + cg4), ww = *(const v4f*)(s_w + cg4), bb = *(const v4f*)(s_b + cg4), kt = *(const v4f*)(s_kt + cg4), rr = *(const v4f*)(s_r + cg4);
      v2f vv = *(const v2f*)(s_v + 2 * rp);
      float* ypw = s_yp + (2 * rp) * 4 + ((tid & 15) >> 2);
#pragma unroll 8
      for (int i = 0; i < 32; ++i) {
        const int in = (i + 1) & 31;
        const v4f kh_n = *(const v4f*)(s_kh + in * 64 + cg4);
        const v4f ww_n = *(const v4f*)(s_w + in * 64 + cg4);
        const v4f bb_n = *(const v4f*)(s_b + in * 64 + cg4);
        const v4f kt_n = *(const v4f*)(s_kt + in * 64 + cg4);
        const v4f rr_n = *(const v4f*)(s_r + in * 64 + cg4);
        const v2f vv_n = *(const v2f*)(s_v + in * 32 + 2 * rp);
        const v2f va = {vv.x, vv.x}, vb = {vv.y, vv.y};
        const v2f pa = __builtin_elementwise_fma(Ab, kh.zw, Aa * kh.xy), pb = __builtin_elementwise_fma(Bb, kh.zw, Ba * kh.xy);
        const float ska = red16(pa.x + pa.y), skb = red16(pb.x + pb.y);
        const v2f sa2 = {ska, ska}, sb2 = {skb, skb};
        Aa = __builtin_elementwise_fma(-sa2, bb.xy, __builtin_elementwise_fma(va, kt.xy, Aa * ww.xy));
        Ab = __builtin_elementwise_fma(-sa2, bb.zw, __builtin_elementwise_fma(va, kt.zw, Ab * ww.zw));
        Ba = __builtin_elementwise_fma(-sb2, bb.xy, __builtin_elementwise_fma(vb, kt.xy, Ba * ww.xy));
        Bb = __builtin_elementwise_fma(-sb2, bb.zw, __builtin_elementwise_fma(vb, kt.zw, Bb * ww.zw));
        const v2f qa = __builtin_elementwise_fma(Ab, rr.zw, Aa * rr.xy), qb = __builtin_elementwise_fma(Bb, rr.zw, Ba * rr.xy);
        const float ya = red4(qa.x + qa.y), yb = red4(qb.x + qb.y);
        if ((tid & 3) == 0) { ypw[i * 128] = ya; ypw[i * 128 + 4] = yb; }
        kh = kh_n; ww = ww_n; bb = bb_n; kt = kt_n; rr = rr_n; vv = vv_n;
      }
    }
    __syncthreads();
    {
      const int i = tid >> 3, r0 = (tid & 7) * 4;
      const int p = c * 32 + i; const int t = z ? (T - 1 - p) : p;
      const float* y0 = s_yp + i * 128 + r0 * 4;
      const float4 u0 = *(const float4*)y0, u1 = *(const float4*)(y0 + 4), u2 = *(const float4*)(y0 + 8), u3 = *(const float4*)(y0 + 12);
      uint2 o; o.x = pack2((u0.x + u0.y) + (u0.z + u0.w), (u1.x + u1.y) + (u1.z + u1.w)); o.y = pack2((u2.x + u2.y) + (u2.z + u2.w), (u3.x + u3.y) + (u3.z + u3.w));
      *(uint2*)(P.hdir + ((size_t)z * NTOK + gs + t) * DM + 768 + h * 64 + rb * 32 + r0) = o;
    }
  }
  if (!sample) {
    float* so = P.out + O_RWKV + ((size_t)((seq * 2 + l) * 2 + z) * 4 + h) * 4096 + irow * 64 + cg4;
    *(float4*)so = make_float4(Aa.x, Aa.y, Ab.x, Ab.y); *(float4*)(so + 64) = make_float4(Ba.x, Ba.y, Bb.x, Bb.y);
  }
#undef RP_PREFETCH
}

DEV void rwkv_sample_task(const Params& P, int l, int task, const int z, char* smem0, const int tid_all_in) {
  const int tid_all = opaque_i(tid_all_in);
  const int half = tid_all >> 8, tid = tid_all & 255;
  constexpr int NR = 8;
  const int chain = task >> 3, rb = task & 7;
  int seq, h; bool sample; decode_chain(chain, seq, h, sample);
  int gs, T; seq_base(seq, gs, T);
  const int nch = T / 32;
#define RS_BUF(B) ((float*)(smem0 + (B) * HALF_LDS))
  if (half == 1) {
    const int si = tid >> 3, sc = (tid & 7) * 8;
    float kkc[8], kac[8], rkc[8];
#pragma unroll
    for (int e = 0; e < 8; ++e) { kkc[e] = P.rwkv_kk[l * 256 + h * 64 + sc + e]; kac[e] = P.rwkv_ka[l * 256 + h * 64 + sc + e]; rkc[e] = P.rwkv_rk[(l * 4 + h) * 64 + sc + e]; }
    float4 pr0, pr1, pk0, pk1, pw0, pw1, pa0, pa1, pv_ = make_float4(0.f, 0.f, 0.f, 0.f); float pinv;
#define RS_PREFETCH(C) { \
      const int p_ = (C) * 32 + si; const int t_ = z ? (T - 1 - p_) : p_; const int g_ = gs + t_; \
      const float* rk_ = P.rkv + (size_t)g_ * 768 + h * 64 + sc; \
      pr0 = *(const float4*)rk_; pr1 = *(const float4*)(rk_ + 4); \
      pk0 = *(const float4*)(rk_ + 256); pk1 = *(const float4*)(rk_ + 260); \
      const float* wp_ = P.wa + ((size_t)(g_ * 2 + z) * 2) * 256 + h * 64 + sc; \
      pw0 = *(const float4*)wp_; pw1 = *(const float4*)(wp_ + 4); \
      pa0 = *(const float4*)(wp_ + 256); pa1 = *(const float4*)(wp_ + 260); \
      pinv = P.khinv[g_ * 4 + h]; \
      if (tid < 64) { \
        const int p2_ = (C) * 32 + (tid >> 1); const int t2_ = z ? (T - 1 - p2_) : p2_; \
        pv_ = *(const float4*)(P.rkv + (size_t)(gs + t2_) * 768 + 512 + h * 64 + rb * NR + (tid & 1) * 4); \
      } }
#define RS_STAGE(C) { \
      float* bf_ = RS_BUF((C) & 1); \
      float* s_kh = bf_; float* s_w = bf_ + 2048; float* s_b = bf_ + 4096; float* s_kt = bf_ + 6144; float* s_r = bf_ + 8192; float* s_v = bf_ + 10240; \
      const float rr[8] = {pr0.x, pr0.y, pr0.z, pr0.w, pr1.x, pr1.y, pr1.z, pr1.w}; \
      const float kk[8] = {pk0.x, pk0.y, pk0.z, pk0.w, pk1.x, pk1.y, pk1.z, pk1.w}; \
      const float aa[8] = {pa0.x, pa0.y, pa0.z, pa0.w, pa1.x, pa1.y, pa1.z, pa1.w}; \
      float bsum = 0.f; float okh[8], ob[8], okt[8]; \
      _Pragma("unroll") for (int e = 0; e < 8; ++e) { okh[e] = kk[e] * kkc[e] * pinv; ob[e] = aa[e] * okh[e]; okt[e] = kk[e] * (1.f + (aa[e] - 1.f) * kac[e]); bsum += rr[e] * okt[e] * rkc[e]; } \
      float* d_; \
      d_ = s_kh + si * 64 + sc; *(float4*)d_ = make_float4(okh[0], okh[1], okh[2], okh[3]); *(float4*)(d_ + 4) = make_float4(okh[4], okh[5], okh[6], okh[7]); \
      d_ = s_w + si * 64 + sc; *(float4*)d_ = pw0; *(float4*)(d_ + 4) = pw1; \
      d_ = s_b + si * 64 + sc; *(float4*)d_ = make_float4(ob[0], ob[1], ob[2], ob[3]); *(float4*)(d_ + 4) = make_float4(ob[4], ob[5], ob[6], ob[7]); \
      d_ = s_kt + si * 64 + sc; *(float4*)d_ = make_float4(okt[0], okt[1], okt[2], okt[3]); *(float4*)(d_ + 4) = make_float4(okt[4], okt[5], okt[6], okt[7]); \
      d_ = s_r + si * 64 + sc; *(float4*)d_ = pr0; *(float4*)(d_ + 4) = pr1; \
      if (tid < 64) *(float4*)(s_v + (tid >> 1) * NR + (tid & 1) * 4) = pv_; \
      bsum += dppf<0xB1>(bsum); bsum += dppf<0x4E>(bsum); bsum += dppf<0x141>(bsum); \
      if (rb == 0 && (tid & 7) == 0) { const int p_ = (C) * 32 + si; const int t_ = z ? (T - 1 - p_) : p_; P.bonus[((size_t)z * NTOK + gs + t_) * 4 + h] = bsum; } }
#define RS_OUT(C) { \
      const float* yp_ = RS_BUF((C) & 1) + 10240 + 256; \
      const int i_ = tid >> 3, q2_ = tid & 7; \
      const int p_ = (C) * 32 + i_; const int t_ = z ? (T - 1 - p_) : p_; \
      const float* y0_ = yp_ + i_ * 128 + q2_ * 16; \
      float a0_ = 0.f; \
      _Pragma("unroll") for (int e = 0; e < 16; e += 4) { const float4 u0_ = *(const float4*)(y0_ + e); a0_ += (u0_.x + u0_.y) + (u0_.z + u0_.w); } \
      P.hdir[((size_t)z * NTOK + gs + t_) * DM + 768 + h * 64 + rb * NR + q2_] = f2bf(a0_); }
    RS_PREFETCH(0)
    RS_STAGE(0)
    if (nch > 1) RS_PREFETCH(1)
    __syncthreads();
    for (int c = 0; c < nch; ++c) {
      if (c + 1 < nch) { RS_STAGE(c + 1) if (c + 2 < nch) RS_PREFETCH(c + 2) }
      if (c > 0) RS_OUT(c - 1)
      __syncthreads();
    }
    RS_OUT(nch - 1)
#undef RS_PREFETCH
#undef RS_STAGE
#undef RS_OUT
  } else {
    const int rl = tid >> 4, cg4 = (tid & 15) * 4;
    const bool rowthread = tid < 128;
    typedef float v2f __attribute__((ext_vector_type(2)));
    typedef float v4f __attribute__((ext_vector_type(4)));
    v2f Sa = {0.f, 0.f}, Sb = {0.f, 0.f};
    if (sample && rowthread) {
      const float4 s4 = *(const float4*)(P.st_rwkv + ((size_t)(((seq - 16) * 2 + l) * 2 + z) * 4 + h) * 4096 + (rb * NR + rl) * 64 + cg4);
      Sa.x = s4.x; Sa.y = s4.y; Sb.x = s4.z; Sb.y = s4.w;
    }
    __syncthreads();
    for (int c = 0; c < nch; ++c) {
      if (rowthread) {
        const float* bf = RS_BUF(c & 1);
        const float* s_kh = bf; const float* s_w = bf + 2048; const float* s_b = bf + 4096; const float* s_kt = bf + 6144; const float* s_r = bf + 8192; const float* s_v = bf + 10240;
        float* s_yp = (float*)bf + 10240 + 256;
        v4f kh = *(const v4f*)(s_kh + cg4), ww = *(const v4f*)(s_w + cg4), bb = *(const v4f*)(s_b + cg4), kt = *(const v4f*)(s_kt + cg4), rr = *(const v4f*)(s_r + cg4);
        float vi = s_v[rl];
#pragma unroll 8
        for (int i = 0; i < 32; ++i) {
          const int in = (i + 1) & 31;
          const v4f kh_n = *(const v4f*)(s_kh + in * 64 + cg4);
          const v4f ww_n = *(const v4f*)(s_w + in * 64 + cg4);
          const v4f bb_n = *(const v4f*)(s_b + in * 64 + cg4);
          const v4f kt_n = *(const v4f*)(s_kt + in * 64 + cg4);
          const v4f rr_n = *(const v4f*)(s_r + in * 64 + cg4);
          const float vi_n = s_v[in * NR + rl];
          const v2f v2 = {vi, vi};
          const v2f pp = __builtin_elementwise_fma(Sb, kh.zw, Sa * kh.xy);
          const float sk = red16(pp.x + pp.y);
          const v2f sk2 = {sk, sk};
          Sa = __builtin_elementwise_fma(-sk2, bb.xy, __builtin_elementwise_fma(v2, kt.xy, Sa * ww.xy));
          Sb = __builtin_elementwise_fma(-sk2, bb.zw, __builtin_elementwise_fma(v2, kt.zw, Sb * ww.zw));
          const v2f qq = __builtin_elementwise_fma(Sb, rr.zw, Sa * rr.xy);
          s_yp[i * 128 + tid] = qq.x + qq.y;
          kh = kh_n; ww = ww_n; bb = bb_n; kt = kt_n; rr = rr_n; vi = vi_n;
        }
      }
      __syncthreads();
    }
  }
#undef RS_BUF
}

DEV void phase_scan(const Params& P, int l, char* smem0, int ctr_idx, int cls) {
  __shared__ int4 s_task4;
  int& s_task = *(int*)&s_task4;
  const int ntask = 560;
  for (;;) {
    __syncthreads();
    if (threadIdx.x == 0) s_task = (int)atomicAdd(P.ctr + ctr_idx, 1u);
    __syncthreads();
    const int t = s_task;
    if (t >= ntask) break;
    const int tid_ = THREAD_ID; const int half = tid_ >> 8, tid = tid_ & 255;
    char* smem = smem0 + half * HALF_LDS;
    if (t < 128) { if (cls & 1) rwkv_sample_task(P, l, t >> 1, t & 1, smem0, tid_); }
    else if (t < 144) { if (cls & 2) delta_sample_task(P, l, (t - 128) >> 1, t & 1, smem0, tid_); }
    else if (t < 160) { if (cls & 4) mlstm_sample_task(P, l, (t - 144) >> 1, t & 1, smem0, tid_); }
    else if (t < 176) { if (cls & 8) ret_sample_task(P, l, (t - 160) >> 1, t & 1, smem0, tid_); }
    else if (t < 304) { if (cls & 1) rwkv_prompt_task(P, l, (t - 176) + 16, half, smem, tid); }
    else if (t < 368) { if (cls & 2) delta_task(P, l, (t - 304) + 8, half, smem, tid, true); }
    else if (t < 432) { if (cls & 4) mlstm_task(P, l, (t - 368) + 8, half, smem, tid, true); }
    else if (t < 560) { if (cls & 8) ret_sample_task(P, l, ((t - 432) >> 1) + 8, t & 1, smem0, tid_); }
    else { if (cls & 16) { if (l == 1) conv_ff_layer1_item(P, 2 * (t - 624) + half, smem, tid); else conv_inout_layer1_item(P, 2 * (t - 624) + half, smem, tid); } }
  }
}

DEV void phase_combine(const Params& P, int l) {
  const int tid_ = THREAD_ID;
  const int lane = tid_ & 63;
  const int wid = blockIdx.x * (NTHREADS / 64) + (tid_ >> 6), nw = gridDim.x * (NTHREADS / 64);
  for (int g = wid; g < NTOK; g += nw) {
   const int c = lane * 4, head = lane >> 4;
#pragma unroll
   for (int m = 0; m < 4; ++m) {
    const uint2 h0 = *(const uint2*)(P.hdir + (size_t)g * DM + m * 256 + c);
    const uint2 h1 = *(const uint2*)(P.hdir + ((size_t)NTOK + g) * DM + m * 256 + c);
    float y[4];
    y[0] = __uint_as_float(h0.x << 16) + __uint_as_float(h1.x << 16);
    y[1] = __uint_as_float(h0.x & 0xffff0000u) + __uint_as_float(h1.x & 0xffff0000u);
    y[2] = __uint_as_float(h0.y << 16) + __uint_as_float(h1.y << 16);
    y[3] = __uint_as_float(h0.y & 0xffff0000u) + __uint_as_float(h1.y & 0xffff0000u);
    if (m != 1) {
      const float mean = red16(y[0] + y[1] + y[2] + y[3]) * (1.f / 64.f);
#pragma unroll
      for (int e = 0; e < 4; ++e) y[e] -= mean;
    }
    const float var = red16(y[0] * y[0] + y[1] * y[1] + y[2] * y[2] + y[3] * y[3]) * (1.f / 64.f);
    const float rs = rsqrtf(var + LNEPS);
    const float* gn = (m == 0 ? P.mlstm_norm : m == 1 ? P.delta_norm : m == 2 ? P.ret_norm : P.rwkv_norm) + l * 256 + c;
    const float4 g4 = *(const float4*)gn;
    y[0] *= rs * g4.x; y[1] *= rs * g4.y; y[2] *= rs * g4.z; y[3] *= rs * g4.w;
    float o[4];
    if (m == 3) {
      const uint2 gg = *(const uint2*)(P.gbuf + (size_t)g * 256 + c);
      const float gt[4] = {__uint_as_float(gg.x << 16), __uint_as_float(gg.x & 0xffff0000u), __uint_as_float(gg.y << 16), __uint_as_float(gg.y & 0xffff0000u)};
      const float bn = P.bonus[(size_t)g * 4 + head] + P.bonus[((size_t)NTOK + g) * 4 + head];
      const float4 v4 = *(const float4*)(P.rkv + (size_t)g * 768 + 512 + c);
      o[0] = gt[0] * (y[0] + bn * v4.x); o[1] = gt[1] * (y[1] + bn * v4.y); o[2] = gt[2] * (y[2] + bn * v4.z); o[3] = gt[3] * (y[3] + bn * v4.w);
    } else {
      const int goff = (m == 0) ? 768 : (m == 1) ? 1808 : 2848;
      const float4 a4 = *(const float4*)(P.projABC + (size_t)g * NABC + goff + c);
      if (m == 0) { o[0] = sigmoidf_(a4.x) * y[0]; o[1] = sigmoidf_(a4.y) * y[1]; o[2] = sigmoidf_(a4.z) * y[2]; o[3] = sigmoidf_(a4.w) * y[3]; }
      else { o[0] = siluf_(a4.x) * y[0]; o[1] = siluf_(a4.y) * y[1]; o[2] = siluf_(a4.z) * y[2]; o[3] = siluf_(a4.w) * y[3]; }
    }
    uint2 ov; ov.x = pack2(o[0], o[1]); ov.y = pack2(o[2], o[3]);
    *(uint2*)(P.ubuf + (size_t)g * DM + m * 256 + c) = ov;
   }
  }
}

#define XB_TMO      128
#define XB_XCNT(j)  (256  + 64 * (j))
#define XB_XSUB(j)  (1280 + 64 * (j))
#define XB_XGEN(j)  (2304 + 64 * (j))
#define XB_TOP      3328
#define XB_TOPGEN   3392
#define XCD_BAR_WORDS 3456
#define XB_SPIN_CAP (1u << 18)
#define LAS __attribute__((address_space(3)))

__device__ __forceinline__ unsigned xb_ld(unsigned* p)              { return __hip_atomic_load(p, __ATOMIC_RELAXED, __HIP_MEMORY_SCOPE_AGENT); }
__device__ __forceinline__ unsigned xb_add(unsigned* p, unsigned v) { return __hip_atomic_fetch_add(p, v, __ATOMIC_RELAXED, __HIP_MEMORY_SCOPE_AGENT); }
__device__ __forceinline__ unsigned xb_xcc_id() { return (unsigned)__builtin_amdgcn_s_getreg((3 << 11) | 20) & 0xFu; }
#define XB_SPIN(cond, bar) do { unsigned _sp = 0; while (cond) { __builtin_amdgcn_s_sleep(1); \
    if ((++_sp & 255u) == 0u) { if (xb_ld(&(bar)[XB_TMO])) break; if (_sp > XB_SPIN_CAP) { atomicAdd(&(bar)[XB_TMO], 1u); break; } } } } while (0)

struct XcdBarrier {
    unsigned* bar; unsigned x;
    volatile LAS unsigned* st;
};

__device__ __forceinline__ XcdBarrier xcd_barrier_post(unsigned* bar, volatile LAS unsigned* st) {
    XcdBarrier b; b.bar = bar; b.x = xb_xcc_id(); b.st = st;
    if (threadIdx.x == 0) (void)xb_add(&bar[XB_XCNT(b.x)], 1u);
    return b;
}
__device__ __forceinline__ void xcd_barrier_complete(unsigned* bar, unsigned x, unsigned& nloc, unsigned& nx) {
    const unsigned G = gridDim.x * gridDim.y * gridDim.z;
    unsigned sum, cnt, mine, sp = 0u;
    for (;;) {
        sum = 0u; cnt = 0u; mine = 0u;
#pragma unroll
        for (unsigned j = 0; j < 16; ++j) { const unsigned c = xb_ld(&bar[XB_XCNT(j)]); sum += c; cnt += (c > 0u) ? 1u : 0u; mine = (j == x) ? c : mine; }
        if (sum == G) break;
        __builtin_amdgcn_s_sleep(1);
        if ((++sp & 255u) == 0u) { if (xb_ld(&bar[XB_TMO])) break; if (sp > XB_SPIN_CAP) { atomicAdd(&bar[XB_TMO], 1u); break; } }
    }
    nloc = mine > 0u ? mine : 1u; nx = cnt > 0u ? cnt : 1u;
}

__device__ __forceinline__ void xcd_barrier(const XcdBarrier& b) {
    asm volatile("s_waitcnt vmcnt(0)" ::: "memory");
    __syncthreads();
    if (threadIdx.x == 0) {
        unsigned* bar = b.bar;
        __builtin_amdgcn_s_waitcnt(0);
        unsigned nloc = b.st[0], nx = b.st[1];
        if (nloc == 0u) { xcd_barrier_complete(bar, b.x, nloc, nx); b.st[0] = nloc; b.st[1] = nx; }
        const unsigned old = xb_add(&bar[XB_XSUB(b.x)], 1u);
        const unsigned gen = old / nloc;
        if (old + 1u == (gen + 1u) * nloc) {
            __builtin_amdgcn_fence(__ATOMIC_RELEASE, "agent");
            asm volatile("s_waitcnt vmcnt(0)" ::: "memory");
            const unsigned og = xb_add(&bar[XB_TOP], 1u);
            const unsigned tg = og / nx;
            if (og + 1u == (tg + 1u) * nx) xb_add(&bar[XB_TOPGEN], 1u);
            else XB_SPIN(xb_ld(&bar[XB_TOPGEN]) == tg, bar);
            __builtin_amdgcn_fence(__ATOMIC_ACQUIRE, "agent");
            xb_add(&bar[XB_XGEN(b.x)], 1u);
            asm volatile("s_waitcnt vmcnt(0)" ::: "memory");
        } else {
            XB_SPIN(xb_ld(&bar[XB_XGEN(b.x)]) == gen, bar);
            __builtin_amdgcn_fence(__ATOMIC_ACQUIRE, "agent");
            asm volatile("s_waitcnt vmcnt(0)" ::: "memory");
        }
    }
    __syncthreads();
}

__global__ void __launch_bounds__(NTHREADS, 2) mega(Params P) {
  extern __shared__ __attribute__((aligned(16))) char smem[];
  cg::grid_group grid = cg::this_grid();
  __shared__ uint4 xb_words;
  if (threadIdx.x == 0) xb_words = make_uint4(0u, 0u, 0u, 0u);
  __syncthreads();
  XcdBarrier xb = xcd_barrier_post(P.bar, (volatile LAS unsigned*)&xb_words);
  for (int i = 0; i < PROBE_EXTRA_SYNCS; ++i) xcd_barrier(xb);
  for (int ph = (int)P.phase_lo; ph < (int)P.phase_hi; ++ph) {
   const int nrep = ((ph >= 2 && ((PROBE_DUP_MASK >> ((ph - 2) % 10)) & 1)) || (ph == 0 && PROBE_DUP_PRO)) ? 2 : 1;
   for (int rep = 0; rep < nrep; ++rep) {
    if (ph == 0) phase_prologue(P, smem, rep);
    else if (ph == 1) phase_ln(P, 0, 0);
    else {
      const int l = (ph - 2) / 10, s = (ph - 2) % 10;
      switch (s) {
        case 0: { EpiProj E; E.projABC = P.projABC; E.pdraw = P.pdraw; E.col0 = 0; phase_gemm(P.ubuf, P.wt_in + (size_t)l * PINP * DM, 4096, DM, E, smem); } break;
        case 1: { if (blockIdx.x < 32) { EpiProj E; E.projABC = P.projABC; E.pdraw = P.pdraw; E.col0 = 4096;
                    phase_gemm(P.ubuf, P.wt_in + (size_t)l * PINP * DM + (size_t)4096 * DM, 256, DM, E, smem, 0, 1 << 20, 32);
                    asm volatile("s_waitcnt vmcnt(0)" ::: "memory"); __syncthreads();
                    if (threadIdx.x == 0) { __threadfence(); atomicAdd(P.ctr + 16 + l * 2 + rep, 1u); } }
                  __shared__ int4 s_it4; int& s_it = *(int*)&s_it4;
                  for (;;) {
                    __syncthreads();
                    if (threadIdx.x == 0) s_it = (int)atomicAdd(P.ctr + 8 + l * 2 + rep, 1u);
                    __syncthreads();
                    const int it = s_it;
                    if (it >= 64 * 9) break;
                    const int tid_ = THREAD_ID; const int half = tid_ >> 8;
                    if (it < 64) rwkv_prep_item(P, l, 2 * it + half, 0, smem + half * HALF_LDS, tid_ & 255);
                    else if (it < 64 * 6) { const int j = it - 64; rwkv_prep_item(P, l, 2 * (j / 5) + half, 1 + j % 5, smem + half * HALF_LDS, tid_ & 255); }
                    else {
                      if (threadIdx.x == 0) { while (__hip_atomic_load(P.ctr + 16 + l * 2 + rep, __ATOMIC_RELAXED, __HIP_MEMORY_SCOPE_AGENT) < 32u) __builtin_amdgcn_s_sleep(2); }
                      __syncthreads();
                      const int j = it - 64 * 6; delta_prep_item(P, l, 2 * (j / 3) + half, j % 3, tid_ & 255); } } } break;
        case 2: { const int tid_ = THREAD_ID; const int half = tid_ >> 8;
                  for (int it = blockIdx.x; it < 512; it += gridDim.x) delta_T_item(P, l, 2 * it + half, smem + half * HALF_LDS, tid_ & 255); } break;
        case 3: phase_scan(P, l, smem, l + 2 * rep, rep == 0 ? 31 : PROBE_SCAN_CLASS); break;
        case 4: phase_combine(P, l); break;
        case 5: { EpiRes E; E.out = P.out; E.xp = (l == 0) ? P.x_prompt : P.out; E.xs = (l == 0) ? P.x_sample : P.out + (size_t)4096 * DM; E.gate = P.mod + (size_t)l * 3 * 6144 + 2048;
                  phase_gemm(P.ubuf, P.wt_out + (size_t)l * DM * DM, DM, DM, E, smem);
                  if (blockIdx.x >= 128) {
                    const int tid_ = THREAD_ID; const int half = tid_ >> 8, tid = tid_ & 255;
                    float* tile = (float*)(smem + half * HALF_LDS);
                    const int npair = (l == 1) ? 1024 : 672;
                    int j = blockIdx.x - 128;
                    ConvDesc d = deferred_conv_desc(P, l, 2 * j + half);
                    float4 a, b, c, e4; conv_tile_load(d, tid, a, b, c, e4);
                    while (j < npair) {
                      const int jn = j + 128;
                      ConvDesc dn = d; float4 an = a, bn = b, cn = c, en = e4;
                      if (jn < npair) { dn = deferred_conv_desc(P, l, 2 * jn + half); conv_tile_load(dn, tid, an, bn, cn, en); }
                      conv_tile_finish(d, tile, tid, a, b, c, e4);
                      d = dn; a = an; b = bn; c = cn; e4 = en; j = jn;
                    }
                  } } break;
        case 6: phase_ln(P, 1, l); break;
        case 7: { EpiFF1 E; E.hidden = P.hidden; phase_gemm(P.ubuf, P.wt_ff1, DFF, DM, E, smem); } break;
        case 8: { EpiResSplit E; E.out = P.out; E.tmp = P.ff2tmp; E.gate = P.mod + (size_t)l * 3 * 6144 + 5120;
                  phase_gemm(P.hidden, P.wt_ff2, 2 * DM, DFF / 2, E, smem, DFF, 4); } break;
        case 9: phase_ln(P, 2, l); break;
      }
    }
    if (ph + 1 < (int)P.phase_hi || rep + 1 < nrep) {
      if (P.phase_hi > 1000) grid.sync(); else xcd_barrier(xb);
    }
   }
  }
}

#ifndef MK_MULTI
#define MK_MULTI 0
#endif

extern "C" void kernel_launch(void* const* d_in, const int* in_sizes, int n_in, void* d_out, int out_size, void* d_ws, size_t ws_size, hipStream_t stream) {
  static int grid_blocks = 0;
  if (!grid_blocks) {
    int dev = 0, cus = 0, per_cu = 0;
    hipGetDevice(&dev);
    hipDeviceGetAttribute(&cus, hipDeviceAttributeMultiprocessorCount, dev);
    if (hipFuncSetAttribute((const void*)mega, hipFuncAttributeMaxDynamicSharedMemorySize, LDS_BYTES) != hipSuccess) fprintf(stderr, "hipFuncSetAttribute failed\n");
    hipOccupancyMaxActiveBlocksPerMultiprocessor(&per_cu, (const void*)mega, NTHREADS, LDS_BYTES);
    if (per_cu < 1) { fprintf(stderr, "occupancy query returned %d\n", per_cu); per_cu = 1; }
    if (per_cu > 1) per_cu = 1;
    grid_blocks = cus * per_cu;
    fprintf(stderr, "mega: cus %d per_cu %d grid %d ws %zu\n", cus, per_cu, grid_blocks, ws_size);
  }
  Params p{};
  const float** pin = (const float**)&p;
  for (int i = 0; i < 39; ++i) pin[i] = (const float*)d_in[i];
  p.out = (float*)d_out;
  char* ws = (char*)d_ws; size_t off = 0;
  auto take = [&](size_t bytes) { char* r = ws + off; off += (bytes + 255) & ~(size_t)255; return r; };
  p.ctr = (unsigned*)take(256);
  p.bar = (unsigned*)take(XCD_BAR_WORDS * 4);
  p.wt_in = (bf16_t*)take((size_t)2 * PINP * DM * 2);
  p.wt_out = (bf16_t*)take((size_t)2 * DM * DM * 2);
  p.wt_ff1 = (bf16_t*)take((size_t)DM * DFF * 2);
  p.wt_ff2 = (bf16_t*)take((size_t)DM * DFF * 2);
  p.ubuf = (bf16_t*)take((size_t)NTOK * DM * 2);
  p.projABC = (float*)take((size_t)NTOK * NABC * 4);
  p.hidden = (bf16_t*)p.projABC;
  p.ff2tmp = (float*)((char*)p.projABC + (size_t)NTOK * DFF * 2);
  p.pdraw = (float*)take((size_t)NTOK * NPD * 4);
  p.hdir = (bf16_t*)p.pdraw;
  p.rkv = (float*)take((size_t)NTOK * 768 * 4);
  p.wa = (float*)take((size_t)NTOK * 1024 * 4);
  p.gbuf = (bf16_t*)take((size_t)NTOK * 256 * 2);
  p.mod = (float*)take((size_t)2 * 3 * 6144 * 4);
  p.khinv = (float*)take((size_t)NTOK * 4 * 4);
  p.bonus = (float*)take((size_t)2 * NTOK * 4 * 4);
  p.dbeta = (float*)take((size_t)8 * NTOK * 4);
  p.dgc = (float*)take((size_t)8 * NTOK * 4);
  p.dT = (bf16_t*)take((size_t)1024 * 4096 * 2);
  p.w2t = (bf16_t*)take((size_t)4 * 256 * 64 * 2);
  p.a2t = (bf16_t*)take((size_t)4 * 256 * 64 * 2);
  p.g2t = (bf16_t*)take((size_t)2 * 256 * 128 * 2);
  if (off > ws_size) { fprintf(stderr, "workspace too small: need %zu have %zu\n", off, ws_size); return; }
  hipMemsetAsync(p.ctr, 0, 256 + ((XCD_BAR_WORDS * 4 + 255) & ~255), stream);
  const int nph = 2 + 10 * 2;
#if MK_MULTI
  for (int ph = 0; ph < nph; ++ph) {
    p.phase_lo = ph; p.phase_hi = ph + 1;
    void* args[] = {&p};
    hipLaunchCooperativeKernel((const void*)mega, dim3(grid_blocks), dim3(NTHREADS), args, LDS_BYTES, stream);
  }
#else
  p.phase_lo = 0; p.phase_hi = nph;
  void* args[] = {&p};
  hipError_t e = hipLaunchCooperativeKernel((const void*)mega, dim3(grid_blocks), dim3(NTHREADS), args, LDS_BYTES, stream);
  if (e != hipSuccess) fprintf(stderr, "cooperative launch failed: %s (grid %d)\n", hipGetErrorString(e), grid_blocks);
#endif
}
```

```cpp
#include <hip/hip_runtime.h>
#include <hip/hip_cooperative_groups.h>
#include <cstdio>
#include <cstdint>
namespace cg = cooperative_groups;

typedef unsigned short bf16_t;
typedef short bf16x8 __attribute__((ext_vector_type(8)));
typedef float f32x16 __attribute__((ext_vector_type(16)));
typedef float f32x4 __attribute__((ext_vector_type(4)));
#define DEV __device__ __forceinline__

#ifndef PROBE_SCAN_CLASS
#define PROBE_SCAN_CLASS 31
#endif
#ifndef PROBE_DUP_PRO
#define PROBE_DUP_PRO 0
#endif
#ifndef PROBE_EXTRA_SYNCS
#define PROBE_EXTRA_SYNCS 0
#endif
#ifndef PROBE_DUP_MASK
#define PROBE_DUP_MASK 0
#endif
constexpr int NTOK = 8192, DM = 1024, PIN = 4256, PINP = 4352, NABC = 3104, NPD = 1152, DFF = 4096;
constexpr float ALPHA = 1.41421356237f, LNEPS = 1e-5f;
constexpr int LDB = 72;
constexpr int TILE_B = 64 * LDB * 2;
constexpr int HALF_LDS = 77824;
constexpr int LDS_BYTES = 2 * HALF_LDS;
constexpr int NTHREADS = 512;
constexpr size_t O_C = 8388608, O_N = 9437184, O_M = 9453568, O_DELTA = 9453824, O_RET = 10502400, O_RWKV = 11550976;

struct Params {
  const float *x_prompt, *x_sample, *c, *st_C, *st_n, *st_m, *st_delta, *st_ret, *st_rwkv, *c_ctx;
  const float *w_mod, *b_mod, *w_in, *w_out, *ln1_g, *ln1_b, *ln2_g, *ln2_b, *w_ff1, *w_ff2;
  const float *mlstm_i_bias, *mlstm_f_bias, *mlstm_norm, *delta_conv, *delta_a_log, *delta_dt_bias, *delta_norm;
  const float *ret_decay, *ret_norm, *rwkv_mu, *rwkv_w0, *rwkv_w2, *rwkv_a0, *rwkv_a2, *rwkv_g2, *rwkv_kk, *rwkv_ka, *rwkv_rk, *rwkv_norm;
  float* out;
  bf16_t *wt_in, *wt_out, *wt_ff1, *wt_ff2, *ubuf, *hdir, *gbuf, *hidden;
  float *mod, *projABC, *pdraw, *rkv, *wa, *khinv, *bonus, *dbeta, *dgc, *ff2tmp;
  bf16_t *dT, *w2t, *a2t, *g2t;
  unsigned* ctr; unsigned* bar;
  long long phase_lo, phase_hi;
};

DEV int opaque_i(int v) { asm volatile("" : "+v"(v)); return v; }
#define THREAD_ID opaque_i((int)threadIdx.x)
typedef float f32x2_t __attribute__((ext_vector_type(2)));
typedef __bf16 bf16x2_t __attribute__((ext_vector_type(2)));
DEV unsigned pack2(float a, float b) { f32x2_t v = {a, b}; bf16x2_t r = __builtin_convertvector(v, bf16x2_t); return __builtin_bit_cast(unsigned, r); }
DEV bf16_t f2bf(float f) { return (bf16_t)pack2(f, f); }
DEV float bf2f(bf16_t h) { return __uint_as_float(((unsigned)h) << 16); }
DEV float sigmoidf_(float x) { return 1.f / (1.f + __expf(-x)); }
DEV float siluf_(float x) { return x / (1.f + __expf(-x)); }
DEV float softplusf_(float x) { return x > 20.f ? x : log1pf(__expf(x)); }
DEV float logsigmoidf_(float x) { return -softplusf_(-x); }
template <int CTRL> DEV float dppf(float x) { return __builtin_bit_cast(float, __builtin_amdgcn_mov_dpp(__builtin_bit_cast(int, x), CTRL, 0xf, 0xf, true)); }
DEV float red4(float x) { x += dppf<0xB1>(x); x += dppf<0x4E>(x); return x; }
DEV float red16(float x) { x = red4(x); x += dppf<0x141>(x); x += dppf<0x128>(x); return x; }
DEV float wave_sum(float x) { x = red16(x); x += __shfl_xor(x, 16); x += __shfl_xor(x, 32); return x; }
DEV void tok_info(int g, int& gs, int& T, int& ci) {
  if (g < 4096) { gs = g & ~255; T = 256; ci = 0; } else { int b = (g - 4096) >> 11; gs = 4096 + (b << 11); T = 2048; ci = 1 + b; }
}
DEV const float* xin_row(const Params& P, int g) { return g < 4096 ? P.x_prompt + (size_t)g * DM : P.x_sample + (size_t)(g - 4096) * DM; }

DEV f32x16 mm64(const bf16_t* A, const bf16_t* Bt, int wr, int wc, int lane, f32x16 acc) {
  const bf16_t* ap = A + (wr * 32 + (lane & 31)) * LDB + (lane >> 5) * 8;
  const bf16_t* bp = Bt + (wc * 32 + (lane & 31)) * LDB + (lane >> 5) * 8;
#pragma unroll
  for (int s = 0; s < 4; ++s) {
    bf16x8 a = *(const bf16x8*)(ap + s * 16);
    bf16x8 b = *(const bf16x8*)(bp + s * 16);
    acc = __builtin_amdgcn_mfma_f32_32x32x16_bf16(a, b, acc, 0, 0, 0);
  }
  return acc;
}
DEV f32x16 zero16() { f32x16 z; for (int i = 0; i < 16; ++i) z[i] = 0.f; return z; }
#define ACC_ROW(idx) (wr * 32 + ((idx) & 3) + 8 * ((idx) >> 2) + 4 * (lane >> 5))
#define ACC_COL (wc * 32 + (lane & 31))

DEV void conv_tile(const float* __restrict__ src, bf16_t* __restrict__ dst, int K, int N, int tk, int tn, float* tile, const int tid_in, const int dst_row_shift = 0) {
  const int tid = opaque_i(tid_in);
  const int k0 = tk * 64, n0 = tn * 64;
  { const int r = tid >> 2, cs = (tid & 3) * 16;
#pragma unroll
    for (int e = 0; e < 16; e += 4) {
      const int n = n0 + cs + e;
      float4 v = make_float4(0.f, 0.f, 0.f, 0.f);
      if (n < N) v = *(const float4*)(src + (size_t)(k0 + r) * N + n);
      tile[r * 65 + cs + e] = v.x; tile[r * 65 + cs + e + 1] = v.y; tile[r * 65 + cs + e + 2] = v.z; tile[r * 65 + cs + e + 3] = v.w;
    } }
  __syncthreads();
  { const int nl = tid >> 2, ks = (tid & 3) * 16;
    unsigned pk[8];
#pragma unroll
    for (int e = 0; e < 8; ++e) pk[e] = pack2(tile[(ks + 2 * e) * 65 + nl], tile[(ks + 2 * e + 1) * 65 + nl]);
    uint4* d = (uint4*)(dst + (size_t)(n0 + nl + dst_row_shift) * K + k0 + ks);
    d[0] = make_uint4(pk[0], pk[1], pk[2], pk[3]); d[1] = make_uint4(pk[4], pk[5], pk[6], pk[7]); }
  __syncthreads();
}

DEV void mod_gemv_item(const Params& P, int item, float* red, const int tid) {
  const int j0 = item * 64, l = j0 / 6144, jj = j0 % 6144;
  const int cq = tid & 15, kg = tid >> 4;
  const float* W = P.w_mod + (size_t)l * DM * 6144 + jj + cq * 4;
  float a0[4] = {0, 0, 0, 0}, a1[4] = {0, 0, 0, 0}, a2[4] = {0, 0, 0, 0};
  for (int kk = 0; kk < 64; ++kk) {
    const int k = kg * 64 + kk;
    const float4 w = *(const float4*)(W + (size_t)k * 6144);
    const float s0 = siluf_(P.c_ctx[k]), s1 = siluf_(P.c[k]), s2 = siluf_(P.c[DM + k]);
    a0[0] += s0 * w.x; a0[1] += s0 * w.y; a0[2] += s0 * w.z; a0[3] += s0 * w.w;
    a1[0] += s1 * w.x; a1[1] += s1 * w.y; a1[2] += s1 * w.z; a1[3] += s1 * w.w;
    a2[0] += s2 * w.x; a2[1] += s2 * w.y; a2[2] += s2 * w.z; a2[3] += s2 * w.w;
  }
#pragma unroll
  for (int e = 0; e < 4; ++e) { red[(kg * 3 + 0) * 64 + cq * 4 + e] = a0[e]; red[(kg * 3 + 1) * 64 + cq * 4 + e] = a1[e]; red[(kg * 3 + 2) * 64 + cq * 4 + e] = a2[e]; }
  __syncthreads();
  if (tid < 192) {
    const int ci = tid >> 6, col = tid & 63;
    float s = P.b_mod[l * 6144 + jj + col];
    for (int g = 0; g < 16; ++g) s += red[(g * 3 + ci) * 64 + col];
    P.mod[(size_t)(l * 3 + ci) * 6144 + jj + col] = s;
  }
  __syncthreads();
}

DEV void prologue_item(const Params& P, int t, float* tile, const int tid) {
  const int n_in = 16 * 68, n_out = 16 * 16, n_ff = 1024;
  const int total = 192 + 48 + n_in + n_out + 2 * n_ff;
  if (t >= total) { __syncthreads(); __syncthreads(); return; }
  if (t < 192) { mod_gemv_item(P, t, tile, tid); return; }
  if (t < 240) {
    const int v = t - 192;
    if (v < 32) { const int m = v >> 2, tn = v & 3, lz = m >> 1, kind = m & 1;
      conv_tile((kind == 0 ? P.rwkv_w2 : P.rwkv_a2) + (size_t)lz * 64 * 256, (kind == 0 ? P.w2t : P.a2t) + (size_t)lz * 256 * 64, 64, 256, 0, tn, tile, tid); }
    else { const int m = (v - 32) >> 3, r = (v - 32) & 7; conv_tile(P.rwkv_g2 + (size_t)m * 128 * 256, P.g2t + (size_t)m * 256 * 128, 128, 256, r >> 2, r & 3, tile, tid); }
    return;
  }
  int u = t - 240;
  if (u < n_in) { const int tn = u % 68; conv_tile(P.w_in, P.wt_in, DM, PIN, u / 68, tn, tile, tid, tn < 12 ? 0 : (tn < 16 ? 3328 : -256)); return; }
  u -= n_in;
  if (u < n_out) { conv_tile(P.w_out, P.wt_out, DM, DM, u / 16, u % 16, tile, tid); return; }
  u -= n_out;
  if (u < n_ff) { conv_tile(P.w_ff1, P.wt_ff1, DM, DFF, u / 64, u % 64, tile, tid); return; }
  u -= n_ff;
  { const int tk = u / 16, kh = tk >> 5; conv_tile(P.w_ff2 + (size_t)kh * 2048 * DM, P.wt_ff2 + (size_t)kh * DM * 2048, 2048, DM, tk & 31, u % 16, tile, tid); }
}
DEV void phase_prologue(const Params& P, char* smem, int rep) {
  const int tid_ = THREAD_ID; const int half = tid_ >> 8, tid = tid_ & 255;
  float* tile = (float*)(smem + half * HALF_LDS);
  const int total = 192 + 48 + 16 * 68 + 256 + 2 * 1024;
  __shared__ int4 s_pj4; int& s_pj = *(int*)&s_pj4;
  for (;;) {
    __syncthreads();
    if (threadIdx.x == 0) s_pj = (int)atomicAdd(P.ctr + 6 + rep, 1u);
    __syncthreads();
    const int j = s_pj;
    if (2 * j >= total) break;
    prologue_item(P, 2 * j + half, tile, tid);
  }
}
struct ConvDesc { const float* src; bf16_t* dst; int K, N, tk, tn, shift; };
DEV void conv_tile_load(const ConvDesc& d, const int tid, float4& a, float4& b, float4& c, float4& e4) {
  const int r = tid >> 2, cs = (tid & 3) * 16;
  const float* p = d.src + (size_t)(d.tk * 64 + r) * d.N + d.tn * 64 + cs;
  const float4 z4 = make_float4(0.f, 0.f, 0.f, 0.f);
  const int n = d.tn * 64 + cs;
  a = z4; b = z4; c = z4; e4 = z4;
  if (n < d.N) a = *(const float4*)p;
  if (n + 4 < d.N) b = *(const float4*)(p + 4);
  if (n + 8 < d.N) c = *(const float4*)(p + 8);
  if (n + 12 < d.N) e4 = *(const float4*)(p + 12);
}
DEV void conv_tile_finish(const ConvDesc& d, float* tile, const int tid, const float4 a, const float4 b, const float4 c, const float4 e4) {
  { const int r = tid >> 2, cs = (tid & 3) * 16;
    float* t = tile + r * 65 + cs;
    t[0] = a.x; t[1] = a.y; t[2] = a.z; t[3] = a.w; t[4] = b.x; t[5] = b.y; t[6] = b.z; t[7] = b.w;
    t[8] = c.x; t[9] = c.y; t[10] = c.z; t[11] = c.w; t[12] = e4.x; t[13] = e4.y; t[14] = e4.z; t[15] = e4.w; }
  __syncthreads();
  { const int nl = tid >> 2, ks = (tid & 3) * 16;
    unsigned pk[8];
#pragma unroll
    for (int e = 0; e < 8; ++e) pk[e] = pack2(tile[(ks + 2 * e) * 65 + nl], tile[(ks + 2 * e + 1) * 65 + nl]);
    uint4* o = (uint4*)(d.dst + (size_t)(d.tn * 64 + nl + d.shift) * d.K + d.tk * 64 + ks);
    o[0] = make_uint4(pk[0], pk[1], pk[2], pk[3]); o[1] = make_uint4(pk[4], pk[5], pk[6], pk[7]); }
  __syncthreads();
}
DEV ConvDesc deferred_conv_desc(const Params& P, int l, int u) {
  ConvDesc d; d.shift = 0;
  if (l == 1) {
    if (u < 1024) { d.src = P.w_ff1 + (size_t)DM * DFF; d.dst = P.wt_ff1; d.K = DM; d.N = DFF; d.tk = u / 64; d.tn = u % 64; }
    else { u -= 1024; const int tk = u / 16, kh = tk >> 5; d.src = P.w_ff2 + (size_t)DM * DFF + (size_t)kh * 2048 * DM; d.dst = P.wt_ff2 + (size_t)kh * DM * 2048; d.K = 2048; d.N = DM; d.tk = tk & 31; d.tn = u % 16; }
  } else {
    if (u < 1088) { const int tn = u % 68; d.src = P.w_in + (size_t)DM * PIN; d.dst = P.wt_in + (size_t)PINP * DM; d.K = DM; d.N = PIN; d.tk = u / 68; d.tn = tn; d.shift = tn < 12 ? 0 : (tn < 16 ? 3328 : -256); }
    else { u -= 1088; d.src = P.w_out + (size_t)DM * DM; d.dst = P.wt_out + (size_t)DM * DM; d.K = DM; d.N = DM; d.tk = u / 16; d.tn = u % 16; }
  }
  return d;
}
DEV void conv_inout_layer1_item(const Params& P, int u, char* smem, const int tid) {
  float* tile = (float*)smem;
  if (u < 1088) { const int tn = u % 68; conv_tile(P.w_in + (size_t)DM * PIN, P.wt_in + (size_t)PINP * DM, DM, PIN, u / 68, tn, tile, tid, tn < 12 ? 0 : (tn < 16 ? 3328 : -256)); }
  else { u -= 1088; conv_tile(P.w_out + (size_t)DM * DM, P.wt_out + (size_t)DM * DM, DM, DM, u / 16, u % 16, tile, tid); }
}
DEV void conv_ff_layer1_item(const Params& P, int u, char* smem, const int tid) {
  float* tile = (float*)smem;
  if (u < 1024) conv_tile(P.w_ff1 + (size_t)DM * DFF, P.wt_ff1, DM, DFF, u / 64, u % 64, tile, tid);
  else { u -= 1024; const int tk = u / 16, kh = tk >> 5; conv_tile(P.w_ff2 + (size_t)DM * DFF + (size_t)kh * 2048 * DM, P.wt_ff2 + (size_t)kh * DM * 2048, 2048, DM, tk & 31, u % 16, tile, tid); }
}

DEV void phase_ln(const Params& P, int mode, int l) {
  const int tid_ = THREAD_ID;
  const int lane = tid_ & 63;
  const int wid = blockIdx.x * (NTHREADS / 64) + (tid_ >> 6), nw = gridDim.x * (NTHREADS / 64);
  float4 nx0, nx1, nx2, nx3, nt0, nt1, nt2, nt3;
  nt0 = nt1 = nt2 = nt3 = make_float4(0.f, 0.f, 0.f, 0.f);
#define LN_LOAD(G) { const float* src_ = (mode == 0) ? xin_row(P, (G)) : (P.out + (size_t)(G) * DM); \
    nx0 = *(const float4*)(src_ + lane * 4); nx1 = *(const float4*)(src_ + 256 + lane * 4); nx2 = *(const float4*)(src_ + 512 + lane * 4); nx3 = *(const float4*)(src_ + 768 + lane * 4); \
    if (mode == 2) { const float* t_ = P.ff2tmp + (size_t)(G) * DM + lane * 4; nt0 = *(const float4*)t_; nt1 = *(const float4*)(t_ + 256); nt2 = *(const float4*)(t_ + 512); nt3 = *(const float4*)(t_ + 768); } }
  if (wid < NTOK) LN_LOAD(wid)
  for (int g = wid; g < NTOK; g += nw) {
    int gs, T, ci; tok_info(g, gs, T, ci);
    float v[16];
    { const float4 xs[4] = {nx0, nx1, nx2, nx3};
#pragma unroll
      for (int k = 0; k < 4; ++k) { v[4 * k] = xs[k].x; v[4 * k + 1] = xs[k].y; v[4 * k + 2] = xs[k].z; v[4 * k + 3] = xs[k].w; } }
    if (mode == 2) {
      const float* gt = P.mod + (size_t)(l * 3 + ci) * 6144 + 5120;
      const float4 ts[4] = {nt0, nt1, nt2, nt3};
#pragma unroll
      for (int k = 0; k < 4; ++k) { const float4 t = ts[k], g4 = *(const float4*)(gt + k * 256 + lane * 4);
        v[4 * k] += g4.x * t.x; v[4 * k + 1] += g4.y * t.y; v[4 * k + 2] += g4.z * t.z; v[4 * k + 3] += g4.w * t.w; }
    }
    if (g + nw < NTOK) LN_LOAD(g + nw)
    float s = 0.f;
#pragma unroll
    for (int i = 0; i < 16; ++i) s += v[i];
    float mu = wave_sum(s) * (1.f / DM);
    float q = 0.f;
#pragma unroll
    for (int i = 0; i < 16; ++i) { v[i] -= mu; q += v[i] * v[i]; }
    float rstd = rsqrtf(wave_sum(q) * (1.f / DM) + LNEPS);
#pragma unroll
    for (int i = 0; i < 16; ++i) v[i] *= rstd;
    int lm = l, shoff = 0, scoff = 1024;
    bool write_u = true;
    if (mode != 0) {
      const float* gg = (mode == 1 ? P.ln1_g : P.ln2_g) + l * DM;
      const float* bb = (mode == 1 ? P.ln1_b : P.ln2_b) + l * DM;
#pragma unroll
      for (int k = 0; k < 4; ++k) {
        const float4 g4 = *(const float4*)(gg + k * 256 + lane * 4), b4 = *(const float4*)(bb + k * 256 + lane * 4);
        v[4 * k] = v[4 * k] * g4.x + b4.x; v[4 * k + 1] = v[4 * k + 1] * g4.y + b4.y; v[4 * k + 2] = v[4 * k + 2] * g4.z + b4.z; v[4 * k + 3] = v[4 * k + 3] * g4.w + b4.w;
        *(float4*)(P.out + (size_t)g * DM + k * 256 + lane * 4) = make_float4(v[4 * k], v[4 * k + 1], v[4 * k + 2], v[4 * k + 3]);
      }
      if (mode == 1) { shoff = 3072; scoff = 4096; } else { lm = l + 1; write_u = (l == 0); }
      if (write_u) {
        s = 0.f;
#pragma unroll
        for (int i = 0; i < 16; ++i) s += v[i];
        mu = wave_sum(s) * (1.f / DM);
        q = 0.f;
#pragma unroll
        for (int i = 0; i < 16; ++i) { v[i] -= mu; q += v[i] * v[i]; }
        rstd = rsqrtf(wave_sum(q) * (1.f / DM) + LNEPS);
#pragma unroll
        for (int i = 0; i < 16; ++i) v[i] *= rstd;
      }
    }
    if (write_u) {
      const float* md = P.mod + (size_t)(lm * 3 + ci) * 6144;
#pragma unroll
      for (int k = 0; k < 4; ++k) {
        const float4 sh = *(const float4*)(md + shoff + k * 256 + lane * 4), sc = *(const float4*)(md + scoff + k * 256 + lane * 4);
        uint2 o;
        o.x = pack2(v[4 * k] * (1.f + sc.x) + sh.x, v[4 * k + 1] * (1.f + sc.y) + sh.y);
        o.y = pack2(v[4 * k + 2] * (1.f + sc.z) + sh.z, v[4 * k + 3] * (1.f + sc.w) + sh.w);
        *(uint2*)(P.ubuf + (size_t)g * DM + k * 256 + lane * 4) = o;
      }
    }
  }
}

namespace pg8 {
#define PG8_LAS __attribute__((address_space(3)))
typedef unsigned short bf16_t;
typedef short bf16x8 __attribute__((ext_vector_type(8)));
typedef float f32x4 __attribute__((ext_vector_type(4)));
typedef unsigned u32x4 __attribute__((ext_vector_type(4)));
constexpr int BM = 256, BK = 64, HALF = 128, HTB = HALF * BK * 2  , STAGE_BYTES = 8 * HTB, NXCD = 8, WGM = 8;

__host__ __device__ __forceinline__ int lds_byte(int r, int c) { const int st = (r >> 4) * 2 + (c >> 5), rr = r & 15, cc = c & 31, ob = rr * 64 + cc * 2; return st * 1024 + (ob ^ (((ob >> 9) & 1) << 5)); }
__host__ __device__ __forceinline__ void stage_rc(int b, int& R, int& C) { const int st = b / 1024, sb = b % 1024, swz = sb ^ (((sb >> 9) & 1) << 5); R = (st >> 1) * 16 + swz / 64; C = (st & 1) * 32 + (swz % 64) / 2; }
__host__ __device__ __forceinline__ int perm32(int rho) { const int n = rho >> 4, i = rho & 15; return 8 * (i >> 2) + 4 * n + (i & 3); }

struct Unit { int pm, pn; };
struct Gemm { const bf16_t* A; const bf16_t* Bt; int M, N, K; int lda; int nsplit; };

struct StaticOrder {
    int nM, nN, nwg, G, c;
    __host__ __device__ void init(int M, int N, int G_, int c_) { nM = M / BM; nN = N / BM; nwg = nM * nN; G = G_; c = c_; }
    __host__ __device__ bool next(int i, Unit& u) const {
        const long L = (long)i * G + c; if (L >= nwg) return false;
        int wgid = (int)L; { const int q = nwg / NXCD, r = nwg % NXCD, xcd = wgid % NXCD, off = wgid / NXCD; wgid = (xcd < r ? xcd * (q + 1) : r * (q + 1) + (xcd - r) * q) + off; }
        const int nig = WGM * nN, gid = wgid / nig, fm = gid * WGM, gsz = (nM - fm) < WGM ? (nM - fm) : WGM;
        u.pm = fm + ((wgid % nig) % gsz); u.pn = (wgid % nig) / gsz; return true;
    }
    __device__ __forceinline__ void a_ready(const Unit&) const {}
    __device__ __forceinline__ void done(const Unit&) const {}
};
__device__ __forceinline__ unsigned cvt_pk_bf16(float lo, float hi) { unsigned r; asm volatile("v_cvt_pk_bf16_f32 %0, %1, %2" : "=v"(r) : "v"(lo), "v"(hi)); return r; }
template <class Epi, class Sched, bool STAMP = false>
__device__ __forceinline__ void gemm_phase(PG8_LAS unsigned char* lds, const Gemm g, const Sched& S, const Epi& E, unsigned long long* stamps) {
    const int tid = THREAD_ID, wid = __builtin_amdgcn_readfirstlane(tid >> 6), lane = tid & 63, wr = wid >> 2, wc = wid & 3, fr = lane & 15, fq = lane >> 4;
    const int K = g.K, nt = K / BK;
    int ts_lo = 0, ts_hi = 0, nts = 0; const unsigned long long rt_entry = STAMP ? (unsigned long long)wall_clock64() : 0ull;
#define PG8_STAMP() do { if (STAMP && wid == 0 && nts < 64) { const unsigned long long _c = (unsigned long long)clock64(); \
        ts_lo = (lane == nts) ? (int)(unsigned)_c : ts_lo; ts_hi = (lane == nts) ? (int)(unsigned)(_c >> 32) : ts_hi; ++nts; } } while (0)
    PG8_STAMP();
    unsigned voffA[2], voffB[2];
#pragma unroll
    for (int i = 0; i < 2; ++i) { int R, C; stage_rc(tid * 16 + i * 8192, R, C); const int Rb = Epi::PERM ? ((R & ~31) + perm32(R & 31)) : R;
        voffA[i] = (unsigned)(R * g.lda + C) * 2u; voffB[i] = (unsigned)(Rb * K + C) * 2u; }
    const size_t kstep = (size_t)(BK * 2);
    const size_t hstep = (size_t)HALF * K * 2, hstepA = (size_t)HALF * g.lda * 2;
    const size_t tstep = 2 * hstep, tstepA = 2 * hstepA;
    const size_t ksplitA = (size_t)K * 2;
    const unsigned ldsw = (unsigned)wid * 1024u;
    const int aoff = lds_byte(wr * 64 + fr, fq * 8), boff = lds_byte(wc * 32 + fr, fq * 8);
#define PG8_SA(b, h) (((b) * 2 + (h)) * HTB)
#define PG8_SB(b, h) ((4 + (b) * 2 + (h)) * HTB)
#define PG8_STAGE(bufoff, gbase, voff) do { _Pragma("unroll") for (int _i = 0; _i < 2; ++_i) \
        __builtin_amdgcn_global_load_lds((const unsigned*)((const char*)(gbase) + (voff)[_i]), (PG8_LAS unsigned*)(lds + (bufoff) + ldsw + _i * 8192), 16, 0, 0); } while (0)
#define PG8_LDA(dst, b, h) do { _Pragma("unroll") for (int m = 0; m < 4; ++m) _Pragma("unroll") for (int k = 0; k < 2; ++k) dst[m][k] = *(const PG8_LAS bf16x8*)(lds + PG8_SA(b, h) + aoff + m * 2048 + k * 1024); } while (0)
#define PG8_LDB(dst, b, h) do { _Pragma("unroll") for (int n = 0; n < 2; ++n) _Pragma("unroll") for (int k = 0; k < 2; ++k) dst[n][k] = *(const PG8_LAS bf16x8*)(lds + PG8_SB(b, h) + boff + n * 2048 + k * 1024); } while (0)
#define PG8_MMA(ai, bj, At, Bt) do { __builtin_amdgcn_s_setprio(1); _Pragma("unroll") for (int m = 0; m < 4; ++m) _Pragma("unroll") for (int n = 0; n < 2; ++n) _Pragma("unroll") for (int k = 0; k < 2; ++k) \
        acc[ai][bj][m][n] = __builtin_amdgcn_mfma_f32_16x16x32_bf16(Bt[n][k], At[m][k], acc[ai][bj][m][n], 0, 0, 0); __builtin_amdgcn_s_setprio(0); } while (0)
#define PG8_WAIT_V(n) asm volatile("s_waitcnt vmcnt(" #n ")" ::: "memory")
#define PG8_WAIT_L(n) asm volatile("s_waitcnt lgkmcnt(" #n ")" ::: "memory")
#define PG8_BAR __builtin_amdgcn_s_barrier()
#define PG8_SCHED __builtin_amdgcn_sched_barrier(0)
    Unit cur, nxt; int ui = 0;
    if (!S.next(0, cur)) return;
    f32x4 acc[2][2][4][2];
#pragma unroll
    for (int a = 0; a < 2; ++a)
#pragma unroll
        for (int b = 0; b < 2; ++b)
#pragma unroll
            for (int m = 0; m < 4; ++m)
#pragma unroll
                for (int n = 0; n < 2; ++n) acc[a][b][m][n] = (f32x4){0.f, 0.f, 0.f, 0.f};
    bf16x8 At[4][2], B0[2][2], B1[2][2];
    const char* cA = (const char*)g.A + (size_t)cur.pm * tstepA + (cur.pn >= g.nsplit ? ksplitA : 0); const char* cB = (const char*)g.Bt + (size_t)cur.pn * tstep;
    S.a_ready(cur);
    PG8_STAGE(PG8_SB(0, 0), cB, voffB); PG8_STAGE(PG8_SA(0, 0), cA, voffA); PG8_STAGE(PG8_SB(0, 1), cB + hstep, voffB); PG8_STAGE(PG8_SA(0, 1), cA + hstepA, voffA);
    if (wr == 1) PG8_BAR;
    PG8_WAIT_V(4); PG8_BAR;
    PG8_STAGE(PG8_SB(1, 0), cB + kstep, voffB); PG8_STAGE(PG8_SA(1, 0), cA + kstep, voffA); PG8_STAGE(PG8_SB(1, 1), cB + hstep + kstep, voffB);
    PG8_WAIT_V(6); PG8_BAR;
    PG8_STAMP();
    for (;;) {
        const bool has_next = S.next(ui + 1, nxt);
        const char* nA = has_next ? (const char*)g.A + (size_t)nxt.pm * tstepA + (nxt.pn >= g.nsplit ? ksplitA : 0) : cA; const char* nB = has_next ? (const char*)g.Bt + (size_t)nxt.pn * tstep : cB;
        for (int t = 0; t < nt; t += 2) {
            const bool last = (t == nt - 2);
            const char* a1 = cA + (size_t)(t + 1) * kstep;
            const char* a2 = last ? nA : cA + (size_t)(t + 2) * kstep; const char* b2 = last ? nB : cB + (size_t)(t + 2) * kstep;
            const char* a3 = a2 + kstep; const char* b3 = b2 + kstep;
            if (last && has_next) S.a_ready(nxt);
            PG8_LDB(B0, 0, 0); PG8_SCHED; PG8_LDA(At, 0, 0); PG8_STAGE(PG8_SA(1, 1), a1 + hstepA, voffA);
            PG8_WAIT_L(8); PG8_BAR; PG8_WAIT_L(0); PG8_MMA(0, 0, At, B0); PG8_BAR; PG8_SCHED;
            PG8_LDB(B1, 0, 1); PG8_STAGE(PG8_SB(0, 0), b2, voffB);
            PG8_BAR; PG8_WAIT_L(0); PG8_MMA(0, 1, At, B1); PG8_BAR;
            PG8_LDA(At, 0, 1); PG8_STAGE(PG8_SA(0, 0), a2, voffA);
            PG8_BAR; PG8_WAIT_L(0); PG8_MMA(1, 0, At, B0); PG8_BAR; PG8_SCHED;
            PG8_STAGE(PG8_SB(0, 1), b2 + hstep, voffB);
            PG8_WAIT_V(6); PG8_BAR; PG8_MMA(1, 1, At, B1); PG8_BAR;
            PG8_LDB(B0, 1, 0); PG8_SCHED; PG8_LDA(At, 1, 0); PG8_STAGE(PG8_SA(0, 1), a2 + hstepA, voffA);
            PG8_WAIT_L(8); PG8_BAR; PG8_WAIT_L(0); PG8_MMA(0, 0, At, B0); PG8_BAR; PG8_SCHED;
            PG8_LDB(B1, 1, 1); PG8_STAGE(PG8_SB(1, 0), b3, voffB);
            PG8_BAR; PG8_WAIT_L(0); PG8_MMA(0, 1, At, B1); PG8_BAR;
            PG8_LDA(At, 1, 1); PG8_STAGE(PG8_SA(1, 0), a3, voffA);
            PG8_BAR; PG8_WAIT_L(0); PG8_MMA(1, 0, At, B0); PG8_BAR; PG8_SCHED;
            PG8_STAGE(PG8_SB(1, 1), b3 + hstep, voffB);
            PG8_WAIT_V(6); PG8_BAR; PG8_MMA(1, 1, At, B1); PG8_BAR;
        }
        PG8_STAMP();
        if constexpr (!Epi::AFTER_DRAIN) { E(acc, cur, wr, wc, fr, fq); S.done(cur); }
        PG8_STAMP();
        if (!has_next) break;
#pragma unroll
        for (int a = 0; a < 2; ++a)
#pragma unroll
            for (int b = 0; b < 2; ++b)
#pragma unroll
                for (int m = 0; m < 4; ++m)
#pragma unroll
                    for (int n = 0; n < 2; ++n) acc[a][b][m][n] = (f32x4){0.f, 0.f, 0.f, 0.f};
        cur = nxt; cA = nA; cB = nB; ++ui;
    }
    PG8_WAIT_V(0);
    if (wr == 0) PG8_BAR;
    PG8_BAR;
    if constexpr (Epi::AFTER_DRAIN) { E.fused(acc, cur, wr, wc, fr, fq, lds, wid, lane); S.done(cur); }
    PG8_STAMP();
    if (STAMP && wid == 0) { stamps[lane] = lane < nts ? (((unsigned long long)(unsigned)ts_hi << 32) | (unsigned)ts_lo) : 0ull;
        if (lane == 62) stamps[62] = rt_entry; if (lane == 63) stamps[63] = (unsigned long long)wall_clock64(); }
#undef PG8_STAMP
#undef PG8_SA
#undef PG8_SB
#undef PG8_STAGE
#undef PG8_LDA
#undef PG8_LDB
#undef PG8_MMA
#undef PG8_WAIT_V
#undef PG8_WAIT_L
#undef PG8_BAR
#undef PG8_SCHED
}
}
struct EpiProj {
  static constexpr bool PERM = false, AFTER_DRAIN = false;
  float* projABC; float* pdraw; int col0;
  __device__ __forceinline__ void operator()(const pg8::f32x4 (&acc)[2][2][4][2], const pg8::Unit& u, int wr, int wc, int fr, int fq) const {
#pragma unroll
    for (int ai = 0; ai < 2; ++ai)
#pragma unroll
      for (int m = 0; m < 4; ++m) {
        const int r = u.pm * 256 + ai * 128 + wr * 64 + m * 16 + fr;
#pragma unroll
        for (int bj = 0; bj < 2; ++bj)
#pragma unroll
          for (int n = 0; n < 2; ++n) {
            const int cp = col0 + u.pn * 256 + bj * 128 + wc * 32 + n * 16 + fq * 4;
            const int c = cp < 768 ? cp : (cp < 4000 ? cp + 256 : (cp < 4096 ? PIN : cp - 3328));
            if (c < NABC) *(pg8::f32x4*)(projABC + (size_t)r * NABC + c) = acc[ai][bj][m][n];
            else if (c < PIN) *(pg8::f32x4*)(pdraw + (size_t)r * NPD + (c - NABC)) = acc[ai][bj][m][n];
          }
      }
  }
};
struct EpiRes {
  static constexpr bool PERM = false, AFTER_DRAIN = false;
  float* out; const float* xp; const float* xs; const float* gate;
  __device__ __forceinline__ void operator()(const pg8::f32x4 (&acc)[2][2][4][2], const pg8::Unit& u, int wr, int wc, int fr, int fq) const {
#pragma unroll
    for (int ai = 0; ai < 2; ++ai)
#pragma unroll
      for (int m = 0; m < 4; ++m) {
        const int r = u.pm * 256 + ai * 128 + wr * 64 + m * 16 + fr;
        int gs, T, ci; tok_info(r, gs, T, ci);
        const float* xr = (r < 4096) ? xp + (size_t)r * DM : xs + (size_t)(r - 4096) * DM;
        const float* gr = gate + (size_t)ci * 6144;
#pragma unroll
        for (int bj = 0; bj < 2; ++bj)
#pragma unroll
          for (int n = 0; n < 2; ++n) {
            const int c = u.pn * 256 + bj * 128 + wc * 32 + n * 16 + fq * 4;
            const pg8::f32x4 x = *(const pg8::f32x4*)(xr + c), g = *(const pg8::f32x4*)(gr + c);
            *(pg8::f32x4*)(out + (size_t)r * DM + c) = x * ALPHA + g * acc[ai][bj][m][n];
          }
      }
  }
};
struct EpiResSplit {
  static constexpr bool PERM = false, AFTER_DRAIN = false;
  float* out; float* tmp; const float* gate;
  __device__ __forceinline__ void operator()(const pg8::f32x4 (&acc)[2][2][4][2], const pg8::Unit& u, int wr, int wc, int fr, int fq) const {
    const bool second = u.pn >= 4; const int pn = u.pn & 3;
#pragma unroll
    for (int ai = 0; ai < 2; ++ai)
#pragma unroll
      for (int m = 0; m < 4; ++m) {
        const int r = u.pm * 256 + ai * 128 + wr * 64 + m * 16 + fr;
        int gs, T, ci; tok_info(r, gs, T, ci);
        const float* gr = gate + (size_t)ci * 6144;
#pragma unroll
        for (int bj = 0; bj < 2; ++bj)
#pragma unroll
          for (int n = 0; n < 2; ++n) {
            const int c = pn * 256 + bj * 128 + wc * 32 + n * 16 + fq * 4;
            if (second) *(pg8::f32x4*)(tmp + (size_t)r * DM + c) = acc[ai][bj][m][n];
            else { const pg8::f32x4 x = *(const pg8::f32x4*)(out + (size_t)r * DM + c), g4 = *(const pg8::f32x4*)(gr + c);
                   *(pg8::f32x4*)(out + (size_t)r * DM + c) = x * ALPHA + g4 * acc[ai][bj][m][n]; }
          }
      }
  }
};
struct EpiFF1 {
  static constexpr bool PERM = true, AFTER_DRAIN = false;
  bf16_t* hidden;
  __device__ __forceinline__ void operator()(const pg8::f32x4 (&acc)[2][2][4][2], const pg8::Unit& u, int wr, int wc, int fr, int fq) const {
#pragma unroll
    for (int ai = 0; ai < 2; ++ai)
#pragma unroll
      for (int m = 0; m < 4; ++m) {
        const int r = u.pm * 256 + ai * 128 + wr * 64 + m * 16 + fr;
#pragma unroll
        for (int bj = 0; bj < 2; ++bj) {
          const int c = u.pn * 256 + bj * 128 + wc * 32 + fq * 8;
          pg8::f32x4 v0 = acc[ai][bj][m][0], v1 = acc[ai][bj][m][1];
#pragma unroll
          for (int e = 0; e < 4; ++e) { v0[e] = fmaxf(v0[e], 0.f); v0[e] *= v0[e]; v1[e] = fmaxf(v1[e], 0.f); v1[e] *= v1[e]; }
          uint4 o; o.x = pack2(v0[0], v0[1]); o.y = pack2(v0[2], v0[3]); o.z = pack2(v1[0], v1[1]); o.w = pack2(v1[2], v1[3]);
          *(uint4*)(hidden + (size_t)r * DFF + c) = o;
        }
      }
  }
};
template <class Epi>
DEV void phase_gemm(const bf16_t* A, const bf16_t* Bt, int N, int K, const Epi& E, char* smem, int lda = 0, int nsplit = 1 << 20, int G = 0) {
  pg8::Gemm g; g.A = A; g.Bt = Bt; g.M = NTOK; g.N = N; g.K = K; g.lda = lda ? lda : K; g.nsplit = nsplit;
  pg8::StaticOrder S; S.init(NTOK, N, G ? G : (int)gridDim.x, (int)blockIdx.x);
  pg8::gemm_phase<Epi, pg8::StaticOrder, false>((PG8_LAS unsigned char*)smem, g, S, E, nullptr);
}

DEV float shiftmix(const float* __restrict__ pd, int g, int col, bool hp, bool hn, float mu) {
  const float x = pd[(size_t)g * NPD + col];
  const float xp = hp ? pd[(size_t)(g - 1) * NPD + col] : 0.f;
  const float xn = hn ? pd[(size_t)(g + 1) * NPD + col] : 0.f;
  return x + mu * (0.5f * (xp + xn) - x);
}
DEV void rwkv_prep_item(const Params& P, int l, int tile, int part, char* smem, const int tid_in) {
  const int tid = opaque_i(tid_in);
  const int lane = tid & 63, w = tid >> 6;
  const int g0 = tile * 64;
  int gs, T, ci; tok_info(g0, gs, T, ci);
  const float* mu = P.rwkv_mu + l * NPD;
  const float* __restrict__ pd = P.pdraw;
  float* __restrict__ rkvp = P.rkv;
  if (part == 0) {
#pragma unroll 4
    for (int idx = tid; idx < 64 * 128; idx += 256) {
      const int row = idx >> 7, c4 = (idx & 127) * 4;
      const int col = c4 < 256 ? c4 : (c4 + 256);
      const int g = g0 + row; const bool hp = g > gs, hn = g + 1 < gs + T;
      const float4 x = *(const float4*)(pd + (size_t)g * NPD + col);
      float4 xp = make_float4(0, 0, 0, 0), xn = make_float4(0, 0, 0, 0);
      if (hp) xp = *(const float4*)(pd + (size_t)(g - 1) * NPD + col);
      if (hn) xn = *(const float4*)(pd + (size_t)(g + 1) * NPD + col);
      const float4 m4 = *(const float4*)(mu + col);
      float4 o;
      o.x = x.x + m4.x * (0.5f * (xp.x + xn.x) - x.x); o.y = x.y + m4.y * (0.5f * (xp.y + xn.y) - x.y);
      o.z = x.z + m4.z * (0.5f * (xp.z + xn.z) - x.z); o.w = x.w + m4.w * (0.5f * (xp.w + xn.w) - x.w);
      *(float4*)(rkvp + (size_t)g * 768 + col) = o;
    }
    { const int cgk = tid & 63, qt = tid >> 6; const int col = 256 + cgk * 4;
      const float4 m4 = *(const float4*)(mu + col);
      const float4 kk = *(const float4*)(P.rwkv_kk + l * 256 + cgk * 4);
#pragma unroll 4
      for (int i = 0; i < 16; ++i) {
        const int g = g0 + qt * 16 + i; const bool hp = g > gs, hn = g + 1 < gs + T;
        const float4 x = *(const float4*)(pd + (size_t)g * NPD + col);
        float4 xp = make_float4(0, 0, 0, 0), xn = make_float4(0, 0, 0, 0);
        if (hp) xp = *(const float4*)(pd + (size_t)(g - 1) * NPD + col);
        if (hn) xn = *(const float4*)(pd + (size_t)(g + 1) * NPD + col);
        float4 o;
        o.x = x.x + m4.x * (0.5f * (xp.x + xn.x) - x.x); o.y = x.y + m4.y * (0.5f * (xp.y + xn.y) - x.y);
        o.z = x.z + m4.z * (0.5f * (xp.z + xn.z) - x.z); o.w = x.w + m4.w * (0.5f * (xp.w + xn.w) - x.w);
        *(float4*)(rkvp + (size_t)g * 768 + col) = o;
        const float ss = red16((o.x * kk.x) * (o.x * kk.x) + (o.y * kk.y) * (o.y * kk.y) + (o.z * kk.z) * (o.z * kk.z) + (o.w * kk.w) * (o.w * kk.w));
        if ((cgk & 15) == 0) P.khinv[g * 4 + (cgk >> 4)] = rsqrtf(ss + 1e-6f);
      }
    }
    return;
  }
  const bool isg = part == 5;
  const int KK = isg ? 128 : 64;
  const int lda = KK + 8;
  int z = 0, kind = 0;
  if (!isg) { const int p = part - 1; z = p >> 1; kind = p & 1; }
  const int acol0 = isg ? 1024 : (768 + kind * 128 + z * 64);
  bf16_t* sA = (bf16_t*)smem;
  {
    const int nq = KK >> 2;
    for (int idx = tid; idx < 64 * nq; idx += 256) {
      const int row = idx / nq, r = (idx % nq) * 4; const int g = g0 + row;
      const bool hp = g > gs, hn = g + 1 < gs + T;
      const float* px = pd + (size_t)g * NPD + acol0 + r;
      const float4 x = *(const float4*)px;
      float4 xp = make_float4(0, 0, 0, 0), xn = make_float4(0, 0, 0, 0);
      if (hp) xp = *(const float4*)(px - NPD);
      if (hn) xn = *(const float4*)(px + NPD);
      const float4 m4 = *(const float4*)(mu + acol0 + r);
      float v0 = x.x + m4.x * (0.5f * (xp.x + xn.x) - x.x), v1 = x.y + m4.y * (0.5f * (xp.y + xn.y) - x.y);
      float v2 = x.z + m4.z * (0.5f * (xp.z + xn.z) - x.z), v3 = x.w + m4.w * (0.5f * (xp.w + xn.w) - x.w);
      if (isg) { v0 = sigmoidf_(v0); v1 = sigmoidf_(v1); v2 = sigmoidf_(v2); v3 = sigmoidf_(v3); }
      else if (kind == 0) { v0 = tanhf(v0); v1 = tanhf(v1); v2 = tanhf(v2); v3 = tanhf(v3); }
      uint2 o; o.x = pack2(v0, v1); o.y = pack2(v2, v3);
      *(uint2*)(sA + row * lda + r) = o;
    }
  }
  const bf16_t* Bt = isg ? (P.g2t + (size_t)l * 256 * 128) : ((kind == 0 ? P.w2t : P.a2t) + (size_t)(l * 2 + z) * 256 * 64);
  __syncthreads();
#pragma unroll 1
  for (int half = 0; half < 2; ++half) {
  const bf16_t* bp = Bt + (size_t)(half * 128 + w * 32 + (lane & 31)) * KK + (lane >> 5) * 8;
  f32x16 acc[2] = {zero16(), zero16()};
  for (int s = 0; s < KK / 16; ++s) {
    const bf16x8 b = *(const bf16x8*)(bp + s * 16);
#pragma unroll
    for (int mi = 0; mi < 2; ++mi) {
      const bf16x8 a = *(const bf16x8*)(sA + (mi * 32 + (lane & 31)) * lda + s * 16 + (lane >> 5) * 8);
      acc[mi] = __builtin_amdgcn_mfma_f32_32x32x16_bf16(a, b, acc[mi], 0, 0, 0);
    }
  }
  const int c = half * 128 + w * 32 + (lane & 31);
  float bias = 0.f;
  if (!isg) bias = (kind == 0 ? P.rwkv_w0 : P.rwkv_a0)[(l * 2 + z) * 256 + c];
#pragma unroll
  for (int mi = 0; mi < 2; ++mi)
#pragma unroll
    for (int idx = 0; idx < 16; ++idx) {
      const int row = mi * 32 + (idx & 3) + 8 * (idx >> 2) + 4 * (lane >> 5);
      const int g = g0 + row;
      const float v = acc[mi][idx];
      if (isg) P.gbuf[(size_t)g * 256 + c] = f2bf(v);
      else {
        const float sg = sigmoidf_(v + bias);
        P.wa[((size_t)(g * 2 + z) * 2 + kind) * 256 + c] = (kind == 0) ? __expf(-0.60653065971f * sg) : sg;
      }
    }
  }
  __syncthreads();
}

DEV float4 dp_load(const float* base, int g, int gs, int T) { float4 r = make_float4(0.f, 0.f, 0.f, 0.f); if (g >= gs && g < gs + T) r = *(const float4*)(base + (size_t)g * NABC); return r; }
DEV void delta_prep_item(const Params& P, int l, int tile, int X, const int tid_in) {
  const int tid = opaque_i(tid_in);
  const int cg = tid & 63, qt = tid >> 6;
  const int g0 = tile * 64 + qt * 16;
  int gs, T, ci; tok_info(g0, gs, T, ci);
  const int col = X * 256 + cg * 4;
  const float* cw = P.delta_conv + (size_t)l * 5 * 768 + col;
  const float4 w0 = *(const float4*)cw, w1 = *(const float4*)(cw + 768), w2 = *(const float4*)(cw + 2 * 768), w3 = *(const float4*)(cw + 3 * 768), w4 = *(const float4*)(cw + 4 * 768);
  const float* base = P.projABC + 1040 + col;
#define DP_LOAD(G) dp_load(base, (G), gs, T)
  float4 xm2 = DP_LOAD(g0 - 2), xm1 = DP_LOAD(g0 - 1), x0 = DP_LOAD(g0), xp1 = DP_LOAD(g0 + 1);
#pragma unroll 4
  for (int i = 0; i < 16; ++i) {
    const int g = g0 + i;
    const float4 xp2 = DP_LOAD(g + 2);
    float4 a;
    a.x = xm2.x * w0.x + xm1.x * w1.x + x0.x * w2.x + xp1.x * w3.x + xp2.x * w4.x;
    a.y = xm2.y * w0.y + xm1.y * w1.y + x0.y * w2.y + xp1.y * w3.y + xp2.y * w4.y;
    a.z = xm2.z * w0.z + xm1.z * w1.z + x0.z * w2.z + xp1.z * w3.z + xp2.z * w4.z;
    a.w = xm2.w * w0.w + xm1.w * w1.w + x0.w * w2.w + xp1.w * w3.w + xp2.w * w4.w;
    a.x = siluf_(a.x); a.y = siluf_(a.y); a.z = siluf_(a.z); a.w = siluf_(a.w);
    float sc = 1.f;
    if (X < 2) { const float ss = red16(a.x * a.x + a.y * a.y + a.z * a.z + a.w * a.w); sc = rsqrtf(ss + 1e-6f) * (X == 0 ? 0.125f : 1.f); }
    uint2 o; o.x = pack2(a.x * sc, a.y * sc); o.y = pack2(a.z * sc, a.w * sc);
    *(uint2*)(P.ubuf + (size_t)g * 768 + col) = o;
    xm2 = xm1; xm1 = x0; x0 = xp1; xp1 = xp2;
  }
#undef DP_LOAD
}

DEV void load16(const float* __restrict__ p, float* v) {
#pragma unroll
  for (int e = 0; e < 4; ++e) { const float4 t = *(const float4*)(p + 4 * e); v[4 * e] = t.x; v[4 * e + 1] = t.y; v[4 * e + 2] = t.z; v[4 * e + 3] = t.w; }
}
DEV void store_row16(bf16_t* dst, const float* v) {
  uint4 a, b;
  a.x = pack2(v[0], v[1]); a.y = pack2(v[2], v[3]); a.z = pack2(v[4], v[5]); a.w = pack2(v[6], v[7]);
  b.x = pack2(v[8], v[9]); b.y = pack2(v[10], v[11]); b.z = pack2(v[12], v[13]); b.w = pack2(v[14], v[15]);
  *(uint4*)dst = a; *(uint4*)(dst + 8) = b;
}
DEV void decode_chain(int task, int& seq, int& h, bool& sample) {
  if (task < 8) { sample = true; seq = 16 + (task >> 2); h = task & 3; }
  else { const int t = task - 8; sample = false; seq = t >> 2; h = t & 3; }
}
DEV void seq_base(int seq, int& gs, int& T) { if (seq < 16) { gs = seq * 256; T = 256; } else { gs = 4096 + (seq - 16) * 2048; T = 2048; } }
DEV float wave_incl_scan_add(float x, int lane) {
#pragma unroll
  for (int o = 1; o < 64; o <<= 1) { const float y = __shfl_up(x, o); if (lane >= o) x += y; }
  return x;
}
DEV float wave_incl_scan_max(float x, int lane) {
#pragma unroll
  for (int o = 1; o < 64; o <<= 1) { const float y = __shfl_up(x, o); if (lane >= o) x = fmaxf(x, y); }
  return x;
}

DEV void ret_task(const Params& P, int l, int task, const int z, char* smem, const int tid_in, const bool active) {
  const int tid = opaque_i(tid_in);
  const int lane = tid & 63, w = tid >> 6, wr = w >> 1, wc = w & 1;
  int seq, h; bool sample; decode_chain(task, seq, h, sample);
  int gs, T; seq_base(seq, gs, T);
  if (!active) { for (int c = 0; c < T / 64; ++c) { __syncthreads(); __syncthreads(); __syncthreads(); } return; }
  bf16_t* sQ = (bf16_t*)smem; bf16_t* sK = sQ + 64 * LDB; bf16_t* sKzt = sK + 64 * LDB; bf16_t* sVt = sKzt + 64 * LDB; bf16_t* sP = sVt + 64 * LDB; bf16_t* sSt = sP + 64 * LDB;
  const float lg = -__expf(P.ret_decay[(l * 2 + z) * 4 + h]);
  const float gl = __expf(64.f * lg);
  f32x16 st = zero16();
  if (sample) {
    const float* s0 = P.st_ret + ((size_t)(((seq - 16) * 2 + l) * 2 + z) * 4 + h) * 4096;
#pragma unroll
    for (int idx = 0; idx < 16; ++idx) st[idx] = s0[ACC_COL * 64 + ACC_ROW(idx)];
  }
#pragma unroll
  for (int idx = 0; idx < 16; ++idx) sSt[ACC_ROW(idx) * LDB + ACC_COL] = f2bf(st[idx]);
  const int nch = T / 64;
  const int tid_outer = tid;
  float4 nq[4], nk[4], nv[4], nq2[4], nk2[4];
#define RET_PREFETCH(C) { \
    const int r_ = tid_outer & 63, sg_ = (tid_outer >> 6) * 16; \
    const int p_ = (C) * 64 + r_; const int g_ = gs + (z ? (T - 1 - p_) : p_); \
    const float* pr_ = P.projABC + (size_t)g_ * NABC + 2080 + h * 64; \
    _Pragma("unroll") for (int e_ = 0; e_ < 4; ++e_) { nq[e_] = *(const float4*)(pr_ + sg_ + 4 * e_); nk[e_] = *(const float4*)(pr_ + 256 + sg_ + 4 * e_); nv[e_] = *(const float4*)(pr_ + 512 + sg_ + 4 * e_); } \
    if (sample) { _Pragma("unroll") for (int e_ = 0; e_ < 4; ++e_) { nq2[e_] = *(const float4*)(pr_ + (sg_ ^ 16) + 4 * e_); nk2[e_] = *(const float4*)(pr_ + 256 + (sg_ ^ 16) + 4 * e_); } } }
  RET_PREFETCH(0)
  for (int c = 0; c < nch; ++c) {
    const int tid = opaque_i(tid_outer);
    const int lane = tid & 63, w = tid >> 6, wr = w >> 1, wc = w & 1;
    const int row = tid & 63, seg = (tid >> 6) * 16;
    {
      const int p = c * 64 + row; const int t = z ? (T - 1 - p) : p;
      float q[16], k[16], v[16];
#pragma unroll
      for (int e = 0; e < 4; ++e) { q[4 * e] = nq[e].x; q[4 * e + 1] = nq[e].y; q[4 * e + 2] = nq[e].z; q[4 * e + 3] = nq[e].w; k[4 * e] = nk[e].x; k[4 * e + 1] = nk[e].y; k[4 * e + 2] = nk[e].z; k[4 * e + 3] = nk[e].w;
        v[4 * e] = nv[e].x; v[4 * e + 1] = nv[e].y; v[4 * e + 2] = nv[e].z; v[4 * e + 3] = nv[e].w; }
      if (sample) {
        float q2[16], k2[16];
#pragma unroll
        for (int e = 0; e < 4; ++e) { q2[4 * e] = nq2[e].x; q2[4 * e + 1] = nq2[e].y; q2[4 * e + 2] = nq2[e].z; q2[4 * e + 3] = nq2[e].w; k2[4 * e] = nk2[e].x; k2[4 * e + 1] = nk2[e].y; k2[4 * e + 2] = nk2[e].z; k2[4 * e + 3] = nk2[e].w; }
        const float pos = (seg < 32) ? (float)(t >> 6) : (float)(t & 63);
        const bool first = (seg & 16) == 0;
#pragma unroll
        for (int e = 0; e < 16; ++e) {
          const float inv = __expf(-(float)e * (9.210340371976184f / 16.f));
          const float sn = __sinf(pos * inv), cs = __cosf(pos * inv);
          const float qs = first ? -q2[e] : q2[e], ks = first ? -k2[e] : k2[e];
          q[e] = q[e] * cs + qs * sn; k[e] = k[e] * cs + ks * sn;
        }
      }
      const float zeta = __expf((63.f - (float)row) * lg);
      float qq[16];
#pragma unroll
      for (int e = 0; e < 16; ++e) qq[e] = q[e] * 0.125f;
      store_row16(sQ + row * LDB + seg, qq);
      store_row16(sK + row * LDB + seg, k);
#pragma unroll
      for (int e = 0; e < 16; ++e) { sKzt[(seg + e) * LDB + row] = f2bf(k[e] * zeta); sVt[(seg + e) * LDB + row] = f2bf(v[e]); }
    }
    __syncthreads();
    if (c + 1 < nch) RET_PREFETCH(c + 1)
    f32x16 s = mm64(sQ, sK, wr, wc, lane, zero16());
#pragma unroll
    for (int idx = 0; idx < 16; ++idx) {
      const int i = ACC_ROW(idx), j = ACC_COL;
      const float val = (i >= j) ? s[idx] * __expf((float)(i - j) * lg) : 0.f;
      sP[i * LDB + j] = f2bf(val);
    }
    __syncthreads();
    f32x16 o1 = mm64(sP, sVt, wr, wc, lane, zero16());
    f32x16 o2 = mm64(sQ, sSt, wr, wc, lane, zero16());
#pragma unroll
    for (int idx = 0; idx < 16; ++idx) st[idx] *= gl;
    st = mm64(sVt, sKzt, wr, wc, lane, st);
#pragma unroll
    for (int idx = 0; idx < 16; ++idx) {
      const int i = ACC_ROW(idx), e = ACC_COL;
      const float xi = __expf((float)(i + 1) * lg);
      const int pp = c * 64 + i; const int tt = z ? (T - 1 - pp) : pp;
      P.hdir[((size_t)z * NTOK + gs + tt) * DM + 512 + h * 64 + e] = f2bf(o1[idx] + xi * o2[idx]);
    }
    __syncthreads();
#pragma unroll
    for (int idx = 0; idx < 16; ++idx) sSt[ACC_ROW(idx) * LDB + ACC_COL] = f2bf(st[idx]);
  }
  if (!sample) {
    float* o = P.out + O_RET + ((size_t)((seq * 2 + l) * 2 + z) * 4 + h) * 4096;
#pragma unroll
    for (int idx = 0; idx < 16; ++idx) o[ACC_COL * 64 + ACC_ROW(idx)] = st[idx];
  }
}

DEV void ret_sample_task(const Params& P, int l, int task, const int z, char* smem0, const int tid_all_in) {
  const int tid_all = opaque_i(tid_all_in);
  const int half = tid_all >> 8, tid0 = tid_all & 255;
  int seq, h; bool sample; decode_chain(task, seq, h, sample);
  int gs, T; seq_base(seq, gs, T);
  const int nch = T / 64;
  const float lg = -__expf(P.ret_decay[(l * 2 + z) * 4 + h]);
#define RT_SET(B) ((bf16_t*)(smem0 + (B) * HALF_LDS))
  bf16_t* sP = RT_SET(0) + 4 * 64 * LDB; bf16_t* sSt = sP + 64 * LDB;
  if (half == 1) {
    const int tid = tid0;
    float4 nq[4], nk[4], nv[4], nq2[4], nk2[4];
#pragma unroll
    for (int e = 0; e < 4; ++e) { nq2[e] = make_float4(0.f, 0.f, 0.f, 0.f); nk2[e] = nq2[e]; }
#define RT_PREFETCH(C) { \
      const int r_ = tid & 63, sg_ = (tid >> 6) * 16; \
      const int p_ = (C) * 64 + r_; const int g_ = gs + (z ? (T - 1 - p_) : p_); \
      const float* pr_ = P.projABC + (size_t)g_ * NABC + 2080 + h * 64; \
      _Pragma("unroll") for (int e_ = 0; e_ < 4; ++e_) { nq[e_] = *(const float4*)(pr_ + sg_ + 4 * e_); nk[e_] = *(const float4*)(pr_ + 256 + sg_ + 4 * e_); nv[e_] = *(const float4*)(pr_ + 512 + sg_ + 4 * e_); \
        if (sample) { nq2[e_] = *(const float4*)(pr_ + (sg_ ^ 16) + 4 * e_); nk2[e_] = *(const float4*)(pr_ + 256 + (sg_ ^ 16) + 4 * e_); } } }
#define RT_STAGE(C) { \
      bf16_t* sQ = RT_SET((C) & 1); bf16_t* sK = sQ + 64 * LDB; bf16_t* sKzt = sK + 64 * LDB; bf16_t* sVt = sKzt + 64 * LDB; \
      const int row = tid & 63, seg = (tid >> 6) * 16; \
      const int p = (C) * 64 + row; const int t = z ? (T - 1 - p) : p; \
      float q[16], k[16], v[16], q2[16], k2[16]; \
      _Pragma("unroll") for (int e = 0; e < 4; ++e) { q[4 * e] = nq[e].x; q[4 * e + 1] = nq[e].y; q[4 * e + 2] = nq[e].z; q[4 * e + 3] = nq[e].w; k[4 * e] = nk[e].x; k[4 * e + 1] = nk[e].y; k[4 * e + 2] = nk[e].z; k[4 * e + 3] = nk[e].w; \
        v[4 * e] = nv[e].x; v[4 * e + 1] = nv[e].y; v[4 * e + 2] = nv[e].z; v[4 * e + 3] = nv[e].w; \
        q2[4 * e] = nq2[e].x; q2[4 * e + 1] = nq2[e].y; q2[4 * e + 2] = nq2[e].z; q2[4 * e + 3] = nq2[e].w; k2[4 * e] = nk2[e].x; k2[4 * e + 1] = nk2[e].y; k2[4 * e + 2] = nk2[e].z; k2[4 * e + 3] = nk2[e].w; } \
      const float pos = (seg < 32) ? (float)(t >> 6) : (float)(t & 63); \
      const bool first = (seg & 16) == 0; \
      if (sample) { _Pragma("unroll") for (int e = 0; e < 16; ++e) { \
        const float inv = __expf(-(float)e * (9.210340371976184f / 16.f)); \
        const float sn = __sinf(pos * inv), cs = __cosf(pos * inv); \
        const float qs = first ? -q2[e] : q2[e], ks = first ? -k2[e] : k2[e]; \
        q[e] = (q[e] * cs + qs * sn) * 0.125f; k[e] = k[e] * cs + ks * sn; } } \
      else { _Pragma("unroll") for (int e = 0; e < 16; ++e) q[e] *= 0.125f; } \
      const float zeta = __expf((63.f - (float)row) * lg); \
      store_row16(sQ + row * LDB + seg, q); \
      store_row16(sK + row * LDB + seg, k); \
      _Pragma("unroll") for (int e = 0; e < 16; ++e) { sKzt[(seg + e) * LDB + row] = f2bf(k[e] * zeta); sVt[(seg + e) * LDB + row] = f2bf(v[e]); } }
    RT_PREFETCH(0)
    RT_STAGE(0)
    if (nch > 1) RT_PREFETCH(1)
    __syncthreads();
    for (int c = 0; c < nch; ++c) {
      if (c + 1 < nch) { RT_STAGE(c + 1) if (c + 2 < nch) RT_PREFETCH(c + 2) }
      __syncthreads(); __syncthreads(); __syncthreads();
    }
#undef RT_PREFETCH
#undef RT_STAGE
  } else {
    const int tid = tid0;
    const int lane = tid & 63, w = tid >> 6, wr = w >> 1, wc = w & 1;
    const float gl = __expf(64.f * lg);
    f32x16 st = zero16();
    if (sample) {
      const float* s0 = P.st_ret + ((size_t)(((seq - 16) * 2 + l) * 2 + z) * 4 + h) * 4096;
#pragma unroll
      for (int idx = 0; idx < 16; ++idx) st[idx] = s0[ACC_COL * 64 + ACC_ROW(idx)];
    }
#pragma unroll
    for (int idx = 0; idx < 16; ++idx) sSt[ACC_ROW(idx) * LDB + ACC_COL] = f2bf(st[idx]);
    __syncthreads();
    for (int c = 0; c < nch; ++c) {
      const bf16_t* sQ = RT_SET(c & 1); const bf16_t* sK = sQ + 64 * LDB; const bf16_t* sKzt = sK + 64 * LDB; const bf16_t* sVt = sKzt + 64 * LDB;
      f32x16 s = mm64(sQ, sK, wr, wc, lane, zero16());
#pragma unroll
      for (int idx = 0; idx < 16; ++idx) {
        const int i = ACC_ROW(idx), j = ACC_COL;
        const float val = (i >= j) ? s[idx] * __expf((float)(i - j) * lg) : 0.f;
        sP[i * LDB + j] = f2bf(val);
      }
      __syncthreads();
      f32x16 o1 = mm64(sP, sVt, wr, wc, lane, zero16());
      f32x16 o2 = mm64(sQ, sSt, wr, wc, lane, zero16());
#pragma unroll
      for (int idx = 0; idx < 16; ++idx) st[idx] *= gl;
      st = mm64(sVt, sKzt, wr, wc, lane, st);
#pragma unroll
      for (int idx = 0; idx < 16; ++idx) {
        const int i = ACC_ROW(idx), e = ACC_COL;
        const float xi = __expf((float)(i + 1) * lg);
        const int pp = c * 64 + i; const int tt = z ? (T - 1 - pp) : pp;
        P.hdir[((size_t)z * NTOK + gs + tt) * DM + 512 + h * 64 + e] = f2bf(o1[idx] + xi * o2[idx]);
      }
      __syncthreads();
#pragma unroll
      for (int idx = 0; idx < 16; ++idx) sSt[ACC_ROW(idx) * LDB + ACC_COL] = f2bf(st[idx]);
      __syncthreads();
    }
    if (!sample) {
      float* o = P.out + O_RET + ((size_t)((seq * 2 + l) * 2 + z) * 4 + h) * 4096;
#pragma unroll
      for (int idx = 0; idx < 16; ++idx) o[ACC_COL * 64 + ACC_ROW(idx)] = st[idx];
    }
  }
#undef RT_SET
}

DEV void mlstm_task(const Params& P, int l, int task, const int z, char* smem, const int tid_in, const bool active) {
  const int tid = opaque_i(tid_in);
  const int lane = tid & 63, w = tid >> 6, wr = w >> 1, wc = w & 1;
  int seq, h; bool sample; decode_chain(task, seq, h, sample);
  int gs, T; seq_base(seq, gs, T);
  if (!active) { for (int c = 0; c < T / 64; ++c) { __syncthreads(); __syncthreads(); __syncthreads(); } return; }
  bf16_t* sQ = (bf16_t*)smem; bf16_t* sK = sQ + 64 * LDB; bf16_t* sKt = sK + 64 * LDB; bf16_t* sVt = sKt + 64 * LDB; bf16_t* sP = sVt + 64 * LDB; bf16_t* sCt = sP + 64 * LDB;
  float* fs = (float*)(sCt + 64 * LDB);
  float* s_gate = fs; float* s_nn = fs + 640;
  const int sidx = sample ? ((((seq - 16) * 2 + l) * 2 + z) * 4 + h) : 0;
  f32x16 st = zero16();
  if (sample) {
    const float* c0 = P.st_C + (size_t)sidx * 4096;
#pragma unroll
    for (int idx = 0; idx < 16; ++idx) st[idx] = c0[ACC_COL * 64 + ACC_ROW(idx)];
  }
#pragma unroll
  for (int idx = 0; idx < 16; ++idx) sCt[ACC_ROW(idx) * LDB + ACC_COL] = f2bf(st[idx]);
  if (tid < 64) s_nn[tid] = sample ? P.st_n[sidx * 64 + tid] : 0.f;
  float m = sample ? P.st_m[sidx] : 0.f;
  const float ib = P.mlstm_i_bias[(l * 2 + z) * 4 + h], fb = P.mlstm_f_bias[(l * 2 + z) * 4 + h];
  const int nch = T / 64;
  const int tid_outer = tid;
  float4 nq[4], nk[4], nv[4]; float ngi, ngf;
#define MLSTM_PREFETCH(C) { \
    const int r_ = tid_outer & 63, sg_ = (tid_outer >> 6) * 16; \
    const int p_ = (C) * 64 + r_; const int g_ = gs + (z ? (T - 1 - p_) : p_); \
    const float* pr_ = P.projABC + (size_t)g_ * NABC + h * 64; \
    _Pragma("unroll") for (int e_ = 0; e_ < 4; ++e_) { nq[e_] = *(const float4*)(pr_ + sg_ + 4 * e_); nk[e_] = *(const float4*)(pr_ + 256 + sg_ + 4 * e_); nv[e_] = *(const float4*)(pr_ + 512 + sg_ + 4 * e_); } \
    const float* gp_ = P.projABC + (size_t)g_ * NABC + 1024 + z * 4 + h; ngi = gp_[0]; ngf = gp_[8]; }
  MLSTM_PREFETCH(0)
  for (int c = 0; c < nch; ++c) {
    const int tid = opaque_i(tid_outer);
    const int lane = tid & 63, w = tid >> 6, wr = w >> 1, wc = w & 1;
    const int row = tid & 63, seg = (tid >> 6) * 16;
    const int par = c & 1;
    float* s_a = s_gate + par * 320; float* s_b = s_a + 64; float* s_M = s_a + 128; float* s_ew = s_a + 192; float* s_dinv = s_a + 256;
    float* s_n = s_nn + par * 64; float* s_n2 = s_nn + (par ^ 1) * 64;
    float sp;
    {
      const float li = ngi + ib, lf = logsigmoidf_(ngf + fb);
      const float b = wave_incl_scan_add(lf, lane);
      const float a = li - b;
      const float cm = wave_incl_scan_max(a, lane);
      const float M = fmaxf(m, cm);
      const float M63 = __shfl(M, 63), bl = __shfl(b, 63);
      const float skj = __expf(a - M63);
      sp = __expf(m - M63);
      if (w == 0) { s_a[lane] = a; s_b[lane] = b; s_M[lane] = M; s_ew[lane] = __expf(m - M); }
      m = bl + M63;
      float q[16], k[16], v[16];
#pragma unroll
      for (int e = 0; e < 4; ++e) { q[4 * e] = nq[e].x; q[4 * e + 1] = nq[e].y; q[4 * e + 2] = nq[e].z; q[4 * e + 3] = nq[e].w;
        k[4 * e] = nk[e].x * 0.125f; k[4 * e + 1] = nk[e].y * 0.125f; k[4 * e + 2] = nk[e].z * 0.125f; k[4 * e + 3] = nk[e].w * 0.125f;
        v[4 * e] = nv[e].x; v[4 * e + 1] = nv[e].y; v[4 * e + 2] = nv[e].z; v[4 * e + 3] = nv[e].w; }
      store_row16(sQ + row * LDB + seg, q);
      store_row16(sK + row * LDB + seg, k);
#pragma unroll
      for (int e = 0; e < 16; ++e) { sKt[(seg + e) * LDB + row] = f2bf(k[e] * skj); sVt[(seg + e) * LDB + row] = f2bf(v[e]); }
    }
    __syncthreads();
    f32x16 s = mm64(sQ, sK, wr, wc, lane, zero16());
#pragma unroll
    for (int idx = 0; idx < 16; ++idx) {
      const int i = ACC_ROW(idx), j = ACC_COL;
      const float val = (i >= j) ? s[idx] * __expf(s_a[j] - s_M[i]) : 0.f;
      sP[i * LDB + j] = f2bf(val);
    }
    __syncthreads();
    if (c + 1 < nch) MLSTM_PREFETCH(c + 1)
    f32x16 o1 = mm64(sP, sVt, wr, wc, lane, zero16());
    f32x16 o2 = mm64(sQ, sCt, wr, wc, lane, zero16());
    {
      const int r4 = tid >> 2, sg4 = (tid & 3) * 16;
      float rs = 0.f, qn = 0.f;
#pragma unroll
      for (int e = 0; e < 16; ++e) { rs += bf2f(sP[r4 * LDB + sg4 + e]); qn += bf2f(sQ[r4 * LDB + sg4 + e]) * s_n[sg4 + e]; }
      rs = red4(rs); qn = red4(qn);
      const float den = rs + qn * s_ew[r4];
      const float mt = s_b[r4] + s_M[r4];
      if ((tid & 3) == 0) s_dinv[r4] = 1.f / fmaxf(fabsf(den), __expf(-mt));
    }
#pragma unroll
    for (int idx = 0; idx < 16; ++idx) st[idx] *= sp;
    st = mm64(sVt, sKt, wr, wc, lane, st);
    if (tid < 64) {
      float a = s_n[tid] * sp;
      for (int j = 0; j < 64; ++j) a += bf2f(sKt[tid * LDB + j]);
      s_n2[tid] = a;
    }
    __syncthreads();
#pragma unroll
    for (int idx = 0; idx < 16; ++idx) {
      const int i = ACC_ROW(idx), e = ACC_COL;
      const int pp = c * 64 + i; const int tt = z ? (T - 1 - pp) : pp;
      P.hdir[((size_t)z * NTOK + gs + tt) * DM + h * 64 + e] = f2bf((o1[idx] + s_ew[i] * o2[idx]) * s_dinv[i]);
    }
#pragma unroll
    for (int idx = 0; idx < 16; ++idx) sCt[ACC_ROW(idx) * LDB + ACC_COL] = f2bf(st[idx]);
  }
  if (!sample) {
    const int oi = ((seq * 2 + l) * 2 + z) * 4 + h;
    float* o = P.out + O_C + (size_t)oi * 4096;
#pragma unroll
    for (int idx = 0; idx < 16; ++idx) o[ACC_COL * 64 + ACC_ROW(idx)] = st[idx];
    __syncthreads();
    if (tid < 64) P.out[O_N + oi * 64 + tid] = s_nn[(nch & 1) * 64 + tid];
    if (tid == 0) P.out[O_M + oi] = m;
  }
}

DEV void mlstm_sample_task(const Params& P, int l, int task, const int z, char* smem0, const int tid_all_in) {
  const int tid_all = opaque_i(tid_all_in);
  const int half = tid_all >> 8, tid = tid_all & 255;
  int seq, h; bool sample; decode_chain(task, seq, h, sample);
  int gs, T; seq_base(seq, gs, T);
  const int nch = T / 64;
  const int sidx = (((seq - 16) * 2 + l) * 2 + z) * 4 + h;
#define ML_SET(B) ((bf16_t*)(smem0 + (B) * HALF_LDS))
#define ML_GATE(B) ((float*)(smem0 + (B) * HALF_LDS + 4 * 64 * LDB * 2))
  bf16_t* sP = (bf16_t*)(smem0 + 4 * 64 * LDB * 2 + 2048); bf16_t* sCt = sP + 64 * LDB;
  float* s_dinv = (float*)(sCt + 64 * LDB); float* s_nn = s_dinv + 64;
  if (half == 1) {
    const int lane = tid & 63, w = tid >> 6;
    float m = P.st_m[sidx];
    const float ib = P.mlstm_i_bias[(l * 2 + z) * 4 + h], fb = P.mlstm_f_bias[(l * 2 + z) * 4 + h];
    float4 nq[4], nk[4], nv[4]; float ngi, ngf;
#define ML_PREFETCH(C) { \
      const int r_ = tid & 63, sg_ = (tid >> 6) * 16; \
      const int p_ = (C) * 64 + r_; const int g_ = gs + (z ? (T - 1 - p_) : p_); \
      const float* pr_ = P.projABC + (size_t)g_ * NABC + h * 64; \
      _Pragma("unroll") for (int e_ = 0; e_ < 4; ++e_) { nq[e_] = *(const float4*)(pr_ + sg_ + 4 * e_); nk[e_] = *(const float4*)(pr_ + 256 + sg_ + 4 * e_); nv[e_] = *(const float4*)(pr_ + 512 + sg_ + 4 * e_); } \
      const float* gp_ = P.projABC + (size_t)g_ * NABC + 1024 + z * 4 + h; ngi = gp_[0]; ngf = gp_[8]; }
#define ML_STAGE(C) { \
      bf16_t* sQ = ML_SET((C) & 1); bf16_t* sK = sQ + 64 * LDB; bf16_t* sKt = sK + 64 * LDB; bf16_t* sVt = sKt + 64 * LDB; \
      float* gt_ = ML_GATE((C) & 1); \
      const int row = tid & 63, seg = (tid >> 6) * 16; \
      const float li = ngi + ib, lf = logsigmoidf_(ngf + fb); \
      const float b = wave_incl_scan_add(lf, lane); \
      const float a = li - b; \
      const float cm = wave_incl_scan_max(a, lane); \
      const float M = fmaxf(m, cm); \
      const float M63 = __shfl(M, 63), bl = __shfl(b, 63); \
      const float skj = __expf(a - M63); \
      if (w == 0) { gt_[lane] = a; gt_[64 + lane] = b; gt_[128 + lane] = M; gt_[192 + lane] = __expf(m - M); if (lane == 0) gt_[256] = __expf(m - M63); } \
      m = bl + M63; \
      float q[16], k[16], v[16]; \
      _Pragma("unroll") for (int e = 0; e < 4; ++e) { q[4 * e] = nq[e].x; q[4 * e + 1] = nq[e].y; q[4 * e + 2] = nq[e].z; q[4 * e + 3] = nq[e].w; \
        k[4 * e] = nk[e].x * 0.125f; k[4 * e + 1] = nk[e].y * 0.125f; k[4 * e + 2] = nk[e].z * 0.125f; k[4 * e + 3] = nk[e].w * 0.125f; \
        v[4 * e] = nv[e].x; v[4 * e + 1] = nv[e].y; v[4 * e + 2] = nv[e].z; v[4 * e + 3] = nv[e].w; } \
      store_row16(sQ + row * LDB + seg, q); \
      store_row16(sK + row * LDB + seg, k); \
      _Pragma("unroll") for (int e = 0; e < 16; ++e) { sKt[(seg + e) * LDB + row] = f2bf(k[e] * skj); sVt[(seg + e) * LDB + row] = f2bf(v[e]); } }
    ML_PREFETCH(0)
    ML_STAGE(0)
    if (nch > 1) ML_PREFETCH(1)
    __syncthreads();
    for (int c = 0; c < nch; ++c) {
      if (c + 1 < nch) { ML_STAGE(c + 1) if (c + 2 < nch) ML_PREFETCH(c + 2) }
      __syncthreads(); __syncthreads(); __syncthreads();
    }
#undef ML_PREFETCH
#undef ML_STAGE
  } else {
    const int lane = tid & 63, w = tid >> 6, wr = w >> 1, wc = w & 1;
    f32x16 st = zero16();
    {
      const float* c0 = P.st_C + (size_t)sidx * 4096;
#pragma unroll
      for (int idx = 0; idx < 16; ++idx) st[idx] = c0[ACC_COL * 64 + ACC_ROW(idx)];
    }
#pragma unroll
    for (int idx = 0; idx < 16; ++idx) sCt[ACC_ROW(idx) * LDB + ACC_COL] = f2bf(st[idx]);
    if (tid < 64) s_nn[tid] = P.st_n[sidx * 64 + tid];
    __syncthreads();
    for (int c = 0; c < nch; ++c) {
      const bf16_t* sQ = ML_SET(c & 1); const bf16_t* sK = sQ + 64 * LDB; const bf16_t* sKt = sK + 64 * LDB; const bf16_t* sVt = sKt + 64 * LDB;
      const float* gt = ML_GATE(c & 1);
      const float* s_a = gt; const float* s_b = gt + 64; const float* s_M = gt + 128; const float* s_ew = gt + 192;
      const float sp = gt[256];
      const float* s_n = s_nn + (c & 1) * 64; float* s_n2 = s_nn + ((c & 1) ^ 1) * 64;
      f32x16 s = mm64(sQ, sK, wr, wc, lane, zero16());
#pragma unroll
      for (int idx = 0; idx < 16; ++idx) {
        const int i = ACC_ROW(idx), j = ACC_COL;
        const float val = (i >= j) ? s[idx] * __expf(s_a[j] - s_M[i]) : 0.f;
        sP[i * LDB + j] = f2bf(val);
      }
      __syncthreads();
      f32x16 o1 = mm64(sP, sVt, wr, wc, lane, zero16());
      f32x16 o2 = mm64(sQ, sCt, wr, wc, lane, zero16());
      {
        const int r4 = tid >> 2, sg4 = (tid & 3) * 16;
        float rs = 0.f, qn = 0.f;
#pragma unroll
        for (int e = 0; e < 16; ++e) { rs += bf2f(sP[r4 * LDB + sg4 + e]); qn += bf2f(sQ[r4 * LDB + sg4 + e]) * s_n[sg4 + e]; }
        rs = red4(rs); qn = red4(qn);
        const float den = rs + qn * s_ew[r4];
        const float mt = s_b[r4] + s_M[r4];
        if ((tid & 3) == 0) s_dinv[r4] = 1.f / fmaxf(fabsf(den), __expf(-mt));
      }
#pragma unroll
      for (int idx = 0; idx < 16; ++idx) st[idx] *= sp;
      st = mm64(sVt, sKt, wr, wc, lane, st);
      if (tid < 64) {
        float a = s_n[tid] * sp;
        for (int j = 0; j < 64; ++j) a += bf2f(sKt[tid * LDB + j]);
        s_n2[tid] = a;
      }
      __syncthreads();
#pragma unroll
      for (int idx = 0; idx < 16; ++idx) {
        const int i = ACC_ROW(idx), e = ACC_COL;
        const int pp = c * 64 + i; const int tt = z ? (T - 1 - pp) : pp;
        P.hdir[((size_t)z * NTOK + gs + tt) * DM + h * 64 + e] = f2bf((o1[idx] + s_ew[i] * o2[idx]) * s_dinv[i]);
      }
#pragma unroll
      for (int idx = 0; idx < 16; ++idx) sCt[ACC_ROW(idx) * LDB + ACC_COL] = f2bf(st[idx]);
      __syncthreads();
    }
  }
#undef ML_SET
#undef ML_GATE
}

DEV void delta_T_item(const Params& P, int l, int item, char* smem, const int tid_in) {
  const int tid = opaque_i(tid_in);
  const int lane = tid & 63, w = tid >> 6, wr = w >> 1, wc = w & 1;
  const int tile = item & 127, zh = item >> 7, z = zh >> 2, h = zh & 3;
  int gs, T, ci; tok_info(tile * 64, gs, T, ci);
  float* sA = (float*)smem;
  float* s_beta = sA + 2016; float* s_gc = s_beta + 64;
  bf16_t* sK = (bf16_t*)(smem + 8576); bf16_t* sT = sK + 64 * LDB;
  const float aneg = -__expf(P.delta_a_log[(l * 2 + z) * 4 + h]), dtb = P.delta_dt_bias[(l * 2 + z) * 4 + h];
  {
    const int row = tid >> 2, seg = (tid & 3) * 16;
    const int g = tile * 64 + (z ? 63 - row : row);
    const bf16_t* src = P.ubuf + (size_t)g * 768 + 256 + h * 64 + seg;
    *(uint4*)(sK + row * LDB + seg) = *(const uint4*)src; *(uint4*)(sK + row * LDB + seg + 8) = *(const uint4*)(src + 8);
  }
  if (w == 0) {
    const int g = tile * 64 + (z ? 63 - lane : lane);
    const float* gp = P.projABC + (size_t)g * NABC + 2064 + z * 4 + h;
    const float beta = sigmoidf_(gp[0]);
    const float gj = aneg * softplusf_(gp[8] + dtb);
    const float gc = wave_incl_scan_add(gj, lane);
    s_beta[lane] = beta; s_gc[lane] = gc;
    P.dbeta[(size_t)zh * NTOK + g] = beta; P.dgc[(size_t)zh * NTOK + g] = gc;
  }
  __syncthreads();
  {
    f32x16 kkm = mm64(sK, sK, wr, wc, lane, zero16());
#pragma unroll
    for (int idx = 0; idx < 16; ++idx) {
      const int i = ACC_ROW(idx), j = ACC_COL;
      const float av = kkm[idx] * __expf(s_gc[i] - s_gc[j]) * s_beta[i];
      if (i > j) sA[i * (i - 1) / 2 + j] = av;
      if (w == 2) sT[i * LDB + j] = f2bf(av);
    }
  }
  __syncthreads();
  if (w < 2 && lane < 32) {
    const int o = w * 32;
    float x[32];
    const float flane = (float)lane;
#pragma unroll
    for (int i = 0; i < 32; ++i) {
      float a = fmaxf(0.f, 1.f - fabsf(flane - (float)i));
      const float* arow = sA + (o + i) * (o + i - 1) / 2 + o;
#pragma unroll
      for (int j = 0; j < i; ++j) a -= arow[j] * x[j];
      x[i] = a;
      sT[(o + i) * LDB + o + lane] = f2bf(a);
      if (w == 0) sT[lane * LDB + 32 + i] = f2bf(a);
    }
  }
  __syncthreads();
  if (w == 0) {
    const bf16_t* aA = sT + (32 + (lane & 31)) * LDB + (lane >> 5) * 8;
    const bf16_t* bT = sT + (lane & 31) * LDB + 32 + (lane >> 5) * 8;
    f32x16 m1 = zero16();
#pragma unroll
    for (int s2 = 0; s2 < 2; ++s2) m1 = __builtin_amdgcn_mfma_f32_32x32x16_bf16(*(const bf16x8*)(aA + s2 * 16), *(const bf16x8*)(bT + s2 * 16), m1, 0, 0, 0);
#pragma unroll
    for (int g4 = 0; g4 < 4; ++g4) {
      uint2 o2; o2.x = pack2(m1[4 * g4], m1[4 * g4 + 1]); o2.y = pack2(m1[4 * g4 + 2], m1[4 * g4 + 3]);
      *(uint2*)(sT + (lane & 31) * LDB + 32 + 8 * g4 + 4 * (lane >> 5)) = o2;
    }
    const bf16_t* a2 = sT + (32 + (lane & 31)) * LDB + 32 + (lane >> 5) * 8;
    f32x16 m2 = zero16();
#pragma unroll
    for (int s2 = 0; s2 < 2; ++s2) m2 = __builtin_amdgcn_mfma_f32_32x32x16_bf16(*(const bf16x8*)(a2 + s2 * 16), *(const bf16x8*)(bT + s2 * 16), m2, 0, 0, 0);
#pragma unroll
    for (int idx = 0; idx < 16; ++idx) sT[(32 + (idx & 3) + 8 * (idx >> 2) + 4 * (lane >> 5)) * LDB + (lane & 31)] = f2bf(-m2[idx]);
    *(uint4*)(sT + (lane & 31) * LDB + 32 + (lane >> 5) * 16) = make_uint4(0u, 0u, 0u, 0u);
    *(uint4*)(sT + (lane & 31) * LDB + 32 + (lane >> 5) * 16 + 8) = make_uint4(0u, 0u, 0u, 0u);
  }
  __syncthreads();
  {
    const int row = tid >> 2, seg = (tid & 3) * 16;
    bf16_t* dst = P.dT + ((size_t)item * 64 + row) * 64 + seg;
    *(uint4*)dst = *(const uint4*)(sT + row * LDB + seg); *(uint4*)(dst + 8) = *(const uint4*)(sT + row * LDB + seg + 8);
  }
  __syncthreads();
}

DEV void delta_task(const Params& P, int l, int task, const int z, char* smem, const int tid_in, const bool active) {
  const int tid = opaque_i(tid_in);
  const int lane = tid & 63, w = tid >> 6, wr = w >> 1, wc = w & 1;
  int seq, h; bool sample; decode_chain(task, seq, h, sample);
  int gs, T; seq_base(seq, gs, T);
  if (!active) { for (int c = 0; c < T / 64; ++c) { __syncthreads(); __syncthreads(); __syncthreads(); __syncthreads(); __syncthreads(); __syncthreads(); } return; }
  float* s_beta = (float*)smem; float* s_gc = s_beta + 64;
  bf16_t* sQ = (bf16_t*)(smem + 512); bf16_t* sK = sQ + 64 * LDB; bf16_t* sKbt = sK + 64 * LDB; bf16_t* sKgt = sKbt + 64 * LDB; bf16_t* sVbt = sKgt + 64 * LDB; bf16_t* sT = sVbt + 64 * LDB; bf16_t* sSt = sT + 64 * LDB;
  bf16_t* sW = sKbt; bf16_t* sVnt = sVbt; bf16_t* sP = sT;
  f32x16 st = zero16();
  if (sample) {
    const float* s0 = P.st_delta + ((size_t)(((seq - 16) * 2 + l) * 2 + z) * 4 + h) * 4096;
#pragma unroll
    for (int idx = 0; idx < 16; ++idx) st[idx] = s0[ACC_COL * 64 + ACC_ROW(idx)];
  }
#pragma unroll
  for (int idx = 0; idx < 16; ++idx) sSt[ACC_ROW(idx) * LDB + ACC_COL] = f2bf(st[idx]);
  const int nch = T / 64;
  const int tid_outer = tid;
  const int zh = z * 4 + h;
  uint4 nq0, nq1, nk0, nk1, nv0, nv1, nt0, nt1; float nbeta, ngc, nglast;
#define DELTA_PREFETCH(C) { \
    const int r_ = tid_outer & 63, sg_ = (tid_outer >> 6) * 16; \
    const int p_ = (C) * 64 + r_; const int g_ = gs + (z ? (T - 1 - p_) : p_); \
    const bf16_t* src_ = P.ubuf + (size_t)g_ * 768 + h * 64 + sg_; \
    nq0 = *(const uint4*)src_; nq1 = *(const uint4*)(src_ + 8); nk0 = *(const uint4*)(src_ + 256); nk1 = *(const uint4*)(src_ + 264); nv0 = *(const uint4*)(src_ + 512); nv1 = *(const uint4*)(src_ + 520); \
    const int tile_ = (gs >> 6) + (z ? (nch - 1 - (C)) : (C)); \
    const bf16_t* tsrc_ = P.dT + (((size_t)zh * 128 + tile_) * 64 + r_) * 64 + sg_; \
    nt0 = *(const uint4*)tsrc_; nt1 = *(const uint4*)(tsrc_ + 8); \
    nbeta = P.dbeta[(size_t)zh * NTOK + g_]; ngc = P.dgc[(size_t)zh * NTOK + g_]; \
    const int pl_ = (C) * 64 + 63; nglast = P.dgc[(size_t)zh * NTOK + gs + (z ? (T - 1 - pl_) : pl_)]; }
  DELTA_PREFETCH(0)
  for (int c = 0; c < nch; ++c) {
    const int tid = opaque_i(tid_outer);
    const int lane = tid & 63, w = tid >> 6, wr = w >> 1, wc = w & 1;
    const int row = tid & 63, seg = (tid >> 6) * 16;
    {
      const uint4 cq0 = nq0, cq1 = nq1, ck0 = nk0, ck1 = nk1, cv0 = nv0, cv1 = nv1, ct0 = nt0, ct1 = nt1;
      const float bj = nbeta, gcj = ngc, glast = nglast;
      float k[16], v[16];
      { const unsigned kw[8] = {ck0.x, ck0.y, ck0.z, ck0.w, ck1.x, ck1.y, ck1.z, ck1.w}, vw[8] = {cv0.x, cv0.y, cv0.z, cv0.w, cv1.x, cv1.y, cv1.z, cv1.w};
#pragma unroll
        for (int e = 0; e < 8; ++e) { k[2 * e] = __uint_as_float(kw[e] << 16); k[2 * e + 1] = __uint_as_float(kw[e] & 0xffff0000u); v[2 * e] = __uint_as_float(vw[e] << 16); v[2 * e + 1] = __uint_as_float(vw[e] & 0xffff0000u); } }
      if (w == 0) { s_beta[row] = bj; s_gc[row] = gcj; }
      const float f1 = bj * __expf(gcj), f2 = __expf(glast - gcj);
      *(uint4*)(sQ + row * LDB + seg) = cq0; *(uint4*)(sQ + row * LDB + seg + 8) = cq1;
      *(uint4*)(sK + row * LDB + seg) = ck0; *(uint4*)(sK + row * LDB + seg + 8) = ck1;
      *(uint4*)(sT + row * LDB + seg) = ct0; *(uint4*)(sT + row * LDB + seg + 8) = ct1;
#pragma unroll
      for (int e = 0; e < 16; ++e) {
        sKbt[(seg + e) * LDB + row] = f2bf(k[e] * f1);
        sKgt[(seg + e) * LDB + row] = f2bf(k[e] * f2);
        sVbt[(seg + e) * LDB + row] = f2bf(v[e] * bj);
      }
    }
    __syncthreads();
    if (c + 1 < nch) DELTA_PREFETCH(c + 1)
    f32x16 U = mm64(sT, sVbt, wr, wc, lane, zero16());
    f32x16 Wm = mm64(sT, sKbt, wr, wc, lane, zero16());
    f32x16 qk = mm64(sQ, sK, wr, wc, lane, zero16());
    __syncthreads();
#pragma unroll
    for (int idx = 0; idx < 16; ++idx) {
      const int i = ACC_ROW(idx), j = ACC_COL;
      sW[i * LDB + j] = f2bf(Wm[idx]);
      sP[i * LDB + j] = f2bf((i >= j) ? qk[idx] * __expf(s_gc[i] - s_gc[j]) : 0.f);
    }
    __syncthreads();
    {
      f32x16 ws = mm64(sW, sSt, wr, wc, lane, zero16());
#pragma unroll
      for (int g4 = 0; g4 < 4; ++g4) {
        const int e = ACC_COL, i0 = wr * 32 + 8 * g4 + 4 * (lane >> 5);
        uint2 o; o.x = pack2(U[4 * g4] - ws[4 * g4], U[4 * g4 + 1] - ws[4 * g4 + 1]); o.y = pack2(U[4 * g4 + 2] - ws[4 * g4 + 2], U[4 * g4 + 3] - ws[4 * g4 + 3]);
        *(uint2*)(sVnt + e * LDB + i0) = o;
      }
    }
    __syncthreads();
    f32x16 o1 = mm64(sP, sVnt, wr, wc, lane, zero16());
    f32x16 o2 = mm64(sQ, sSt, wr, wc, lane, zero16());
#pragma unroll
    for (int idx = 0; idx < 16; ++idx) {
      const int i = ACC_ROW(idx), e = ACC_COL;
      const int pp = c * 64 + i; const int tt = z ? (T - 1 - pp) : pp;
      P.hdir[((size_t)z * NTOK + gs + tt) * DM + 256 + h * 64 + e] = f2bf(o1[idx] + __expf(s_gc[i]) * o2[idx]);
    }
    const float egl = __expf(s_gc[63]);
#pragma unroll
    for (int idx = 0; idx < 16; ++idx) st[idx] *= egl;
    st = mm64(sVnt, sKgt, wr, wc, lane, st);
    __syncthreads();
#pragma unroll
    for (int idx = 0; idx < 16; ++idx) sSt[ACC_ROW(idx) * LDB + ACC_COL] = f2bf(st[idx]);
    __syncthreads();
  }
  if (!sample) {
    float* o = P.out + O_DELTA + ((size_t)((seq * 2 + l) * 2 + z) * 4 + h) * 4096;
#pragma unroll
    for (int idx = 0; idx < 16; ++idx) o[ACC_COL * 64 + ACC_ROW(idx)] = st[idx];
  }
}

DEV void delta_sample_task(const Params& P, int l, int task, const int z, char* smem0, const int tid_all_in) {
  const int tid_all = opaque_i(tid_all_in);
  const int half = tid_all >> 8, tid = tid_all & 255;
  int seq, h; bool sample; decode_chain(task, seq, h, sample);
  int gs, T; seq_base(seq, gs, T);
  const int nch = T / 64;
  const int zh = z * 4 + h;
#define DL_GATE(B) ((float*)(smem0 + (B) * HALF_LDS))
#define DL_SET(B) ((bf16_t*)(smem0 + (B) * HALF_LDS + 512))
  bf16_t* sSt = DL_SET(0) + 6 * 64 * LDB;
  if (half == 1) {
    uint4 nq0, nq1, nk0, nk1, nv0, nv1, nt0, nt1; float nbeta, ngc, nglast;
#define DL_PREFETCH(C) { \
      const int r_ = tid & 63, sg_ = (tid >> 6) * 16; \
      const int p_ = (C) * 64 + r_; const int g_ = gs + (z ? (T - 1 - p_) : p_); \
      const bf16_t* src_ = P.ubuf + (size_t)g_ * 768 + h * 64 + sg_; \
      nq0 = *(const uint4*)src_; nq1 = *(const uint4*)(src_ + 8); nk0 = *(const uint4*)(src_ + 256); nk1 = *(const uint4*)(src_ + 264); nv0 = *(const uint4*)(src_ + 512); nv1 = *(const uint4*)(src_ + 520); \
      const int tile_ = (gs >> 6) + (z ? (nch - 1 - (C)) : (C)); \
      const bf16_t* tsrc_ = P.dT + (((size_t)zh * 128 + tile_) * 64 + r_) * 64 + sg_; \
      nt0 = *(const uint4*)tsrc_; nt1 = *(const uint4*)(tsrc_ + 8); \
      nbeta = P.dbeta[(size_t)zh * NTOK + g_]; ngc = P.dgc[(size_t)zh * NTOK + g_]; \
      const int pl_ = (C) * 64 + 63; nglast = P.dgc[(size_t)zh * NTOK + gs + (z ? (T - 1 - pl_) : pl_)]; }
#define DL_STAGE(C) { \
      float* s_beta = DL_GATE((C) & 1); float* s_gc = s_beta + 64; \
      bf16_t* sQ = DL_SET((C) & 1); bf16_t* sK = sQ + 64 * LDB; bf16_t* sKbt = sK + 64 * LDB; bf16_t* sKgt = sKbt + 64 * LDB; bf16_t* sVbt = sKgt + 64 * LDB; bf16_t* sT = sVbt + 64 * LDB; \
      const int row = tid & 63, seg = (tid >> 6) * 16, w = tid >> 6; \
      const float bj = nbeta, gcj = ngc, glast = nglast; \
      float k[16], v[16]; \
      { const unsigned kw[8] = {nk0.x, nk0.y, nk0.z, nk0.w, nk1.x, nk1.y, nk1.z, nk1.w}, vw[8] = {nv0.x, nv0.y, nv0.z, nv0.w, nv1.x, nv1.y, nv1.z, nv1.w}; \
        _Pragma("unroll") for (int e = 0; e < 8; ++e) { k[2 * e] = __uint_as_float(kw[e] << 16); k[2 * e + 1] = __uint_as_float(kw[e] & 0xffff0000u); v[2 * e] = __uint_as_float(vw[e] << 16); v[2 * e + 1] = __uint_as_float(vw[e] & 0xffff0000u); } } \
      if (w == 0) { s_beta[row] = bj; s_gc[row] = gcj; } \
      const float f1 = bj * __expf(gcj), f2 = __expf(glast - gcj); \
      *(uint4*)(sQ + row * LDB + seg) = nq0; *(uint4*)(sQ + row * LDB + seg + 8) = nq1; \
      *(uint4*)(sK + row * LDB + seg) = nk0; *(uint4*)(sK + row * LDB + seg + 8) = nk1; \
      *(uint4*)(sT + row * LDB + seg) = nt0; *(uint4*)(sT + row * LDB + seg + 8) = nt1; \
      _Pragma("unroll") for (int e = 0; e < 16; ++e) { \
        sKbt[(seg + e) * LDB + row] = f2bf(k[e] * f1); \
        sKgt[(seg + e) * LDB + row] = f2bf(k[e] * f2); \
        sVbt[(seg + e) * LDB + row] = f2bf(v[e] * bj); } }
    DL_PREFETCH(0)
    DL_STAGE(0)
    if (nch > 1) DL_PREFETCH(1)
    __syncthreads();
    for (int c = 0; c < nch; ++c) {
      if (c + 1 < nch) { DL_STAGE(c + 1) if (c + 2 < nch) DL_PREFETCH(c + 2) }
      __syncthreads(); __syncthreads(); __syncthreads(); __syncthreads(); __syncthreads();
    }
#undef DL_PREFETCH
#undef DL_STAGE
  } else {
    const int lane = tid & 63, w = tid >> 6, wr = w >> 1, wc = w & 1;
    f32x16 st = zero16();
    {
      const float* s0 = P.st_delta + ((size_t)(((seq - 16) * 2 + l) * 2 + z) * 4 + h) * 4096;
#pragma unroll
      for (int idx = 0; idx < 16; ++idx) st[idx] = s0[ACC_COL * 64 + ACC_ROW(idx)];
    }
#pragma unroll
    for (int idx = 0; idx < 16; ++idx) sSt[ACC_ROW(idx) * LDB + ACC_COL] = f2bf(st[idx]);
    __syncthreads();
    for (int c = 0; c < nch; ++c) {
      const float* s_gc = DL_GATE(c & 1) + 64;
      bf16_t* sQ = DL_SET(c & 1); bf16_t* sK = sQ + 64 * LDB; bf16_t* sKbt = sK + 64 * LDB; bf16_t* sKgt = sKbt + 64 * LDB; bf16_t* sVbt = sKgt + 64 * LDB; bf16_t* sT = sVbt + 64 * LDB;
      bf16_t* sW = sKbt; bf16_t* sVnt = sVbt; bf16_t* sP = sT;
      f32x16 U = mm64(sT, sVbt, wr, wc, lane, zero16());
      f32x16 Wm = mm64(sT, sKbt, wr, wc, lane, zero16());
      f32x16 qk = mm64(sQ, sK, wr, wc, lane, zero16());
      __syncthreads();
#pragma unroll
      for (int idx = 0; idx < 16; ++idx) {
        const int i = ACC_ROW(idx), j = ACC_COL;
        sW[i * LDB + j] = f2bf(Wm[idx]);
        sP[i * LDB + j] = f2bf((i >= j) ? qk[idx] * __expf(s_gc[i] - s_gc[j]) : 0.f);
      }
      __syncthreads();
      {
        f32x16 ws = mm64(sW, sSt, wr, wc, lane, zero16());
#pragma unroll
        for (int g4 = 0; g4 < 4; ++g4) {
          const int e = ACC_COL, i0 = wr * 32 + 8 * g4 + 4 * (lane >> 5);
          uint2 o; o.x = pack2(U[4 * g4] - ws[4 * g4], U[4 * g4 + 1] - ws[4 * g4 + 1]); o.y = pack2(U[4 * g4 + 2] - ws[4 * g4 + 2], U[4 * g4 + 3] - ws[4 * g4 + 3]);
          *(uint2*)(sVnt + e * LDB + i0) = o;
        }
      }
      __syncthreads();
      f32x16 o1 = mm64(sP, sVnt, wr, wc, lane, zero16());
      f32x16 o2 = mm64(sQ, sSt, wr, wc, lane, zero16());
#pragma unroll
      for (int idx = 0; idx < 16; ++idx) {
        const int i = ACC_ROW(idx), e = ACC_COL;
        const int pp = c * 64 + i; const int tt = z ? (T - 1 - pp) : pp;
        P.hdir[((size_t)z * NTOK + gs + tt) * DM + 256 + h * 64 + e] = f2bf(o1[idx] + __expf(s_gc[i]) * o2[idx]);
      }
      const float egl = __expf(s_gc[63]);
#pragma unroll
      for (int idx = 0; idx < 16; ++idx) st[idx] *= egl;
      st = mm64(sVnt, sKgt, wr, wc, lane, st);
      __syncthreads();
#pragma unroll
      for (int idx = 0; idx < 16; ++idx) sSt[ACC_ROW(idx) * LDB + ACC_COL] = f2bf(st[idx]);
      __syncthreads();
    }
  }
#undef DL_GATE
#undef DL_SET
}

template <int RWAVES>
DEV void rwkv_task(const Params& P, int l, int task, const int z, char* smem, const int tid_in, const bool active) {
  const int tid = opaque_i(tid_in);
  constexpr int NR = 4 * RWAVES, NRB = 64 / NR;
  const int chain = task / NRB, rb = task % NRB;
  int seq, h; bool sample; decode_chain(chain, seq, h, sample);
  int gs, T; seq_base(seq, gs, T);
  if (!active) { for (int c = 0; c < T / 32; ++c) { __syncthreads(); __syncthreads(); } return; }
  float* s_kh = (float*)smem; float* s_w = s_kh + 2048; float* s_b = s_w + 2048; float* s_kt = s_b + 2048; float* s_r = s_kt + 2048; float* s_v = s_r + 2048; float* s_yp = s_v + 512;
  const int rl = tid >> 4, cg4 = (tid & 15) * 4;
  const int irow = rb * NR + (rl & (NR - 1));
  const bool rowthread = tid < 64 * RWAVES;
  float S0 = 0.f, S1 = 0.f, S2 = 0.f, S3 = 0.f;
  if (sample) {
    const float4 s4 = *(const float4*)(P.st_rwkv + ((size_t)(((seq - 16) * 2 + l) * 2 + z) * 4 + h) * 4096 + irow * 64 + cg4);
    S0 = s4.x; S1 = s4.y; S2 = s4.z; S3 = s4.w;
  }
  const int si = tid >> 3, sc = (tid & 7) * 8;
  float kkc[8], kac[8], rkc[8];
#pragma unroll
  for (int e = 0; e < 8; ++e) { kkc[e] = P.rwkv_kk[l * 256 + h * 64 + sc + e]; kac[e] = P.rwkv_ka[l * 256 + h * 64 + sc + e]; rkc[e] = P.rwkv_rk[(l * 4 + h) * 64 + sc + e]; }
  const int nch = T / 32;
  float4 pr0, pr1, pk0, pk1, pw0, pw1, pa0, pa1, pv_ = make_float4(0.f, 0.f, 0.f, 0.f); float pinv;
#define RWKV_PREFETCH(C) { \
    const int p_ = (C) * 32 + si; const int t_ = z ? (T - 1 - p_) : p_; const int g_ = gs + t_; \
    const float* rk_ = P.rkv + (size_t)g_ * 768 + h * 64 + sc; \
    pr0 = *(const float4*)rk_; pr1 = *(const float4*)(rk_ + 4); \
    pk0 = *(const float4*)(rk_ + 256); pk1 = *(const float4*)(rk_ + 260); \
    const float* wp_ = P.wa + ((size_t)(g_ * 2 + z) * 2) * 256 + h * 64 + sc; \
    pw0 = *(const float4*)wp_; pw1 = *(const float4*)(wp_ + 4); \
    pa0 = *(const float4*)(wp_ + 256); pa1 = *(const float4*)(wp_ + 260); \
    pinv = P.khinv[g_ * 4 + h]; \
    if (tid < 8 * NR) { \
      const int p2_ = (C) * 32 + (tid / (NR / 4)); const int t2_ = z ? (T - 1 - p2_) : p2_; \
      pv_ = *(const float4*)(P.rkv + (size_t)(gs + t2_) * 768 + 512 + h * 64 + rb * NR + (tid % (NR / 4)) * 4); \
    } }
  RWKV_PREFETCH(0)
  for (int c = 0; c < nch; ++c) {
    {
      const float rr[8] = {pr0.x, pr0.y, pr0.z, pr0.w, pr1.x, pr1.y, pr1.z, pr1.w};
      const float kk[8] = {pk0.x, pk0.y, pk0.z, pk0.w, pk1.x, pk1.y, pk1.z, pk1.w};
      const float aa[8] = {pa0.x, pa0.y, pa0.z, pa0.w, pa1.x, pa1.y, pa1.z, pa1.w};
      float bsum = 0.f;
      float okh[8], ob[8], okt[8];
#pragma unroll
      for (int e = 0; e < 8; ++e) {
        okh[e] = kk[e] * kkc[e] * pinv; ob[e] = aa[e] * okh[e]; okt[e] = kk[e] * (1.f + (aa[e] - 1.f) * kac[e]);
        bsum += rr[e] * okt[e] * rkc[e];
      }
      float* d;
      d = s_kh + si * 64 + sc; *(float4*)d = make_float4(okh[0], okh[1], okh[2], okh[3]); *(float4*)(d + 4) = make_float4(okh[4], okh[5], okh[6], okh[7]);
      d = s_w + si * 64 + sc; *(float4*)d = pw0; *(float4*)(d + 4) = pw1;
      d = s_b + si * 64 + sc; *(float4*)d = make_float4(ob[0], ob[1], ob[2], ob[3]); *(float4*)(d + 4) = make_float4(ob[4], ob[5], ob[6], ob[7]);
      d = s_kt + si * 64 + sc; *(float4*)d = make_float4(okt[0], okt[1], okt[2], okt[3]); *(float4*)(d + 4) = make_float4(okt[4], okt[5], okt[6], okt[7]);
      d = s_r + si * 64 + sc; *(float4*)d = pr0; *(float4*)(d + 4) = pr1;
      if (tid < 8 * NR) *(float4*)(s_v + (tid / (NR / 4)) * NR + (tid % (NR / 4)) * 4) = pv_;
      bsum += dppf<0xB1>(bsum); bsum += dppf<0x4E>(bsum); bsum += dppf<0x141>(bsum);
      if (rb == 0 && (tid & 7) == 0) {
        const int p = c * 32 + si; const int t = z ? (T - 1 - p) : p;
        P.bonus[((size_t)z * NTOK + gs + t) * 4 + h] = bsum;
      }
    }
    __syncthreads();
    if (c + 1 < nch) RWKV_PREFETCH(c + 1)
    if (rowthread) {
      typedef float v2f __attribute__((ext_vector_type(2)));
      typedef float v4f __attribute__((ext_vector_type(4)));
      v2f Sa = {S0, S1}, Sb = {S2, S3};
      v4f kh = *(const v4f*)(s_kh + cg4), ww = *(const v4f*)(s_w + cg4), bb = *(const v4f*)(s_b + cg4), kt = *(const v4f*)(s_kt + cg4), rr = *(const v4f*)(s_r + cg4);
      float vi = s_v[rl];
#pragma unroll 8
      for (int i = 0; i < 32; ++i) {
        const int in = (i + 1) & 31;
        const v4f kh_n = *(const v4f*)(s_kh + in * 64 + cg4);
        const v4f ww_n = *(const v4f*)(s_w + in * 64 + cg4);
        const v4f bb_n = *(const v4f*)(s_b + in * 64 + cg4);
        const v4f kt_n = *(const v4f*)(s_kt + in * 64 + cg4);
        const v4f rr_n = *(const v4f*)(s_r + in * 64 + cg4);
        const float vi_n = s_v[in * NR + rl];
        const v2f v2 = {vi, vi};
        const v2f pp = __builtin_elementwise_fma(Sb, kh.zw, Sa * kh.xy);
        const float sk = red16(pp.x + pp.y);
        const v2f sk2 = {sk, sk};
        Sa = __builtin_elementwise_fma(-sk2, bb.xy, __builtin_elementwise_fma(v2, kt.xy, Sa * ww.xy));
        Sb = __builtin_elementwise_fma(-sk2, bb.zw, __builtin_elementwise_fma(v2, kt.zw, Sb * ww.zw));
        const v2f qq = __builtin_elementwise_fma(Sb, rr.zw, Sa * rr.xy);
        s_yp[i * (64 * RWAVES) + tid] = qq.x + qq.y;
        kh = kh_n; ww = ww_n; bb = bb_n; kt = kt_n; rr = rr_n; vi = vi_n;
      }
      S0 = Sa.x; S1 = Sa.y; S2 = Sb.x; S3 = Sb.y;
    }
    __syncthreads();
    {
      const int i = tid >> 3, q2 = tid & 7;
      const int p = c * 32 + i; const int t = z ? (T - 1 - p) : p;
      if (NR == 16) {
        const float* y0 = s_yp + i * 256 + (2 * q2) * 16;
        float a0 = 0.f, a1 = 0.f;
#pragma unroll
        for (int e = 0; e < 16; e += 4) { const float4 u0 = *(const float4*)(y0 + e), u1 = *(const float4*)(y0 + 16 + e); a0 += (u0.x + u0.y) + (u0.z + u0.w); a1 += (u1.x + u1.y) + (u1.z + u1.w); }
        *(unsigned*)(P.hdir + ((size_t)z * NTOK + gs + t) * DM + 768 + h * 64 + rb * 16 + 2 * q2) = pack2(a0, a1);
      } else {
        const float* y0 = s_yp + i * (64 * RWAVES) + q2 * 16;
        float a0 = 0.f;
#pragma unroll
        for (int e = 0; e < 16; e += 4) { const float4 u0 = *(const float4*)(y0 + e); a0 += (u0.x + u0.y) + (u0.z + u0.w); }
        P.hdir[((size_t)z * NTOK + gs + t) * DM + 768 + h * 64 + rb * NR + q2] = f2bf(a0);
      }
    }
  }
  if (!sample && rowthread) {
    *(float4*)(P.out + O_RWKV + ((size_t)((seq * 2 + l) * 2 + z) * 4 + h) * 4096 + irow * 64 + cg4) = make_float4(S0, S1, S2, S3);
  }
}

DEV void rwkv_prompt_task(const Params& P, int l, int task, const int z, char* smem, const int tid_in) {
  const int tid = opaque_i(tid_in);
  const int chain = task >> 1, rb = task & 1;
  int seq, h; bool sample; decode_chain(chain, seq, h, sample);
  int gs, T; seq_base(seq, gs, T);
  float* s_kh = (float*)smem; float* s_w = s_kh + 2048; float* s_b = s_w + 2048; float* s_kt = s_b + 2048; float* s_r = s_kt + 2048; float* s_v = s_r + 2048; float* s_yp = s_v + 1024;
  const int rp = tid >> 4, cg4 = (tid & 15) * 4;
  const int irow = rb * 32 + 2 * rp;
  typedef float v2f __attribute__((ext_vector_type(2)));
  typedef float v4f __attribute__((ext_vector_type(4)));
  v2f Aa = {0.f, 0.f}, Ab = {0.f, 0.f}, Ba = {0.f, 0.f}, Bb = {0.f, 0.f};
  if (sample) {
    const float* sp0 = P.st_rwkv + ((size_t)(((seq - 16) * 2 + l) * 2 + z) * 4 + h) * 4096 + irow * 64 + cg4;
    const float4 a4 = *(const float4*)sp0, b4 = *(const float4*)(sp0 + 64);
    Aa.x = a4.x; Aa.y = a4.y; Ab.x = a4.z; Ab.y = a4.w; Ba.x = b4.x; Ba.y = b4.y; Bb.x = b4.z; Bb.y = b4.w;
  }
  const int si = tid >> 3, sc = (tid & 7) * 8;
  float kkc[8], kac[8], rkc[8];
#pragma unroll
  for (int e = 0; e < 8; ++e) { kkc[e] = P.rwkv_kk[l * 256 + h * 64 + sc + e]; kac[e] = P.rwkv_ka[l * 256 + h * 64 + sc + e]; rkc[e] = P.rwkv_rk[(l * 4 + h) * 64 + sc + e]; }
  const int nch = T / 32;
  float4 pr0, pr1, pk0, pk1, pw0, pw1, pa0, pa1, pv_; float pinv;
#define RP_PREFETCH(C) { \
    const int p_ = (C) * 32 + si; const int t_ = z ? (T - 1 - p_) : p_; const int g_ = gs + t_; \
    const float* rk_ = P.rkv + (size_t)g_ * 768 + h * 64 + sc; \
    pr0 = *(const float4*)rk_; pr1 = *(const float4*)(rk_ + 4); \
    pk0 = *(const float4*)(rk_ + 256); pk1 = *(const float4*)(rk_ + 260); \
    const float* wp_ = P.wa + ((size_t)(g_ * 2 + z) * 2) * 256 + h * 64 + sc; \
    pw0 = *(const float4*)wp_; pw1 = *(const float4*)(wp_ + 4); \
    pa0 = *(const float4*)(wp_ + 256); pa1 = *(const float4*)(wp_ + 260); \
    pinv = P.khinv[g_ * 4 + h]; \
    pv_ = *(const float4*)(P.rkv + (size_t)g_ * 768 + 512 + h * 64 + rb * 32 + (tid & 7) * 4); }
  RP_PREFETCH(0)
  for (int c = 0; c < nch; ++c) {
    {
      const float rr[8] = {pr0.x, pr0.y, pr0.z, pr0.w, pr1.x, pr1.y, pr1.z, pr1.w};
      const float kk[8] = {pk0.x, pk0.y, pk0.z, pk0.w, pk1.x, pk1.y, pk1.z, pk1.w};
      const float aa[8] = {pa0.x, pa0.y, pa0.z, pa0.w, pa1.x, pa1.y, pa1.z, pa1.w};
      float bsum = 0.f;
      float okh[8], ob[8], okt[8];
#pragma unroll
      for (int e = 0; e < 8; ++e) {
        okh[e] = kk[e] * kkc[e] * pinv; ob[e] = aa[e] * okh[e]; okt[e] = kk[e] * (1.f + (aa[e] - 1.f) * kac[e]);
        bsum += rr[e] * okt[e] * rkc[e];
      }
      float* d;
      d = s_kh + si * 64 + sc; *(float4*)d = make_float4(okh[0], okh[1], okh[2], okh[3]); *(float4*)(d + 4) = make_float4(okh[4], okh[5], okh[6], okh[7]);
      d = s_w + si * 64 + sc; *(float4*)d = pw0; *(float4*)(d + 4) = pw1;
      d = s_b + si * 64 + sc; *(float4*)d = make_float4(ob[0], ob[1], ob[2], ob[3]); *(float4*)(d + 4) = make_float4(ob[4], ob[5], ob[6], ob[7]);
      d = s_kt + si * 64 + sc; *(float4*)d = make_float4(okt[0], okt[1], okt[2], okt[3]); *(float4*)(d + 4) = make_float4(okt[4], okt[5], okt[6], okt[7]);
      d = s_r + si * 64 + sc; *(float4*)d = pr0; *(float4*)(d + 4) = pr1;
      *(float4*)(s_v + si * 32 + (tid & 7) * 4) = pv_;
      bsum += dppf<0xB1>(bsum); bsum += dppf<0x4E>(bsum); bsum += dppf<0x141>(bsum);
      if (rb == 0 && (tid & 7) == 0) {
        const int p = c * 32 + si; const int t = z ? (T - 1 - p) : p;
        P.bonus[((size_t)z * NTOK + gs + t) * 4 + h] = bsum;
      }
    }
    __syncthreads();
    if (c + 1 < nch) RP_PREFETCH(c + 1)
    {
      v4f kh = *(const v4f*)(s_kh + cg4), ww = *(const v4f*)(s_w + cg4), bb = *(const v4f*)(s_b + cg4), kt = *(const v4f*)(s_kt + cg4), rr = *(const v4f*)(s_r + cg4);
      v2f vv = *(const v2f*)(s_v + 2 * rp);
      float* ypw = s_yp + (2 * rp) * 4 + ((tid & 15) >> 2);
#pragma unroll 8
      for (int i = 0; i < 32; ++i) {
        const int in = (i + 1) & 31;
        const v4f kh_n = *(const v4f*)(s_kh + in * 64 + cg4);
        const v4f ww_n = *(const v4f*)(s_w + in * 64 + cg4);
        const v4f bb_n = *(const v4f*)(s_b + in * 64 + cg4);
        const v4f kt_n = *(const v4f*)(s_kt + in * 64 + cg4);
        const v4f rr_n = *(const v4f*)(s_r + in * 64 + cg4);
        const v2f vv_n = *(const v2f*)(s_v + in * 32 + 2 * rp);
        const v2f va = {vv.x, vv.x}, vb = {vv.y, vv.y};
        const v2f pa = __builtin_elementwise_fma(Ab, kh.zw, Aa * kh.xy), pb = __builtin_elementwise_fma(Bb, kh.zw, Ba * kh.xy);
        const float ska = red16(pa.x + pa.y), skb = red16(pb.x + pb.y);
        const v2f sa2 = {ska, ska}, sb2 = {skb, skb};
        Aa = __builtin_elementwise_fma(-sa2, bb.xy, __builtin_elementwise_fma(va, kt.xy, Aa * ww.xy));
        Ab = __builtin_elementwise_fma(-sa2, bb.zw, __builtin_elementwise_fma(va, kt.zw, Ab * ww.zw));
        Ba = __builtin_elementwise_fma(-sb2, bb.xy, __builtin_elementwise_fma(vb, kt.xy, Ba * ww.xy));
        Bb = __builtin_elementwise_fma(-sb2, bb.zw, __builtin_elementwise_fma(vb, kt.zw, Bb * ww.zw));
        const v2f qa = __builtin_elementwise_fma(Ab, rr.zw, Aa * rr.xy), qb = __builtin_elementwise_fma(Bb, rr.zw, Ba * rr.xy);
        const float ya = red4(qa.x + qa.y), yb = red4(qb.x + qb.y);
        if ((tid & 3) == 0) { ypw[i * 128] = ya; ypw[i * 128 + 4] = yb; }
        kh = kh_n; ww = ww_n; bb = bb_n; kt = kt_n; rr = rr_n; vv = vv_n;
      }
    }
    __syncthreads();
    {
      const int i = tid >> 3, r0 = (tid & 7) * 4;
      const int p = c * 32 + i; const int t = z ? (T - 1 - p) : p;
      const float* y0 = s_yp + i * 128 + r0 * 4;
      const float4 u0 = *(const float4*)y0, u1 = *(const float4*)(y0 + 4), u2 = *(const float4*)(y0 + 8), u3 = *(const float4*)(y0 + 12);
      uint2 o; o.x = pack2((u0.x + u0.y) + (u0.z + u0.w), (u1.x + u1.y) + (u1.z + u1.w)); o.y = pack2((u2.x + u2.y) + (u2.z + u2.w), (u3.x + u3.y) + (u3.z + u3.w));
      *(uint2*)(P.hdir + ((size_t)z * NTOK + gs + t) * DM + 768 + h * 64 + rb * 32 + r0) = o;
    }
  }
  if (!sample) {
    float* so = P.out + O_RWKV + ((size_t)((seq * 2 + l) * 2 + z) * 4 + h) * 4096 + irow * 64 + cg4;
    *(float4*)so = make_float4(Aa.x, Aa.y, Ab.x, Ab.y); *(float4*)(so + 64) = make_float4(Ba.x, Ba.y, Bb.x, Bb.y);
  }
#undef RP_PREFETCH
}

DEV void rwkv_sample_task(const Params& P, int l, int task, const int z, char* smem0, const int tid_all_in) {
  const int tid_all = opaque_i(tid_all_in);
  const int half = tid_all >> 8, tid = tid_all & 255;
  constexpr int NR = 8;
  const int chain = task >> 3, rb = task & 7;
  int seq, h; bool sample; decode_chain(chain, seq, h, sample);
  int gs, T; seq_base(seq, gs, T);
  const int nch = T / 32;
#define RS_BUF(B) ((float*)(smem0 + (B) * HALF_LDS))
  if (half == 1) {
    const int si = tid >> 3, sc = (tid & 7) * 8;
    float kkc[8], kac[8], rkc[8];
#pragma unroll
    for (int e = 0; e < 8; ++e) { kkc[e] = P.rwkv_kk[l * 256 + h * 64 + sc + e]; kac[e] = P.rwkv_ka[l * 256 + h * 64 + sc + e]; rkc[e] = P.rwkv_rk[(l * 4 + h) * 64 + sc + e]; }
    float4 pr0, pr1, pk0, pk1, pw0, pw1, pa0, pa1, pv_ = make_float4(0.f, 0.f, 0.f, 0.f); float pinv;
#define RS_PREFETCH(C) { \
      const int p_ = (C) * 32 + si; const int t_ = z ? (T - 1 - p_) : p_; const int g_ = gs + t_; \
      const float* rk_ = P.rkv + (size_t)g_ * 768 + h * 64 + sc; \
      pr0 = *(const float4*)rk_; pr1 = *(const float4*)(rk_ + 4); \
      pk0 = *(const float4*)(rk_ + 256); pk1 = *(const float4*)(rk_ + 260); \
      const float* wp_ = P.wa + ((size_t)(g_ * 2 + z) * 2) * 256 + h * 64 + sc; \
      pw0 = *(const float4*)wp_; pw1 = *(const float4*)(wp_ + 4); \
      pa0 = *(const float4*)(wp_ + 256); pa1 = *(const float4*)(wp_ + 260); \
      pinv = P.khinv[g_ * 4 + h]; \
      if (tid < 64) { \
        const int p2_ = (C) * 32 + (tid >> 1); const int t2_ = z ? (T - 1 - p2_) : p2_; \
        pv_ = *(const float4*)(P.rkv + (size_t)(gs + t2_) * 768 + 512 + h * 64 + rb * NR + (tid & 1) * 4); \
      } }
#define RS_STAGE(C) { \
      float* bf_ = RS_BUF((C) & 1); \
      float* s_kh = bf_; float* s_w = bf_ + 2048; float* s_b = bf_ + 4096; float* s_kt = bf_ + 6144; float* s_r = bf_ + 8192; float* s_v = bf_ + 10240; \
      const float rr[8] = {pr0.x, pr0.y, pr0.z, pr0.w, pr1.x, pr1.y, pr1.z, pr1.w}; \
      const float kk[8] = {pk0.x, pk0.y, pk0.z, pk0.w, pk1.x, pk1.y, pk1.z, pk1.w}; \
      const float aa[8] = {pa0.x, pa0.y, pa0.z, pa0.w, pa1.x, pa1.y, pa1.z, pa1.w}; \
      float bsum = 0.f; float okh[8], ob[8], okt[8]; \
      _Pragma("unroll") for (int e = 0; e < 8; ++e) { okh[e] = kk[e] * kkc[e] * pinv; ob[e] = aa[e] * okh[e]; okt[e] = kk[e] * (1.f + (aa[e] - 1.f) * kac[e]); bsum += rr[e] * okt[e] * rkc[e]; } \
      float* d_; \
      d_ = s_kh + si * 64 + sc; *(float4*)d_ = make_float4(okh[0], okh[1], okh[2], okh[3]); *(float4*)(d_ + 4) = make_float4(okh[4], okh[5], okh[6], okh[7]); \
      d_ = s_w + si * 64 + sc; *(float4*)d_ = pw0; *(float4*)(d_ + 4) = pw1; \
      d_ = s_b + si * 64 + sc; *(float4*)d_ = make_float4(ob[0], ob[1], ob[2], ob[3]); *(float4*)(d_ + 4) = make_float4(ob[4], ob[5], ob[6], ob[7]); \
      d_ = s_kt + si * 64 + sc; *(float4*)d_ = make_float4(okt[0], okt[1], okt[2], okt[3]); *(float4*)(d_ + 4) = make_float4(okt[4], okt[5], okt[6], okt[7]); \
      d_ = s_r + si * 64 + sc; *(float4*)d_ = pr0; *(float4*)(d_ + 4) = pr1; \
      if (tid < 64) *(float4*)(s_v + (tid >> 1) * NR + (tid & 1) * 4) = pv_; \
      bsum += dppf<0xB1>(bsum); bsum += dppf<0x4E>(bsum); bsum += dppf<0x141>(bsum); \
      if (rb == 0 && (tid & 7) == 0) { const int p_ = (C) * 32 + si; const int t_ = z ? (T - 1 - p_) : p_; P.bonus[((size_t)z * NTOK + gs + t_) * 4 + h] = bsum; } }
#define RS_OUT(C) { \
      const float* yp_ = RS_BUF((C) & 1) + 10240 + 256; \
      const int i_ = tid >> 3, q2_ = tid & 7; \
      const int p_ = (C) * 32 + i_; const int t_ = z ? (T - 1 - p_) : p_; \
      const float* y0_ = yp_ + i_ * 128 + q2_ * 16; \
      float a0_ = 0.f; \
      _Pragma("unroll") for (int e = 0; e < 16; e += 4) { const float4 u0_ = *(const float4*)(y0_ + e); a0_ += (u0_.x + u0_.y) + (u0_.z + u0_.w); } \
      P.hdir[((size_t)z * NTOK + gs + t_) * DM + 768 + h * 64 + rb * NR + q2_] = f2bf(a0_); }
    RS_PREFETCH(0)
    RS_STAGE(0)
    if (nch > 1) RS_PREFETCH(1)
    __syncthreads();
    for (int c = 0; c < nch; ++c) {
      if (c + 1 < nch) { RS_STAGE(c + 1) if (c + 2 < nch) RS_PREFETCH(c + 2) }
      if (c > 0) RS_OUT(c - 1)
      __syncthreads();
    }
    RS_OUT(nch - 1)
#undef RS_PREFETCH
#undef RS_STAGE
#undef RS_OUT
  } else {
    const int rl = tid >> 4, cg4 = (tid & 15) * 4;
    const bool rowthread = tid < 128;
    typedef float v2f __attribute__((ext_vector_type(2)));
    typedef float v4f __attribute__((ext_vector_type(4)));
    v2f Sa = {0.f, 0.f}, Sb = {0.f, 0.f};
    if (sample && rowthread) {
      const float4 s4 = *(const float4*)(P.st_rwkv + ((size_t)(((seq - 16) * 2 + l) * 2 + z) * 4 + h) * 4096 + (rb * NR + rl) * 64 + cg4);
      Sa.x = s4.x; Sa.y = s4.y; Sb.x = s4.z; Sb.y = s4.w;
    }
    __syncthreads();
    for (int c = 0; c < nch; ++c) {
      if (rowthread) {
        const float* bf = RS_BUF(c & 1);
        const float* s_kh = bf; const float* s_w = bf + 2048; const float* s_b = bf + 4096; const float* s_kt = bf + 6144; const float* s_r = bf + 8192; const float* s_v = bf + 10240;
        float* s_yp = (float*)bf + 10240 + 256;
        v4f kh = *(const v4f*)(s_kh + cg4), ww = *(const v4f*)(s_w + cg4), bb = *(const v4f*)(s_b + cg4), kt = *(const v4f*)(s_kt + cg4), rr = *(const v4f*)(s_r + cg4);
        float vi = s_v[rl];
#pragma unroll 8
        for (int i = 0; i < 32; ++i) {
          const int in = (i + 1) & 31;
          const v4f kh_n = *(const v4f*)(s_kh + in * 64 + cg4);
          const v4f ww_n = *(const v4f*)(s_w + in * 64 + cg4);
          const v4f bb_n = *(const v4f*)(s_b + in * 64 + cg4);
          const v4f kt_n = *(const v4f*)(s_kt + in * 64 + cg4);
          const v4f rr_n = *(const v4f*)(s_r + in * 64 + cg4);
          const float vi_n = s_v[in * NR + rl];
          const v2f v2 = {vi, vi};
          const v2f pp = __builtin_elementwise_fma(Sb, kh.zw, Sa * kh.xy);
          const float sk = red16(pp.x + pp.y);
          const v2f sk2 = {sk, sk};
          Sa = __builtin_elementwise_fma(-sk2, bb.xy, __builtin_elementwise_fma(v2, kt.xy, Sa * ww.xy));
          Sb = __builtin_elementwise_fma(-sk2, bb.zw, __builtin_elementwise_fma(v2, kt.zw, Sb * ww.zw));
          const v2f qq = __builtin_elementwise_fma(Sb, rr.zw, Sa * rr.xy);
          s_yp[i * 128 + tid] = qq.x + qq.y;
          kh = kh_n; ww = ww_n; bb = bb_n; kt = kt_n; rr = rr_n; vi = vi_n;
        }
      }
      __syncthreads();
    }
  }
#undef RS_BUF
}

DEV void phase_scan(const Params& P, int l, char* smem0, int ctr_idx, int cls) {
  __shared__ int4 s_task4;
  int& s_task = *(int*)&s_task4;
  const int ntask = 560;
  for (;;) {
    __syncthreads();
    if (threadIdx.x == 0) s_task = (int)atomicAdd(P.ctr + ctr_idx, 1u);
    __syncthreads();
    const int t = s_task;
    if (t >= ntask) break;
    const int tid_ = THREAD_ID; const int half = tid_ >> 8, tid = tid_ & 255;
    char* smem = smem0 + half * HALF_LDS;
    if (t < 128) { if (cls & 1) rwkv_sample_task(P, l, t >> 1, t & 1, smem0, tid_); }
    else if (t < 144) { if (cls & 2) delta_sample_task(P, l, (t - 128) >> 1, t & 1, smem0, tid_); }
    else if (t < 160) { if (cls & 4) mlstm_sample_task(P, l, (t - 144) >> 1, t & 1, smem0, tid_); }
    else if (t < 176) { if (cls & 8) ret_sample_task(P, l, (t - 160) >> 1, t & 1, smem0, tid_); }
    else if (t < 304) { if (cls & 1) rwkv_prompt_task(P, l, (t - 176) + 16, half, smem, tid); }
    else if (t < 368) { if (cls & 2) delta_task(P, l, (t - 304) + 8, half, smem, tid, true); }
    else if (t < 432) { if (cls & 4) mlstm_task(P, l, (t - 368) + 8, half, smem, tid, true); }
    else if (t < 560) { if (cls & 8) ret_sample_task(P, l, ((t - 432) >> 1) + 8, t & 1, smem0, tid_); }
    else { if (cls & 16) { if (l == 1) conv_ff_layer1_item(P, 2 * (t - 624) + half, smem, tid); else conv_inout_layer1_item(P, 2 * (t - 624) + half, smem, tid); } }
  }
}

DEV void phase_combine(const Params& P, int l) {
  const int tid_ = THREAD_ID;
  const int lane = tid_ & 63;
  const int wid = blockIdx.x * (NTHREADS / 64) + (tid_ >> 6), nw = gridDim.x * (NTHREADS / 64);
  const int c = lane * 4, head = lane >> 4;
  float4 gnorm[4];
  gnorm[0] = *(const float4*)(P.mlstm_norm + l * 256 + c); gnorm[1] = *(const float4*)(P.delta_norm + l * 256 + c);
  gnorm[2] = *(const float4*)(P.ret_norm + l * 256 + c); gnorm[3] = *(const float4*)(P.rwkv_norm + l * 256 + c);
  for (int g = wid; g < NTOK; g += nw) {
    uint2 h0[4], h1[4];
#pragma unroll
    for (int m = 0; m < 4; ++m) { h0[m] = *(const uint2*)(P.hdir + (size_t)g * DM + m * 256 + c); h1[m] = *(const uint2*)(P.hdir + ((size_t)NTOK + g) * DM + m * 256 + c); }
    const float* pj = P.projABC + (size_t)g * NABC + c;
    const float4 ga0 = *(const float4*)(pj + 768), ga1 = *(const float4*)(pj + 1808), ga2 = *(const float4*)(pj + 2848);
    const uint2 gg = *(const uint2*)(P.gbuf + (size_t)g * 256 + c);
    const float bn = P.bonus[(size_t)g * 4 + head] + P.bonus[((size_t)NTOK + g) * 4 + head];
    const float4 v4 = *(const float4*)(P.rkv + (size_t)g * 768 + 512 + c);
    uint2 ov[4];
#pragma unroll
    for (int m = 0; m < 4; ++m) {
      float y[4];
      y[0] = __uint_as_float(h0[m].x << 16) + __uint_as_float(h1[m].x << 16);
      y[1] = __uint_as_float(h0[m].x & 0xffff0000u) + __uint_as_float(h1[m].x & 0xffff0000u);
      y[2] = __uint_as_float(h0[m].y << 16) + __uint_as_float(h1[m].y << 16);
      y[3] = __uint_as_float(h0[m].y & 0xffff0000u) + __uint_as_float(h1[m].y & 0xffff0000u);
      if (m != 1) {
        const float mean = red16(y[0] + y[1] + y[2] + y[3]) * (1.f / 64.f);
#pragma unroll
        for (int e = 0; e < 4; ++e) y[e] -= mean;
      }
      const float var = red16(y[0] * y[0] + y[1] * y[1] + y[2] * y[2] + y[3] * y[3]) * (1.f / 64.f);
      const float rs = rsqrtf(var + LNEPS);
      const float4 g4 = gnorm[m];
      y[0] *= rs * g4.x; y[1] *= rs * g4.y; y[2] *= rs * g4.z; y[3] *= rs * g4.w;
      float o[4];
      if (m == 3) {
        const float gt[4] = {__uint_as_float(gg.x << 16), __uint_as_float(gg.x & 0xffff0000u), __uint_as_float(gg.y << 16), __uint_as_float(gg.y & 0xffff0000u)};
        o[0] = gt[0] * (y[0] + bn * v4.x); o[1] = gt[1] * (y[1] + bn * v4.y); o[2] = gt[2] * (y[2] + bn * v4.z); o[3] = gt[3] * (y[3] + bn * v4.w);
      } else {
        const float4 a4 = (m == 0) ? ga0 : (m == 1) ? ga1 : ga2;
        if (m == 0) { o[0] = sigmoidf_(a4.x) * y[0]; o[1] = sigmoidf_(a4.y) * y[1]; o[2] = sigmoidf_(a4.z) * y[2]; o[3] = sigmoidf_(a4.w) * y[3]; }
        else { o[0] = siluf_(a4.x) * y[0]; o[1] = siluf_(a4.y) * y[1]; o[2] = siluf_(a4.z) * y[2]; o[3] = siluf_(a4.w) * y[3]; }
      }
      ov[m].x = pack2(o[0], o[1]); ov[m].y = pack2(o[2], o[3]);
    }
#pragma unroll
    for (int m = 0; m < 4; ++m) *(uint2*)(P.ubuf + (size_t)g * DM + m * 256 + c) = ov[m];
  }
}

#define XB_TMO      128
#define XB_XCNT(j)  (256  + 64 * (j))
#define XB_XSUB(j)  (1280 + 64 * (j))
#define XB_XGEN(j)  (2304 + 64 * (j))
#define XB_TOP      3328
#define XB_TOPGEN   3392
#define XCD_BAR_WORDS 3456
#define XB_SPIN_CAP (1u << 18)
#define LAS __attribute__((address_space(3)))

__device__ __forceinline__ unsigned xb_ld(unsigned* p)              { return __hip_atomic_load(p, __ATOMIC_RELAXED, __HIP_MEMORY_SCOPE_AGENT); }
__device__ __forceinline__ unsigned xb_add(unsigned* p, unsigned v) { return __hip_atomic_fetch_add(p, v, __ATOMIC_RELAXED, __HIP_MEMORY_SCOPE_AGENT); }
__device__ __forceinline__ unsigned xb_xcc_id() { return (unsigned)__builtin_amdgcn_s_getreg((3 << 11) | 20) & 0xFu; }
#define XB_SPIN(cond, bar) do { unsigned _sp = 0; while (cond) { __builtin_amdgcn_s_sleep(1); \
    if ((++_sp & 255u) == 0u) { if (xb_ld(&(bar)[XB_TMO])) break; if (_sp > XB_SPIN_CAP) { atomicAdd(&(bar)[XB_TMO], 1u); break; } } } } while (0)

struct XcdBarrier {
    unsigned* bar; unsigned x;
    volatile LAS unsigned* st;
};

__device__ __forceinline__ XcdBarrier xcd_barrier_post(unsigned* bar, volatile LAS unsigned* st) {
    XcdBarrier b; b.bar = bar; b.x = xb_xcc_id(); b.st = st;
    if (threadIdx.x == 0) (void)xb_add(&bar[XB_XCNT(b.x)], 1u);
    return b;
}
__device__ __forceinline__ void xcd_barrier_complete(unsigned* bar, unsigned x, unsigned& nloc, unsigned& nx) {
    const unsigned G = gridDim.x * gridDim.y * gridDim.z;
    unsigned sum, cnt, mine, sp = 0u;
    for (;;) {
        sum = 0u; cnt = 0u; mine = 0u;
#pragma unroll
        for (unsigned j = 0; j < 16; ++j) { const unsigned c = xb_ld(&bar[XB_XCNT(j)]); sum += c; cnt += (c > 0u) ? 1u : 0u; mine = (j == x) ? c : mine; }
        if (sum == G) break;
        __builtin_amdgcn_s_sleep(1);
        if ((++sp & 255u) == 0u) { if (xb_ld(&bar[XB_TMO])) break; if (sp > XB_SPIN_CAP) { atomicAdd(&bar[XB_TMO], 1u); break; } }
    }
    nloc = mine > 0u ? mine : 1u; nx = cnt > 0u ? cnt : 1u;
}

__device__ __forceinline__ void xcd_barrier(const XcdBarrier& b) {
    asm volatile("s_waitcnt vmcnt(0)" ::: "memory");
    __syncthreads();
    if (threadIdx.x == 0) {
        unsigned* bar = b.bar;
        __builtin_amdgcn_s_waitcnt(0);
        unsigned nloc = b.st[0], nx = b.st[1];
        if (nloc == 0u) { xcd_barrier_complete(bar, b.x, nloc, nx); b.st[0] = nloc; b.st[1] = nx; }
        const unsigned old = xb_add(&bar[XB_XSUB(b.x)], 1u);
        const unsigned gen = old / nloc;
        if (old + 1u == (gen + 1u) * nloc) {
            __builtin_amdgcn_fence(__ATOMIC_RELEASE, "agent");
            asm volatile("s_waitcnt vmcnt(0)" ::: "memory");
            const unsigned og = xb_add(&bar[XB_TOP], 1u);
            const unsigned tg = og / nx;
            if (og + 1u == (tg + 1u) * nx) xb_add(&bar[XB_TOPGEN], 1u);
            else XB_SPIN(xb_ld(&bar[XB_TOPGEN]) == tg, bar);
            __builtin_amdgcn_fence(__ATOMIC_ACQUIRE, "agent");
            xb_add(&bar[XB_XGEN(b.x)], 1u);
            asm volatile("s_waitcnt vmcnt(0)" ::: "memory");
        } else {
            XB_SPIN(xb_ld(&bar[XB_XGEN(b.x)]) == gen, bar);
            __builtin_amdgcn_fence(__ATOMIC_ACQUIRE, "agent");
            asm volatile("s_waitcnt vmcnt(0)" ::: "memory");
        }
    }
    __syncthreads();
}

__global__ void __launch_bounds__(NTHREADS, 2) mega(Params P) {
  extern __shared__ __attribute__((aligned(16))) char smem[];
  cg::grid_group grid = cg::this_grid();
  __shared__ uint4 xb_words;
  if (threadIdx.x == 0) xb_words = make_uint4(0u, 0u, 0u, 0u);
  __syncthreads();
  XcdBarrier xb = xcd_barrier_post(P.bar, (volatile LAS unsigned*)&xb_words);
  for (int i = 0; i < PROBE_EXTRA_SYNCS; ++i) xcd_barrier(xb);
  for (int ph = (int)P.phase_lo; ph < (int)P.phase_hi; ++ph) {
   const int nrep = ((ph >= 2 && ((PROBE_DUP_MASK >> ((ph - 2) % 10)) & 1)) || (ph == 0 && PROBE_DUP_PRO)) ? 2 : 1;
   for (int rep = 0; rep < nrep; ++rep) {
    if (ph == 0) phase_prologue(P, smem, rep);
    else if (ph == 1) phase_ln(P, 0, 0);
    else {
      const int l = (ph - 2) / 10, s = (ph - 2) % 10;
      switch (s) {
        case 0: { EpiProj E; E.projABC = P.projABC; E.pdraw = P.pdraw; E.col0 = 0; phase_gemm(P.ubuf, P.wt_in + (size_t)l * PINP * DM, 4096, DM, E, smem); } break;
        case 1: { if (blockIdx.x < 32) { EpiProj E; E.projABC = P.projABC; E.pdraw = P.pdraw; E.col0 = 4096;
                    phase_gemm(P.ubuf, P.wt_in + (size_t)l * PINP * DM + (size_t)4096 * DM, 256, DM, E, smem, 0, 1 << 20, 32);
                    asm volatile("s_waitcnt vmcnt(0)" ::: "memory"); __syncthreads();
                    if (threadIdx.x == 0) { __threadfence(); atomicAdd(P.ctr + 16 + l * 2 + rep, 1u); } }
                  __shared__ int4 s_it4; int& s_it = *(int*)&s_it4;
                  for (;;) {
                    __syncthreads();
                    if (threadIdx.x == 0) s_it = (int)atomicAdd(P.ctr + 8 + l * 2 + rep, 1u);
                    __syncthreads();
                    const int it = s_it;
                    if (it >= 64 * 9) break;
                    const int tid_ = THREAD_ID; const int half = tid_ >> 8;
                    if (it < 64) rwkv_prep_item(P, l, 2 * it + half, 0, smem + half * HALF_LDS, tid_ & 255);
                    else if (it < 64 * 6) { const int j = it - 64; rwkv_prep_item(P, l, 2 * (j / 5) + half, 1 + j % 5, smem + half * HALF_LDS, tid_ & 255); }
                    else {
                      if (threadIdx.x == 0) { while (__hip_atomic_load(P.ctr + 16 + l * 2 + rep, __ATOMIC_RELAXED, __HIP_MEMORY_SCOPE_AGENT) < 32u) __builtin_amdgcn_s_sleep(2); }
                      __syncthreads();
                      const int j = it - 64 * 6; delta_prep_item(P, l, 2 * (j / 3) + half, j % 3, tid_ & 255); } } } break;
        case 2: { const int tid_ = THREAD_ID; const int half = tid_ >> 8;
                  for (int it = blockIdx.x; it < 512; it += gridDim.x) delta_T_item(P, l, 2 * it + half, smem + half * HALF_LDS, tid_ & 255); } break;
        case 3: phase_scan(P, l, smem, l + 2 * rep, rep == 0 ? 31 : PROBE_SCAN_CLASS); break;
        case 4: phase_combine(P, l); break;
        case 5: { EpiRes E; E.out = P.out; E.xp = (l == 0) ? P.x_prompt : P.out; E.xs = (l == 0) ? P.x_sample : P.out + (size_t)4096 * DM; E.gate = P.mod + (size_t)l * 3 * 6144 + 2048;
                  phase_gemm(P.ubuf, P.wt_out + (size_t)l * DM * DM, DM, DM, E, smem);
                  if (blockIdx.x >= 128) {
                    const int tid_ = THREAD_ID; const int half = tid_ >> 8, tid = tid_ & 255;
                    float* tile = (float*)(smem + half * HALF_LDS);
                    const int npair = (l == 1) ? 1024 : 672;
                    int j = blockIdx.x - 128;
                    ConvDesc d = deferred_conv_desc(P, l, 2 * j + half);
                    float4 a, b, c, e4; conv_tile_load(d, tid, a, b, c, e4);
                    while (j < npair) {
                      const int jn = j + 128;
                      ConvDesc dn = d; float4 an = a, bn = b, cn = c, en = e4;
                      if (jn < npair) { dn = deferred_conv_desc(P, l, 2 * jn + half); conv_tile_load(dn, tid, an, bn, cn, en); }
                      conv_tile_finish(d, tile, tid, a, b, c, e4);
                      d = dn; a = an; b = bn; c = cn; e4 = en; j = jn;
                    }
                  } } break;
        case 6: phase_ln(P, 1, l); break;
        case 7: { EpiFF1 E; E.hidden = P.hidden; phase_gemm(P.ubuf, P.wt_ff1, DFF, DM, E, smem); } break;
        case 8: { EpiResSplit E; E.out = P.out; E.tmp = P.ff2tmp; E.gate = P.mod + (size_t)l * 3 * 6144 + 5120;
                  phase_gemm(P.hidden, P.wt_ff2, 2 * DM, DFF / 2, E, smem, DFF, 4); } break;
        case 9: phase_ln(P, 2, l); break;
      }
    }
    if (ph + 1 < (int)P.phase_hi || rep + 1 < nrep) {
      if (P.phase_hi > 1000) grid.sync(); else xcd_barrier(xb);
    }
   }
  }
}

#ifndef MK_MULTI
#define MK_MULTI 0
#endif

extern "C" void kernel_launch(void* const* d_in, const int* in_sizes, int n_in, void* d_out, int out_size, void* d_ws, size_t ws_size, hipStream_t stream) {
  static int grid_blocks = 0;
  if (!grid_blocks) {
    int dev = 0, cus = 0, per_cu = 0;
    hipGetDevice(&dev);
    hipDeviceGetAttribute(&cus, hipDeviceAttributeMultiprocessorCount, dev);
    if (hipFuncSetAttribute((const void*)mega, hipFuncAttributeMaxDynamicSharedMemorySize, LDS_BYTES) != hipSuccess) fprintf(stderr, "hipFuncSetAttribute failed\n");
    hipOccupancyMaxActiveBlocksPerMultiprocessor(&per_cu, (const void*)mega, NTHREADS, LDS_BYTES);
    if (per_cu < 1) { fprintf(stderr, "occupancy query returned %d\n", per_cu); per_cu = 1; }
    if (per_cu > 1) per_cu = 1;
    grid_blocks = cus * per_cu;
    fprintf(stderr, "mega: cus %d per_cu %d grid %d ws %zu\n", cus, per_cu, grid_blocks, ws_size);
  }
  Params p{};
  const float** pin = (const float**)&p;
  for (int i = 0; i < 39; ++i) pin[i] = (const float*)d_in[i];
  p.out = (float*)d_out;
  char* ws = (char*)d_ws; size_t off = 0;
  auto take = [&](size_t bytes) { char* r = ws + off; off += (bytes + 255) & ~(size_t)255; return r; };
  p.ctr = (unsigned*)take(256);
  p.bar = (unsigned*)take(XCD_BAR_WORDS * 4);
  p.wt_in = (bf16_t*)take((size_t)2 * PINP * DM * 2);
  p.wt_out = (bf16_t*)take((size_t)2 * DM * DM * 2);
  p.wt_ff1 = (bf16_t*)take((size_t)DM * DFF * 2);
  p.wt_ff2 = (bf16_t*)take((size_t)DM * DFF * 2);
  p.ubuf = (bf16_t*)take((size_t)NTOK * DM * 2);
  p.projABC = (float*)take((size_t)NTOK * NABC * 4);
  p.hidden = (bf16_t*)p.projABC;
  p.ff2tmp = (float*)((char*)p.projABC + (size_t)NTOK * DFF * 2);
  p.pdraw = (float*)take((size_t)NTOK * NPD * 4);
  p.hdir = (bf16_t*)p.pdraw;
  p.rkv = (float*)take((size_t)NTOK * 768 * 4);
  p.wa = (float*)take((size_t)NTOK * 1024 * 4);
  p.gbuf = (bf16_t*)take((size_t)NTOK * 256 * 2);
  p.mod = (float*)take((size_t)2 * 3 * 6144 * 4);
  p.khinv = (float*)take((size_t)NTOK * 4 * 4);
  p.bonus = (float*)take((size_t)2 * NTOK * 4 * 4);
  p.dbeta = (float*)take((size_t)8 * NTOK * 4);
  p.dgc = (float*)take((size_t)8 * NTOK * 4);
  p.dT = (bf16_t*)take((size_t)1024 * 4096 * 2);
  p.w2t = (bf16_t*)take((size_t)4 * 256 * 64 * 2);
  p.a2t = (bf16_t*)take((size_t)4 * 256 * 64 * 2);
  p.g2t = (bf16_t*)take((size_t)2 * 256 * 128 * 2);
  if (off > ws_size) { fprintf(stderr, "workspace too small: need %zu have %zu\n", off, ws_size); return; }
  hipMemsetAsync(p.ctr, 0, 256 + ((XCD_BAR_WORDS * 4 + 255) & ~255), stream);
  const int nph = 2 + 10 * 2;
#if MK_MULTI
  for (int ph = 0; ph < nph; ++ph) {
    p.phase_lo = ph; p.phase_hi = ph + 1;
    void* args[] = {&p};
    hipLaunchCooperativeKernel((const void*)mega, dim3(grid_blocks), dim3(NTHREADS), args, LDS_BYTES, stream);
  }
#else
  p.phase_lo = 0; p.phase_hi = nph;
  void* args[] = {&p};
  hipError_t e = hipLaunchCooperativeKernel((const void*)mega, dim3(grid_blocks), dim3(NTHREADS), args, LDS_BYTES, stream);
  if (e != hipSuccess) fprintf(stderr, "cooperative launch failed: %s (grid %d)\n", hipGetErrorString(e), grid_blocks);
#endif
}
```

```cpp
#include <hip/hip_runtime.h>
#include <hip/hip_cooperative_groups.h>
#include <cstdio>
#include <cstdint>
namespace cg = cooperative_groups;

typedef unsigned short bf16_t;
typedef short bf16x8 __attribute__((ext_vector_type(8)));
typedef float f32x16 __attribute__((ext_vector_type(16)));
typedef float f32x4 __attribute__((ext_vector_type(4)));
#define DEV __device__ __forceinline__

#ifndef PROBE_SCAN_CLASS
#define PROBE_SCAN_CLASS 31
#endif
#ifndef PROBE_DUP_PRO
#define PROBE_DUP_PRO 0
#endif
#ifndef PROBE_EXTRA_SYNCS
#define PROBE_EXTRA_SYNCS 0
#endif
#ifndef PROBE_DUP_MASK
#define PROBE_DUP_MASK 0
#endif
constexpr int NTOK = 8192, DM = 1024, PIN = 4256, PINP = 4352, NABC = 3104, NPD = 1152, DFF = 4096;
constexpr float ALPHA = 1.41421356237f, LNEPS = 1e-5f;
constexpr int LDB = 72;
constexpr int TILE_B = 64 * LDB * 2;
constexpr int HALF_LDS = 77824;
constexpr int LDS_BYTES = 2 * HALF_LDS;
constexpr int NTHREADS = 512;
constexpr size_t O_C = 8388608, O_N = 9437184, O_M = 9453568, O_DELTA = 9453824, O_RET = 10502400, O_RWKV = 11550976;

struct Params {
  const float *x_prompt, *x_sample, *c, *st_C, *st_n, *st_m, *st_delta, *st_ret, *st_rwkv, *c_ctx;
  const float *w_mod, *b_mod, *w_in, *w_out, *ln1_g, *ln1_b, *ln2_g, *ln2_b, *w_ff1, *w_ff2;
  const float *mlstm_i_bias, *mlstm_f_bias, *mlstm_norm, *delta_conv, *delta_a_log, *delta_dt_bias, *delta_norm;
  const float *ret_decay, *ret_norm, *rwkv_mu, *rwkv_w0, *rwkv_w2, *rwkv_a0, *rwkv_a2, *rwkv_g2, *rwkv_kk, *rwkv_ka, *rwkv_rk, *rwkv_norm;
  float* out;
  bf16_t *wt_in, *wt_out, *wt_ff1, *wt_ff2, *ubuf, *hdir, *gbuf, *hidden;
  float *mod, *projABC, *pdraw, *rkv, *wa, *khinv, *bonus, *dbeta, *dgc, *ff2tmp;
  bf16_t *dT, *w2t, *a2t, *g2t;
  unsigned* ctr; unsigned* bar;
  long long phase_lo, phase_hi;
};

DEV int opaque_i(int v) { asm volatile("" : "+v"(v)); return v; }
#define THREAD_ID opaque_i((int)threadIdx.x)
typedef float f32x2_t __attribute__((ext_vector_type(2)));
typedef __bf16 bf16x2_t __attribute__((ext_vector_type(2)));
DEV unsigned pack2(float a, float b) { f32x2_t v = {a, b}; bf16x2_t r = __builtin_convertvector(v, bf16x2_t); return __builtin_bit_cast(unsigned, r); }
DEV bf16_t f2bf(float f) { return (bf16_t)pack2(f, f); }
DEV float bf2f(bf16_t h) { return __uint_as_float(((unsigned)h) << 16); }
DEV float sigmoidf_(float x) { return 1.f / (1.f + __expf(-x)); }
DEV float siluf_(float x) { return x / (1.f + __expf(-x)); }
DEV float softplusf_(float x) { return x > 20.f ? x : log1pf(__expf(x)); }
DEV float logsigmoidf_(float x) { return -softplusf_(-x); }
template <int CTRL> DEV float dppf(float x) { return __builtin_bit_cast(float, __builtin_amdgcn_mov_dpp(__builtin_bit_cast(int, x), CTRL, 0xf, 0xf, true)); }
DEV float red4(float x) { x += dppf<0xB1>(x); x += dppf<0x4E>(x); return x; }
DEV float red16(float x) { x = red4(x); x += dppf<0x141>(x); x += dppf<0x128>(x); return x; }
DEV float wave_sum(float x) { x = red16(x); x += __shfl_xor(x, 16); x += __shfl_xor(x, 32); return x; }
DEV void tok_info(int g, int& gs, int& T, int& ci) {
  if (g < 4096) { gs = g & ~255; T = 256; ci = 0; } else { int b = (g - 4096) >> 11; gs = 4096 + (b << 11); T = 2048; ci = 1 + b; }
}
DEV const float* xin_row(const Params& P, int g) { return g < 4096 ? P.x_prompt + (size_t)g * DM : P.x_sample + (size_t)(g - 4096) * DM; }

DEV f32x16 mm64(const bf16_t* A, const bf16_t* Bt, int wr, int wc, int lane, f32x16 acc) {
  const bf16_t* ap = A + (wr * 32 + (lane & 31)) * LDB + (lane >> 5) * 8;
  const bf16_t* bp = Bt + (wc * 32 + (lane & 31)) * LDB + (lane >> 5) * 8;
#pragma unroll
  for (int s = 0; s < 4; ++s) {
    bf16x8 a = *(const bf16x8*)(ap + s * 16);
    bf16x8 b = *(const bf16x8*)(bp + s * 16);
    acc = __builtin_amdgcn_mfma_f32_32x32x16_bf16(a, b, acc, 0, 0, 0);
  }
  return acc;
}
DEV f32x16 zero16() { f32x16 z; for (int i = 0; i < 16; ++i) z[i] = 0.f; return z; }
#define ACC_ROW(idx) (wr * 32 + ((idx) & 3) + 8 * ((idx) >> 2) + 4 * (lane >> 5))
#define ACC_COL (wc * 32 + (lane & 31))

DEV void conv_tile(const float* __restrict__ src, bf16_t* __restrict__ dst, int K, int N, int tk, int tn, float* tile, const int tid_in, const int dst_row_shift = 0) {
  const int tid = opaque_i(tid_in);
  const int k0 = tk * 64, n0 = tn * 64;
  { const int r = tid >> 2, cs = (tid & 3) * 16;
#pragma unroll
    for (int e = 0; e < 16; e += 4) {
      const int n = n0 + cs + e;
      float4 v = make_float4(0.f, 0.f, 0.f, 0.f);
      if (n < N) v = *(const float4*)(src + (size_t)(k0 + r) * N + n);
      tile[r * 65 + cs + e] = v.x; tile[r * 65 + cs + e + 1] = v.y; tile[r * 65 + cs + e + 2] = v.z; tile[r * 65 + cs + e + 3] = v.w;
    } }
  __syncthreads();
  { const int nl = tid >> 2, ks = (tid & 3) * 16;
    unsigned pk[8];
#pragma unroll
    for (int e = 0; e < 8; ++e) pk[e] = pack2(tile[(ks + 2 * e) * 65 + nl], tile[(ks + 2 * e + 1) * 65 + nl]);
    uint4* d = (uint4*)(dst + (size_t)(n0 + nl + dst_row_shift) * K + k0 + ks);
    d[0] = make_uint4(pk[0], pk[1], pk[2], pk[3]); d[1] = make_uint4(pk[4], pk[5], pk[6], pk[7]); }
  __syncthreads();
}

DEV void mod_gemv_item(const Params& P, int item, float* red, const int tid) {
  const int j0 = item * 64, l = j0 / 6144, jj = j0 % 6144;
  const int cq = tid & 15, kg = tid >> 4;
  const float* W = P.w_mod + (size_t)l * DM * 6144 + jj + cq * 4;
  float a0[4] = {0, 0, 0, 0}, a1[4] = {0, 0, 0, 0}, a2[4] = {0, 0, 0, 0};
  for (int kk = 0; kk < 64; ++kk) {
    const int k = kg * 64 + kk;
    const float4 w = *(const float4*)(W + (size_t)k * 6144);
    const float s0 = siluf_(P.c_ctx[k]), s1 = siluf_(P.c[k]), s2 = siluf_(P.c[DM + k]);
    a0[0] += s0 * w.x; a0[1] += s0 * w.y; a0[2] += s0 * w.z; a0[3] += s0 * w.w;
    a1[0] += s1 * w.x; a1[1] += s1 * w.y; a1[2] += s1 * w.z; a1[3] += s1 * w.w;
    a2[0] += s2 * w.x; a2[1] += s2 * w.y; a2[2] += s2 * w.z; a2[3] += s2 * w.w;
  }
#pragma unroll
  for (int e = 0; e < 4; ++e) { red[(kg * 3 + 0) * 64 + cq * 4 + e] = a0[e]; red[(kg * 3 + 1) * 64 + cq * 4 + e] = a1[e]; red[(kg * 3 + 2) * 64 + cq * 4 + e] = a2[e]; }
  __syncthreads();
  if (tid < 192) {
    const int ci = tid >> 6, col = tid & 63;
    float s = P.b_mod[l * 6144 + jj + col];
    for (int g = 0; g < 16; ++g) s += red[(g * 3 + ci) * 64 + col];
    P.mod[(size_t)(l * 3 + ci) * 6144 + jj + col] = s;
  }
  __syncthreads();
}

DEV void prologue_item(const Params& P, int t, float* tile, const int tid) {
  const int n_in = 16 * 68, n_out = 16 * 16, n_ff = 1024;
  const int total = 192 + 48 + n_in + n_out + 2 * n_ff;
  if (t >= total) { __syncthreads(); __syncthreads(); return; }
  if (t < 192) { mod_gemv_item(P, t, tile, tid); return; }
  if (t < 240) {
    const int v = t - 192;
    if (v < 32) { const int m = v >> 2, tn = v & 3, lz = m >> 1, kind = m & 1;
      conv_tile((kind == 0 ? P.rwkv_w2 : P.rwkv_a2) + (size_t)lz * 64 * 256, (kind == 0 ? P.w2t : P.a2t) + (size_t)lz * 256 * 64, 64, 256, 0, tn, tile, tid); }
    else { const int m = (v - 32) >> 3, r = (v - 32) & 7; conv_tile(P.rwkv_g2 + (size_t)m * 128 * 256, P.g2t + (size_t)m * 256 * 128, 128, 256, r >> 2, r & 3, tile, tid); }
    return;
  }
  int u = t - 240;
  if (u < n_in) { const int tn = u % 68; conv_tile(P.w_in, P.wt_in, DM, PIN, u / 68, tn, tile, tid, tn < 12 ? 0 : (tn < 16 ? 3328 : -256)); return; }
  u -= n_in;
  if (u < n_out) { conv_tile(P.w_out, P.wt_out, DM, DM, u / 16, u % 16, tile, tid); return; }
  u -= n_out;
  if (u < n_ff) { conv_tile(P.w_ff1, P.wt_ff1, DM, DFF, u / 64, u % 64, tile, tid); return; }
  u -= n_ff;
  { const int tk = u / 16, kh = tk >> 5; conv_tile(P.w_ff2 + (size_t)kh * 2048 * DM, P.wt_ff2 + (size_t)kh * DM * 2048, 2048, DM, tk & 31, u % 16, tile, tid); }
}
DEV void phase_prologue(const Params& P, char* smem, int rep) {
  const int tid_ = THREAD_ID; const int half = tid_ >> 8, tid = tid_ & 255;
  float* tile = (float*)(smem + half * HALF_LDS);
  const int total = 192 + 48 + 16 * 68 + 256 + 2 * 1024;
  __shared__ int4 s_pj4; int& s_pj = *(int*)&s_pj4;
  for (;;) {
    __syncthreads();
    if (threadIdx.x == 0) s_pj = (int)atomicAdd(P.ctr + 6 + rep, 1u);
    __syncthreads();
    const int j = s_pj;
    if (2 * j >= total) break;
    prologue_item(P, 2 * j + half, tile, tid);
  }
}
struct ConvDesc { const float* src; bf16_t* dst; int K, N, tk, tn, shift; };
DEV void conv_tile_load(const ConvDesc& d, const int tid, float4& a, float4& b, float4& c, float4& e4) {
  const int r = tid >> 2, cs = (tid & 3) * 16;
  const float* p = d.src + (size_t)(d.tk * 64 + r) * d.N + d.tn * 64 + cs;
  const float4 z4 = make_float4(0.f, 0.f, 0.f, 0.f);
  const int n = d.tn * 64 + cs;
  a = z4; b = z4; c = z4; e4 = z4;
  if (n < d.N) a = *(const float4*)p;
  if (n + 4 < d.N) b = *(const float4*)(p + 4);
  if (n + 8 < d.N) c = *(const float4*)(p + 8);
  if (n + 12 < d.N) e4 = *(const float4*)(p + 12);
}
DEV void conv_tile_finish(const ConvDesc& d, float* tile, const int tid, const float4 a, const float4 b, const float4 c, const float4 e4) {
  { const int r = tid >> 2, cs = (tid & 3) * 16;
    float* t = tile + r * 65 + cs;
    t[0] = a.x; t[1] = a.y; t[2] = a.z; t[3] = a.w; t[4] = b.x; t[5] = b.y; t[6] = b.z; t[7] = b.w;
    t[8] = c.x; t[9] = c.y; t[10] = c.z; t[11] = c.w; t[12] = e4.x; t[13] = e4.y; t[14] = e4.z; t[15] = e4.w; }
  __syncthreads();
  { const int nl = tid >> 2, ks = (tid & 3) * 16;
    unsigned pk[8];
#pragma unroll
    for (int e = 0; e < 8; ++e) pk[e] = pack2(tile[(ks + 2 * e) * 65 + nl], tile[(ks + 2 * e + 1) * 65 + nl]);
    uint4* o = (uint4*)(d.dst + (size_t)(d.tn * 64 + nl + d.shift) * d.K + d.tk * 64 + ks);
    o[0] = make_uint4(pk[0], pk[1], pk[2], pk[3]); o[1] = make_uint4(pk[4], pk[5], pk[6], pk[7]); }
  __syncthreads();
}
DEV ConvDesc deferred_conv_desc(const Params& P, int l, int u) {
  ConvDesc d; d.shift = 0;
  if (l == 1) {
    if (u < 1024) { d.src = P.w_ff1 + (size_t)DM * DFF; d.dst = P.wt_ff1; d.K = DM; d.N = DFF; d.tk = u / 64; d.tn = u % 64; }
    else { u -= 1024; const int tk = u / 16, kh = tk >> 5; d.src = P.w_ff2 + (size_t)DM * DFF + (size_t)kh * 2048 * DM; d.dst = P.wt_ff2 + (size_t)kh * DM * 2048; d.K = 2048; d.N = DM; d.tk = tk & 31; d.tn = u % 16; }
  } else {
    if (u < 1088) { const int tn = u % 68; d.src = P.w_in + (size_t)DM * PIN; d.dst = P.wt_in + (size_t)PINP * DM; d.K = DM; d.N = PIN; d.tk = u / 68; d.tn = tn; d.shift = tn < 12 ? 0 : (tn < 16 ? 3328 : -256); }
    else { u -= 1088; d.src = P.w_out + (size_t)DM * DM; d.dst = P.wt_out + (size_t)DM * DM; d.K = DM; d.N = DM; d.tk = u / 16; d.tn = u % 16; }
  }
  return d;
}
DEV void conv_inout_layer1_item(const Params& P, int u, char* smem, const int tid) {
  float* tile = (float*)smem;
  if (u < 1088) { const int tn = u % 68; conv_tile(P.w_in + (size_t)DM * PIN, P.wt_in + (size_t)PINP * DM, DM, PIN, u / 68, tn, tile, tid, tn < 12 ? 0 : (tn < 16 ? 3328 : -256)); }
  else { u -= 1088; conv_tile(P.w_out + (size_t)DM * DM, P.wt_out + (size_t)DM * DM, DM, DM, u / 16, u % 16, tile, tid); }
}
DEV void conv_ff_layer1_item(const Params& P, int u, char* smem, const int tid) {
  float* tile = (float*)smem;
  if (u < 1024) conv_tile(P.w_ff1 + (size_t)DM * DFF, P.wt_ff1, DM, DFF, u / 64, u % 64, tile, tid);
  else { u -= 1024; const int tk = u / 16, kh = tk >> 5; conv_tile(P.w_ff2 + (size_t)DM * DFF + (size_t)kh * 2048 * DM, P.wt_ff2 + (size_t)kh * DM * 2048, 2048, DM, tk & 31, u % 16, tile, tid); }
}

DEV void phase_ln(const Params& P, int mode, int l) {
  const int tid_ = THREAD_ID;
  const int lane = tid_ & 63;
  const int wid = blockIdx.x * (NTHREADS / 64) + (tid_ >> 6), nw = gridDim.x * (NTHREADS / 64);
  float4 nx0, nx1, nx2, nx3, nt0, nt1, nt2, nt3;
  nt0 = nt1 = nt2 = nt3 = make_float4(0.f, 0.f, 0.f, 0.f);
#define LN_LOAD(G) { const float* src_ = (mode == 0) ? xin_row(P, (G)) : (P.out + (size_t)(G) * DM); \
    nx0 = *(const float4*)(src_ + lane * 4); nx1 = *(const float4*)(src_ + 256 + lane * 4); nx2 = *(const float4*)(src_ + 512 + lane * 4); nx3 = *(const float4*)(src_ + 768 + lane * 4); \
    if (mode == 2) { const float* t_ = P.ff2tmp + (size_t)(G) * DM + lane * 4; nt0 = *(const float4*)t_; nt1 = *(const float4*)(t_ + 256); nt2 = *(const float4*)(t_ + 512); nt3 = *(const float4*)(t_ + 768); } }
  if (wid < NTOK) LN_LOAD(wid)
  for (int g = wid; g < NTOK; g += nw) {
    int gs, T, ci; tok_info(g, gs, T, ci);
    float v[16];
    { const float4 xs[4] = {nx0, nx1, nx2, nx3};
#pragma unroll
      for (int k = 0; k < 4; ++k) { v[4 * k] = xs[k].x; v[4 * k + 1] = xs[k].y; v[4 * k + 2] = xs[k].z; v[4 * k + 3] = xs[k].w; } }
    if (mode == 2) {
      const float* gt = P.mod + (size_t)(l * 3 + ci) * 6144 + 5120;
      const float4 ts[4] = {nt0, nt1, nt2, nt3};
#pragma unroll
      for (int k = 0; k < 4; ++k) { const float4 t = ts[k], g4 = *(const float4*)(gt + k * 256 + lane * 4);
        v[4 * k] += g4.x * t.x; v[4 * k + 1] += g4.y * t.y; v[4 * k + 2] += g4.z * t.z; v[4 * k + 3] += g4.w * t.w; }
    }
    if (g + nw < NTOK) LN_LOAD(g + nw)
    float s = 0.f;
#pragma unroll
    for (int i = 0; i < 16; ++i) s += v[i];
    float mu = wave_sum(s) * (1.f / DM);
    float q = 0.f;
#pragma unroll
    for (int i = 0; i < 16; ++i) { v[i] -= mu; q += v[i] * v[i]; }
    float rstd = rsqrtf(wave_sum(q) * (1.f / DM) + LNEPS);
#pragma unroll
    for (int i = 0; i < 16; ++i) v[i] *= rstd;
    int lm = l, shoff = 0, scoff = 1024;
    bool write_u = true;
    if (mode != 0) {
      const float* gg = (mode == 1 ? P.ln1_g : P.ln2_g) + l * DM;
      const float* bb = (mode == 1 ? P.ln1_b : P.ln2_b) + l * DM;
#pragma unroll
      for (int k = 0; k < 4; ++k) {
        const float4 g4 = *(const float4*)(gg + k * 256 + lane * 4), b4 = *(const float4*)(bb + k * 256 + lane * 4);
        v[4 * k] = v[4 * k] * g4.x + b4.x; v[4 * k + 1] = v[4 * k + 1] * g4.y + b4.y; v[4 * k + 2] = v[4 * k + 2] * g4.z + b4.z; v[4 * k + 3] = v[4 * k + 3] * g4.w + b4.w;
        *(float4*)(P.out + (size_t)g * DM + k * 256 + lane * 4) = make_float4(v[4 * k], v[4 * k + 1], v[4 * k + 2], v[4 * k + 3]);
      }
      if (mode == 1) { shoff = 3072; scoff = 4096; } else { lm = l + 1; write_u = (l == 0); }
      if (write_u) {
        s = 0.f;
#pragma unroll
        for (int i = 0; i < 16; ++i) s += v[i];
        mu = wave_sum(s) * (1.f / DM);
        q = 0.f;
#pragma unroll
        for (int i = 0; i < 16; ++i) { v[i] -= mu; q += v[i] * v[i]; }
        rstd = rsqrtf(wave_sum(q) * (1.f / DM) + LNEPS);
#pragma unroll
        for (int i = 0; i < 16; ++i) v[i] *= rstd;
      }
    }
    if (write_u) {
      const float* md = P.mod + (size_t)(lm * 3 + ci) * 6144;
#pragma unroll
      for (int k = 0; k < 4; ++k) {
        const float4 sh = *(const float4*)(md + shoff + k * 256 + lane * 4), sc = *(const float4*)(md + scoff + k * 256 + lane * 4);
        uint2 o;
        o.x = pack2(v[4 * k] * (1.f + sc.x) + sh.x, v[4 * k + 1] * (1.f + sc.y) + sh.y);
        o.y = pack2(v[4 * k + 2] * (1.f + sc.z) + sh.z, v[4 * k + 3] * (1.f + sc.w) + sh.w);
        *(uint2*)(P.ubuf + (size_t)g * DM + k * 256 + lane * 4) = o;
      }
    }
  }
}

namespace pg8 {
#define PG8_LAS __attribute__((address_space(3)))
typedef unsigned short bf16_t;
typedef short bf16x8 __attribute__((ext_vector_type(8)));
typedef float f32x4 __attribute__((ext_vector_type(4)));
typedef unsigned u32x4 __attribute__((ext_vector_type(4)));
constexpr int BM = 256, BK = 64, HALF = 128, HTB = HALF * BK * 2  , STAGE_BYTES = 8 * HTB, NXCD = 8, WGM = 8;

__host__ __device__ __forceinline__ int lds_byte(int r, int c) { const int st = (r >> 4) * 2 + (c >> 5), rr = r & 15, cc = c & 31, ob = rr * 64 + cc * 2; return st * 1024 + (ob ^ (((ob >> 9) & 1) << 5)); }
__host__ __device__ __forceinline__ void stage_rc(int b, int& R, int& C) { const int st = b / 1024, sb = b % 1024, swz = sb ^ (((sb >> 9) & 1) << 5); R = (st >> 1) * 16 + swz / 64; C = (st & 1) * 32 + (swz % 64) / 2; }
__host__ __device__ __forceinline__ int perm32(int rho) { const int n = rho >> 4, i = rho & 15; return 8 * (i >> 2) + 4 * n + (i & 3); }

struct Unit { int pm, pn; };
struct Gemm { const bf16_t* A; const bf16_t* Bt; int M, N, K; int lda; int nsplit; };

struct StaticOrder {
    int nM, nN, nwg, G, c;
    __host__ __device__ void init(int M, int N, int G_, int c_) { nM = M / BM; nN = N / BM; nwg = nM * nN; G = G_; c = c_; }
    __host__ __device__ bool next(int i, Unit& u) const {
        const long L = (long)i * G + c; if (L >= nwg) return false;
        int wgid = (int)L; { const int q = nwg / NXCD, r = nwg % NXCD, xcd = wgid % NXCD, off = wgid / NXCD; wgid = (xcd < r ? xcd * (q + 1) : r * (q + 1) + (xcd - r) * q) + off; }
        const int nig = WGM * nN, gid = wgid / nig, fm = gid * WGM, gsz = (nM - fm) < WGM ? (nM - fm) : WGM;
        u.pm = fm + ((wgid % nig) % gsz); u.pn = (wgid % nig) / gsz; return true;
    }
    __device__ __forceinline__ void a_ready(const Unit&) const {}
    __device__ __forceinline__ void done(const Unit&) const {}
};
__device__ __forceinline__ unsigned cvt_pk_bf16(float lo, float hi) { unsigned r; asm volatile("v_cvt_pk_bf16_f32 %0, %1, %2" : "=v"(r) : "v"(lo), "v"(hi)); return r; }
template <class Epi, class Sched, bool STAMP = false>
__device__ __forceinline__ void gemm_phase(PG8_LAS unsigned char* lds, const Gemm g, const Sched& S, const Epi& E, unsigned long long* stamps) {
    const int tid = THREAD_ID, wid = __builtin_amdgcn_readfirstlane(tid >> 6), lane = tid & 63, wr = wid >> 2, wc = wid & 3, fr = lane & 15, fq = lane >> 4;
    const int K = g.K, nt = K / BK;
    int ts_lo = 0, ts_hi = 0, nts = 0; const unsigned long long rt_entry = STAMP ? (unsigned long long)wall_clock64() : 0ull;
#define PG8_STAMP() do { if (STAMP && wid == 0 && nts < 64) { const unsigned long long _c = (unsigned long long)clock64(); \
        ts_lo = (lane == nts) ? (int)(unsigned)_c : ts_lo; ts_hi = (lane == nts) ? (int)(unsigned)(_c >> 32) : ts_hi; ++nts; } } while (0)
    PG8_STAMP();
    unsigned voffA[2], voffB[2];
#pragma unroll
    for (int i = 0; i < 2; ++i) { int R, C; stage_rc(tid * 16 + i * 8192, R, C); const int Rb = Epi::PERM ? ((R & ~31) + perm32(R & 31)) : R;
        voffA[i] = (unsigned)(R * g.lda + C) * 2u; voffB[i] = (unsigned)(Rb * K + C) * 2u; }
    const size_t kstep = (size_t)(BK * 2);
    const size_t hstep = (size_t)HALF * K * 2, hstepA = (size_t)HALF * g.lda * 2;
    const size_t tstep = 2 * hstep, tstepA = 2 * hstepA;
    const size_t ksplitA = (size_t)K * 2;
    const unsigned ldsw = (unsigned)wid * 1024u;
    const int aoff = lds_byte(wr * 64 + fr, fq * 8), boff = lds_byte(wc * 32 + fr, fq * 8);
#define PG8_SA(b, h) (((b) * 2 + (h)) * HTB)
#define PG8_SB(b, h) ((4 + (b) * 2 + (h)) * HTB)
#define PG8_STAGE(bufoff, gbase, voff) do { _Pragma("unroll") for (int _i = 0; _i < 2; ++_i) \
        __builtin_amdgcn_global_load_lds((const unsigned*)((const char*)(gbase) + (voff)[_i]), (PG8_LAS unsigned*)(lds + (bufoff) + ldsw + _i * 8192), 16, 0, 0); } while (0)
#define PG8_LDA(dst, b, h) do { _Pragma("unroll") for (int m = 0; m < 4; ++m) _Pragma("unroll") for (int k = 0; k < 2; ++k) dst[m][k] = *(const PG8_LAS bf16x8*)(lds + PG8_SA(b, h) + aoff + m * 2048 + k * 1024); } while (0)
#define PG8_LDB(dst, b, h) do { _Pragma("unroll") for (int n = 0; n < 2; ++n) _Pragma("unroll") for (int k = 0; k < 2; ++k) dst[n][k] = *(const PG8_LAS bf16x8*)(lds + PG8_SB(b, h) + boff + n * 2048 + k * 1024); } while (0)
#define PG8_MMA(ai, bj, At, Bt) do { __builtin_amdgcn_s_setprio(1); _Pragma("unroll") for (int m = 0; m < 4; ++m) _Pragma("unroll") for (int n = 0; n < 2; ++n) _Pragma("unroll") for (int k = 0; k < 2; ++k) \
        acc[ai][bj][m][n] = __builtin_amdgcn_mfma_f32_16x16x32_bf16(Bt[n][k], At[m][k], acc[ai][bj][m][n], 0, 0, 0); __builtin_amdgcn_s_setprio(0); } while (0)
#define PG8_WAIT_V(n) asm volatile("s_waitcnt vmcnt(" #n ")" ::: "memory")
#define PG8_WAIT_L(n) asm volatile("s_waitcnt lgkmcnt(" #n ")" ::: "memory")
#define PG8_BAR __builtin_amdgcn_s_barrier()
#define PG8_SCHED __builtin_amdgcn_sched_barrier(0)
    Unit cur, nxt; int ui = 0;
    if (!S.next(0, cur)) return;
    f32x4 acc[2][2][4][2];
#pragma unroll
    for (int a = 0; a < 2; ++a)
#pragma unroll
        for (int b = 0; b < 2; ++b)
#pragma unroll
            for (int m = 0; m < 4; ++m)
#pragma unroll
                for (int n = 0; n < 2; ++n) acc[a][b][m][n] = (f32x4){0.f, 0.f, 0.f, 0.f};
    bf16x8 At[4][2], B0[2][2], B1[2][2];
    const char* cA = (const char*)g.A + (size_t)cur.pm * tstepA + (cur.pn >= g.nsplit ? ksplitA : 0); const char* cB = (const char*)g.Bt + (size_t)cur.pn * tstep;
    S.a_ready(cur);
    PG8_STAGE(PG8_SB(0, 0), cB, voffB); PG8_STAGE(PG8_SA(0, 0), cA, voffA); PG8_STAGE(PG8_SB(0, 1), cB + hstep, voffB); PG8_STAGE(PG8_SA(0, 1), cA + hstepA, voffA);
    if (wr == 1) PG8_BAR;
    PG8_WAIT_V(4); PG8_BAR;
    PG8_STAGE(PG8_SB(1, 0), cB + kstep, voffB); PG8_STAGE(PG8_SA(1, 0), cA + kstep, voffA); PG8_STAGE(PG8_SB(1, 1), cB + hstep + kstep, voffB);
    PG8_WAIT_V(6); PG8_BAR;
    PG8_STAMP();
    for (;;) {
        const bool has_next = S.next(ui + 1, nxt);
        const char* nA = has_next ? (const char*)g.A + (size_t)nxt.pm * tstepA + (nxt.pn >= g.nsplit ? ksplitA : 0) : cA; const char* nB = has_next ? (const char*)g.Bt + (size_t)nxt.pn * tstep : cB;
        for (int t = 0; t < nt; t += 2) {
            const bool last = (t == nt - 2);
            const char* a1 = cA + (size_t)(t + 1) * kstep;
            const char* a2 = last ? nA : cA + (size_t)(t + 2) * kstep; const char* b2 = last ? nB : cB + (size_t)(t + 2) * kstep;
            const char* a3 = a2 + kstep; const char* b3 = b2 + kstep;
            if (last && has_next) S.a_ready(nxt);
            PG8_LDB(B0, 0, 0); PG8_SCHED; PG8_LDA(At, 0, 0); PG8_STAGE(PG8_SA(1, 1), a1 + hstepA, voffA);
            PG8_WAIT_L(8); PG8_BAR; PG8_WAIT_L(0); PG8_MMA(0, 0, At, B0); PG8_BAR; PG8_SCHED;
            PG8_LDB(B1, 0, 1); PG8_STAGE(PG8_SB(0, 0), b2, voffB);
            PG8_BAR; PG8_WAIT_L(0); PG8_MMA(0, 1, At, B1); PG8_BAR;
            PG8_LDA(At, 0, 1); PG8_STAGE(PG8_SA(0, 0), a2, voffA);
            PG8_BAR; PG8_WAIT_L(0); PG8_MMA(1, 0, At, B0); PG8_BAR; PG8_SCHED;
            PG8_STAGE(PG8_SB(0, 1), b2 + hstep, voffB);
            PG8_WAIT_V(6); PG8_BAR; PG8_MMA(1, 1, At, B1); PG8_BAR;
            PG8_LDB(B0, 1, 0); PG8_SCHED; PG8_LDA(At, 1, 0); PG8_STAGE(PG8_SA(0, 1), a2 + hstepA, voffA);
            PG8_WAIT_L(8); PG8_BAR; PG8_WAIT_L(0); PG8_MMA(0, 0, At, B0); PG8_BAR; PG8_SCHED;
            PG8_LDB(B1, 1, 1); PG8_STAGE(PG8_SB(1, 0), b3, voffB);
            PG8_BAR; PG8_WAIT_L(0); PG8_MMA(0, 1, At, B1); PG8_BAR;
            PG8_LDA(At, 1, 1); PG8_STAGE(PG8_SA(1, 0), a3, voffA);
            PG8_BAR; PG8_WAIT_L(0); PG8_MMA(1, 0, At, B0); PG8_BAR; PG8_SCHED;
            PG8_STAGE(PG8_SB(1, 1), b3 + hstep, voffB);
            PG8_WAIT_V(6); PG8_BAR; PG8_MMA(1, 1, At, B1); PG8_BAR;
        }
        PG8_STAMP();
        if constexpr (!Epi::AFTER_DRAIN) { E(acc, cur, wr, wc, fr, fq); S.done(cur); }
        PG8_STAMP();
        if (!has_next) break;
#pragma unroll
        for (int a = 0; a < 2; ++a)
#pragma unroll
            for (int b = 0; b < 2; ++b)
#pragma unroll
                for (int m = 0; m < 4; ++m)
#pragma unroll
                    for (int n = 0; n < 2; ++n) acc[a][b][m][n] = (f32x4){0.f, 0.f, 0.f, 0.f};
        cur = nxt; cA = nA; cB = nB; ++ui;
    }
    PG8_WAIT_V(0);
    if (wr == 0) PG8_BAR;
    PG8_BAR;
    if constexpr (Epi::AFTER_DRAIN) { E.fused(acc, cur, wr, wc, fr, fq, lds, wid, lane); S.done(cur); }
    PG8_STAMP();
    if (STAMP && wid == 0) { stamps[lane] = lane < nts ? (((unsigned long long)(unsigned)ts_hi << 32) | (unsigned)ts_lo) : 0ull;
        if (lane == 62) stamps[62] = rt_entry; if (lane == 63) stamps[63] = (unsigned long long)wall_clock64(); }
#undef PG8_STAMP
#undef PG8_SA
#undef PG8_SB
#undef PG8_STAGE
#undef PG8_LDA
#undef PG8_LDB
#undef PG8_MMA
#undef PG8_WAIT_V
#undef PG8_WAIT_L
#undef PG8_BAR
#undef PG8_SCHED
}
}
struct EpiProj {
  static constexpr bool PERM = false, AFTER_DRAIN = false;
  float* projABC; float* pdraw; int col0;
  __device__ __forceinline__ void operator()(const pg8::f32x4 (&acc)[2][2][4][2], const pg8::Unit& u, int wr, int wc, int fr, int fq) const {
#pragma unroll
    for (int ai = 0; ai < 2; ++ai)
#pragma unroll
      for (int m = 0; m < 4; ++m) {
        const int r = u.pm * 256 + ai * 128 + wr * 64 + m * 16 + fr;
#pragma unroll
        for (int bj = 0; bj < 2; ++bj)
#pragma unroll
          for (int n = 0; n < 2; ++n) {
            const int cp = col0 + u.pn * 256 + bj * 128 + wc * 32 + n * 16 + fq * 4;
            const int c = cp < 768 ? cp : (cp < 4000 ? cp + 256 : (cp < 4096 ? PIN : cp - 3328));
            if (c < NABC) *(pg8::f32x4*)(projABC + (size_t)r * NABC + c) = acc[ai][bj][m][n];
            else if (c < PIN) *(pg8::f32x4*)(pdraw + (size_t)r * NPD + (c - NABC)) = acc[ai][bj][m][n];
          }
      }
  }
};
struct EpiRes {
  static constexpr bool PERM = false, AFTER_DRAIN = false;
  float* out; const float* xp; const float* xs; const float* gate;
  __device__ __forceinline__ void operator()(const pg8::f32x4 (&acc)[2][2][4][2], const pg8::Unit& u, int wr, int wc, int fr, int fq) const {
#pragma unroll
    for (int ai = 0; ai < 2; ++ai)
#pragma unroll
      for (int m = 0; m < 4; ++m) {
        const int r = u.pm * 256 + ai * 128 + wr * 64 + m * 16 + fr;
        int gs, T, ci; tok_info(r, gs, T, ci);
        const float* xr = (r < 4096) ? xp + (size_t)r * DM : xs + (size_t)(r - 4096) * DM;
        const float* gr = gate + (size_t)ci * 6144;
#pragma unroll
        for (int bj = 0; bj < 2; ++bj)
#pragma unroll
          for (int n = 0; n < 2; ++n) {
            const int c = u.pn * 256 + bj * 128 + wc * 32 + n * 16 + fq * 4;
            const pg8::f32x4 x = *(const pg8::f32x4*)(xr + c), g = *(const pg8::f32x4*)(gr + c);
            *(pg8::f32x4*)(out + (size_t)r * DM + c) = x * ALPHA + g * acc[ai][bj][m][n];
          }
      }
  }
};
struct EpiResSplit {
  static constexpr bool PERM = false, AFTER_DRAIN = false;
  float* out; float* tmp; const float* gate;
  __device__ __forceinline__ void operator()(const pg8::f32x4 (&acc)[2][2][4][2], const pg8::Unit& u, int wr, int wc, int fr, int fq) const {
    const bool second = u.pn >= 4; const int pn = u.pn & 3;
#pragma unroll
    for (int ai = 0; ai < 2; ++ai)
#pragma unroll
      for (int m = 0; m < 4; ++m) {
        const int r = u.pm * 256 + ai * 128 + wr * 64 + m * 16 + fr;
        int gs, T, ci; tok_info(r, gs, T, ci);
        const float* gr = gate + (size_t)ci * 6144;
#pragma unroll
        for (int bj = 0; bj < 2; ++bj)
#pragma unroll
          for (int n = 0; n < 2; ++n) {
            const int c = pn * 256 + bj * 128 + wc * 32 + n * 16 + fq * 4;
            if (second) *(pg8::f32x4*)(tmp + (size_t)r * DM + c) = acc[ai][bj][m][n];
            else { const pg8::f32x4 x = *(const pg8::f32x4*)(out + (size_t)r * DM + c), g4 = *(const pg8::f32x4*)(gr + c);
                   *(pg8::f32x4*)(out + (size_t)r * DM + c) = x * ALPHA + g4 * acc[ai][bj][m][n]; }
          }
      }
  }
};
struct EpiFF1 {
  static constexpr bool PERM = true, AFTER_DRAIN = false;
  bf16_t* hidden;
  __device__ __forceinline__ void operator()(const pg8::f32x4 (&acc)[2][2][4][2], const pg8::Unit& u, int wr, int wc, int fr, int fq) const {
#pragma unroll
    for (int ai = 0; ai < 2; ++ai)
#pragma unroll
      for (int m = 0; m < 4; ++m) {
        const int r = u.pm * 256 + ai * 128 + wr * 64 + m * 16 + fr;
#pragma unroll
        for (int bj = 0; bj < 2; ++bj) {
          const int c = u.pn * 256 + bj * 128 + wc * 32 + fq * 8;
          pg8::f32x4 v0 = acc[ai][bj][m][0], v1 = acc[ai][bj][m][1];
#pragma unroll
          for (int e = 0; e < 4; ++e) { v0[e] = fmaxf(v0[e], 0.f); v0[e] *= v0[e]; v1[e] = fmaxf(v1[e], 0.f); v1[e] *= v1[e]; }
          uint4 o; o.x = pack2(v0[0], v0[1]); o.y = pack2(v0[2], v0[3]); o.z = pack2(v1[0], v1[1]); o.w = pack2(v1[2], v1[3]);
          *(uint4*)(hidden + (size_t)r * DFF + c) = o;
        }
      }
  }
};
template <class Epi>
DEV void phase_gemm(const bf16_t* A, const bf16_t* Bt, int N, int K, const Epi& E, char* smem, int lda = 0, int nsplit = 1 << 20, int G = 0) {
  pg8::Gemm g; g.A = A; g.Bt = Bt; g.M = NTOK; g.N = N; g.K = K; g.lda = lda ? lda : K; g.nsplit = nsplit;
  pg8::StaticOrder S; S.init(NTOK, N, G ? G : (int)gridDim.x, (int)blockIdx.x);
  pg8::gemm_phase<Epi, pg8::StaticOrder, false>((PG8_LAS unsigned char*)smem, g, S, E, nullptr);
}

DEV float shiftmix(const float* __restrict__ pd, int g, int col, bool hp, bool hn, float mu) {
  const float x = pd[(size_t)g * NPD + col];
  const float xp = hp ? pd[(size_t)(g - 1) * NPD + col] : 0.f;
  const float xn = hn ? pd[(size_t)(g + 1) * NPD + col] : 0.f;
  return x + mu * (0.5f * (xp + xn) - x);
}
DEV void rwkv_prep_item(const Params& P, int l, int tile, int part, char* smem, const int tid_in) {
  const int tid = opaque_i(tid_in);
  const int lane = tid & 63, w = tid >> 6;
  const int g0 = tile * 64;
  int gs, T, ci; tok_info(g0, gs, T, ci);
  const float* mu = P.rwkv_mu + l * NPD;
  const float* __restrict__ pd = P.pdraw;
  float* __restrict__ rkvp = P.rkv;
  if (part == 0) {
#pragma unroll 4
    for (int idx = tid; idx < 64 * 128; idx += 256) {
      const int row = idx >> 7, c4 = (idx & 127) * 4;
      const int col = c4 < 256 ? c4 : (c4 + 256);
      const int g = g0 + row; const bool hp = g > gs, hn = g + 1 < gs + T;
      const float4 x = *(const float4*)(pd + (size_t)g * NPD + col);
      float4 xp = make_float4(0, 0, 0, 0), xn = make_float4(0, 0, 0, 0);
      if (hp) xp = *(const float4*)(pd + (size_t)(g - 1) * NPD + col);
      if (hn) xn = *(const float4*)(pd + (size_t)(g + 1) * NPD + col);
      const float4 m4 = *(const float4*)(mu + col);
      float4 o;
      o.x = x.x + m4.x * (0.5f * (xp.x + xn.x) - x.x); o.y = x.y + m4.y * (0.5f * (xp.y + xn.y) - x.y);
      o.z = x.z + m4.z * (0.5f * (xp.z + xn.z) - x.z); o.w = x.w + m4.w * (0.5f * (xp.w + xn.w) - x.w);
      *(float4*)(rkvp + (size_t)g * 768 + col) = o;
    }
    { const int cgk = tid & 63, qt = tid >> 6; const int col = 256 + cgk * 4;
      const float4 m4 = *(const float4*)(mu + col);
      const float4 kk = *(const float4*)(P.rwkv_kk + l * 256 + cgk * 4);
#pragma unroll 4
      for (int i = 0; i < 16; ++i) {
        const int g = g0 + qt * 16 + i; const bool hp = g > gs, hn = g + 1 < gs + T;
        const float4 x = *(const float4*)(pd + (size_t)g * NPD + col);
        float4 xp = make_float4(0, 0, 0, 0), xn = make_float4(0, 0, 0, 0);
        if (hp) xp = *(const float4*)(pd + (size_t)(g - 1) * NPD + col);
        if (hn) xn = *(const float4*)(pd + (size_t)(g + 1) * NPD + col);
        float4 o;
        o.x = x.x + m4.x * (0.5f * (xp.x + xn.x) - x.x); o.y = x.y + m4.y * (0.5f * (xp.y + xn.y) - x.y);
        o.z = x.z + m4.z * (0.5f * (xp.z + xn.z) - x.z); o.w = x.w + m4.w * (0.5f * (xp.w + xn.w) - x.w);
        *(float4*)(rkvp + (size_t)g * 768 + col) = o;
        const float ss = red16((o.x * kk.x) * (o.x * kk.x) + (o.y * kk.y) * (o.y * kk.y) + (o.z * kk.z) * (o.z * kk.z) + (o.w * kk.w) * (o.w * kk.w));
        if ((cgk & 15) == 0) P.khinv[g * 4 + (cgk >> 4)] = rsqrtf(ss + 1e-6f);
      }
    }
    return;
  }
  const bool isg = part == 5;
  const int KK = isg ? 128 : 64;
  const int lda = KK + 8;
  int z = 0, kind = 0;
  if (!isg) { const int p = part - 1; z = p >> 1; kind = p & 1; }
  const int acol0 = isg ? 1024 : (768 + kind * 128 + z * 64);
  bf16_t* sA = (bf16_t*)smem;
  {
    const int nq = KK >> 2;
    for (int idx = tid; idx < 64 * nq; idx += 256) {
      const int row = idx / nq, r = (idx % nq) * 4; const int g = g0 + row;
      const bool hp = g > gs, hn = g + 1 < gs + T;
      const float* px = pd + (size_t)g * NPD + acol0 + r;
      const float4 x = *(const float4*)px;
      float4 xp = make_float4(0, 0, 0, 0), xn = make_float4(0, 0, 0, 0);
      if (hp) xp = *(const float4*)(px - NPD);
      if (hn) xn = *(const float4*)(px + NPD);
      const float4 m4 = *(const float4*)(mu + acol0 + r);
      float v0 = x.x + m4.x * (0.5f * (xp.x + xn.x) - x.x), v1 = x.y + m4.y * (0.5f * (xp.y + xn.y) - x.y);
      float v2 = x.z + m4.z * (0.5f * (xp.z + xn.z) - x.z), v3 = x.w + m4.w * (0.5f * (xp.w + xn.w) - x.w);
      if (isg) { v0 = sigmoidf_(v0); v1 = sigmoidf_(v1); v2 = sigmoidf_(v2); v3 = sigmoidf_(v3); }
      else if (kind == 0) { v0 = tanhf(v0); v1 = tanhf(v1); v2 = tanhf(v2); v3 = tanhf(v3); }
      uint2 o; o.x = pack2(v0, v1); o.y = pack2(v2, v3);
      *(uint2*)(sA + row * lda + r) = o;
    }
  }
  const bf16_t* Bt = isg ? (P.g2t + (size_t)l * 256 * 128) : ((kind == 0 ? P.w2t : P.a2t) + (size_t)(l * 2 + z) * 256 * 64);
  __syncthreads();
#pragma unroll 1
  for (int half = 0; half < 2; ++half) {
  const bf16_t* bp = Bt + (size_t)(half * 128 + w * 32 + (lane & 31)) * KK + (lane >> 5) * 8;
  f32x16 acc[2] = {zero16(), zero16()};
  for (int s = 0; s < KK / 16; ++s) {
    const bf16x8 b = *(const bf16x8*)(bp + s * 16);
#pragma unroll
    for (int mi = 0; mi < 2; ++mi) {
      const bf16x8 a = *(const bf16x8*)(sA + (mi * 32 + (lane & 31)) * lda + s * 16 + (lane >> 5) * 8);
      acc[mi] = __builtin_amdgcn_mfma_f32_32x32x16_bf16(a, b, acc[mi], 0, 0, 0);
    }
  }
  const int c = half * 128 + w * 32 + (lane & 31);
  float bias = 0.f;
  if (!isg) bias = (kind == 0 ? P.rwkv_w0 : P.rwkv_a0)[(l * 2 + z) * 256 + c];
#pragma unroll
  for (int mi = 0; mi < 2; ++mi)
#pragma unroll
    for (int idx = 0; idx < 16; ++idx) {
      const int row = mi * 32 + (idx & 3) + 8 * (idx >> 2) + 4 * (lane >> 5);
      const int g = g0 + row;
      const float v = acc[mi][idx];
      if (isg) P.gbuf[(size_t)g * 256 + c] = f2bf(v);
      else {
        const float sg = sigmoidf_(v + bias);
        P.wa[((size_t)(g * 2 + z) * 2 + kind) * 256 + c] = (kind == 0) ? __expf(-0.60653065971f * sg) : sg;
      }
    }
  }
  __syncthreads();
}

DEV float4 dp_load(const float* base, int g, int gs, int T) { float4 r = make_float4(0.f, 0.f, 0.f, 0.f); if (g >= gs && g < gs + T) r = *(const float4*)(base + (size_t)g * NABC); return r; }
DEV void delta_prep_item(const Params& P, int l, int tile, int X, const int tid_in) {
  const int tid = opaque_i(tid_in);
  const int cg = tid & 63, qt = tid >> 6;
  const int g0 = tile * 64 + qt * 16;
  int gs, T, ci; tok_info(g0, gs, T, ci);
  const int col = X * 256 + cg * 4;
  const float* cw = P.delta_conv + (size_t)l * 5 * 768 + col;
  const float4 w0 = *(const float4*)cw, w1 = *(const float4*)(cw + 768), w2 = *(const float4*)(cw + 2 * 768), w3 = *(const float4*)(cw + 3 * 768), w4 = *(const float4*)(cw + 4 * 768);
  const float* base = P.projABC + 1040 + col;
#define DP_LOAD(G) dp_load(base, (G), gs, T)
  float4 xm2 = DP_LOAD(g0 - 2), xm1 = DP_LOAD(g0 - 1), x0 = DP_LOAD(g0), xp1 = DP_LOAD(g0 + 1);
#pragma unroll 4
  for (int i = 0; i < 16; ++i) {
    const int g = g0 + i;
    const float4 xp2 = DP_LOAD(g + 2);
    float4 a;
    a.x = xm2.x * w0.x + xm1.x * w1.x + x0.x * w2.x + xp1.x * w3.x + xp2.x * w4.x;
    a.y = xm2.y * w0.y + xm1.y * w1.y + x0.y * w2.y + xp1.y * w3.y + xp2.y * w4.y;
    a.z = xm2.z * w0.z + xm1.z * w1.z + x0.z * w2.z + xp1.z * w3.z + xp2.z * w4.z;
    a.w = xm2.w * w0.w + xm1.w * w1.w + x0.w * w2.w + xp1.w * w3.w + xp2.w * w4.w;
    a.x = siluf_(a.x); a.y = siluf_(a.y); a.z = siluf_(a.z); a.w = siluf_(a.w);
    float sc = 1.f;
    if (X < 2) { const float ss = red16(a.x * a.x + a.y * a.y + a.z * a.z + a.w * a.w); sc = rsqrtf(ss + 1e-6f) * (X == 0 ? 0.125f : 1.f); }
    uint2 o; o.x = pack2(a.x * sc, a.y * sc); o.y = pack2(a.z * sc, a.w * sc);
    *(uint2*)(P.ubuf + (size_t)g * 768 + col) = o;
    xm2 = xm1; xm1 = x0; x0 = xp1; xp1 = xp2;
  }
#undef DP_LOAD
}

DEV void load16(const float* __restrict__ p, float* v) {
#pragma unroll
  for (int e = 0; e < 4; ++e) { const float4 t = *(const float4*)(p + 4 * e); v[4 * e] = t.x; v[4 * e + 1] = t.y; v[4 * e + 2] = t.z; v[4 * e + 3] = t.w; }
}
DEV void store_row16(bf16_t* dst, const float* v) {
  uint4 a, b;
  a.x = pack2(v[0], v[1]); a.y = pack2(v[2], v[3]); a.z = pack2(v[4], v[5]); a.w = pack2(v[6], v[7]);
  b.x = pack2(v[8], v[9]); b.y = pack2(v[10], v[11]); b.z = pack2(v[12], v[13]); b.w = pack2(v[14], v[15]);
  *(uint4*)dst = a; *(uint4*)(dst + 8) = b;
}
DEV void decode_chain(int task, int& seq, int& h, bool& sample) {
  if (task < 8) { sample = true; seq = 16 + (task >> 2); h = task & 3; }
  else { const int t = task - 8; sample = false; seq = t >> 2; h = t & 3; }
}
DEV void seq_base(int seq, int& gs, int& T) { if (seq < 16) { gs = seq * 256; T = 256; } else { gs = 4096 + (seq - 16) * 2048; T = 2048; } }
DEV float wave_incl_scan_add(float x, int lane) {
#pragma unroll
  for (int o = 1; o < 64; o <<= 1) { const float y = __shfl_up(x, o); if (lane >= o) x += y; }
  return x;
}
DEV float wave_incl_scan_max(float x, int lane) {
#pragma unroll
  for (int o = 1; o < 64; o <<= 1) { const float y = __shfl_up(x, o); if (lane >= o) x = fmaxf(x, y); }
  return x;
}

DEV void ret_task(const Params& P, int l, int task, const int z, char* smem, const int tid_in, const bool active) {
  const int tid = opaque_i(tid_in);
  const int lane = tid & 63, w = tid >> 6, wr = w >> 1, wc = w & 1;
  int seq, h; bool sample; decode_chain(task, seq, h, sample);
  int gs, T; seq_base(seq, gs, T);
  if (!active) { for (int c = 0; c < T / 64; ++c) { __syncthreads(); __syncthreads(); __syncthreads(); } return; }
  bf16_t* sQ = (bf16_t*)smem; bf16_t* sK = sQ + 64 * LDB; bf16_t* sKzt = sK + 64 * LDB; bf16_t* sVt = sKzt + 64 * LDB; bf16_t* sP = sVt + 64 * LDB; bf16_t* sSt = sP + 64 * LDB;
  const float lg = -__expf(P.ret_decay[(l * 2 + z) * 4 + h]);
  const float gl = __expf(64.f * lg);
  f32x16 st = zero16();
  if (sample) {
    const float* s0 = P.st_ret + ((size_t)(((seq - 16) * 2 + l) * 2 + z) * 4 + h) * 4096;
#pragma unroll
    for (int idx = 0; idx < 16; ++idx) st[idx] = s0[ACC_COL * 64 + ACC_ROW(idx)];
  }
#pragma unroll
  for (int idx = 0; idx < 16; ++idx) sSt[ACC_ROW(idx) * LDB + ACC_COL] = f2bf(st[idx]);
  const int nch = T / 64;
  const int tid_outer = tid;
  float4 nq[4], nk[4], nv[4], nq2[4], nk2[4];
#define RET_PREFETCH(C) { \
    const int r_ = tid_outer & 63, sg_ = (tid_outer >> 6) * 16; \
    const int p_ = (C) * 64 + r_; const int g_ = gs + (z ? (T - 1 - p_) : p_); \
    const float* pr_ = P.projABC + (size_t)g_ * NABC + 2080 + h * 64; \
    _Pragma("unroll") for (int e_ = 0; e_ < 4; ++e_) { nq[e_] = *(const float4*)(pr_ + sg_ + 4 * e_); nk[e_] = *(const float4*)(pr_ + 256 + sg_ + 4 * e_); nv[e_] = *(const float4*)(pr_ + 512 + sg_ + 4 * e_); } \
    if (sample) { _Pragma("unroll") for (int e_ = 0; e_ < 4; ++e_) { nq2[e_] = *(const float4*)(pr_ + (sg_ ^ 16) + 4 * e_); nk2[e_] = *(const float4*)(pr_ + 256 + (sg_ ^ 16) + 4 * e_); } } }
  RET_PREFETCH(0)
  for (int c = 0; c < nch; ++c) {
    const int tid = opaque_i(tid_outer);
    const int lane = tid & 63, w = tid >> 6, wr = w >> 1, wc = w & 1;
    const int row = tid & 63, seg = (tid >> 6) * 16;
    {
      const int p = c * 64 + row; const int t = z ? (T - 1 - p) : p;
      float q[16], k[16], v[16];
#pragma unroll
      for (int e = 0; e < 4; ++e) { q[4 * e] = nq[e].x; q[4 * e + 1] = nq[e].y; q[4 * e + 2] = nq[e].z; q[4 * e + 3] = nq[e].w; k[4 * e] = nk[e].x; k[4 * e + 1] = nk[e].y; k[4 * e + 2] = nk[e].z; k[4 * e + 3] = nk[e].w;
        v[4 * e] = nv[e].x; v[4 * e + 1] = nv[e].y; v[4 * e + 2] = nv[e].z; v[4 * e + 3] = nv[e].w; }
      if (sample) {
        float q2[16], k2[16];
#pragma unroll
        for (int e = 0; e < 4; ++e) { q2[4 * e] = nq2[e].x; q2[4 * e + 1] = nq2[e].y; q2[4 * e + 2] = nq2[e].z; q2[4 * e + 3] = nq2[e].w; k2[4 * e] = nk2[e].x; k2[4 * e + 1] = nk2[e].y; k2[4 * e + 2] = nk2[e].z; k2[4 * e + 3] = nk2[e].w; }
        const float pos = (seg < 32) ? (float)(t >> 6) : (float)(t & 63);
        const bool first = (seg & 16) == 0;
#pragma unroll
        for (int e = 0; e < 16; ++e) {
          const float inv = __expf(-(float)e * (9.210340371976184f / 16.f));
          const float sn = __sinf(pos * inv), cs = __cosf(pos * inv);
          const float qs = first ? -q2[e] : q2[e], ks = first ? -k2[e] : k2[e];
          q[e] = q[e] * cs + qs * sn; k[e] = k[e] * cs + ks * sn;
        }
      }
      const float zeta = __expf((63.f - (float)row) * lg);
      float qq[16];
#pragma unroll
      for (int e = 0; e < 16; ++e) qq[e] = q[e] * 0.125f;
      store_row16(sQ + row * LDB + seg, qq);
      store_row16(sK + row * LDB + seg, k);
#pragma unroll
      for (int e = 0; e < 16; ++e) { sKzt[(seg + e) * LDB + row] = f2bf(k[e] * zeta); sVt[(seg + e) * LDB + row] = f2bf(v[e]); }
    }
    __syncthreads();
    if (c + 1 < nch) RET_PREFETCH(c + 1)
    f32x16 s = mm64(sQ, sK, wr, wc, lane, zero16());
#pragma unroll
    for (int idx = 0; idx < 16; ++idx) {
      const int i = ACC_ROW(idx), j = ACC_COL;
      const float val = (i >= j) ? s[idx] * __expf((float)(i - j) * lg) : 0.f;
      sP[i * LDB + j] = f2bf(val);
    }
    __syncthreads();
    f32x16 o1 = mm64(sP, sVt, wr, wc, lane, zero16());
    f32x16 o2 = mm64(sQ, sSt, wr, wc, lane, zero16());
#pragma unroll
    for (int idx = 0; idx < 16; ++idx) st[idx] *= gl;
    st = mm64(sVt, sKzt, wr, wc, lane, st);
#pragma unroll
    for (int idx = 0; idx < 16; ++idx) {
      const int i = ACC_ROW(idx), e = ACC_COL;
      const float xi = __expf((float)(i + 1) * lg);
      const int pp = c * 64 + i; const int tt = z ? (T - 1 - pp) : pp;
      P.hdir[((size_t)z * NTOK + gs + tt) * DM + 512 + h * 64 + e] = f2bf(o1[idx] + xi * o2[idx]);
    }
    __syncthreads();
#pragma unroll
    for (int idx = 0; idx < 16; ++idx) sSt[ACC_ROW(idx) * LDB + ACC_COL] = f2bf(st[idx]);
  }
  if (!sample) {
    float* o = P.out + O_RET + ((size_t)((seq * 2 + l) * 2 + z) * 4 + h) * 4096;
#pragma unroll
    for (int idx = 0; idx < 16; ++idx) o[ACC_COL * 64 + ACC_ROW(idx)] = st[idx];
  }
}

DEV void ret_sample_task(const Params& P, int l, int task, const int z, char* smem0, const int tid_all_in) {
  const int tid_all = opaque_i(tid_all_in);
  const int half = tid_all >> 8, tid0 = tid_all & 255;
  int seq, h; bool sample; decode_chain(task, seq, h, sample);
  int gs, T; seq_base(seq, gs, T);
  const int nch = T / 64;
  const float lg = -__expf(P.ret_decay[(l * 2 + z) * 4 + h]);
#define RT_SET(B) ((bf16_t*)(smem0 + (B) * HALF_LDS))
  bf16_t* sP = RT_SET(0) + 4 * 64 * LDB; bf16_t* sSt = sP + 64 * LDB;
  if (half == 1) {
    const int tid = tid0;
    float4 nq[4], nk[4], nv[4], nq2[4], nk2[4];
#pragma unroll
    for (int e = 0; e < 4; ++e) { nq2[e] = make_float4(0.f, 0.f, 0.f, 0.f); nk2[e] = nq2[e]; }
#define RT_PREFETCH(C) { \
      const int r_ = tid & 63, sg_ = (tid >> 6) * 16; \
      const int p_ = (C) * 64 + r_; const int g_ = gs + (z ? (T - 1 - p_) : p_); \
      const float* pr_ = P.projABC + (size_t)g_ * NABC + 2080 + h * 64; \
      _Pragma("unroll") for (int e_ = 0; e_ < 4; ++e_) { nq[e_] = *(const float4*)(pr_ + sg_ + 4 * e_); nk[e_] = *(const float4*)(pr_ + 256 + sg_ + 4 * e_); nv[e_] = *(const float4*)(pr_ + 512 + sg_ + 4 * e_); \
        if (sample) { nq2[e_] = *(const float4*)(pr_ + (sg_ ^ 16) + 4 * e_); nk2[e_] = *(const float4*)(pr_ + 256 + (sg_ ^ 16) + 4 * e_); } } }
#define RT_STAGE(C) { \
      bf16_t* sQ = RT_SET((C) & 1); bf16_t* sK = sQ + 64 * LDB; bf16_t* sKzt = sK + 64 * LDB; bf16_t* sVt = sKzt + 64 * LDB; \
      const int row = tid & 63, seg = (tid >> 6) * 16; \
      const int p = (C) * 64 + row; const int t = z ? (T - 1 - p) : p; \
      float q[16], k[16], v[16], q2[16], k2[16]; \
      _Pragma("unroll") for (int e = 0; e < 4; ++e) { q[4 * e] = nq[e].x; q[4 * e + 1] = nq[e].y; q[4 * e + 2] = nq[e].z; q[4 * e + 3] = nq[e].w; k[4 * e] = nk[e].x; k[4 * e + 1] = nk[e].y; k[4 * e + 2] = nk[e].z; k[4 * e + 3] = nk[e].w; \
        v[4 * e] = nv[e].x; v[4 * e + 1] = nv[e].y; v[4 * e + 2] = nv[e].z; v[4 * e + 3] = nv[e].w; \
        q2[4 * e] = nq2[e].x; q2[4 * e + 1] = nq2[e].y; q2[4 * e + 2] = nq2[e].z; q2[4 * e + 3] = nq2[e].w; k2[4 * e] = nk2[e].x; k2[4 * e + 1] = nk2[e].y; k2[4 * e + 2] = nk2[e].z; k2[4 * e + 3] = nk2[e].w; } \
      const float pos = (seg < 32) ? (float)(t >> 6) : (float)(t & 63); \
      const bool first = (seg & 16) == 0; \
      if (sample) { _Pragma("unroll") for (int e = 0; e < 16; ++e) { \
        const float inv = __expf(-(float)e * (9.210340371976184f / 16.f)); \
        const float sn = __sinf(pos * inv), cs = __cosf(pos * inv); \
        const float qs = first ? -q2[e] : q2[e], ks = first ? -k2[e] : k2[e]; \
        q[e] = (q[e] * cs + qs * sn) * 0.125f; k[e] = k[e] * cs + ks * sn; } } \
      else { _Pragma("unroll") for (int e = 0; e < 16; ++e) q[e] *= 0.125f; } \
      const float zeta = __expf((63.f - (float)row) * lg); \
      store_row16(sQ + row * LDB + seg, q); \
      store_row16(sK + row * LDB + seg, k); \
      _Pragma("unroll") for (int e = 0; e < 16; ++e) { sKzt[(seg + e) * LDB + row] = f2bf(k[e] * zeta); sVt[(seg + e) * LDB + row] = f2bf(v[e]); } }
    RT_PREFETCH(0)
    RT_STAGE(0)
    if (nch > 1) RT_PREFETCH(1)
    __syncthreads();
    for (int c = 0; c < nch; ++c) {
      if (c + 1 < nch) { RT_STAGE(c + 1) if (c + 2 < nch) RT_PREFETCH(c + 2) }
      __syncthreads(); __syncthreads(); __syncthreads();
    }
#undef RT_PREFETCH
#undef RT_STAGE
  } else {
    const int tid = tid0;
    const int lane = tid & 63, w = tid >> 6, wr = w >> 1, wc = w & 1;
    const float gl = __expf(64.f * lg);
    f32x16 st = zero16();
    if (sample) {
      const float* s0 = P.st_ret + ((size_t)(((seq - 16) * 2 + l) * 2 + z) * 4 + h) * 4096;
#pragma unroll
      for (int idx = 0; idx < 16; ++idx) st[idx] = s0[ACC_COL * 64 + ACC_ROW(idx)];
    }
#pragma unroll
    for (int idx = 0; idx < 16; ++idx) sSt[ACC_ROW(idx) * LDB + ACC_COL] = f2bf(st[idx]);
    __syncthreads();
    for (int c = 0; c < nch; ++c) {
      const bf16_t* sQ = RT_SET(c & 1); const bf16_t* sK = sQ + 64 * LDB; const bf16_t* sKzt = sK + 64 * LDB; const bf16_t* sVt = sKzt + 64 * LDB;
      f32x16 s = mm64(sQ, sK, wr, wc, lane, zero16());
#pragma unroll
      for (int idx = 0; idx < 16; ++idx) {
        const int i = ACC_ROW(idx), j = ACC_COL;
        const float val = (i >= j) ? s[idx] * __expf((float)(i - j) * lg) : 0.f;
        sP[i * LDB + j] = f2bf(val);
      }
      __syncthreads();
      f32x16 o1 = mm64(sP, sVt, wr, wc, lane, zero16());
      f32x16 o2 = mm64(sQ, sSt, wr, wc, lane, zero16());
#pragma unroll
      for (int idx = 0; idx < 16; ++idx) st[idx] *= gl;
      st = mm64(sVt, sKzt, wr, wc, lane, st);
#pragma unroll
      for (int idx = 0; idx < 16; ++idx) {
        const int i = ACC_ROW(idx), e = ACC_COL;
        const float xi = __expf((float)(i + 1) * lg);
        const int pp = c * 64 + i; const int tt = z ? (T - 1 - pp) : pp;
        P.hdir[((size_t)z * NTOK + gs + tt) * DM + 512 + h * 64 + e] = f2bf(o1[idx] + xi * o2[idx]);
      }
      __syncthreads();
#pragma unroll
      for (int idx = 0; idx < 16; ++idx) sSt[ACC_ROW(idx) * LDB + ACC_COL] = f2bf(st[idx]);
      __syncthreads();
    }
    if (!sample) {
      float* o = P.out + O_RET + ((size_t)((seq * 2 + l) * 2 + z) * 4 + h) * 4096;
#pragma unroll
      for (int idx = 0; idx < 16; ++idx) o[ACC_COL * 64 + ACC_ROW(idx)] = st[idx];
    }
  }
#undef RT_SET
}

DEV void mlstm_task(const Params& P, int l, int task, const int z, char* smem, const int tid_in, const bool active) {
  const int tid = opaque_i(tid_in);
  const int lane = tid & 63, w = tid >> 6, wr = w >> 1, wc = w & 1;
  int seq, h; bool sample; decode_chain(task, seq, h, sample);
  int gs, T; seq_base(seq, gs, T);
  if (!active) { for (int c = 0; c < T / 64; ++c) { __syncthreads(); __syncthreads(); __syncthreads(); } return; }
  bf16_t* sQ = (bf16_t*)smem; bf16_t* sK = sQ + 64 * LDB; bf16_t* sKt = sK + 64 * LDB; bf16_t* sVt = sKt + 64 * LDB; bf16_t* sP = sVt + 64 * LDB; bf16_t* sCt = sP + 64 * LDB;
  float* fs = (float*)(sCt + 64 * LDB);
  float* s_gate = fs; float* s_nn = fs + 640;
  const int sidx = sample ? ((((seq - 16) * 2 + l) * 2 + z) * 4 + h) : 0;
  f32x16 st = zero16();
  if (sample) {
    const float* c0 = P.st_C + (size_t)sidx * 4096;
#pragma unroll
    for (int idx = 0; idx < 16; ++idx) st[idx] = c0[ACC_COL * 64 + ACC_ROW(idx)];
  }
#pragma unroll
  for (int idx = 0; idx < 16; ++idx) sCt[ACC_ROW(idx) * LDB + ACC_COL] = f2bf(st[idx]);
  if (tid < 64) s_nn[tid] = sample ? P.st_n[sidx * 64 + tid] : 0.f;
  float m = sample ? P.st_m[sidx] : 0.f;
  const float ib = P.mlstm_i_bias[(l * 2 + z) * 4 + h], fb = P.mlstm_f_bias[(l * 2 + z) * 4 + h];
  const int nch = T / 64;
  const int tid_outer = tid;
  float4 nq[4], nk[4], nv[4]; float ngi, ngf;
#define MLSTM_PREFETCH(C) { \
    const int r_ = tid_outer & 63, sg_ = (tid_outer >> 6) * 16; \
    const int p_ = (C) * 64 + r_; const int g_ = gs + (z ? (T - 1 - p_) : p_); \
    const float* pr_ = P.projABC + (size_t)g_ * NABC + h * 64; \
    _Pragma("unroll") for (int e_ = 0; e_ < 4; ++e_) { nq[e_] = *(const float4*)(pr_ + sg_ + 4 * e_); nk[e_] = *(const float4*)(pr_ + 256 + sg_ + 4 * e_); nv[e_] = *(const float4*)(pr_ + 512 + sg_ + 4 * e_); } \
    const float* gp_ = P.projABC + (size_t)g_ * NABC + 1024 + z * 4 + h; ngi = gp_[0]; ngf = gp_[8]; }
  MLSTM_PREFETCH(0)
  for (int c = 0; c < nch; ++c) {
    const int tid = opaque_i(tid_outer);
    const int lane = tid & 63, w = tid >> 6, wr = w >> 1, wc = w & 1;
    const int row = tid & 63, seg = (tid >> 6) * 16;
    const int par = c & 1;
    float* s_a = s_gate + par * 320; float* s_b = s_a + 64; float* s_M = s_a + 128; float* s_ew = s_a + 192; float* s_dinv = s_a + 256;
    float* s_n = s_nn + par * 64; float* s_n2 = s_nn + (par ^ 1) * 64;
    float sp;
    {
      const float li = ngi + ib, lf = logsigmoidf_(ngf + fb);
      const float b = wave_incl_scan_add(lf, lane);
      const float a = li - b;
      const float cm = wave_incl_scan_max(a, lane);
      const float M = fmaxf(m, cm);
      const float M63 = __shfl(M, 63), bl = __shfl(b, 63);
      const float skj = __expf(a - M63);
      sp = __expf(m - M63);
      if (w == 0) { s_a[lane] = a; s_b[lane] = b; s_M[lane] = M; s_ew[lane] = __expf(m - M); }
      m = bl + M63;
      float q[16], k[16], v[16];
#pragma unroll
      for (int e = 0; e < 4; ++e) { q[4 * e] = nq[e].x; q[4 * e + 1] = nq[e].y; q[4 * e + 2] = nq[e].z; q[4 * e + 3] = nq[e].w;
        k[4 * e] = nk[e].x * 0.125f; k[4 * e + 1] = nk[e].y * 0.125f; k[4 * e + 2] = nk[e].z * 0.125f; k[4 * e + 3] = nk[e].w * 0.125f;
        v[4 * e] = nv[e].x; v[4 * e + 1] = nv[e].y; v[4 * e + 2] = nv[e].z; v[4 * e + 3] = nv[e].w; }
      store_row16(sQ + row * LDB + seg, q);
      store_row16(sK + row * LDB + seg, k);
#pragma unroll
      for (int e = 0; e < 16; ++e) { sKt[(seg + e) * LDB + row] = f2bf(k[e] * skj); sVt[(seg + e) * LDB + row] = f2bf(v[e]); }
    }
    __syncthreads();
    f32x16 s = mm64(sQ, sK, wr, wc, lane, zero16());
#pragma unroll
    for (int idx = 0; idx < 16; ++idx) {
      const int i = ACC_ROW(idx), j = ACC_COL;
      const float val = (i >= j) ? s[idx] * __expf(s_a[j] - s_M[i]) : 0.f;
      sP[i * LDB + j] = f2bf(val);
    }
    __syncthreads();
    if (c + 1 < nch) MLSTM_PREFETCH(c + 1)
    f32x16 o1 = mm64(sP, sVt, wr, wc, lane, zero16());
    f32x16 o2 = mm64(sQ, sCt, wr, wc, lane, zero16());
    {
      const int r4 = tid >> 2, sg4 = (tid & 3) * 16;
      float rs = 0.f, qn = 0.f;
#pragma unroll
      for (int e = 0; e < 16; ++e) { rs += bf2f(sP[r4 * LDB + sg4 + e]); qn += bf2f(sQ[r4 * LDB + sg4 + e]) * s_n[sg4 + e]; }
      rs = red4(rs); qn = red4(qn);
      const float den = rs + qn * s_ew[r4];
      const float mt = s_b[r4] + s_M[r4];
      if ((tid & 3) == 0) s_dinv[r4] = 1.f / fmaxf(fabsf(den), __expf(-mt));
    }
#pragma unroll
    for (int idx = 0; idx < 16; ++idx) st[idx] *= sp;
    st = mm64(sVt, sKt, wr, wc, lane, st);
    if (tid < 64) {
      float a = s_n[tid] * sp;
      for (int j = 0; j < 64; ++j) a += bf2f(sKt[tid * LDB + j]);
      s_n2[tid] = a;
    }
    __syncthreads();
#pragma unroll
    for (int idx = 0; idx < 16; ++idx) {
      const int i = ACC_ROW(idx), e = ACC_COL;
      const int pp = c * 64 + i; const int tt = z ? (T - 1 - pp) : pp;
      P.hdir[((size_t)z * NTOK + gs + tt) * DM + h * 64 + e] = f2bf((o1[idx] + s_ew[i] * o2[idx]) * s_dinv[i]);
    }
#pragma unroll
    for (int idx = 0; idx < 16; ++idx) sCt[ACC_ROW(idx) * LDB + ACC_COL] = f2bf(st[idx]);
  }
  if (!sample) {
    const int oi = ((seq * 2 + l) * 2 + z) * 4 + h;
    float* o = P.out + O_C + (size_t)oi * 4096;
#pragma unroll
    for (int idx = 0; idx < 16; ++idx) o[ACC_COL * 64 + ACC_ROW(idx)] = st[idx];
    __syncthreads();
    if (tid < 64) P.out[O_N + oi * 64 + tid] = s_nn[(nch & 1) * 64 + tid];
    if (tid == 0) P.out[O_M + oi] = m;
  }
}

DEV void mlstm_sample_task(const Params& P, int l, int task, const int z, char* smem0, const int tid_all_in) {
  const int tid_all = opaque_i(tid_all_in);
  const int half = tid_all >> 8, tid = tid_all & 255;
  int seq, h; bool sample; decode_chain(task, seq, h, sample);
  int gs, T; seq_base(seq, gs, T);
  const int nch = T / 64;
  const int sidx = (((seq - 16) * 2 + l) * 2 + z) * 4 + h;
#define ML_SET(B) ((bf16_t*)(smem0 + (B) * HALF_LDS))
#define ML_GATE(B) ((float*)(smem0 + (B) * HALF_LDS + 4 * 64 * LDB * 2))
  bf16_t* sP = (bf16_t*)(smem0 + 4 * 64 * LDB * 2 + 2048); bf16_t* sCt = sP + 64 * LDB;
  float* s_dinv = (float*)(sCt + 64 * LDB); float* s_nn = s_dinv + 64;
  if (half == 1) {
    const int lane = tid & 63, w = tid >> 6;
    float m = P.st_m[sidx];
    const float ib = P.mlstm_i_bias[(l * 2 + z) * 4 + h], fb = P.mlstm_f_bias[(l * 2 + z) * 4 + h];
    float4 nq[4], nk[4], nv[4]; float ngi, ngf;
#define ML_PREFETCH(C) { \
      const int r_ = tid & 63, sg_ = (tid >> 6) * 16; \
      const int p_ = (C) * 64 + r_; const int g_ = gs + (z ? (T - 1 - p_) : p_); \
      const float* pr_ = P.projABC + (size_t)g_ * NABC + h * 64; \
      _Pragma("unroll") for (int e_ = 0; e_ < 4; ++e_) { nq[e_] = *(const float4*)(pr_ + sg_ + 4 * e_); nk[e_] = *(const float4*)(pr_ + 256 + sg_ + 4 * e_); nv[e_] = *(const float4*)(pr_ + 512 + sg_ + 4 * e_); } \
      const float* gp_ = P.projABC + (size_t)g_ * NABC + 1024 + z * 4 + h; ngi = gp_[0]; ngf = gp_[8]; }
#define ML_STAGE(C) { \
      bf16_t* sQ = ML_SET((C) & 1); bf16_t* sK = sQ + 64 * LDB; bf16_t* sKt = sK + 64 * LDB; bf16_t* sVt = sKt + 64 * LDB; \
      float* gt_ = ML_GATE((C) & 1); \
      const int row = tid & 63, seg = (tid >> 6) * 16; \
      const float li = ngi + ib, lf = logsigmoidf_(ngf + fb); \
      const float b = wave_incl_scan_add(lf, lane); \
      const float a = li - b; \
      const float cm = wave_incl_scan_max(a, lane); \
      const float M = fmaxf(m, cm); \
      const float M63 = __shfl(M, 63), bl = __shfl(b, 63); \
      const float skj = __expf(a - M63); \
      if (w == 0) { gt_[lane] = a; gt_[64 + lane] = b; gt_[128 + lane] = M; gt_[192 + lane] = __expf(m - M); if (lane == 0) gt_[256] = __expf(m - M63); } \
      m = bl + M63; \
      float q[16], k[16], v[16]; \
      _Pragma("unroll") for (int e = 0; e < 4; ++e) { q[4 * e] = nq[e].x; q[4 * e + 1] = nq[e].y; q[4 * e + 2] = nq[e].z; q[4 * e + 3] = nq[e].w; \
        k[4 * e] = nk[e].x * 0.125f; k[4 * e + 1] = nk[e].y * 0.125f; k[4 * e + 2] = nk[e].z * 0.125f; k[4 * e + 3] = nk[e].w * 0.125f; \
        v[4 * e] = nv[e].x; v[4 * e + 1] = nv[e].y; v[4 * e + 2] = nv[e].z; v[4 * e + 3] = nv[e].w; } \
      store_row16(sQ + row * LDB + seg, q); \
      store_row16(sK + row * LDB + seg, k); \
      _Pragma("unroll") for (int e = 0; e < 16; ++e) { sKt[(seg + e) * LDB + row] = f2bf(k[e] * skj); sVt[(seg + e) * LDB + row] = f2bf(v[e]); } }
    ML_PREFETCH(0)
    ML_STAGE(0)
    if (nch > 1) ML_PREFETCH(1)
    __syncthreads();
    for (int c = 0; c < nch; ++c) {
      if (c + 1 < nch) { ML_STAGE(c + 1) if (c + 2 < nch) ML_PREFETCH(c + 2) }
      __syncthreads(); __syncthreads(); __syncthreads();
    }
#undef ML_PREFETCH
#undef ML_STAGE
  } else {
    const int lane = tid & 63, w = tid >> 6, wr = w >> 1, wc = w & 1;
    f32x16 st = zero16();
    {
      const float* c0 = P.st_C + (size_t)sidx * 4096;
#pragma unroll
      for (int idx = 0; idx < 16; ++idx) st[idx] = c0[ACC_COL * 64 + ACC_ROW(idx)];
    }
#pragma unroll
    for (int idx = 0; idx < 16; ++idx) sCt[ACC_ROW(idx) * LDB + ACC_COL] = f2bf(st[idx]);
    if (tid < 64) s_nn[tid] = P.st_n[sidx * 64 + tid];
    __syncthreads();
    for (int c = 0; c < nch; ++c) {
      const bf16_t* sQ = ML_SET(c & 1); const bf16_t* sK = sQ + 64 * LDB; const bf16_t* sKt = sK + 64 * LDB; const bf16_t* sVt = sKt + 64 * LDB;
      const float* gt = ML_GATE(c & 1);
      const float* s_a = gt; const float* s_b = gt + 64; const float* s_M = gt + 128; const float* s_ew = gt + 192;
      const float sp = gt[256];
      const float* s_n = s_nn + (c & 1) * 64; float* s_n2 = s_nn + ((c & 1) ^ 1) * 64;
      f32x16 s = mm64(sQ, sK, wr, wc, lane, zero16());
#pragma unroll
      for (int idx = 0; idx < 16; ++idx) {
        const int i = ACC_ROW(idx), j = ACC_COL;
        const float val = (i >= j) ? s[idx] * __expf(s_a[j] - s_M[i]) : 0.f;
        sP[i * LDB + j] = f2bf(val);
      }
      __syncthreads();
      f32x16 o1 = mm64(sP, sVt, wr, wc, lane, zero16());
      f32x16 o2 = mm64(sQ, sCt, wr, wc, lane, zero16());
      {
        const int r4 = tid >> 2, sg4 = (tid & 3) * 16;
        float rs = 0.f, qn = 0.f;
#pragma unroll
        for (int e = 0; e < 16; ++e) { rs += bf2f(sP[r4 * LDB + sg4 + e]); qn += bf2f(sQ[r4 * LDB + sg4 + e]) * s_n[sg4 + e]; }
        rs = red4(rs); qn = red4(qn);
        const float den = rs + qn * s_ew[r4];
        const float mt = s_b[r4] + s_M[r4];
        if ((tid & 3) == 0) s_dinv[r4] = 1.f / fmaxf(fabsf(den), __expf(-mt));
      }
#pragma unroll
      for (int idx = 0; idx < 16; ++idx) st[idx] *= sp;
      st = mm64(sVt, sKt, wr, wc, lane, st);
      if (tid < 64) {
        float a = s_n[tid] * sp;
        for (int j = 0; j < 64; ++j) a += bf2f(sKt[tid * LDB + j]);
        s_n2[tid] = a;
      }
      __syncthreads();
#pragma unroll
      for (int idx = 0; idx < 16; ++idx) {
        const int i = ACC_ROW(idx), e = ACC_COL;
        const int pp = c * 64 + i; const int tt = z ? (T - 1 - pp) : pp;
        P.hdir[((size_t)z * NTOK + gs + tt) * DM + h * 64 + e] = f2bf((o1[idx] + s_ew[i] * o2[idx]) * s_dinv[i]);
      }
#pragma unroll
      for (int idx = 0; idx < 16; ++idx) sCt[ACC_ROW(idx) * LDB + ACC_COL] = f2bf(st[idx]);
      __syncthreads();
    }
  }
#undef ML_SET
#undef ML_GATE
}

DEV void delta_T_item(const Params& P, int l, int item, char* smem, const int tid_in) {
  const int tid = opaque_i(tid_in);
  const int lane = tid & 63, w = tid >> 6, wr = w >> 1, wc = w & 1;
  const int tile = item & 127, zh = item >> 7, z = zh >> 2, h = zh & 3;
  int gs, T, ci; tok_info(tile * 64, gs, T, ci);
  float* sA = (float*)smem;
  float* s_beta = sA + 2016; float* s_gc = s_beta + 64;
  bf16_t* sK = (bf16_t*)(smem + 8576); bf16_t* sT = sK + 64 * LDB;
  const float aneg = -__expf(P.delta_a_log[(l * 2 + z) * 4 + h]), dtb = P.delta_dt_bias[(l * 2 + z) * 4 + h];
  {
    const int row = tid >> 2, seg = (tid & 3) * 16;
    const int g = tile * 64 + (z ? 63 - row : row);
    const bf16_t* src = P.ubuf + (size_t)g * 768 + 256 + h * 64 + seg;
    *(uint4*)(sK + row * LDB + seg) = *(const uint4*)src; *(uint4*)(sK + row * LDB + seg + 8) = *(const uint4*)(src + 8);
  }
  if (w == 0) {
    const int g = tile * 64 + (z ? 63 - lane : lane);
    const float* gp = P.projABC + (size_t)g * NABC + 2064 + z * 4 + h;
    const float beta = sigmoidf_(gp[0]);
    const float gj = aneg * softplusf_(gp[8] + dtb);
    const float gc = wave_incl_scan_add(gj, lane);
    s_beta[lane] = beta; s_gc[lane] = gc;
    P.dbeta[(size_t)zh * NTOK + g] = beta; P.dgc[(size_t)zh * NTOK + g] = gc;
  }
  __syncthreads();
  {
    f32x16 kkm = mm64(sK, sK, wr, wc, lane, zero16());
#pragma unroll
    for (int idx = 0; idx < 16; ++idx) {
      const int i = ACC_ROW(idx), j = ACC_COL;
      const float av = kkm[idx] * __expf(s_gc[i] - s_gc[j]) * s_beta[i];
      if (i > j) sA[i * (i - 1) / 2 + j] = av;
      if (w == 2) sT[i * LDB + j] = f2bf(av);
    }
  }
  __syncthreads();
  if (w < 2 && lane < 32) {
    const int o = w * 32;
    float x[32];
    const float flane = (float)lane;
#pragma unroll
    for (int i = 0; i < 32; ++i) {
      float a = fmaxf(0.f, 1.f - fabsf(flane - (float)i));
      const float* arow = sA + (o + i) * (o + i - 1) / 2 + o;
#pragma unroll
      for (int j = 0; j < i; ++j) a -= arow[j] * x[j];
      x[i] = a;
      sT[(o + i) * LDB + o + lane] = f2bf(a);
      if (w == 0) sT[lane * LDB + 32 + i] = f2bf(a);
    }
  }
  __syncthreads();
  if (w == 0) {
    const bf16_t* aA = sT + (32 + (lane & 31)) * LDB + (lane >> 5) * 8;
    const bf16_t* bT = sT + (lane & 31) * LDB + 32 + (lane >> 5) * 8;
    f32x16 m1 = zero16();
#pragma unroll
    for (int s2 = 0; s2 < 2; ++s2) m1 = __builtin_amdgcn_mfma_f32_32x32x16_bf16(*(const bf16x8*)(aA + s2 * 16), *(const bf16x8*)(bT + s2 * 16), m1, 0, 0, 0);
#pragma unroll
    for (int g4 = 0; g4 < 4; ++g4) {
      uint2 o2; o2.x = pack2(m1[4 * g4], m1[4 * g4 + 1]); o2.y = pack2(m1[4 * g4 + 2], m1[4 * g4 + 3]);
      *(uint2*)(sT + (lane & 31) * LDB + 32 + 8 * g4 + 4 * (lane >> 5)) = o2;
    }
    const bf16_t* a2 = sT + (32 + (lane & 31)) * LDB + 32 + (lane >> 5) * 8;
    f32x16 m2 = zero16();
#pragma unroll
    for (int s2 = 0; s2 < 2; ++s2) m2 = __builtin_amdgcn_mfma_f32_32x32x16_bf16(*(const bf16x8*)(a2 + s2 * 16), *(const bf16x8*)(bT + s2 * 16), m2, 0, 0, 0);
#pragma unroll
    for (int idx = 0; idx < 16; ++idx) sT[(32 + (idx & 3) + 8 * (idx >> 2) + 4 * (lane >> 5)) * LDB + (lane & 31)] = f2bf(-m2[idx]);
    *(uint4*)(sT + (lane & 31) * LDB + 32 + (lane >> 5) * 16) = make_uint4(0u, 0u, 0u, 0u);
    *(uint4*)(sT + (lane & 31) * LDB + 32 + (lane >> 5) * 16 + 8) = make_uint4(0u, 0u, 0u, 0u);
  }
  __syncthreads();
  {
    const int row = tid >> 2, seg = (tid & 3) * 16;
    bf16_t* dst = P.dT + ((size_t)item * 64 + row) * 64 + seg;
    *(uint4*)dst = *(const uint4*)(sT + row * LDB + seg); *(uint4*)(dst + 8) = *(const uint4*)(sT + row * LDB + seg + 8);
  }
  __syncthreads();
}

DEV void delta_task(const Params& P, int l, int task, const int z, char* smem, const int tid_in, const bool active) {
  const int tid = opaque_i(tid_in);
  const int lane = tid & 63, w = tid >> 6, wr = w >> 1, wc = w & 1;
  int seq, h; bool sample; decode_chain(task, seq, h, sample);
  int gs, T; seq_base(seq, gs, T);
  if (!active) { for (int c = 0; c < T / 64; ++c) { __syncthreads(); __syncthreads(); __syncthreads(); __syncthreads(); __syncthreads(); __syncthreads(); } return; }
  float* s_beta = (float*)smem; float* s_gc = s_beta + 64;
  bf16_t* sQ = (bf16_t*)(smem + 512); bf16_t* sK = sQ + 64 * LDB; bf16_t* sKbt = sK + 64 * LDB; bf16_t* sKgt = sKbt + 64 * LDB; bf16_t* sVbt = sKgt + 64 * LDB; bf16_t* sT = sVbt + 64 * LDB; bf16_t* sSt = sT + 64 * LDB;
  bf16_t* sW = sKbt; bf16_t* sVnt = sVbt; bf16_t* sP = sT;
  f32x16 st = zero16();
  if (sample) {
    const float* s0 = P.st_delta + ((size_t)(((seq - 16) * 2 + l) * 2 + z) * 4 + h) * 4096;
#pragma unroll
    for (int idx = 0; idx < 16; ++idx) st[idx] = s0[ACC_COL * 64 + ACC_ROW(idx)];
  }
#pragma unroll
  for (int idx = 0; idx < 16; ++idx) sSt[ACC_ROW(idx) * LDB + ACC_COL] = f2bf(st[idx]);
  const int nch = T / 64;
  const int tid_outer = tid;
  const int zh = z * 4 + h;
  uint4 nq0, nq1, nk0, nk1, nv0, nv1, nt0, nt1; float nbeta, ngc, nglast;
#define DELTA_PREFETCH(C) { \
    const int r_ = tid_outer & 63, sg_ = (tid_outer >> 6) * 16; \
    const int p_ = (C) * 64 + r_; const int g_ = gs + (z ? (T - 1 - p_) : p_); \
    const bf16_t* src_ = P.ubuf + (size_t)g_ * 768 + h * 64 + sg_; \
    nq0 = *(const uint4*)src_; nq1 = *(const uint4*)(src_ + 8); nk0 = *(const uint4*)(src_ + 256); nk1 = *(const uint4*)(src_ + 264); nv0 = *(const uint4*)(src_ + 512); nv1 = *(const uint4*)(src_ + 520); \
    const int tile_ = (gs >> 6) + (z ? (nch - 1 - (C)) : (C)); \
    const bf16_t* tsrc_ = P.dT + (((size_t)zh * 128 + tile_) * 64 + r_) * 64 + sg_; \
    nt0 = *(const uint4*)tsrc_; nt1 = *(const uint4*)(tsrc_ + 8); \
    nbeta = P.dbeta[(size_t)zh * NTOK + g_]; ngc = P.dgc[(size_t)zh * NTOK + g_]; \
    const int pl_ = (C) * 64 + 63; nglast = P.dgc[(size_t)zh * NTOK + gs + (z ? (T - 1 - pl_) : pl_)]; }
  DELTA_PREFETCH(0)
  for (int c = 0; c < nch; ++c) {
    const int tid = opaque_i(tid_outer);
    const int lane = tid & 63, w = tid >> 6, wr = w >> 1, wc = w & 1;
    const int row = tid & 63, seg = (tid >> 6) * 16;
    {
      const uint4 cq0 = nq0, cq1 = nq1, ck0 = nk0, ck1 = nk1, cv0 = nv0, cv1 = nv1, ct0 = nt0, ct1 = nt1;
      const float bj = nbeta, gcj = ngc, glast = nglast;
      float k[16], v[16];
      { const unsigned kw[8] = {ck0.x, ck0.y, ck0.z, ck0.w, ck1.x, ck1.y, ck1.z, ck1.w}, vw[8] = {cv0.x, cv0.y, cv0.z, cv0.w, cv1.x, cv1.y, cv1.z, cv1.w};
#pragma unroll
        for (int e = 0; e < 8; ++e) { k[2 * e] = __uint_as_float(kw[e] << 16); k[2 * e + 1] = __uint_as_float(kw[e] & 0xffff0000u); v[2 * e] = __uint_as_float(vw[e] << 16); v[2 * e + 1] = __uint_as_float(vw[e] & 0xffff0000u); } }
      if (w == 0) { s_beta[row] = bj; s_gc[row] = gcj; }
      const float f1 = bj * __expf(gcj), f2 = __expf(glast - gcj);
      *(uint4*)(sQ + row * LDB + seg) = cq0; *(uint4*)(sQ + row * LDB + seg + 8) = cq1;
      *(uint4*)(sK + row * LDB + seg) = ck0; *(uint4*)(sK + row * LDB + seg + 8) = ck1;
      *(uint4*)(sT + row * LDB + seg) = ct0; *(uint4*)(sT + row * LDB + seg + 8) = ct1;
#pragma unroll
      for (int e = 0; e < 16; ++e) {
        sKbt[(seg + e) * LDB + row] = f2bf(k[e] * f1);
        sKgt[(seg + e) * LDB + row] = f2bf(k[e] * f2);
        sVbt[(seg + e) * LDB + row] = f2bf(v[e] * bj);
      }
    }
    __syncthreads();
    if (c + 1 < nch) DELTA_PREFETCH(c + 1)
    f32x16 U = mm64(sT, sVbt, wr, wc, lane, zero16());
    f32x16 Wm = mm64(sT, sKbt, wr, wc, lane, zero16());
    f32x16 qk = mm64(sQ, sK, wr, wc, lane, zero16());
    __syncthreads();
#pragma unroll
    for (int idx = 0; idx < 16; ++idx) {
      const int i = ACC_ROW(idx), j = ACC_COL;
      sW[i * LDB + j] = f2bf(Wm[idx]);
      sP[i * LDB + j] = f2bf((i >= j) ? qk[idx] * __expf(s_gc[i] - s_gc[j]) : 0.f);
    }
    __syncthreads();
    {
      f32x16 ws = mm64(sW, sSt, wr, wc, lane, zero16());
#pragma unroll
      for (int g4 = 0; g4 < 4; ++g4) {
        const int e = ACC_COL, i0 = wr * 32 + 8 * g4 + 4 * (lane >> 5);
        uint2 o; o.x = pack2(U[4 * g4] - ws[4 * g4], U[4 * g4 + 1] - ws[4 * g4 + 1]); o.y = pack2(U[4 * g4 + 2] - ws[4 * g4 + 2], U[4 * g4 + 3] - ws[4 * g4 + 3]);
        *(uint2*)(sVnt + e * LDB + i0) = o;
      }
    }
    __syncthreads();
    f32x16 o1 = mm64(sP, sVnt, wr, wc, lane, zero16());
    f32x16 o2 = mm64(sQ, sSt, wr, wc, lane, zero16());
#pragma unroll
    for (int idx = 0; idx < 16; ++idx) {
      const int i = ACC_ROW(idx), e = ACC_COL;
      const int pp = c * 64 + i; const int tt = z ? (T - 1 - pp) : pp;
      P.hdir[((size_t)z * NTOK + gs + tt) * DM + 256 + h * 64 + e] = f2bf(o1[idx] + __expf(s_gc[i]) * o2[idx]);
    }
    const float egl = __expf(s_gc[63]);
#pragma unroll
    for (int idx = 0; idx < 16; ++idx) st[idx] *= egl;
    st = mm64(sVnt, sKgt, wr, wc, lane, st);
    __syncthreads();
#pragma unroll
    for (int idx = 0; idx < 16; ++idx) sSt[ACC_ROW(idx) * LDB + ACC_COL] = f2bf(st[idx]);
    __syncthreads();
  }
  if (!sample) {
    float* o = P.out + O_DELTA + ((size_t)((seq * 2 + l) * 2 + z) * 4 + h) * 4096;
#pragma unroll
    for (int idx = 0; idx < 16; ++idx) o[ACC_COL * 64 + ACC_ROW(idx)] = st[idx];
  }
}

DEV void delta_sample_task(const Params& P, int l, int task, const int z, char* smem0, const int tid_all_in) {
  const int tid_all = opaque_i(tid_all_in);
  const int half = tid_all >> 8, tid = tid_all & 255;
  int seq, h; bool sample; decode_chain(task, seq, h, sample);
  int gs, T; seq_base(seq, gs, T);
  const int nch = T / 64;
  const int zh = z * 4 + h;
#define DL_GATE(B) ((float*)(smem0 + (B) * HALF_LDS))
#define DL_SET(B) ((bf16_t*)(smem0 + (B) * HALF_LDS + 512))
  bf16_t* sSt = DL_SET(0) + 6 * 64 * LDB;
  if (half == 1) {
    uint4 nq0, nq1, nk0, nk1, nv0, nv1, nt0, nt1; float nbeta, ngc, nglast;
#define DL_PREFETCH(C) { \
      const int r_ = tid & 63, sg_ = (tid >> 6) * 16; \
      const int p_ = (C) * 64 + r_; const int g_ = gs + (z ? (T - 1 - p_) : p_); \
      const bf16_t* src_ = P.ubuf + (size_t)g_ * 768 + h * 64 + sg_; \
      nq0 = *(const uint4*)src_; nq1 = *(const uint4*)(src_ + 8); nk0 = *(const uint4*)(src_ + 256); nk1 = *(const uint4*)(src_ + 264); nv0 = *(const uint4*)(src_ + 512); nv1 = *(const uint4*)(src_ + 520); \
      const int tile_ = (gs >> 6) + (z ? (nch - 1 - (C)) : (C)); \
      const bf16_t* tsrc_ = P.dT + (((size_t)zh * 128 + tile_) * 64 + r_) * 64 + sg_; \
      nt0 = *(const uint4*)tsrc_; nt1 = *(const uint4*)(tsrc_ + 8); \
      nbeta = P.dbeta[(size_t)zh * NTOK + g_]; ngc = P.dgc[(size_t)zh * NTOK + g_]; \
      const int pl_ = (C) * 64 + 63; nglast = P.dgc[(size_t)zh * NTOK + gs + (z ? (T - 1 - pl_) : pl_)]; }
#define DL_STAGE(C) { \
      float* s_beta = DL_GATE((C) & 1); float* s_gc = s_beta + 64; \
      bf16_t* sQ = DL_SET((C) & 1); bf16_t* sK = sQ + 64 * LDB; bf16_t* sKbt = sK + 64 * LDB; bf16_t* sKgt = sKbt + 64 * LDB; bf16_t* sVbt = sKgt + 64 * LDB; bf16_t* sT = sVbt + 64 * LDB; \
      const int row = tid & 63, seg = (tid >> 6) * 16, w = tid >> 6; \
      const float bj = nbeta, gcj = ngc, glast = nglast; \
      float k[16], v[16]; \
      { const unsigned kw[8] = {nk0.x, nk0.y, nk0.z, nk0.w, nk1.x, nk1.y, nk1.z, nk1.w}, vw[8] = {nv0.x, nv0.y, nv0.z, nv0.w, nv1.x, nv1.y, nv1.z, nv1.w}; \
        _Pragma("unroll") for (int e = 0; e < 8; ++e) { k[2 * e] = __uint_as_float(kw[e] << 16); k[2 * e + 1] = __uint_as_float(kw[e] & 0xffff0000u); v[2 * e] = __uint_as_float(vw[e] << 16); v[2 * e + 1] = __uint_as_float(vw[e] & 0xffff0000u); } } \
      if (w == 0) { s_beta[row] = bj; s_gc[row] = gcj; } \
      const float f1 = bj * __expf(gcj), f2 = __expf(glast - gcj); \
      *(uint4*)(sQ + row * LDB + seg) = nq0; *(uint4*)(sQ + row * LDB + seg + 8) = nq1; \
      *(uint4*)(sK + row * LDB + seg) = nk0; *(uint4*)(sK + row * LDB + seg + 8) = nk1; \
      *(uint4*)(sT + row * LDB + seg) = nt0; *(uint4*)(sT + row * LDB + seg + 8) = nt1; \
      _Pragma("unroll") for (int e = 0; e < 16; ++e) { \
        sKbt[(seg + e) * LDB + row] = f2bf(k[e] * f1); \
        sKgt[(seg + e) * LDB + row] = f2bf(k[e] * f2); \
        sVbt[(seg + e) * LDB + row] = f2bf(v[e] * bj); } }
    DL_PREFETCH(0)
    DL_STAGE(0)
    if (nch > 1) DL_PREFETCH(1)
    __syncthreads();
    for (int c = 0; c < nch; ++c) {
      if (c + 1 < nch) { DL_STAGE(c + 1) if (c + 2 < nch) DL_PREFETCH(c + 2) }
      __syncthreads(); __syncthreads(); __syncthreads(); __syncthreads(); __syncthreads();
    }
#undef DL_PREFETCH
#undef DL_STAGE
  } else {
    const int lane = tid & 63, w = tid >> 6, wr = w >> 1, wc = w & 1;
    f32x16 st = zero16();
    {
      const float* s0 = P.st_delta + ((size_t)(((seq - 16) * 2 + l) * 2 + z) * 4 + h) * 4096;
#pragma unroll
      for (int idx = 0; idx < 16; ++idx) st[idx] = s0[ACC_COL * 64 + ACC_ROW(idx)];
    }
#pragma unroll
    for (int idx = 0; idx < 16; ++idx) sSt[ACC_ROW(idx) * LDB + ACC_COL] = f2bf(st[idx]);
    __syncthreads();
    for (int c = 0; c < nch; ++c) {
      const float* s_gc = DL_GATE(c & 1) + 64;
      bf16_t* sQ = DL_SET(c & 1); bf16_t* sK = sQ + 64 * LDB; bf16_t* sKbt = sK + 64 * LDB; bf16_t* sKgt = sKbt + 64 * LDB; bf16_t* sVbt = sKgt + 64 * LDB; bf16_t* sT = sVbt + 64 * LDB;
      bf16_t* sW = sKbt; bf16_t* sVnt = sVbt; bf16_t* sP = sT;
      f32x16 U = mm64(sT, sVbt, wr, wc, lane, zero16());
      f32x16 Wm = mm64(sT, sKbt, wr, wc, lane, zero16());
      f32x16 qk = mm64(sQ, sK, wr, wc, lane, zero16());
      __syncthreads();
#pragma unroll
      for (int idx = 0; idx < 16; ++idx) {
        const int i = ACC_ROW(idx), j = ACC_COL;
        sW[i * LDB + j] = f2bf(Wm[idx]);
        sP[i * LDB + j] = f2bf((i >= j) ? qk[idx] * __expf(s_gc[i] - s_gc[j]) : 0.f);
      }
      __syncthreads();
      {
        f32x16 ws = mm64(sW, sSt, wr, wc, lane, zero16());
#pragma unroll
        for (int g4 = 0; g4 < 4; ++g4) {
          const int e = ACC_COL, i0 = wr * 32 + 8 * g4 + 4 * (lane >> 5);
          uint2 o; o.x = pack2(U[4 * g4] - ws[4 * g4], U[4 * g4 + 1] - ws[4 * g4 + 1]); o.y = pack2(U[4 * g4 + 2] - ws[4 * g4 + 2], U[4 * g4 + 3] - ws[4 * g4 + 3]);
          *(uint2*)(sVnt + e * LDB + i0) = o;
        }
      }
      __syncthreads();
      f32x16 o1 = mm64(sP, sVnt, wr, wc, lane, zero16());
      f32x16 o2 = mm64(sQ, sSt, wr, wc, lane, zero16());
#pragma unroll
      for (int idx = 0; idx < 16; ++idx) {
        const int i = ACC_ROW(idx), e = ACC_COL;
        const int pp = c * 64 + i; const int tt = z ? (T - 1 - pp) : pp;
        P.hdir[((size_t)z * NTOK + gs + tt) * DM + 256 + h * 64 + e] = f2bf(o1[idx] + __expf(s_gc[i]) * o2[idx]);
      }
      const float egl = __expf(s_gc[63]);
#pragma unroll
      for (int idx = 0; idx < 16; ++idx) st[idx] *= egl;
      st = mm64(sVnt, sKgt, wr, wc, lane, st);
      __syncthreads();
#pragma unroll
      for (int idx = 0; idx < 16; ++idx) sSt[ACC_ROW(idx) * LDB + ACC_COL] = f2bf(st[idx]);
      __syncthreads();
    }
  }
#undef DL_GATE
#undef DL_SET
}

template <int RWAVES>
DEV void rwkv_task(const Params& P, int l, int task, const int z, char* smem, const int tid_in, const bool active) {
  const int tid = opaque_i(tid_in);
  constexpr int NR = 4 * RWAVES, NRB = 64 / NR;
  const int chain = task / NRB, rb = task % NRB;
  int seq, h; bool sample; decode_chain(chain, seq, h, sample);
  int gs, T; seq_base(seq, gs, T);
  if (!active) { for (int c = 0; c < T / 32; ++c) { __syncthreads(); __syncthreads(); } return; }
  float* s_kh = (float*)smem; float* s_w = s_kh + 2048; float* s_b = s_w + 2048; float* s_kt = s_b + 2048; float* s_r = s_kt + 2048; float* s_v = s_r + 2048; float* s_yp = s_v + 512;
  const int rl = tid >> 4, cg4 = (tid & 15) * 4;
  const int irow = rb * NR + (rl & (NR - 1));
  const bool rowthread = tid < 64 * RWAVES;
  float S0 = 0.f, S1 = 0.f, S2 = 0.f, S3 = 0.f;
  if (sample) {
    const float4 s4 = *(const float4*)(P.st_rwkv + ((size_t)(((seq - 16) * 2 + l) * 2 + z) * 4 + h) * 4096 + irow * 64 + cg4);
    S0 = s4.x; S1 = s4.y; S2 = s4.z; S3 = s4.w;
  }
  const int si = tid >> 3, sc = (tid & 7) * 8;
  float kkc[8], kac[8], rkc[8];
#pragma unroll
  for (int e = 0; e < 8; ++e) { kkc[e] = P.rwkv_kk[l * 256 + h * 64 + sc + e]; kac[e] = P.rwkv_ka[l * 256 + h * 64 + sc + e]; rkc[e] = P.rwkv_rk[(l * 4 + h) * 64 + sc + e]; }
  const int nch = T / 32;
  float4 pr0, pr1, pk0, pk1, pw0, pw1, pa0, pa1, pv_ = make_float4(0.f, 0.f, 0.f, 0.f); float pinv;
#define RWKV_PREFETCH(C) { \
    const int p_ = (C) * 32 + si; const int t_ = z ? (T - 1 - p_) : p_; const int g_ = gs + t_; \
    const float* rk_ = P.rkv + (size_t)g_ * 768 + h * 64 + sc; \
    pr0 = *(const float4*)rk_; pr1 = *(const float4*)(rk_ + 4); \
    pk0 = *(const float4*)(rk_ + 256); pk1 = *(const float4*)(rk_ + 260); \
    const float* wp_ = P.wa + ((size_t)(g_ * 2 + z) * 2) * 256 + h * 64 + sc; \
    pw0 = *(const float4*)wp_; pw1 = *(const float4*)(wp_ + 4); \
    pa0 = *(const float4*)(wp_ + 256); pa1 = *(const float4*)(wp_ + 260); \
    pinv = P.khinv[g_ * 4 + h]; \
    if (tid < 8 * NR) { \
      const int p2_ = (C) * 32 + (tid / (NR / 4)); const int t2_ = z ? (T - 1 - p2_) : p2_; \
      pv_ = *(const float4*)(P.rkv + (size_t)(gs + t2_) * 768 + 512 + h * 64 + rb * NR + (tid % (NR / 4)) * 4); \
    } }
  RWKV_PREFETCH(0)
  for (int c = 0; c < nch; ++c) {
    {
      const float rr[8] = {pr0.x, pr0.y, pr0.z, pr0.w, pr1.x, pr1.y, pr1.z, pr1.w};
      const float kk[8] = {pk0.x, pk0.y, pk0.z, pk0.w, pk1.x, pk1.y, pk1.z, pk1.w};
      const float aa[8] = {pa0.x, pa0.y, pa0.z, pa0.w, pa1.x, pa1.y, pa1.z, pa1.w};
      float bsum = 0.f;
      float okh[8], ob[8], okt[8];
#pragma unroll
      for (int e = 0; e < 8; ++e) {
        okh[e] = kk[e] * kkc[e] * pinv; ob[e] = aa[e] * okh[e]; okt[e] = kk[e] * (1.f + (aa[e] - 1.f) * kac[e]);
        bsum += rr[e] * okt[e] * rkc[e];
      }
      float* d;
      d = s_kh + si * 64 + sc; *(float4*)d = make_float4(okh[0], okh[1], okh[2], okh[3]); *(float4*)(d + 4) = make_float4(okh[4], okh[5], okh[6], okh[7]);
      d = s_w + si * 64 + sc; *(float4*)d = pw0; *(float4*)(d + 4) = pw1;
      d = s_b + si * 64 + sc; *(float4*)d = make_float4(ob[0], ob[1], ob[2], ob[3]); *(float4*)(d + 4) = make_float4(ob[4], ob[5], ob[6], ob[7]);
      d = s_kt + si * 64 + sc; *(float4*)d = make_float4(okt[0], okt[1], okt[2], okt[3]); *(float4*)(d + 4) = make_float4(okt[4], okt[5], okt[6], okt[7]);
      d = s_r + si * 64 + sc; *(float4*)d = pr0; *(float4*)(d + 4) = pr1;
      if (tid < 8 * NR) *(float4*)(s_v + (tid / (NR / 4)) * NR + (tid % (NR / 4)) * 4) = pv_;
      bsum += dppf<0xB1>(bsum); bsum += dppf<0x4E>(bsum); bsum += dppf<0x141>(bsum);
      if (rb == 0 && (tid & 7) == 0) {
        const int p = c * 32 + si; const int t = z ? (T - 1 - p) : p;
        P.bonus[((size_t)z * NTOK + gs + t) * 4 + h] = bsum;
      }
    }
    __syncthreads();
    if (c + 1 < nch) RWKV_PREFETCH(c + 1)
    if (rowthread) {
      typedef float v2f __attribute__((ext_vector_type(2)));
      typedef float v4f __attribute__((ext_vector_type(4)));
      v2f Sa = {S0, S1}, Sb = {S2, S3};
      v4f kh = *(const v4f*)(s_kh + cg4), ww = *(const v4f*)(s_w + cg4), bb = *(const v4f*)(s_b + cg4), kt = *(const v4f*)(s_kt + cg4), rr = *(const v4f*)(s_r + cg4);
      float vi = s_v[rl];
#pragma unroll 8
      for (int i = 0; i < 32; ++i) {
        const int in = (i + 1) & 31;
        const v4f kh_n = *(const v4f*)(s_kh + in * 64 + cg4);
        const v4f ww_n = *(const v4f*)(s_w + in * 64 + cg4);
        const v4f bb_n = *(const v4f*)(s_b + in * 64 + cg4);
        const v4f kt_n = *(const v4f*)(s_kt + in * 64 + cg4);
        const v4f rr_n = *(const v4f*)(s_r + in * 64 + cg4);
        const float vi_n = s_v[in * NR + rl];
        const v2f v2 = {vi, vi};
        const v2f pp = __builtin_elementwise_fma(Sb, kh.zw, Sa * kh.xy);
        const float sk = red16(pp.x + pp.y);
        const v2f sk2 = {sk, sk};
        Sa = __builtin_elementwise_fma(-sk2, bb.xy, __builtin_elementwise_fma(v2, kt.xy, Sa * ww.xy));
        Sb = __builtin_elementwise_fma(-sk2, bb.zw, __builtin_elementwise_fma(v2, kt.zw, Sb * ww.zw));
        const v2f qq = __builtin_elementwise_fma(Sb, rr.zw, Sa * rr.xy);
        s_yp[i * (64 * RWAVES) + tid] = qq.x + qq.y;
        kh = kh_n; ww = ww_n; bb = bb_n; kt = kt_n; rr = rr_n; vi = vi_n;
      }
      S0 = Sa.x; S1 = Sa.y; S2 = Sb.x; S3 = Sb.y;
    }
    __syncthreads();
    {
      const int i = tid >> 3, q2 = tid & 7;
      const int p = c * 32 + i; const int t = z ? (T - 1 - p) : p;
      if (NR == 16) {
        const float* y0 = s_yp + i * 256 + (2 * q2) * 16;
        float a0 = 0.f, a1 = 0.f;
#pragma unroll
        for (int e = 0; e < 16; e += 4) { const float4 u0 = *(const float4*)(y0 + e), u1 = *(const float4*)(y0 + 16 + e); a0 += (u0.x + u0.y) + (u0.z + u0.w); a1 += (u1.x + u1.y) + (u1.z + u1.w); }
        *(unsigned*)(P.hdir + ((size_t)z * NTOK + gs + t) * DM + 768 + h * 64 + rb * 16 + 2 * q2) = pack2(a0, a1);
      } else {
        const float* y0 = s_yp + i * (64 * RWAVES) + q2 * 16;
        float a0 = 0.f;
#pragma unroll
        for (int e = 0; e < 16; e += 4) { const float4 u0 = *(const float4*)(y0 + e); a0 += (u0.x + u0.y) + (u0.z + u0.w); }
        P.hdir[((size_t)z * NTOK + gs + t) * DM + 768 + h * 64 + rb * NR + q2] = f2bf(a0);
      }
    }
  }
  if (!sample && rowthread) {
    *(float4*)(P.out + O_RWKV + ((size_t)((seq * 2 + l) * 2 + z) * 4 + h) * 4096 + irow * 64 + cg4) = make_float4(S0, S1, S2, S3);
  }
}

DEV void rwkv_prompt_task(const Params& P, int l, int task, const int z, char* smem, const int tid_in) {
  const int tid = opaque_i(tid_in);
  const int chain = task >> 1, rb = task & 1;
  int seq, h; bool sample; decode_chain(chain, seq, h, sample);
  int gs, T; seq_base(seq, gs, T);
  float* s_kh = (float*)smem; float* s_w = s_kh + 2048; float* s_b = s_w + 2048; float* s_kt = s_b + 2048; float* s_r = s_kt + 2048; float* s_v = s_r + 2048; float* s_yp = s_v + 1024;
  const int rp = tid >> 4, cg4 = (tid & 15) * 4;
  const int irow = rb * 32 + 2 * rp;
  typedef float v2f __attribute__((ext_vector_type(2)));
  typedef float v4f __attribute__((ext_vector_type(4)));
  v2f Aa = {0.f, 0.f}, Ab = {0.f, 0.f}, Ba = {0.f, 0.f}, Bb = {0.f, 0.f};
  if (sample) {
    const float* sp0 = P.st_rwkv + ((size_t)(((seq - 16) * 2 + l) * 2 + z) * 4 + h) * 4096 + irow * 64 + cg4;
    const float4 a4 = *(const float4*)sp0, b4 = *(const float4*)(sp0 + 64);
    Aa.x = a4.x; Aa.y = a4.y; Ab.x = a4.z; Ab.y = a4.w; Ba.x = b4.x; Ba.y = b4.y; Bb.x = b4.z; Bb.y = b4.w;
  }
  const int si = tid >> 3, sc = (tid & 7) * 8;
  float kkc[8], kac[8], rkc[8];
#pragma unroll
  for (int e = 0; e < 8; ++e) { kkc[e] = P.rwkv_kk[l * 256 + h * 64 + sc + e]; kac[e] = P.rwkv_ka[l * 256 + h * 64 + sc + e]; rkc[e] = P.rwkv_rk[(l * 4 + h) * 64 + sc + e]; }
  const int nch = T / 32;
  float4 pr0, pr1, pk0, pk1, pw0, pw1, pa0, pa1, pv_; float pinv;
#define RP_PREFETCH(C) { \
    const int p_ = (C) * 32 + si; const int t_ = z ? (T - 1 - p_) : p_; const int g_ = gs + t_; \
    const float* rk_ = P.rkv + (size_t)g_ * 768 + h * 64 + sc; \
    pr0 = *(const float4*)rk_; pr1 = *(const float4*)(rk_ + 4); \
    pk0 = *(const float4*)(rk_ + 256); pk1 = *(const float4*)(rk_ + 260); \
    const float* wp_ = P.wa + ((size_t)(g_ * 2 + z) * 2) * 256 + h * 64 + sc; \
    pw0 = *(const float4*)wp_; pw1 = *(const float4*)(wp_ + 4); \
    pa0 = *(const float4*)(wp_ + 256); pa1 = *(const float4*)(wp_ + 260); \
    pinv = P.khinv[g_ * 4 + h]; \
    pv_ = *(const float4*)(P.rkv + (size_t)g_ * 768 + 512 + h * 64 + rb * 32 + (tid & 7) * 4); }
  RP_PREFETCH(0)
  for (int c = 0; c < nch; ++c) {
    {
      const float rr[8] = {pr0.x, pr0.y, pr0.z, pr0.w, pr1.x, pr1.y, pr1.z, pr1.w};
      const float kk[8] = {pk0.x, pk0.y, pk0.z, pk0.w, pk1.x, pk1.y, pk1.z, pk1.w};
      const float aa[8] = {pa0.x, pa0.y, pa0.z, pa0.w, pa1.x, pa1.y, pa1.z, pa1.w};
      float bsum = 0.f;
      float okh[8], ob[8], okt[8];
#pragma unroll
      for (int e = 0; e < 8; ++e) {
        okh[e] = kk[e] * kkc[e] * pinv; ob[e] = aa[e] * okh[e]; okt[e] = kk[e] * (1.f + (aa[e] - 1.f) * kac[e]);
        bsum += rr[e] * okt[e] * rkc[e];
      }
      float* d;
      d = s_kh + si * 64 + sc; *(float4*)d = make_float4(okh[0], okh[1], okh[2], okh[3]); *(float4*)(d + 4) = make_float4(okh[4], okh[5], okh[6], okh[7]);
      d = s_w + si * 64 + sc; *(float4*)d = pw0; *(float4*)(d + 4) = pw1;
      d = s_b + si * 64 + sc; *(float4*)d = make_float4(ob[0], ob[1], ob[2], ob[3]); *(float4*)(d + 4) = make_float4(ob[4], ob[5], ob[6], ob[7]);
      d = s_kt + si * 64 + sc; *(float4*)d = make_float4(okt[0], okt[1], okt[2], okt[3]); *(float4*)(d + 4) = make_float4(okt[4], okt[5], okt[6], okt[7]);
      d = s_r + si * 64 + sc; *(float4*)d = pr0; *(float4*)(d + 4) = pr1;
      *(float4*)(s_v + si * 32 + (tid & 7) * 4) = pv_;
      bsum += dppf<0xB1>(bsum); bsum += dppf<0x4E>(bsum); bsum += dppf<0x141>(bsum);
      if (rb == 0 && (tid & 7) == 0) {
        const int p = c * 32 + si; const int t = z ? (T - 1 - p) : p;
        P.bonus[((size_t)z * NTOK + gs + t) * 4 + h] = bsum;
      }
    }
    __syncthreads();
    if (c + 1 < nch) RP_PREFETCH(c + 1)
    {
      v4f kh = *(const v4f*)(s_kh + cg4), ww = *(const v4f*)(s_w + cg4), bb = *(const v4f*)(s_b + cg4), kt = *(const v4f*)(s_kt + cg4), rr = *(const v4f*)(s_r + cg4);
      v2f vv = *(const v2f*)(s_v + 2 * rp);
      float* ypw = s_yp + (2 * rp) * 4 + ((tid & 15) >> 2);
#pragma unroll 8
      for (int i = 0; i < 32; ++i) {
        const int in = (i + 1) & 31;
        const v4f kh_n = *(const v4f*)(s_kh + in * 64 + cg4);
        const v4f ww_n = *(const v4f*)(s_w + in * 64 + cg4);
        const v4f bb_n = *(const v4f*)(s_b + in * 64 + cg4);
        const v4f kt_n = *(const v4f*)(s_kt + in * 64 + cg4);
        const v4f rr_n = *(const v4f*)(s_r + in * 64 + cg4);
        const v2f vv_n = *(const v2f*)(s_v + in * 32 + 2 * rp);
        const v2f va = {vv.x, vv.x}, vb = {vv.y, vv.y};
        const v2f pa = __builtin_elementwise_fma(Ab, kh.zw, Aa * kh.xy), pb = __builtin_elementwise_fma(Bb, kh.zw, Ba * kh.xy);
        const float ska = red16(pa.x + pa.y), skb = red16(pb.x + pb.y);
        const v2f sa2 = {ska, ska}, sb2 = {skb, skb};
        Aa = __builtin_elementwise_fma(-sa2, bb.xy, __builtin_elementwise_fma(va, kt.xy, Aa * ww.xy));
        Ab = __builtin_elementwise_fma(-sa2, bb.zw, __builtin_elementwise_fma(va, kt.zw, Ab * ww.zw));
        Ba = __builtin_elementwise_fma(-sb2, bb.xy, __builtin_elementwise_fma(vb, kt.xy, Ba * ww.xy));
        Bb = __builtin_elementwise_fma(-sb2, bb.zw, __builtin_elementwise_fma(vb, kt.zw, Bb * ww.zw));
        const v2f qa = __builtin_elementwise_fma(Ab, rr.zw, Aa * rr.xy), qb = __builtin_elementwise_fma(Bb, rr.zw, Ba * rr.xy);
        const float ya = red4(qa.x + qa.y), yb = red4(qb.x + qb.y);
        if ((tid & 3) == 0) { ypw[i * 128] = ya; ypw[i * 128 + 4] = yb; }
        kh = kh_n; ww = ww_n; bb = bb_n; kt = kt_n; rr = rr_n; vv = vv_n;
      }
    }
    __syncthreads();
    {
      const int i = tid >> 3, r0 = (tid & 7) * 4;
      const int p = c * 32 + i; const int t = z ? (T - 1 - p) : p;
      const float* y0 = s_yp + i * 128 + r0 * 4;
      const float4 u0 = *(const float4*)y0, u1 = *(const float4*)(y0 + 4), u2 = *(const float4*)(y0 + 8), u3 = *(const float4*)(y0 + 12);
      uint2 o; o.x = pack2((u0.x + u0.y) + (u0.z + u0.w), (u1.x + u1.y) + (u1.z + u1.w)); o.y = pack2((u2.x + u2.y) + (u2.z + u2.w), (u3.x + u3.y) + (u3.z + u3.w));
      *(uint2*)(P.hdir + ((size_t)z * NTOK + gs + t) * DM + 768 + h * 64 + rb * 32 + r0) = o;
    }
  }
  if (!sample) {
    float* so = P.out + O_RWKV + ((size_t)((seq * 2 + l) * 2 + z) * 4 + h) * 4096 + irow * 64 + cg4;
    *(float4*)so = make_float4(Aa.x, Aa.y, Ab.x, Ab.y); *(float4*)(so + 64) = make_float4(Ba.x, Ba.y, Bb.x, Bb.y);
  }
#undef RP_PREFETCH
}

DEV void rwkv_sample_task(const Params& P, int l, int task, const int z, char* smem0, const int tid_all_in) {
  const int tid_all = opaque_i(tid_all_in);
  const int half = tid_all >> 8, tid = tid_all & 255;
  constexpr int NR = 8;
  const int chain = task >> 3, rb = task & 7;
  int seq, h; bool sample; decode_chain(chain, seq, h, sample);
  int gs, T; seq_base(seq, gs, T);
  const int nch = T / 32;
#define RS_BUF(B) ((float*)(smem0 + (B) * HALF_LDS))
  if (half == 1) {
    const int si = tid >> 3, sc = (tid & 7) * 8;
    float kkc[8], kac[8], rkc[8];
#pragma unroll
    for (int e = 0; e < 8; ++e) { kkc[e] = P.rwkv_kk[l * 256 + h * 64 + sc + e]; kac[e] = P.rwkv_ka[l * 256 + h * 64 + sc + e]; rkc[e] = P.rwkv_rk[(l * 4 + h) * 64 + sc + e]; }
    float4 pr0, pr1, pk0, pk1, pw0, pw1, pa0, pa1, pv_ = make_float4(0.f, 0.f, 0.f, 0.f); float pinv;
#define RS_PREFETCH(C) { \
      const int p_ = (C) * 32 + si; const int t_ = z ? (T - 1 - p_) : p_; const int g_ = gs + t_; \
      const float* rk_ = P.rkv + (size_t)g_ * 768 + h * 64 + sc; \
      pr0 = *(const float4*)rk_; pr1 = *(const float4*)(rk_ + 4); \
      pk0 = *(const float4*)(rk_ + 256); pk1 = *(const float4*)(rk_ + 260); \
      const float* wp_ = P.wa + ((size_t)(g_ * 2 + z) * 2) * 256 + h * 64 + sc; \
      pw0 = *(const float4*)wp_; pw1 = *(const float4*)(wp_ + 4); \
      pa0 = *(const float4*)(wp_ + 256); pa1 = *(const float4*)(wp_ + 260); \
      pinv = P.khinv[g_ * 4 + h]; \
      if (tid < 64) { \
        const int p2_ = (C) * 32 + (tid >> 1); const int t2_ = z ? (T - 1 - p2_) : p2_; \
        pv_ = *(const float4*)(P.rkv + (size_t)(gs + t2_) * 768 + 512 + h * 64 + rb * NR + (tid & 1) * 4); \
      } }
#define RS_STAGE(C) { \
      float* bf_ = RS_BUF((C) & 1); \
      float* s_kh = bf_; float* s_w = bf_ + 2048; float* s_b = bf_ + 4096; float* s_kt = bf_ + 6144; float* s_r = bf_ + 8192; float* s_v = bf_ + 10240; \
      const float rr[8] = {pr0.x, pr0.y, pr0.z, pr0.w, pr1.x, pr1.y, pr1.z, pr1.w}; \
      const float kk[8] = {pk0.x, pk0.y, pk0.z, pk0.w, pk1.x, pk1.y, pk1.z, pk1.w}; \
      const float aa[8] = {pa0.x, pa0.y, pa0.z, pa0.w, pa1.x, pa1.y, pa1.z, pa1.w}; \
      float bsum = 0.f; float okh[8], ob[8], okt[8]; \
      _Pragma("unroll") for (int e = 0; e < 8; ++e) { okh[e] = kk[e] * kkc[e] * pinv; ob[e] = aa[e] * okh[e]; okt[e] = kk[e] * (1.f + (aa[e] - 1.f) * kac[e]); bsum += rr[e] * okt[e] * rkc[e]; } \
      float* d_; \
      d_ = s_kh + si * 64 + sc; *(float4*)d_ = make_float4(okh[0], okh[1], okh[2], okh[3]); *(float4*)(d_ + 4) = make_float4(okh[4], okh[5], okh[6], okh[7]); \
      d_ = s_w + si * 64 + sc; *(float4*)d_ = pw0; *(float4*)(d_ + 4) = pw1; \
      d_ = s_b + si * 64 + sc; *(float4*)d_ = make_float4(ob[0], ob[1], ob[2], ob[3]); *(float4*)(d_ + 4) = make_float4(ob[4], ob[5], ob[6], ob[7]); \
      d_ = s_kt + si * 64 + sc; *(float4*)d_ = make_float4(okt[0], okt[1], okt[2], okt[3]); *(float4*)(d_ + 4) = make_float4(okt[4], okt[5], okt[6], okt[7]); \
      d_ = s_r + si * 64 + sc; *(float4*)d_ = pr0; *(float4*)(d_ + 4) = pr1; \
      if (tid < 64) *(float4*)(s_v + (tid >> 1) * NR + (tid & 1) * 4) = pv_; \
      bsum += dppf<0xB1>(bsum); bsum += dppf<0x4E>(bsum); bsum += dppf<0x141>(bsum); \
      if (rb == 0 && (tid & 7) == 0) { const int p_ = (C) * 32 + si; const int t_ = z ? (T - 1 - p_) : p_; P.bonus[((size_t)z * NTOK + gs + t_) * 4 + h] = bsum; } }
#define RS_OUT(C) { \
      const float* yp_ = RS_BUF((C) & 1) + 10240 + 256; \
      const int i_ = tid >> 3, q2_ = tid & 7; \
      const int p_ = (C) * 32 + i_; const int t_ = z ? (T - 1 - p_) : p_; \
      const float* y0_ = yp_ + i_ * 128 + q2_ * 16; \
      float a0_ = 0.f; \
      _Pragma("unroll") for (int e = 0; e < 16; e += 4) { const float4 u0_ = *(const float4*)(y0_ + e); a0_ += (u0_.x + u0_.y) + (u0_.z + u0_.w); } \
      P.hdir[((size_t)z * NTOK + gs + t_) * DM + 768 + h * 64 + rb * NR + q2_] = f2bf(a0_); }
    RS_PREFETCH(0)
    RS_STAGE(0)
    if (nch > 1) RS_PREFETCH(1)
    __syncthreads();
    for (int c = 0; c < nch; ++c) {
      if (c + 1 < nch) { RS_STAGE(c + 1) if (c + 2 < nch) RS_PREFETCH(c + 2) }
      if (c > 0) RS_OUT(c - 1)
      __syncthreads();
    }
    RS_OUT(nch - 1)
#undef RS_PREFETCH
#undef RS_STAGE
#undef RS_OUT
  } else {
    __builtin_amdgcn_s_setprio(3);
    const int rl = tid >> 4, cg4 = (tid & 15) * 4;
    const bool rowthread = tid < 128;
    typedef float v2f __attribute__((ext_vector_type(2)));
    typedef float v4f __attribute__((ext_vector_type(4)));
    v2f Sa = {0.f, 0.f}, Sb = {0.f, 0.f};
    if (sample && rowthread) {
      const float4 s4 = *(const float4*)(P.st_rwkv + ((size_t)(((seq - 16) * 2 + l) * 2 + z) * 4 + h) * 4096 + (rb * NR + rl) * 64 + cg4);
      Sa.x = s4.x; Sa.y = s4.y; Sb.x = s4.z; Sb.y = s4.w;
    }
    __syncthreads();
    for (int c = 0; c < nch; ++c) {
      if (rowthread) {
        const float* bf = RS_BUF(c & 1);
        const float* s_kh = bf; const float* s_w = bf + 2048; const float* s_b = bf + 4096; const float* s_kt = bf + 6144; const float* s_r = bf + 8192; const float* s_v = bf + 10240;
        float* s_yp = (float*)bf + 10240 + 256;
        v4f kh = *(const v4f*)(s_kh + cg4), ww = *(const v4f*)(s_w + cg4), bb = *(const v4f*)(s_b + cg4), kt = *(const v4f*)(s_kt + cg4), rr = *(const v4f*)(s_r + cg4);
        float vi = s_v[rl];
#pragma unroll 8
        for (int i = 0; i < 32; ++i) {
          const int in = (i + 1) & 31;
          const v4f kh_n = *(const v4f*)(s_kh + in * 64 + cg4);
          const v4f ww_n = *(const v4f*)(s_w + in * 64 + cg4);
          const v4f bb_n = *(const v4f*)(s_b + in * 64 + cg4);
          const v4f kt_n = *(const v4f*)(s_kt + in * 64 + cg4);
          const v4f rr_n = *(const v4f*)(s_r + in * 64 + cg4);
          const float vi_n = s_v[in * NR + rl];
          const v2f v2 = {vi, vi};
          const v2f pp = __builtin_elementwise_fma(Sb, kh.zw, Sa * kh.xy);
          const float sk = red16(pp.x + pp.y);
          const v2f sk2 = {sk, sk};
          Sa = __builtin_elementwise_fma(-sk2, bb.xy, __builtin_elementwise_fma(v2, kt.xy, Sa * ww.xy));
          Sb = __builtin_elementwise_fma(-sk2, bb.zw, __builtin_elementwise_fma(v2, kt.zw, Sb * ww.zw));
          const v2f qq = __builtin_elementwise_fma(Sb, rr.zw, Sa * rr.xy);
          s_yp[i * 128 + tid] = qq.x + qq.y;
          kh = kh_n; ww = ww_n; bb = bb_n; kt = kt_n; rr = rr_n; vi = vi_n;
        }
      }
      __syncthreads();
    }
  }
  __builtin_amdgcn_s_setprio(0);
#undef RS_BUF
}

DEV void phase_scan(const Params& P, int l, char* smem0, int ctr_idx, int cls) {
  __shared__ int4 s_task4;
  int& s_task = *(int*)&s_task4;
  const int ntask = 560;
  for (;;) {
    __syncthreads();
    if (threadIdx.x == 0) s_task = (int)atomicAdd(P.ctr + ctr_idx, 1u);
    __syncthreads();
    const int t = s_task;
    if (t >= ntask) break;
    const int tid_ = THREAD_ID; const int half = tid_ >> 8, tid = tid_ & 255;
    char* smem = smem0 + half * HALF_LDS;
    if (t < 128) { if (cls & 1) rwkv_sample_task(P, l, t >> 1, t & 1, smem0, tid_); }
    else if (t < 144) { if (cls & 2) delta_sample_task(P, l, (t - 128) >> 1, t & 1, smem0, tid_); }
    else if (t < 160) { if (cls & 4) mlstm_sample_task(P, l, (t - 144) >> 1, t & 1, smem0, tid_); }
    else if (t < 176) { if (cls & 8) ret_sample_task(P, l, (t - 160) >> 1, t & 1, smem0, tid_); }
    else if (t < 304) { if (cls & 1) rwkv_prompt_task(P, l, (t - 176) + 16, half, smem, tid); }
    else if (t < 368) { if (cls & 2) delta_task(P, l, (t - 304) + 8, half, smem, tid, true); }
    else if (t < 432) { if (cls & 4) mlstm_task(P, l, (t - 368) + 8, half, smem, tid, true); }
    else if (t < 560) { if (cls & 8) ret_sample_task(P, l, ((t - 432) >> 1) + 8, t & 1, smem0, tid_); }
    else { if (cls & 16) { if (l == 1) conv_ff_layer1_item(P, 2 * (t - 624) + half, smem, tid); else conv_inout_layer1_item(P, 2 * (t - 624) + half, smem, tid); } }
  }
}

DEV void phase_combine(const Params& P, int l) {
  const int tid_ = THREAD_ID;
  const int lane = tid_ & 63;
  const int wid = blockIdx.x * (NTHREADS / 64) + (tid_ >> 6), nw = gridDim.x * (NTHREADS / 64);
  const int c = lane * 4, head = lane >> 4;
  float4 gnorm[4];
  gnorm[0] = *(const float4*)(P.mlstm_norm + l * 256 + c); gnorm[1] = *(const float4*)(P.delta_norm + l * 256 + c);
  gnorm[2] = *(const float4*)(P.ret_norm + l * 256 + c); gnorm[3] = *(const float4*)(P.rwkv_norm + l * 256 + c);
  for (int g = wid; g < NTOK; g += nw) {
    uint2 h0[4], h1[4];
#pragma unroll
    for (int m = 0; m < 4; ++m) { h0[m] = *(const uint2*)(P.hdir + (size_t)g * DM + m * 256 + c); h1[m] = *(const uint2*)(P.hdir + ((size_t)NTOK + g) * DM + m * 256 + c); }
    const float* pj = P.projABC + (size_t)g * NABC + c;
    const float4 ga0 = *(const float4*)(pj + 768), ga1 = *(const float4*)(pj + 1808), ga2 = *(const float4*)(pj + 2848);
    const uint2 gg = *(const uint2*)(P.gbuf + (size_t)g * 256 + c);
    const float bn = P.bonus[(size_t)g * 4 + head] + P.bonus[((size_t)NTOK + g) * 4 + head];
    const float4 v4 = *(const float4*)(P.rkv + (size_t)g * 768 + 512 + c);
    uint2 ov[4];
#pragma unroll
    for (int m = 0; m < 4; ++m) {
      float y[4];
      y[0] = __uint_as_float(h0[m].x << 16) + __uint_as_float(h1[m].x << 16);
      y[1] = __uint_as_float(h0[m].x & 0xffff0000u) + __uint_as_float(h1[m].x & 0xffff0000u);
      y[2] = __uint_as_float(h0[m].y << 16) + __uint_as_float(h1[m].y << 16);
      y[3] = __uint_as_float(h0[m].y & 0xffff0000u) + __uint_as_float(h1[m].y & 0xffff0000u);
      if (m != 1) {
        const float mean = red16(y[0] + y[1] + y[2] + y[3]) * (1.f / 64.f);
#pragma unroll
        for (int e = 0; e < 4; ++e) y[e] -= mean;
      }
      const float var = red16(y[0] * y[0] + y[1] * y[1] + y[2] * y[2] + y[3] * y[3]) * (1.f / 64.f);
      const float rs = rsqrtf(var + LNEPS);
      const float4 g4 = gnorm[m];
      y[0] *= rs * g4.x; y[1] *= rs * g4.y; y[2] *= rs * g4.z; y[3] *= rs * g4.w;
      float o[4];
      if (m == 3) {
        const float gt[4] = {__uint_as_float(gg.x << 16), __uint_as_float(gg.x & 0xffff0000u), __uint_as_float(gg.y << 16), __uint_as_float(gg.y & 0xffff0000u)};
        o[0] = gt[0] * (y[0] + bn * v4.x); o[1] = gt[1] * (y[1] + bn * v4.y); o[2] = gt[2] * (y[2] + bn * v4.z); o[3] = gt[3] * (y[3] + bn * v4.w);
      } else {
        const float4 a4 = (m == 0) ? ga0 : (m == 1) ? ga1 : ga2;
        if (m == 0) { o[0] = sigmoidf_(a4.x) * y[0]; o[1] = sigmoidf_(a4.y) * y[1]; o[2] = sigmoidf_(a4.z) * y[2]; o[3] = sigmoidf_(a4.w) * y[3]; }
        else { o[0] = siluf_(a4.x) * y[0]; o[1] = siluf_(a4.y) * y[1]; o[2] = siluf_(a4.z) * y[2]; o[3] = siluf_(a4.w) * y[3]; }
      }
      ov[m].x = pack2(o[0], o[1]); ov[m].y = pack2(o[2], o[3]);
    }
#pragma unroll
    for (int m = 0; m < 4; ++m) *(uint2*)(P.ubuf + (size_t)g * DM + m * 256 + c) = ov[m];
  }
}

#define XB_TMO      128
#define XB_XCNT(j)  (256  + 64 * (j))
#define XB_XSUB(j)  (1280 + 64 * (j))
#define XB_XGEN(j)  (2304 + 64 * (j))
#define XB_TOP      3328
#define XB_TOPGEN   3392
#define XCD_BAR_WORDS 3456
#define XB_SPIN_CAP (1u << 18)
#define LAS __attribute__((address_space(3)))

__device__ __forceinline__ unsigned xb_ld(unsigned* p)              { return __hip_atomic_load(p, __ATOMIC_RELAXED, __HIP_MEMORY_SCOPE_AGENT); }
__device__ __forceinline__ unsigned xb_add(unsigned* p, unsigned v) { return __hip_atomic_fetch_add(p, v, __ATOMIC_RELAXED, __HIP_MEMORY_SCOPE_AGENT); }
__device__ __forceinline__ unsigned xb_xcc_id() { return (unsigned)__builtin_amdgcn_s_getreg((3 << 11) | 20) & 0xFu; }
#define XB_SPIN(cond, bar) do { unsigned _sp = 0; while (cond) { __builtin_amdgcn_s_sleep(1); \
    if ((++_sp & 255u) == 0u) { if (xb_ld(&(bar)[XB_TMO])) break; if (_sp > XB_SPIN_CAP) { atomicAdd(&(bar)[XB_TMO], 1u); break; } } } } while (0)

struct XcdBarrier {
    unsigned* bar; unsigned x;
    volatile LAS unsigned* st;
};

__device__ __forceinline__ XcdBarrier xcd_barrier_post(unsigned* bar, volatile LAS unsigned* st) {
    XcdBarrier b; b.bar = bar; b.x = xb_xcc_id(); b.st = st;
    if (threadIdx.x == 0) (void)xb_add(&bar[XB_XCNT(b.x)], 1u);
    return b;
}
__device__ __forceinline__ void xcd_barrier_complete(unsigned* bar, unsigned x, unsigned& nloc, unsigned& nx) {
    const unsigned G = gridDim.x * gridDim.y * gridDim.z;
    unsigned sum, cnt, mine, sp = 0u;
    for (;;) {
        sum = 0u; cnt = 0u; mine = 0u;
#pragma unroll
        for (unsigned j = 0; j < 16; ++j) { const unsigned c = xb_ld(&bar[XB_XCNT(j)]); sum += c; cnt += (c > 0u) ? 1u : 0u; mine = (j == x) ? c : mine; }
        if (sum == G) break;
        __builtin_amdgcn_s_sleep(1);
        if ((++sp & 255u) == 0u) { if (xb_ld(&bar[XB_TMO])) break; if (sp > XB_SPIN_CAP) { atomicAdd(&bar[XB_TMO], 1u); break; } }
    }
    nloc = mine > 0u ? mine : 1u; nx = cnt > 0u ? cnt : 1u;
}

__device__ __forceinline__ void xcd_barrier(const XcdBarrier& b) {
    asm volatile("s_waitcnt vmcnt(0)" ::: "memory");
    __syncthreads();
    if (threadIdx.x == 0) {
        unsigned* bar = b.bar;
        __builtin_amdgcn_s_waitcnt(0);
        unsigned nloc = b.st[0], nx = b.st[1];
        if (nloc == 0u) { xcd_barrier_complete(bar, b.x, nloc, nx); b.st[0] = nloc; b.st[1] = nx; }
        const unsigned old = xb_add(&bar[XB_XSUB(b.x)], 1u);
        const unsigned gen = old / nloc;
        if (old + 1u == (gen + 1u) * nloc) {
            __builtin_amdgcn_fence(__ATOMIC_RELEASE, "agent");
            asm volatile("s_waitcnt vmcnt(0)" ::: "memory");
            const unsigned og = xb_add(&bar[XB_TOP], 1u);
            const unsigned tg = og / nx;
            if (og + 1u == (tg + 1u) * nx) xb_add(&bar[XB_TOPGEN], 1u);
            else XB_SPIN(xb_ld(&bar[XB_TOPGEN]) == tg, bar);
            __builtin_amdgcn_fence(__ATOMIC_ACQUIRE, "agent");
            xb_add(&bar[XB_XGEN(b.x)], 1u);
            asm volatile("s_waitcnt vmcnt(0)" ::: "memory");
        } else {
            XB_SPIN(xb_ld(&bar[XB_XGEN(b.x)]) == gen, bar);
            __builtin_amdgcn_fence(__ATOMIC_ACQUIRE, "agent");
            asm volatile("s_waitcnt vmcnt(0)" ::: "memory");
        }
    }
    __syncthreads();
}

__global__ void __launch_bounds__(NTHREADS, 2) mega(Params P) {
  extern __shared__ __attribute__((aligned(16))) char smem[];
  cg::grid_group grid = cg::this_grid();
  __shared__ uint4 xb_words;
  if (threadIdx.x == 0) xb_words = make_uint4(0u, 0u, 0u, 0u);
  __syncthreads();
  XcdBarrier xb = xcd_barrier_post(P.bar, (volatile LAS unsigned*)&xb_words);
  for (int i = 0; i < PROBE_EXTRA_SYNCS; ++i) xcd_barrier(xb);
  for (int ph = (int)P.phase_lo; ph < (int)P.phase_hi; ++ph) {
   const int nrep = ((ph >= 2 && ((PROBE_DUP_MASK >> ((ph - 2) % 10)) & 1)) || (ph == 0 && PROBE_DUP_PRO)) ? 2 : 1;
   for (int rep = 0; rep < nrep; ++rep) {
    if (ph == 0) phase_prologue(P, smem, rep);
    else if (ph == 1) phase_ln(P, 0, 0);
    else {
      const int l = (ph - 2) / 10, s = (ph - 2) % 10;
      switch (s) {
        case 0: { EpiProj E; E.projABC = P.projABC; E.pdraw = P.pdraw; E.col0 = 0; phase_gemm(P.ubuf, P.wt_in + (size_t)l * PINP * DM, 4096, DM, E, smem); } break;
        case 1: { if (blockIdx.x < 32) { EpiProj E; E.projABC = P.projABC; E.pdraw = P.pdraw; E.col0 = 4096;
                    phase_gemm(P.ubuf, P.wt_in + (size_t)l * PINP * DM + (size_t)4096 * DM, 256, DM, E, smem, 0, 1 << 20, 32);
                    asm volatile("s_waitcnt vmcnt(0)" ::: "memory"); __syncthreads();
                    if (threadIdx.x == 0) { __threadfence(); atomicAdd(P.ctr + 16 + l * 2 + rep, 1u); } }
                  __shared__ int4 s_it4; int& s_it = *(int*)&s_it4;
                  for (;;) {
                    __syncthreads();
                    if (threadIdx.x == 0) s_it = (int)atomicAdd(P.ctr + 8 + l * 2 + rep, 1u);
                    __syncthreads();
                    const int it = s_it;
                    if (it >= 64 * 9) break;
                    const int tid_ = THREAD_ID; const int half = tid_ >> 8;
                    if (it < 64) rwkv_prep_item(P, l, 2 * it + half, 0, smem + half * HALF_LDS, tid_ & 255);
                    else if (it < 64 * 6) { const int j = it - 64; rwkv_prep_item(P, l, 2 * (j / 5) + half, 1 + j % 5, smem + half * HALF_LDS, tid_ & 255); }
                    else {
                      if (threadIdx.x == 0) { while (__hip_atomic_load(P.ctr + 16 + l * 2 + rep, __ATOMIC_RELAXED, __HIP_MEMORY_SCOPE_AGENT) < 32u) __builtin_amdgcn_s_sleep(2); }
                      __syncthreads();
                      const int j = it - 64 * 6; delta_prep_item(P, l, 2 * (j / 3) + half, j % 3, tid_ & 255); } } } break;
        case 2: { const int tid_ = THREAD_ID; const int half = tid_ >> 8;
                  for (int it = blockIdx.x; it < 512; it += gridDim.x) delta_T_item(P, l, 2 * it + half, smem + half * HALF_LDS, tid_ & 255); } break;
        case 3: phase_scan(P, l, smem, l + 2 * rep, rep == 0 ? 31 : PROBE_SCAN_CLASS); break;
        case 4: phase_combine(P, l); break;
        case 5: { EpiRes E; E.out = P.out; E.xp = (l == 0) ? P.x_prompt : P.out; E.xs = (l == 0) ? P.x_sample : P.out + (size_t)4096 * DM; E.gate = P.mod + (size_t)l * 3 * 6144 + 2048;
                  phase_gemm(P.ubuf, P.wt_out + (size_t)l * DM * DM, DM, DM, E, smem);
                  if (blockIdx.x >= 128) {
                    const int tid_ = THREAD_ID; const int half = tid_ >> 8, tid = tid_ & 255;
                    float* tile = (float*)(smem + half * HALF_LDS);
                    const int npair = (l == 1) ? 1024 : 672;
                    int j = blockIdx.x - 128;
                    ConvDesc d = deferred_conv_desc(P, l, 2 * j + half);
                    float4 a, b, c, e4; conv_tile_load(d, tid, a, b, c, e4);
                    while (j < npair) {
                      const int jn = j + 128;
                      ConvDesc dn = d; float4 an = a, bn = b, cn = c, en = e4;
                      if (jn < npair) { dn = deferred_conv_desc(P, l, 2 * jn + half); conv_tile_load(dn, tid, an, bn, cn, en); }
                      conv_tile_finish(d, tile, tid, a, b, c, e4);
                      d = dn; a = an; b = bn; c = cn; e4 = en; j = jn;
                    }
                  } } break;
        case 6: phase_ln(P, 1, l); break;
        case 7: { EpiFF1 E; E.hidden = P.hidden; phase_gemm(P.ubuf, P.wt_ff1, DFF, DM, E, smem); } break;
        case 8: { EpiResSplit E; E.out = P.out; E.tmp = P.ff2tmp; E.gate = P.mod + (size_t)l * 3 * 6144 + 5120;
                  phase_gemm(P.hidden, P.wt_ff2, 2 * DM, DFF / 2, E, smem, DFF, 4); } break;
        case 9: phase_ln(P, 2, l); break;
      }
    }
    if (ph + 1 < (int)P.phase_hi || rep + 1 < nrep) {
      if (P.phase_hi > 1000) grid.sync(); else xcd_barrier(xb);
    }
   }
  }
}

#ifndef MK_MULTI
#define MK_MULTI 0
#endif

extern "C" void kernel_launch(void* const* d_in, const int* in_sizes, int n_in, void* d_out, int out_size, void* d_ws, size_t ws_size, hipStream_t stream) {
  static int grid_blocks = 0;
  if (!grid_blocks) {
    int dev = 0, cus = 0, per_cu = 0;
    hipGetDevice(&dev);
    hipDeviceGetAttribute(&cus, hipDeviceAttributeMultiprocessorCount, dev);
    if (hipFuncSetAttribute((const void*)mega, hipFuncAttributeMaxDynamicSharedMemorySize, LDS_BYTES) != hipSuccess) fprintf(stderr, "hipFuncSetAttribute failed\n");
    hipOccupancyMaxActiveBlocksPerMultiprocessor(&per_cu, (const void*)mega, NTHREADS, LDS_BYTES);
    if (per_cu < 1) { fprintf(stderr, "occupancy query returned %d\n", per_cu); per_cu = 1; }
    if (per_cu > 1) per_cu = 1;
    grid_blocks = cus * per_cu;
    fprintf(stderr, "mega: cus %d per_cu %d grid %d ws %zu\n", cus, per_cu, grid_blocks, ws_size);
  }
  Params p{};
  const float** pin = (const float**)&p;
  for (int i = 0; i < 39; ++i) pin[i] = (const float*)d_in[i];
  p.out = (float*)d_out;
  char* ws = (char*)d_ws; size_t off = 0;
  auto take = [&](size_t bytes) { char* r = ws + off; off += (bytes + 255) & ~(size_t)255; return r; };
  p.ctr = (unsigned*)take(256);
  p.bar = (unsigned*)take(XCD_BAR_WORDS * 4);
  p.wt_in = (bf16_t*)take((size_t)2 * PINP * DM * 2);
  p.wt_out = (bf16_t*)take((size_t)2 * DM * DM * 2);
  p.wt_ff1 = (bf16_t*)take((size_t)DM * DFF * 2);
  p.wt_ff2 = (bf16_t*)take((size_t)DM * DFF * 2);
  p.ubuf = (bf16_t*)take((size_t)NTOK * DM * 2);
  p.projABC = (float*)take((size_t)NTOK * NABC * 4);
  p.hidden = (bf16_t*)p.projABC;
  p.ff2tmp = (float*)((char*)p.projABC + (size_t)NTOK * DFF * 2);
  p.pdraw = (float*)take((size_t)NTOK * NPD * 4);
  p.hdir = (bf16_t*)p.pdraw;
  p.rkv = (float*)take((size_t)NTOK * 768 * 4);
  p.wa = (float*)take((size_t)NTOK * 1024 * 4);
  p.gbuf = (bf16_t*)take((size_t)NTOK * 256 * 2);
  p.mod = (float*)take((size_t)2 * 3 * 6144 * 4);
  p.khinv = (float*)take((size_t)NTOK * 4 * 4);
  p.bonus = (float*)take((size_t)2 * NTOK * 4 * 4);
  p.dbeta = (float*)take((size_t)8 * NTOK * 4);
  p.dgc = (float*)take((size_t)8 * NTOK * 4);
  p.dT = (bf16_t*)take((size_t)1024 * 4096 * 2);
  p.w2t = (bf16_t*)take((size_t)4 * 256 * 64 * 2);
  p.a2t = (bf16_t*)take((size_t)4 * 256 * 64 * 2);
  p.g2t = (bf16_t*)take((size_t)2 * 256 * 128 * 2);
  if (off > ws_size) { fprintf(stderr, "workspace too small: need %zu have %zu\n", off, ws_size); return; }
  hipMemsetAsync(p.ctr, 0, 256 + ((XCD_BAR_WORDS * 4 + 255) & ~255), stream);
  const int nph = 2 + 10 * 2;
#if MK_MULTI
  for (int ph = 0; ph < nph; ++ph) {
    p.phase_lo = ph; p.phase_hi = ph + 1;
    void* args[] = {&p};
    hipLaunchCooperativeKernel((const void*)mega, dim3(grid_blocks), dim3(NTHREADS), args, LDS_BYTES, stream);
  }
#else
  p.phase_lo = 0; p.phase_hi = nph;
  void* args[] = {&p};
  hipError_t e = hipLaunchCooperativeKernel((const void*)mega, dim3(grid_blocks), dim3(NTHREADS), args, LDS_BYTES, stream);
  if (e != hipSuccess) fprintf(stderr, "cooperative launch failed: %s (grid %d)\n", hipGetErrorString(e), grid_blocks);
#endif
}
```
